# Optimizing an MI355X kernel written in HIP

```python
import math
import jax
import jax.numpy as jnp
from jax import lax
import numpy as np

D_MODEL = 1024
BATCH = 1
SEQ = 16384
DEPTH = 2

PLE_DIM = 256
ROPE_THETA = 10000.0
Q_BLOCK = 128
EPS = 1e-6
FOX_HEADS = 4
FOX_HD = 64
NSA_HEADS = 8
NSA_KV = 2
NSA_HD = 64
CMP_LEN = 32
CMP_STRIDE = 16
SLC_LEN = 64
SLC_TOPK = 16
WIN = 512
FORCE_BONUS = 1.0e4
DIFF_HEADS = 4
DIFF_QK = 32
DIFF_V = 64
PEER_HEADS = 8
PEER_NKEYS = 128
PEER_EXPERTS = PEER_NKEYS * PEER_NKEYS
PEER_DQ = 256
PEER_TOPK = 16
PEER_TOK_BLOCK = 128

IN_WIDTHS = (FOX_HEADS * FOX_HD, FOX_HEADS * FOX_HD, FOX_HEADS * FOX_HD, FOX_HEADS,
             NSA_HEADS * NSA_HD, NSA_KV * NSA_HD, NSA_KV * NSA_HD, NSA_KV * NSA_HD,
             NSA_KV * NSA_HD, NSA_KV * NSA_HD, NSA_KV * NSA_HD, 3 * NSA_HEADS,
             DIFF_HEADS * 2 * DIFF_QK, DIFF_HEADS * 2 * DIFF_QK, DIFF_HEADS * DIFF_V)
IN_WIDTH = sum(IN_WIDTHS)
MIX_WIDTH = FOX_HEADS * FOX_HD + NSA_HEADS * NSA_HD + DIFF_HEADS * DIFF_V

kernel_name = 'hymba_fox_nsa_diff_peer_trunk'


def rmsnorm(x, w):
    xf = x.astype(jnp.float32)
    y = xf * lax.rsqrt(jnp.mean(xf * xf, axis=-1, keepdims=True) + EPS)
    return (y * w.astype(jnp.float32)).astype(x.dtype)


def rope(x, pos):
    half = x.shape[-1] // 2
    inv_freq = ROPE_THETA ** (-jnp.arange(half, dtype=jnp.float32) / half)
    ang = pos.astype(jnp.float32)[..., None] * inv_freq
    cos = jnp.cos(ang)[:, :, None, :]
    sin = jnp.sin(ang)[:, :, None, :]
    xf = x.astype(jnp.float32)
    x1, x2 = xf[..., :half], xf[..., half:]
    return jnp.concatenate([x1 * cos - x2 * sin, x2 * cos + x1 * sin], axis=-1).astype(x.dtype)


def masked_softmax(s, mask):
    s = jnp.where(mask, s, -jnp.inf)
    m = jnp.max(s, axis=-1, keepdims=True)
    m = jnp.where(jnp.isfinite(m), m, 0.0)
    e = jnp.exp(s - m)
    den = jnp.sum(e, axis=-1, keepdims=True)
    return e / jnp.where(den > 0, den, 1.0)


def to_blocks(a, blk):
    b, s = a.shape[0], a.shape[1]
    return jnp.moveaxis(a.reshape((b, s // blk, blk) + a.shape[2:]), 1, 0)


def from_blocks(a):
    a = jnp.moveaxis(a, 0, 1)
    return a.reshape((a.shape[0], a.shape[1] * a.shape[2]) + a.shape[3:])


def split_proj(proj):
    idx = np.cumsum(np.array(IN_WIDTHS))[:-1].tolist()
    return jnp.split(proj, idx, axis=-1)


def fox_attention(q, k, v, f_logit):
    b, s, nh, hd = q.shape
    scale = hd ** -0.5
    c = jnp.cumsum(jax.nn.log_sigmoid(f_logit.astype(jnp.float32)), axis=1)
    c_keys = jnp.moveaxis(c, 1, 2)
    kpos = jnp.arange(s)

    def block(args):
        qb, cb, bi = args
        qpos = bi * Q_BLOCK + jnp.arange(Q_BLOCK)
        sc = jnp.einsum('bqhd,bkhd->bhqk', qb, k).astype(jnp.float32) * scale
        sc = sc + jnp.moveaxis(cb, 1, 2)[..., None] - c_keys[:, :, None, :]
        pr = masked_softmax(sc, kpos[None, :] <= qpos[:, None])
        return jnp.einsum('bhqk,bkhd->bqhd', pr.astype(v.dtype), v)

    out = lax.map(block, (to_blocks(q, Q_BLOCK), to_blocks(c, Q_BLOCK), jnp.arange(s // Q_BLOCK)))
    return from_blocks(out)


def nsa_compress(kv, pos_emb, w):
    b, s, g, hd = kv.shape
    n_cmp = (s - CMP_LEN) // CMP_STRIDE + 1
    idx = (jnp.arange(n_cmp) * CMP_STRIDE)[:, None] + jnp.arange(CMP_LEN)[None, :]
    blk = kv[:, idx] + pos_emb[:, None, :]
    blk = jnp.moveaxis(blk, 3, 2).reshape(b, n_cmp, g, CMP_LEN * hd)
    return blk @ w


def nsa_attention(q, kc, vc, ks, vs, kw, vw, gates, positions, q_norm_w, k_norm_w, cmp_pos, cmp_w):
    b, s, hq, hd = q.shape
    g = NSA_KV
    hpg = hq // g
    scale = hd ** -0.5
    qn = rmsnorm(q, q_norm_w)
    qr = rope(qn, positions)
    kc_c = rmsnorm(nsa_compress(kc, cmp_pos[0], cmp_w[0]), k_norm_w)
    vc_c = nsa_compress(vc, cmp_pos[1], cmp_w[1])
    ks_r = rope(rmsnorm(ks, k_norm_w), positions)
    kw_r = rope(rmsnorm(kw, k_norm_w), positions)
    n_cmp = kc_c.shape[1]
    ns = s // SLC_LEN
    n_sel = min(SLC_TOPK, ns)
    cmp_end = jnp.arange(n_cmp) * CMP_STRIDE + CMP_LEN - 1
    ci = jnp.arange(n_cmp)[:, None] * CMP_STRIDE
    sj = jnp.arange(ns)[None, :] * SLC_LEN
    overlap = ((ci < sj + SLC_LEN) & (ci + CMP_LEN > sj)).astype(jnp.float32)
    ks_g = jnp.moveaxis(ks_r.reshape(b, ns, SLC_LEN, g, hd), 3, 1)
    vs_g = jnp.moveaxis(vs.reshape(b, ns, SLC_LEN, g, hd), 3, 1)
    kw_p = jnp.pad(kw_r, ((0, 0), (WIN, 0), (0, 0), (0, 0)))
    vw_p = jnp.pad(vw, ((0, 0), (WIN, 0), (0, 0), (0, 0)))
    b_ix = jnp.arange(b)[:, None, None, None]
    g_ix = jnp.arange(g)[None, :, None, None]
    blk_ids = jnp.arange(ns)

    def block(args):
        qn_b, qr_b, g_b, bi = args
        qpos = bi * Q_BLOCK + jnp.arange(Q_BLOCK)
        qn_b = qn_b.reshape(b, Q_BLOCK, g, hpg, hd)
        qr_b = qr_b.reshape(b, Q_BLOCK, g, hpg, hd)
        s_c = jnp.einsum('bqghd,bngd->bghqn', qn_b, kc_c).astype(jnp.float32) * scale
        p_c = masked_softmax(s_c, cmp_end[None, :] <= qpos[:, None])
        o_c = jnp.einsum('bghqn,bngd->bqghd', p_c.astype(vc_c.dtype), vc_c)
        imp = jnp.einsum('bghqn,nm->bgqm', p_c, overlap)
        cur = qpos // SLC_LEN
        valid = blk_ids[None, :] * SLC_LEN <= qpos[:, None]
        forced = (blk_ids[None, :] == 0) | (blk_ids[None, :] == cur[:, None]) | (blk_ids[None, :] == cur[:, None] - 1)
        score = jnp.where(valid, imp + FORCE_BONUS * forced.astype(jnp.float32), -jnp.inf)
        _, sel = lax.top_k(score, n_sel)
        k_sel = ks_g[b_ix, g_ix, sel].reshape(b, g, Q_BLOCK, n_sel * SLC_LEN, hd)
        v_sel = vs_g[b_ix, g_ix, sel].reshape(b, g, Q_BLOCK, n_sel * SLC_LEN, hd)
        kpos_s = (sel[..., None] * SLC_LEN + jnp.arange(SLC_LEN)).reshape(b, g, Q_BLOCK, n_sel * SLC_LEN)
        mask_s = kpos_s <= qpos[None, None, :, None]
        s_s = jnp.einsum('bqghd,bgqkd->bghqk', qr_b, k_sel).astype(jnp.float32) * scale
        p_s = masked_softmax(s_s, mask_s[:, :, None])
        o_s = jnp.einsum('bghqk,bgqkd->bqghd', p_s.astype(v_sel.dtype), v_sel)
        k_w = lax.dynamic_slice_in_dim(kw_p, bi * Q_BLOCK, WIN + Q_BLOCK, axis=1)
        v_w = lax.dynamic_slice_in_dim(vw_p, bi * Q_BLOCK, WIN + Q_BLOCK, axis=1)
        kpos_w = bi * Q_BLOCK - WIN + jnp.arange(WIN + Q_BLOCK)
        dlt = qpos[:, None] - kpos_w[None, :]
        mask_w = (dlt >= 0) & (dlt < WIN) & (kpos_w[None, :] >= 0)
        s_w = jnp.einsum('bqghd,bkgd->bghqk', qr_b, k_w).astype(jnp.float32) * scale
        p_w = masked_softmax(s_w, mask_w)
        o_w = jnp.einsum('bghqk,bkgd->bqghd', p_w.astype(v_w.dtype), v_w)
        gt = jax.nn.sigmoid(g_b.astype(jnp.float32)).reshape(b, Q_BLOCK, g, hpg, 3).astype(o_c.dtype)
        out = gt[..., 0:1] * o_c + gt[..., 1:2] * o_s + gt[..., 2:3] * o_w
        return out.reshape(b, Q_BLOCK, hq, hd)

    out = lax.map(block, (to_blocks(qn, Q_BLOCK), to_blocks(qr, Q_BLOCK), to_blocks(gates, Q_BLOCK),
                          jnp.arange(s // Q_BLOCK)))
    return from_blocks(out)


def diff_lambda_init(layer):
    return 0.8 - 0.6 * math.exp(-0.3 * layer)


def diff_attention(q, k, v, positions, q_norm_w, k_norm_w, lam_vecs, subln_w, lambda_init):
    b, s = q.shape[0], q.shape[1]
    scale = DIFF_QK ** -0.5
    q = rope(rmsnorm(q.reshape(b, s, DIFF_HEADS * 2, DIFF_QK), q_norm_w), positions)
    k = rope(rmsnorm(k.reshape(b, s, DIFF_HEADS * 2, DIFF_QK), k_norm_w), positions)
    q = q.reshape(b, s, DIFF_HEADS, 2, DIFF_QK)
    k = k.reshape(b, s, DIFF_HEADS, 2, DIFF_QK)
    v = v.reshape(b, s, DIFF_HEADS, DIFF_V)
    lv = lam_vecs.astype(jnp.float32)
    lam = jnp.exp(jnp.sum(lv[0] * lv[1])) - jnp.exp(jnp.sum(lv[2] * lv[3])) + lambda_init
    kpos = jnp.arange(s)

    def block(args):
        qb, bi = args
        qpos = bi * Q_BLOCK + jnp.arange(Q_BLOCK)
        sc = jnp.einsum('bqhcd,bkhcd->bhcqk', qb, k).astype(jnp.float32) * scale
        pr = masked_softmax(sc, kpos[None, :] <= qpos[:, None])
        a = pr[:, :, 0] - lam * pr[:, :, 1]
        return jnp.einsum('bhqk,bkhd->bqhd', a.astype(v.dtype), v)

    o = from_blocks(lax.map(block, (to_blocks(q, Q_BLOCK), jnp.arange(s // Q_BLOCK))))
    return rmsnorm(o, subln_w) * (1.0 - lambda_init)


def peer_ffn(x, w_q, sub_keys, u, v):
    b, s, _ = x.shape
    q = (x @ w_q).reshape(b, s, PEER_HEADS, 2, PEER_DQ // 2)
    sc = jnp.einsum('bshcd,hcnd->bshcn', q, sub_keys).astype(jnp.float32)
    s1, i1 = lax.top_k(sc[..., 0, :], PEER_TOPK)
    s2, i2 = lax.top_k(sc[..., 1, :], PEER_TOPK)
    cand = (s1[..., :, None] + s2[..., None, :]).reshape(b, s, PEER_HEADS, PEER_TOPK * PEER_TOPK)
    cidx = (i1[..., :, None] * PEER_NKEYS + i2[..., None, :]).reshape(b, s, PEER_HEADS, PEER_TOPK * PEER_TOPK)
    top_s, pos = lax.top_k(cand, PEER_TOPK)
    eidx = jnp.take_along_axis(cidx, pos, axis=-1)
    gate = jax.nn.softmax(top_s, axis=-1)

    def block(args):
        xb, eb, gb = args
        hid = jax.nn.gelu(jnp.einsum('btd,bthkd->bthk', xb, u[eb]).astype(jnp.float32), approximate=False)
        w = (gb * hid).astype(x.dtype)
        return jnp.einsum('bthk,bthkd->btd', w, v[eb])

    out = lax.map(block, (to_blocks(x, PEER_TOK_BLOCK), to_blocks(eidx, PEER_TOK_BLOCK), to_blocks(gate, PEER_TOK_BLOCK)))
    return from_blocks(out)


def setup_inputs(seed: int = 0) -> dict:
    key = jax.random.key(seed)
    ks = iter(jax.random.split(key, 32))
    L = DEPTH
    D = D_MODEL

    def nrm(shape, scale):
        return jax.random.normal(next(ks), shape, jnp.float32) * scale

    return {
        'x': nrm((BATCH, SEQ, D), 1.0),
        'p': nrm((L, BATCH, SEQ, PLE_DIM), 1.0),
        'positions': jnp.broadcast_to(jnp.arange(SEQ, dtype=jnp.int32), (BATCH, SEQ)),
        'attn_norm_w': 1.0 + nrm((L, D), 0.02),
        'w_in': nrm((L, D, IN_WIDTH), D ** -0.5),
        'fox_f_bias': jnp.linspace(1.0, 6.0, FOX_HEADS, dtype=jnp.float32)[None, :] + nrm((L, FOX_HEADS), 0.1),
        'fox_q_norm_w': 1.0 + nrm((L, FOX_HD), 0.02),
        'fox_k_norm_w': 1.0 + nrm((L, FOX_HD), 0.02),
        'nsa_q_norm_w': 1.0 + nrm((L, NSA_HD), 0.02),
        'nsa_k_norm_w': 1.0 + nrm((L, NSA_HD), 0.02),
        'nsa_cmp_pos': nrm((L, 2, CMP_LEN, NSA_HD), 0.1),
        'nsa_cmp_w': nrm((L, 2, CMP_LEN * NSA_HD, NSA_HD), (CMP_LEN * NSA_HD) ** -0.5),
        'diff_q_norm_w': 1.0 + nrm((L, DIFF_QK), 0.02),
        'diff_k_norm_w': 1.0 + nrm((L, DIFF_QK), 0.02),
        'diff_lambda': nrm((L, 4, DIFF_QK), 0.1),
        'diff_subln_w': 1.0 + nrm((L, DIFF_V), 0.02),
        'w_out': nrm((L, MIX_WIDTH, D), MIX_WIDTH ** -0.5),
        'ffn_norm_w': 1.0 + nrm((L, D), 0.02),
        'peer_w_q': nrm((L, D, PEER_HEADS * PEER_DQ), D ** -0.5),
        'peer_sub_keys': nrm((L, PEER_HEADS, 2, PEER_NKEYS, PEER_DQ // 2), (PEER_DQ // 2) ** -0.5),
        'peer_u': nrm((L, PEER_EXPERTS, D), D ** -0.5),
        'peer_v': nrm((L, PEER_EXPERTS, D), PEER_TOPK ** -0.5),
        'ple_norm_w': 1.0 + nrm((L, D), 0.02),
        'ple_w_gate': nrm((L, D, D), D ** -0.5),
        'ple_w_proj': nrm((L, PLE_DIM, D), PLE_DIM ** -0.5),
    }


def reference(x, p, positions, attn_norm_w, w_in, fox_f_bias, fox_q_norm_w, fox_k_norm_w,
              nsa_q_norm_w, nsa_k_norm_w, nsa_cmp_pos, nsa_cmp_w, diff_q_norm_w, diff_k_norm_w,
              diff_lambda, diff_subln_w, w_out, ffn_norm_w, peer_w_q, peer_sub_keys, peer_u, peer_v,
              ple_norm_w, ple_w_gate, ple_w_proj):
    b, s, _ = x.shape
    h = x
    for i in range(DEPTH):
        a = rmsnorm(h, attn_norm_w[i])
        proj = a @ w_in[i]
        (fq, fk, fv, ff, nq, nkc, nvc, nks, nvs, nkw, nvw, ng, dq, dk, dv) = split_proj(proj)
        fq = rmsnorm(fq.reshape(b, s, FOX_HEADS, FOX_HD), fox_q_norm_w[i])
        fk = rmsnorm(fk.reshape(b, s, FOX_HEADS, FOX_HD), fox_k_norm_w[i])
        fv = fv.reshape(b, s, FOX_HEADS, FOX_HD)
        o_fox = fox_attention(fq, fk, fv, ff + fox_f_bias[i])
        kv_shape = (b, s, NSA_KV, NSA_HD)
        o_nsa = nsa_attention(nq.reshape(b, s, NSA_HEADS, NSA_HD), nkc.reshape(kv_shape), nvc.reshape(kv_shape),
                              nks.reshape(kv_shape), nvs.reshape(kv_shape), nkw.reshape(kv_shape), nvw.reshape(kv_shape),
                              ng.reshape(b, s, NSA_HEADS, 3), positions, nsa_q_norm_w[i], nsa_k_norm_w[i],
                              nsa_cmp_pos[i], nsa_cmp_w[i])
        o_diff = diff_attention(dq, dk, dv, positions, diff_q_norm_w[i], diff_k_norm_w[i], diff_lambda[i],
                                diff_subln_w[i], diff_lambda_init(i))
        mix = jnp.concatenate([o_fox.reshape(b, s, -1), o_nsa.reshape(b, s, -1), o_diff.reshape(b, s, -1)], axis=-1)
        h = h + mix @ w_out[i]
        h = h + peer_ffn(rmsnorm(h, ffn_norm_w[i]), peer_w_q[i], peer_sub_keys[i], peer_u[i], peer_v[i])
        gate = jax.nn.sigmoid((rmsnorm(h, ple_norm_w[i]) @ ple_w_gate[i]).astype(jnp.float32)).astype(h.dtype)
        h = h + gate * (p[i] @ ple_w_proj[i])
    return h
```

```cpp
#include <hip/hip_runtime.h>
#include <hip/hip_cooperative_groups.h>
#include <cstdio>
#include <cstdint>
#include <cstring>
namespace cg = cooperative_groups;

typedef __attribute__((ext_vector_type(8))) short bf16x8;
typedef __attribute__((ext_vector_type(4))) short bf16x4;
typedef __attribute__((ext_vector_type(16))) float f32x16;
typedef __attribute__((ext_vector_type(4))) float f32x4;
typedef __attribute__((ext_vector_type(2))) float f32x2;
typedef __attribute__((ext_vector_type(2))) __bf16 bf2_t;
typedef unsigned short u16;
typedef unsigned int u32;
typedef __attribute__((ext_vector_type(4))) unsigned int u32x4;
typedef __attribute__((ext_vector_type(2))) unsigned int u32x2;

#define DI __device__ __forceinline__
#define MFMA32(a, b, c) __builtin_amdgcn_mfma_f32_32x32x16_bf16((a), (b), (c), 0, 0, 0)
#define MFMA16(a, b, c) __builtin_amdgcn_mfma_f32_16x16x32_bf16((a), (b), (c), 0, 0, 0)

constexpr int S = 16384;
constexpr int D = 1024;
constexpr int NT = 256;
constexpr int NIN = 2844;
constexpr int NINP = 2944;
constexpr int SMEM_BYTES = 72704;
constexpr float LOG2E = 1.4426950408889634f;
#ifndef ABLATE
#define ABLATE 0
#endif

struct Params {
  const float* x; const float* p; const int* positions;
  const float* attn_norm_w; const float* w_in; const float* fox_f_bias; const float* fox_q_norm_w; const float* fox_k_norm_w;
  const float* nsa_q_norm_w; const float* nsa_k_norm_w; const float* nsa_cmp_pos; const float* nsa_cmp_w;
  const float* diff_q_norm_w; const float* diff_k_norm_w; const float* diff_lambda; const float* diff_subln_w;
  const float* w_out; const float* ffn_norm_w; const float* peer_w_q; const float* peer_sub_keys; const float* peer_u; const float* peer_v;
  const float* ple_norm_w; const float* ple_w_gate; const float* ple_w_proj;
  float* out;
  u16* WinT;
  u16* WoutT;
  u16* WqT;
  u16* WgT;
  u16* WpT;
  u16* SubK;
  u16* CmpWT;
  float* cmpbias;
  unsigned char* U8;
  unsigned char* V8;
  float* Uinv; float* Vinv;
  u16* hb;
  u16* hb2;
  u16* pb;
  float* ropeN;
  float* ropeD;
  u16* QF; u16* KF; u16* VFt;
  float* cloc; float* ctot;
  u16* QN; u16* QR;
  u16* KC; u16* VC;
  u16* KCC; u16* VCCt;
  unsigned char* KS8; unsigned char* VS8t;
  u16* KW; u16* VWt;
  float* gates;
  u16* QD; u16* KD; u16* VDt;
  u16* mix;
  float* dstash;
  float* impA; float* impB;
  u32* topk;
  int phase_lo, phase_hi;
  int rep_ph, rep_n, rep_sec, rep_nsa_only;
};

DI u32x4 mk4(u32 a, u32 b, u32 c, u32 d) { return (u32x4){a, b, c, d}; }
DI u32x2 mk2(u32 a, u32 b) { return (u32x2){a, b}; }
DI u32 pack2(float a, float b) { f32x2 v = {a, b}; bf2_t r = __builtin_convertvector(v, bf2_t); return __builtin_bit_cast(u32, r); }
DI u16 f2bf(float a) { return (u16)(pack2(a, 0.f) & 0xffffu); }
DI float bf2f(u16 x) { return __uint_as_float(((u32)x) << 16); }
DI float bflo(u32 x) { return __uint_as_float(x << 16); }
DI float bfhi(u32 x) { return __uint_as_float(x & 0xffff0000u); }
DI int opaque_tid() { int t = threadIdx.x; asm volatile("" : "+v"(t)); return t; }
DI int crow(int reg, int h) { return (reg & 3) + 8 * (reg >> 2) + 4 * h; }
DI float wave_sum(float v) {
#pragma unroll
  for (int o = 32; o > 0; o >>= 1) v += __shfl_xor(v, o);
  return v;
}
DI float wave_max(float v) {
#pragma unroll
  for (int o = 32; o > 0; o >>= 1) v = fmaxf(v, __shfl_xor(v, o));
  return v;
}

DI int inproj_old_col(int j) {
  if (j < 768) return j;
  if (j < 2048) return j + 4;
  if (j < 2816) return j + 28;
  if (j < 2820) return j - 2048;
  if (j < 2844) return j - 768;
  return -1;
}
DI void transpose_tile(const float* __restrict__ src, int ldsrc, u16* __restrict__ dst, int K, const float* __restrict__ scale,
                       int n0, int k0, int mode, int nvalid, float* tile) {
  const int t = threadIdx.x;
  const int nn = t & 63, kq = t >> 6;
  int col = n0 + nn;
  if (mode == 1) col = inproj_old_col(col); else if (col >= nvalid) col = -1;
  float v[16];
#pragma unroll
  for (int i = 0; i < 16; ++i) v[i] = (col >= 0) ? src[(size_t)(k0 + kq + 4 * i) * ldsrc + col] : 0.f;
  if (scale) {
#pragma unroll
    for (int i = 0; i < 16; ++i) v[i] *= scale[k0 + kq + 4 * i];
  }
#pragma unroll
  for (int i = 0; i < 16; ++i) tile[(kq + 4 * i) * 65 + nn] = v[i];
  __syncthreads();
  const int n2 = t >> 2, kc = (t & 3) * 16;
  u32 o[8];
#pragma unroll
  for (int i = 0; i < 8; ++i) o[i] = pack2(tile[(kc + 2 * i) * 65 + n2], tile[(kc + 2 * i + 1) * 65 + n2]);
  u32x4* dp = (u32x4*)(dst + (size_t)(n0 + n2) * K + k0 + kc);
  dp[0] = mk4(o[0], o[1], o[2], o[3]);
  dp[1] = mk4(o[4], o[5], o[6], o[7]);
  __syncthreads();
}

DI void convert_rows(const float* __restrict__ src, u16* __restrict__ dst, size_t n8, float* __restrict__ copy) {
  const size_t stride = (size_t)gridDim.x * NT;
  for (size_t i0 = (size_t)blockIdx.x * NT + threadIdx.x; i0 < n8; i0 += 4 * stride) {
    f32x4 a[4], b[4];
#pragma unroll
    for (int u = 0; u < 4; ++u) {
      const size_t i = i0 + u * stride;
      if (i < n8) { a[u] = ((const f32x4*)src)[2 * i]; b[u] = ((const f32x4*)src)[2 * i + 1]; }
    }
#pragma unroll
    for (int u = 0; u < 4; ++u) {
      const size_t i = i0 + u * stride;
      if (i < n8) {
        if (copy) { ((f32x4*)copy)[2 * i] = a[u]; ((f32x4*)copy)[2 * i + 1] = b[u]; }
        ((u32x4*)dst)[i] = mk4(pack2(a[u][0], a[u][1]), pack2(a[u][2], a[u][3]), pack2(b[u][0], b[u][1]), pack2(b[u][2], b[u][3]));
      }
    }
  }
}

__device__ void phase_prep(const Params& P, char* smem) {
  float* tile = (float*)smem;
  const int bid = blockIdx.x, nb = gridDim.x, t = threadIdx.x;
  for (int it0 = bid; it0 < 2 * 1952; it0 += nb) {
    const int l = it0 / 1952;
    int it = it0 % 1952;
    if (it < 736) { transpose_tile(P.w_in + (size_t)l * D * NIN, NIN, P.WinT + (size_t)l * NINP * D, D, P.attn_norm_w + l * D, (it >> 4) * 64, (it & 15) * 64, 1, 0, tile); continue; }
    it -= 736;
    if (it < 256) { transpose_tile(P.w_out + (size_t)l * D * D, D, P.WoutT + (size_t)l * D * D, D, nullptr, (it >> 4) * 64, (it & 15) * 64, 0, D, tile); continue; }
    it -= 256;
    if (it < 512) { transpose_tile(P.peer_w_q + (size_t)l * D * 2048, 2048, P.WqT + (size_t)l * 2048 * D, D, P.ffn_norm_w + l * D, (it >> 4) * 64, (it & 15) * 64, 0, 2048, tile); continue; }
    it -= 512;
    if (it < 256) { transpose_tile(P.ple_w_gate + (size_t)l * D * D, D, P.WgT + (size_t)l * D * D, D, P.ple_norm_w + l * D, (it >> 4) * 64, (it & 15) * 64, 0, D, tile); continue; }
    it -= 256;
    if (it < 64) { transpose_tile(P.ple_w_proj + (size_t)l * 256 * D, D, P.WpT + (size_t)l * D * 256, 256, nullptr, (it >> 2) * 64, (it & 3) * 64, 0, D, tile); continue; }
    it -= 64;
    { const int kv = it >> 6, i2 = it & 63;
      transpose_tile(P.nsa_cmp_w + (size_t)(l * 2 + kv) * 2048 * 64, 64, P.CmpWT + (size_t)(l * 2 + kv) * 128 * 2048, 2048, nullptr, (i2 >> 5) * 64, (i2 & 31) * 64, 0, 64, tile); }
  }
  convert_rows(P.peer_sub_keys, P.SubK, (size_t)2 * 16 * 128 * 128 / 8, nullptr);
  {
    const int lane = t & 63, gw = bid * 4 + (t >> 6), ngw = nb * 4;
    for (int r = gw; r < 4 * S; r += ngw) {
      const int tbl = r / (2 * S), l = (r / S) & 1, e = r % S;
      const float* src = (tbl ? P.peer_v : P.peer_u) + ((size_t)l * S + e) * D + lane * 16;
      float v[16];
#pragma unroll
      for (int i = 0; i < 4; ++i) { const f32x4 q4 = ((const f32x4*)src)[i]; v[4 * i] = q4[0]; v[4 * i + 1] = q4[1]; v[4 * i + 2] = q4[2]; v[4 * i + 3] = q4[3]; }
      if (tbl == 0) {
        const float* w = P.ffn_norm_w + l * D + lane * 16;
#pragma unroll
        for (int i = 0; i < 16; ++i) v[i] *= w[i];
      }
      float m = 0.f;
#pragma unroll
      for (int i = 0; i < 16; ++i) m = fmaxf(m, fabsf(v[i]));
      m = wave_max(m);
      const float sc = (m > 0.f) ? 240.f / m : 0.f;
      u32 o[4];
#pragma unroll
      for (int i = 0; i < 4; ++i) {
        int wd = 0;
        wd = __builtin_amdgcn_cvt_pk_fp8_f32(v[4 * i] * sc, v[4 * i + 1] * sc, wd, false);
        wd = __builtin_amdgcn_cvt_pk_fp8_f32(v[4 * i + 2] * sc, v[4 * i + 3] * sc, wd, true);
        o[i] = (u32)wd;
      }
      unsigned char* dst = (tbl ? P.V8 : P.U8) + ((size_t)l * S + e) * D + lane * 16;
      *(u32x4*)dst = mk4(o[0], o[1], o[2], o[3]);
      if (lane == 0) (tbl ? P.Vinv : P.Uinv)[l * S + e] = m * (1.f / 240.f);
    }
  }
  convert_rows(P.p, P.pb, (size_t)2 * S * 256 / 8, nullptr);
  convert_rows(P.x, P.hb, (size_t)S * D / 8, P.out);
  const size_t gtid = (size_t)bid * NT + t, gstride = (size_t)nb * NT;
  __syncthreads();
  if (t < 48) tile[t] = (t < 32) ? powf(10000.f, -(float)t / 32.f) : powf(10000.f, -(float)(t - 32) / 16.f);
  __syncthreads();
  for (size_t i = gtid; i < (size_t)S * 48; i += gstride) {
    const int tok = (int)(i / 48), r = (int)(i % 48);
    const float pos = (float)P.positions[tok];
    const float invf = tile[r];
    const float ang = pos * invf;
    const double rev = (double)ang * 0.15915494309189535;
    const float fr = (float)(rev - floor(rev));
    const float c = __builtin_amdgcn_cosf(fr), s = __builtin_amdgcn_sinf(fr);
    if (r < 32) { P.ropeN[(size_t)tok * 64 + r] = c; P.ropeN[(size_t)tok * 64 + 32 + r] = s; }
    else { P.ropeD[(size_t)tok * 32 + (r - 32)] = c; P.ropeD[(size_t)tok * 32 + 16 + (r - 32)] = s; }
  }
  {
    const int lane = t & 63, gw = bid * 4 + (t >> 6), ngw = nb * 4;
    for (int i = gw; i < 2 * 2 * 64; i += ngw) {
      const int lk = i >> 6, e = i & 63;
      const float* pos = P.nsa_cmp_pos + (size_t)lk * 2048;
      const float* w = P.nsa_cmp_w + (size_t)lk * 2048 * 64;
      float a = 0.f;
#pragma unroll 8
      for (int k = lane; k < 2048; k += 64) a += pos[k] * w[(size_t)k * 64 + e];
      a = wave_sum(a);
      if (lane == 0) P.cmpbias[i] = a;
    }
  }
  for (size_t i = gtid; i < 2 * 2 * 64 * 64; i += gstride) {
    const int which = (int)(i / (2 * 64 * 64)), r = (int)(i % (2 * 64 * 64));
    const int g = r / (64 * 64), o = r % (64 * 64);
    u16* base = which ? P.VC : P.KC;
    base[(size_t)g * (S + 64) * 64 + (size_t)S * 64 + o] = 0;
  }
}

constexpr int GST = 144;
constexpr int G_BOFF = 128 * GST;
constexpr int G_RS_OFF = 71680;

DI float ssq8(const u32x4& v) {
  float s = 0.f;
  float a;
  a = bflo(v.x); s += a * a; a = bfhi(v.x); s += a * a;
  a = bflo(v.y); s += a * a; a = bfhi(v.y); s += a * a;
  a = bflo(v.z); s += a * a; a = bfhi(v.z); s += a * a;
  a = bflo(v.w); s += a * a; a = bfhi(v.w); s += a * a;
  return s;
}

template <bool SSQ>
DI void gemm_mainloop(const u16* __restrict__ A, int lda, const u16* __restrict__ Bt, int ldb, int K, char* sm, f32x16 (&acc)[2][2]) {
  const int tid = threadIdx.x, lane = tid & 63, wave = tid >> 6;
  const int wr = wave >> 1, wc = wave & 1;
  const int lrow = tid >> 3, lcol = (tid & 7) * 8;
  char* As = sm; char* Bs = sm + G_BOFF;
  u32x4 ra[4], rb[4];
  float ssq[4] = {0.f, 0.f, 0.f, 0.f};
#pragma unroll
  for (int i = 0; i < 4; ++i) {
    ra[i] = *(const u32x4*)(A + (size_t)(lrow + 32 * i) * lda + lcol);
    rb[i] = *(const u32x4*)(Bt + (size_t)(lrow + 32 * i) * ldb + lcol);
  }
  const int aoff = (wr * 64 + (lane & 31)) * GST + (lane >> 5) * 16;
  const int boff = (wc * 64 + (lane & 31)) * GST + (lane >> 5) * 16;
  for (int k0 = 0; k0 < K; k0 += 64) {
    __syncthreads();
#pragma unroll
    for (int i = 0; i < 4; ++i) {
      *(u32x4*)(As + (lrow + 32 * i) * GST + lcol * 2) = ra[i];
      *(u32x4*)(Bs + (lrow + 32 * i) * GST + lcol * 2) = rb[i];
      if (SSQ) ssq[i] += ssq8(ra[i]);
    }
    __syncthreads();
    if (k0 + 64 < K) {
#pragma unroll
      for (int i = 0; i < 4; ++i) {
        ra[i] = *(const u32x4*)(A + (size_t)(lrow + 32 * i) * lda + k0 + 64 + lcol);
        rb[i] = *(const u32x4*)(Bt + (size_t)(lrow + 32 * i) * ldb + k0 + 64 + lcol);
      }
    }
#pragma unroll
    for (int ks = 0; ks < 4; ++ks) {
      bf16x8 af[2], bfr[2];
#pragma unroll
      for (int i = 0; i < 2; ++i) af[i] = *(const bf16x8*)(As + aoff + i * 32 * GST + ks * 32);
#pragma unroll
      for (int j = 0; j < 2; ++j) bfr[j] = *(const bf16x8*)(Bs + boff + j * 32 * GST + ks * 32);
#pragma unroll
      for (int i = 0; i < 2; ++i)
#pragma unroll
        for (int j = 0; j < 2; ++j) acc[i][j] = MFMA32(af[i], bfr[j], acc[i][j]);
    }
  }
  __syncthreads();
  if (SSQ) {
    float* rs = (float*)(sm + G_RS_OFF);
#pragma unroll
    for (int i = 0; i < 4; ++i) {
      float s = ssq[i];
      s += __shfl_xor(s, 1); s += __shfl_xor(s, 2); s += __shfl_xor(s, 4);
      if ((tid & 7) == 0) rs[lrow + 32 * i] = rsqrtf(s * (1.f / (float)K) + 1e-6f);
    }
  }
}

DI void zero_acc(f32x16 (&acc)[2][2]) {
#pragma unroll
  for (int i = 0; i < 2; ++i)
#pragma unroll
    for (int j = 0; j < 2; ++j)
#pragma unroll
      for (int r = 0; r < 16; ++r) acc[i][j][r] = 0.f;
}

constexpr int EPS_LD = 132;
DI void acc_to_lds(const f32x16 (&acc)[2][2], float* tile) {
  const int lane = threadIdx.x & 63, wave = threadIdx.x >> 6;
  const int wr = wave >> 1, wc = wave & 1;
#pragma unroll
  for (int i = 0; i < 2; ++i)
#pragma unroll
    for (int j = 0; j < 2; ++j)
#pragma unroll
      for (int r = 0; r < 16; ++r)
        tile[(wr * 64 + i * 32 + crow(r, lane >> 5)) * EPS_LD + wc * 64 + j * 32 + (lane & 31)] = acc[i][j][r];
}

DI float log_sigmoid(float x) { return fminf(x, 0.f) - log1pf(expf(-fabsf(x))); }
DI float sigmoidf_(float x) { return 1.f / (1.f + expf(-x)); }

DI void store32_bf16(u16* dst, const float* o) {
  u32x4* d4 = (u32x4*)dst;
#pragma unroll
  for (int i = 0; i < 4; ++i)
    d4[i] = mk4(pack2(o[8 * i], o[8 * i + 1]), pack2(o[8 * i + 2], o[8 * i + 3]), pack2(o[8 * i + 4], o[8 * i + 5]), pack2(o[8 * i + 6], o[8 * i + 7]));
}

__device__ void inproj_epilogue_half(const Params& P, int l, int mt, int nt, int half, const float* tile, const float* rs) {
  const int tid = threadIdx.x, lane = tid & 63, wave = tid >> 6;
  const int hl = wave >> 1, h32 = wave & 1;
  const int sg = 2 * nt + hl;
  const int rloc = half * 64 + lane;
  const int tok = mt * 128 + rloc;
  const float rstd = rs[rloc];
  if (sg >= 45) return;
  float v[64];
  {
    const f32x4* src = (const f32x4*)(tile + rloc * EPS_LD + hl * 64);
#pragma unroll
    for (int i = 0; i < 16; ++i) { f32x4 t = src[i]; v[4 * i] = t[0] * rstd; v[4 * i + 1] = t[1] * rstd; v[4 * i + 2] = t[2] * rstd; v[4 * i + 3] = t[3] * rstd; }
  }
  const u32 hmask = (u32)(-(int)h32);
#define VO(i) __uint_as_float((__float_as_uint(v[32 + (i)]) & hmask) | (__float_as_uint(v[(i)]) & ~hmask))
  if (sg == 44) {
    if (h32 == 0) {
      const int chunk = tok >> 6;
#pragma unroll
      for (int hd = 0; hd < 4; ++hd) {
        float x = log_sigmoid(v[hd] + P.fox_f_bias[l * 4 + hd]);
#pragma unroll
        for (int o = 1; o < 64; o <<= 1) { float t = __shfl_up(x, o); if (lane >= o) x += t; }
        P.cloc[(size_t)hd * S + tok] = x;
        if (lane == 63) P.ctot[chunk * 4 + hd] = x;
      }
    } else {
      float* g = P.gates + (size_t)tok * 24;
#pragma unroll
      for (int i = 0; i < 24; ++i) g[i] = sigmoidf_(v[4 + i]);
    }
    return;
  }
  float o[32];
  const bool is_vt = (sg >= 8 && sg < 12) || (sg == 26 || sg == 27) || (sg == 30 || sg == 31) || (sg >= 40);
  const bool is_raw = (sg >= 20 && sg < 24);
  const bool is_diff = (sg >= 32 && sg < 40);
  if (is_vt) {
    if (sg == 26 || sg == 27) {
      const int key = tok & 63, G = key >> 5, h4 = (key & 31) >> 3, j = key & 7;
      unsigned char* b8 = P.VS8t + (size_t)(sg - 26) * 64 * S + (size_t)(tok >> 6) * 4096 + G * 2048 + h4 * 128 + j;
#pragma unroll
      for (int i = 0; i < 32; i += 2) {
        const int wd = __builtin_amdgcn_cvt_pk_fp8_f32(VO(i), VO(i + 1), 0, false);
        const int d0 = h32 * 32 + i, d1 = d0 + 1;
        b8[(d0 >> 4) * 512 + (d0 & 15) * 8] = (unsigned char)(wd & 0xff);
        b8[(d1 >> 4) * 512 + (d1 & 15) * 8] = (unsigned char)((wd >> 8) & 0xff);
      }
      return;
    }
    u16* base;
    if (sg < 12) base = P.VFt + (size_t)(sg - 8) * 64 * S;
    else if (sg < 32) base = P.VWt + (size_t)(sg - 30) * 64 * S;
    else base = P.VDt + (size_t)(sg - 40) * 64 * S;
#pragma unroll
    for (int i = 0; i < 32; ++i) base[(size_t)(h32 * 32 + i) * S + tok] = f2bf(VO(i));
    return;
  }
  if (is_raw) {
    u16* base = (sg < 22) ? P.KC + (size_t)(sg - 20) * (S + 64) * 64 : P.VC + (size_t)(sg - 22) * (S + 64) * 64;
#pragma unroll
    for (int i = 0; i < 32; ++i) o[i] = VO(i);
    store32_bf16(base + (size_t)tok * 64 + h32 * 32, o);
    return;
  }
  if (is_diff) {
    const float* w = (sg < 36 ? P.diff_q_norm_w : P.diff_k_norm_w) + l * 32;
    float ss = 0.f;
#pragma unroll
    for (int i = 0; i < 32; ++i) ss += VO(i) * VO(i);
    const float rn = rsqrtf(ss * (1.f / 32.f) + 1e-6f);
    const float sc = (sg < 36) ? 0.17677669529663687f * LOG2E : 1.f;
    const float* rp = P.ropeD + (size_t)tok * 32;
#pragma unroll
    for (int i = 0; i < 16; ++i) {
      const float y1 = VO(i) * rn * w[i], y2 = VO(16 + i) * rn * w[16 + i];
      const float c = rp[i], s = rp[16 + i];
      o[i] = (y1 * c - y2 * s) * sc;
      o[16 + i] = (y2 * c + y1 * s) * sc;
    }
    u16* base = (sg < 36) ? P.QD + (size_t)(sg - 32) * S * 64 : P.KD + (size_t)(sg - 36) * S * 64;
    store32_bf16(base + (size_t)tok * 64 + h32 * 32, o);
    return;
  }
  const float* w;
  if (sg < 4) w = P.fox_q_norm_w + l * 64; else if (sg < 8) w = P.fox_k_norm_w + l * 64; else if (sg < 20) w = P.nsa_q_norm_w + l * 64; else w = P.nsa_k_norm_w + l * 64;
  float ss = 0.f;
#pragma unroll
  for (int i = 0; i < 64; ++i) ss += v[i] * v[i];
  const float rn = rsqrtf(ss * (1.f / 64.f) + 1e-6f);
  const float qs = 0.125f * LOG2E;
  if (sg < 8) {
    const float sc = (sg < 4) ? qs : 1.f;
#pragma unroll
    for (int i = 0; i < 32; ++i) o[i] = VO(i) * rn * w[h32 * 32 + i] * sc;
    u16* base = (sg < 4) ? P.QF + (size_t)sg * S * 64 : P.KF + (size_t)(sg - 4) * S * 64;
    store32_bf16(base + (size_t)tok * 64 + h32 * 32, o);
    return;
  }
  const float* rp = P.ropeN + (size_t)tok * 64;
  const float sc = (sg < 20) ? qs : 1.f;
  if (sg < 20) {
#pragma unroll
    for (int i = 0; i < 32; ++i) o[i] = VO(i) * rn * w[h32 * 32 + i] * sc;
    store32_bf16(P.QN + ((size_t)(sg - 12) * S + tok) * 64 + h32 * 32, o);
  }
#pragma unroll
  for (int i = 0; i < 32; ++i) {
    const float y1 = v[i] * rn * w[i], y2 = v[32 + i] * rn * w[32 + i];
    const float c = rp[i], s = rp[32 + i];
    o[i] = (h32 == 0 ? (y1 * c - y2 * s) : (y2 * c + y1 * s)) * sc;
  }
  if (sg == 24 || sg == 25) {
    const int key = tok & 63, G = key >> 5, r32 = key & 31, t = (r32 >> 2) & 1, i = ((r32 >> 3) << 2) | (r32 & 3);
    unsigned char* d8 = P.KS8 + (size_t)(sg - 24) * S * 64 + (size_t)(tok >> 6) * 4096 + ((G * 2 + t) * 2 + h32) * 512 + i * 8;
#pragma unroll
    for (int h4 = 0; h4 < 4; ++h4) {
      int w0 = 0, w1 = 0;
      w0 = __builtin_amdgcn_cvt_pk_fp8_f32(o[8 * h4], o[8 * h4 + 1], w0, false);
      w0 = __builtin_amdgcn_cvt_pk_fp8_f32(o[8 * h4 + 2], o[8 * h4 + 3], w0, true);
      w1 = __builtin_amdgcn_cvt_pk_fp8_f32(o[8 * h4 + 4], o[8 * h4 + 5], w1, false);
      w1 = __builtin_amdgcn_cvt_pk_fp8_f32(o[8 * h4 + 6], o[8 * h4 + 7], w1, true);
      *(u32x2*)(d8 + h4 * 128) = mk2((u32)w0, (u32)w1);
    }
    return;
  }
  u16* base;
  if (sg < 20) base = P.QR + (size_t)(sg - 12) * S * 64;
  else base = P.KW + (size_t)(sg - 28) * S * 64;
  store32_bf16(base + (size_t)tok * 64 + h32 * 32, o);
}

#undef VO
__device__ void phase_inproj(const Params& P, int l, char* smem) {
  const u16* Wt = P.WinT + (size_t)l * NINP * D;
  float* tile = (float*)smem;
  const float* rs = (const float*)(smem + G_RS_OFF);
  for (int it = blockIdx.x; it < 128 * 23; it += gridDim.x) {
    const int mt = it / 23, nt = it % 23;
    f32x16 acc[2][2];
    zero_acc(acc);
    gemm_mainloop<true>(P.hb + (size_t)mt * 128 * D, D, Wt + (size_t)nt * 128 * D, D, D, smem, acc);
    acc_to_lds(acc, tile);
    __syncthreads();
#pragma unroll 1
    for (int half = 0; half < 2; ++half) inproj_epilogue_half(P, l, mt, nt, half, tile, rs);
  }
}

__device__ void phase_compress(const Params& P, int l, char* smem) {
  float* tile = (float*)smem;
  for (int it = blockIdx.x; it < 32; it += gridDim.x) {
    const int kv = it >> 4, g = (it >> 3) & 1, mt = it & 7;
    const u16* A = (kv ? P.VC : P.KC) + (size_t)g * (S + 64) * 64 + (size_t)mt * 128 * 1024;
    const u16* Bt = P.CmpWT + (size_t)(l * 2 + kv) * 128 * 2048;
    const float* bias = P.cmpbias + (l * 2 + kv) * 64;
    f32x16 acc[2][2];
    zero_acc(acc);
    gemm_mainloop<false>(A, 1024, Bt, 2048, 2048, smem, acc);
    acc_to_lds(acc, tile);
    __syncthreads();
#pragma unroll 1
    for (int half = 0; half < 2; ++half) {
      {
        const int lane = threadIdx.x & 63, wave = threadIdx.x >> 6;
        const int idx = mt * 128 + half * 64 + lane;
        float v[64];
        const f32x4* src = (const f32x4*)(tile + (half * 64 + lane) * EPS_LD);
#pragma unroll
        for (int i = 0; i < 16; ++i) { f32x4 t = src[i]; v[4 * i] = t[0] + bias[4 * i]; v[4 * i + 1] = t[1] + bias[4 * i + 1]; v[4 * i + 2] = t[2] + bias[4 * i + 2]; v[4 * i + 3] = t[3] + bias[4 * i + 3]; }
        float vo[16];
#pragma unroll
        for (int i = 0; i < 4; ++i) { f32x4 t = src[wave * 4 + i]; const float* bb = bias + wave * 16 + 4 * i; vo[4 * i] = t[0] + bb[0]; vo[4 * i + 1] = t[1] + bb[1]; vo[4 * i + 2] = t[2] + bb[2]; vo[4 * i + 3] = t[3] + bb[3]; }
        if (kv == 0) {
          const float* w = P.nsa_k_norm_w + l * 64;
          float ss = 0.f;
#pragma unroll
          for (int i = 0; i < 64; ++i) ss += v[i] * v[i];
          const float rn = rsqrtf(ss * (1.f / 64.f) + 1e-6f);
          u32 o[8];
#pragma unroll
          for (int i = 0; i < 8; ++i) o[i] = pack2(vo[2 * i] * rn * w[wave * 16 + 2 * i], vo[2 * i + 1] * rn * w[wave * 16 + 2 * i + 1]);
          u32x4* dp = (u32x4*)(P.KCC + ((size_t)g * 1024 + idx) * 64 + wave * 16);
          dp[0] = mk4(o[0], o[1], o[2], o[3]);
          dp[1] = mk4(o[4], o[5], o[6], o[7]);
        } else {
#pragma unroll
          for (int i = 0; i < 16; ++i) P.VCCt[((size_t)g * 64 + wave * 16 + i) * 1024 + idx] = f2bf(vo[i]);
        }
      }
    }
  }
}

constexpr int AK_ST = 144;
constexpr int AV_ST = 136;
constexpr int AT_VOFF = 64 * AK_ST;
constexpr int AT_COFF = AT_VOFF + 64 * AV_ST;
constexpr int AT_STAGE = AT_COFF + 256;
constexpr int AT_MISC = 2 * AT_STAGE;

struct TileRegs { u32x4 k[2]; u32x4 v[2]; };

DI void tile_load(int t, TileRegs& r, const u16* __restrict__ K, const u16* __restrict__ Vt, size_t ldv, int key0, bool with_v) {
#pragma unroll
  for (int i = 0; i < 2; ++i) {
    const int c = t + 256 * i, row = c >> 3, part = c & 7;
    r.k[i] = *(const u32x4*)(K + (size_t)(key0 + row) * 64 + part * 8);
    if (with_v) r.v[i] = *(const u32x4*)(Vt + (size_t)row * ldv + key0 + part * 8);
  }
}
DI void tile_store(int t, const TileRegs& r, char* st, bool with_v) {
#pragma unroll
  for (int i = 0; i < 2; ++i) {
    const int c = t + 256 * i, row = c >> 3, part = c & 7;
    *(u32x4*)(st + row * AK_ST + part * 16) = r.k[i];
    if (with_v) {
      u32x2* d = (u32x2*)(st + AT_VOFF + row * AV_ST + part * 16);
      d[0] = mk2(r.v[i].x, r.v[i].y);
      d[1] = mk2(r.v[i].z, r.v[i].w);
    }
  }
}
DI bf16x8 pack_p(const f32x16& p, int sp) {
  u32x4 u = mk4(pack2(p[8 * sp], p[8 * sp + 1]), pack2(p[8 * sp + 2], p[8 * sp + 3]), pack2(p[8 * sp + 4], p[8 * sp + 5]), pack2(p[8 * sp + 6], p[8 * sp + 7]));
  return __builtin_bit_cast(bf16x8, u);
}
template <int NKS, bool ZINIT>
DI void qk_half(int tid, const char* st, int dofs_bytes, int kt, const bf16x8 (&qf)[NKS], f32x16& s) {
  const int lane = tid & 63;
  const char* base = st + (kt * 32 + (lane & 31)) * AK_ST + (lane >> 5) * 16 + dofs_bytes;
#pragma unroll
  for (int ks = 0; ks < NKS; ++ks) {
    const bf16x8 a = *(const bf16x8*)(base + ks * 32);
    if (ZINIT && ks == 0) { const f32x16 z = {0.f, 0.f, 0.f, 0.f, 0.f, 0.f, 0.f, 0.f, 0.f, 0.f, 0.f, 0.f, 0.f, 0.f, 0.f, 0.f}; s = MFMA32(a, qf[ks], z); }
    else s = MFMA32(a, qf[ks], s);
  }
}
DI void pv_half(int tid, const char* st, int kt, const f32x16& p, f32x16 (&o)[2]) {
  const int lane = tid & 63;
  const char* vb = st + AT_VOFF + (lane & 31) * AV_ST + (lane >> 5) * 8 + kt * 64;
#pragma unroll
  for (int sp = 0; sp < 2; ++sp) {
    const bf16x8 pb = pack_p(p, sp);
#pragma unroll
    for (int dt = 0; dt < 2; ++dt) {
      const char* a = vb + dt * 32 * AV_ST + sp * 32;
      const u32x2 lo = *(const u32x2*)a, hi = *(const u32x2*)(a + 16);
      const u32x4 u = mk4(lo.x, lo.y, hi.x, hi.y);
      o[dt] = MFMA32(__builtin_bit_cast(bf16x8, u), pb, o[dt]);
    }
  }
}
DI void load_q4(int tid, bf16x8 (&qf)[4], const u16* __restrict__ Q, int tok) {
  const int lane = tid & 63;
  const u16* b = Q + (size_t)tok * 64 + (lane >> 5) * 8;
#pragma unroll
  for (int ks = 0; ks < 4; ++ks) qf[ks] = *(const bf16x8*)(b + ks * 16);
}
DI float max_abs64(int tid, const float* w) {
  return wave_max(fabsf(w[tid & 63]));
}

struct AttnArgs {
  const u16* K; const u16* Vt; size_t ldv;
  int t0, t1;
  int q;
  int wq0;
  float M2;
  int dofs;
  int lim_hi, lim_lo, whi, wlo;
  int mask_hi, mask_lo;
  float cq; const float* cloc; const float* base;
};

template <int MODE, int NKS, bool MASK>
DI void attn_tile(int tid, const AttnArgs& a, const char* cur, int key0, int lim_hi, int lim_lo, const bf16x8 (&qf)[NKS], f32x16 (&o)[2], float& l) {
  const int h = (tid & 63) >> 5;
#pragma unroll
  for (int kt = 0; kt < 2; ++kt) {
    f32x16 s;
    if (MODE == 0) {
      const float* ckb = (const float*)(cur + AT_COFF);
#pragma unroll
      for (int rg = 0; rg < 4; ++rg) {
        const f32x4 c4 = *(const f32x4*)(ckb + 32 * kt + 8 * rg + 4 * h);
#pragma unroll
        for (int i = 0; i < 4; ++i) s[4 * rg + i] = a.cq - c4[i];
      }
      qk_half<NKS, false>(tid, cur, a.dofs, kt, qf, s);
    } else {
      qk_half<NKS, true>(tid, cur, a.dofs, kt, qf, s);
    }
#pragma unroll
    for (int i = 0; i < 16; ++i) {
      float p = __builtin_amdgcn_exp2f(s[i]);
      if (MASK) { const int key = key0 + 32 * kt + crow(i, h); if (key > lim_hi || key < lim_lo) p = 0.f; }
      s[i] = p; l += p;
    }
    pv_half(tid, cur, kt, s, o);
  }
}
template <int MODE, int NKS, bool PF2 = false>
DI void attn_loop(int tid, const AttnArgs& a, const bf16x8 (&qf)[NKS], f32x16 (&o)[2], float& l, char* smem) {
  TileRegs rA, rB; float cbA = 0.f, cbB = 0.f;
  if (a.t0 >= a.t1) return;
  tile_load(tid, rA, a.K, a.Vt, a.ldv, a.t0 * 64, true);
  if (MODE == 0 && tid < 64) cbA = a.cloc[a.t0 * 64 + tid];
  tile_store(tid, rA, smem, true);
  if (MODE == 0 && tid < 64) ((float*)(smem + AT_COFF))[tid] = (a.base[a.t0] + cbA) * LOG2E;
  __syncthreads();
  auto step = [&](int t, TileRegs& rs, float& cbs, TileRegs& rl, float& cbl, int dist) {
    char* cur = smem + ((t - a.t0) & 1) * AT_STAGE;
    char* nxt = smem + ((t - a.t0 + 1) & 1) * AT_STAGE;
    if (t + dist < a.t1) {
      tile_load(tid, rl, a.K, a.Vt, a.ldv, (t + dist) * 64, true);
      if (MODE == 0 && tid < 64) cbl = a.cloc[(t + dist) * 64 + tid];
    }
    const int key0 = t * 64;
    bool active, need_mask;
    if (MODE == 0 || MODE == 3) { active = key0 <= a.wq0 + 31; need_mask = key0 + 63 > a.wq0; }
    else if (MODE == 1) { const int nmax_w = (a.wq0 + 31 - 31) >> 4; active = (a.wq0 + 31 >= 31) && key0 <= nmax_w; need_mask = true; }
    else if (MODE == 2) { active = (key0 <= a.wq0 + 31) && (key0 + 63 >= a.wq0 - 511); need_mask = (key0 + 63 > a.wq0) || (key0 < a.wq0 + 31 - 511); }
    else { active = (key0 <= a.whi) && (key0 + 63 >= a.wlo); need_mask = (key0 + 63 > a.mask_hi) || (key0 < a.mask_lo); }
    if (active) {
      int lim_hi, lim_lo;
      if (MODE == 0 || MODE == 3) { lim_hi = a.q; lim_lo = 0; }
      else if (MODE == 1) { lim_hi = (a.q >= 31) ? ((a.q - 31) >> 4) : -1; lim_lo = 0; }
      else if (MODE == 2) { lim_hi = a.q; lim_lo = a.q - 511; }
      else { lim_hi = a.lim_hi; lim_lo = a.lim_lo; }
      if (__builtin_amdgcn_readfirstlane((int)need_mask)) attn_tile<MODE, NKS, true>(tid, a, cur, key0, lim_hi, lim_lo, qf, o, l);
      else attn_tile<MODE, NKS, false>(tid, a, cur, key0, lim_hi, lim_lo, qf, o, l);
    }
    if (t + 1 < a.t1) {
      tile_store(tid, rs, nxt, true);
      if (MODE == 0 && tid < 64) ((float*)(nxt + AT_COFF))[tid] = (a.base[t + 1] + cbs) * LOG2E;
    }
    __syncthreads();
  };
  if (!PF2) {
    for (int t = a.t0; t < a.t1; ++t) step(t, rA, cbA, rA, cbA, 1);
  } else {
    if (a.t0 + 1 < a.t1) { tile_load(tid, rA, a.K, a.Vt, a.ldv, (a.t0 + 1) * 64, true); if (MODE == 0 && tid < 64) cbA = a.cloc[(a.t0 + 1) * 64 + tid]; }
    for (int t = a.t0; t < a.t1; t += 2) {
      step(t, rA, cbA, rB, cbB, 2);
      if (t + 1 >= a.t1) break;
      step(t + 1, rB, cbB, rA, cbA, 2);
    }
  }
}

DI void zero_o(f32x16 (&o)[2]) {
#pragma unroll
  for (int d = 0; d < 2; ++d)
#pragma unroll
    for (int i = 0; i < 16; ++i) o[d][i] = 0.f;
}

DI void fox_chunk_bases(int tid, const Params& P, int hd, float* base, float* wtot) {
  const int lane = tid & 63, wave = tid >> 6;
  const float x = P.ctot[tid * 4 + hd];
  float inc = x;
#pragma unroll
  for (int o = 1; o < 64; o <<= 1) { float t = __shfl_up(inc, o); if (lane >= o) inc += t; }
  if (lane == 63) wtot[wave] = inc;
  __syncthreads();
  float off = 0.f;
  for (int w = 0; w < wave; ++w) off += wtot[w];
  base[tid] = inc - x + off;
  __syncthreads();
}

__device__ void fox_item(const Params& P, int l, int hd, int qb, char* smem) {
  const int tid = opaque_tid(), lane = tid & 63, wave = tid >> 6, h = lane >> 5;
  float* base = (float*)(smem + AT_MISC);
  float* wtot = base + 256;
  fox_chunk_bases(tid, P, hd, base, wtot);
  const float M2 = 8.f * max_abs64(tid, P.fox_q_norm_w + l * 64) * max_abs64(tid, P.fox_k_norm_w + l * 64) * LOG2E * 1.01f + 0.1f;
  const int wq0 = qb * 128 + wave * 32, q = wq0 + (lane & 31);
  AttnArgs a;
  a.K = P.KF + (size_t)hd * S * 64; a.Vt = P.VFt + (size_t)hd * 64 * S; a.ldv = S;
  a.t1 = 2 * qb + 2; a.q = q; a.wq0 = wq0; a.M2 = M2;
  a.cloc = P.cloc + (size_t)hd * S; a.base = base;
  {
    const bool skip = (tid + 1 < 2 * qb) && ((base[2 * qb] - base[tid + 1]) * LOG2E < -160.f);
    a.t0 = __syncthreads_count(skip ? 1 : 0);
  }
  a.cq = (base[q >> 6] + a.cloc[q]) * LOG2E - M2;
  bf16x8 qf[4];
  load_q4(tid, qf, P.QF + (size_t)hd * S * 64, q);
  f32x16 o[2]; zero_o(o);
  float ls = 0.f;
  a.dofs = 0;
  attn_loop<0, 4, true>(tid, a, qf, o, ls, smem);
  ls += __shfl_xor(ls, 32);
  const float inv = (ABLATE & 1) ? 0.f : 1.f / ls;
  u16* dst = P.mix + (size_t)q * 1024 + hd * 64 + 4 * h;
#pragma unroll
  for (int dt = 0; dt < 2; ++dt)
#pragma unroll
    for (int rg = 0; rg < 4; ++rg)
      *(u32x2*)(dst + 32 * dt + 8 * rg) = mk2(pack2(o[dt][4 * rg] * inv, o[dt][4 * rg + 1] * inv), pack2(o[dt][4 * rg + 2] * inv, o[dt][4 * rg + 3] * inv));
}

__device__ void diff_item(const Params& P, int l, int hd, int qb, char* smem) {
  const int tid = opaque_tid(), lane = tid & 63, wave = tid >> 6, h = lane >> 5;
  const float mq = wave_max(fabsf(P.diff_q_norm_w[l * 32 + (lane & 31)])), mk = wave_max(fabsf(P.diff_k_norm_w[l * 32 + (lane & 31)]));
  const float M2 = 5.656854249f * mq * mk * LOG2E * 1.01f + 0.1f;
  const float* lv = P.diff_lambda + l * 128;
  float d1 = (lane < 32) ? lv[lane] * lv[32 + lane] : 0.f, d2 = (lane < 32) ? lv[64 + lane] * lv[96 + lane] : 0.f;
  d1 = wave_sum(d1); d2 = wave_sum(d2);
  const float lam_init = 0.8f - 0.6f * expf(-0.3f * (float)l);
  const float lam = expf(d1) - expf(d2) + lam_init;
  const int wq0 = qb * 128 + wave * 32, q = wq0 + (lane & 31);
  AttnArgs a;
  a.K = P.KD + (size_t)hd * S * 64; a.Vt = P.VDt + (size_t)hd * 64 * S; a.ldv = S;
  a.t0 = 0; a.t1 = 2 * qb + 2; a.q = q; a.wq0 = wq0; a.M2 = M2; a.cq = 0.f; a.cloc = nullptr; a.base = nullptr;
  float* stash = P.dstash + (size_t)blockIdx.x * (128 * 64) + tid;
  f32x16 o[2];
#pragma unroll 1
  for (int c = 0; c < 2; ++c) {
    const int tid = opaque_tid(), lane = tid & 63, h = lane >> 5;
    bf16x8 qf[2];
    {
      const u16* b = P.QD + ((size_t)hd * S + q) * 64 + c * 32 + h * 8;
      qf[0] = *(const bf16x8*)b; qf[1] = *(const bf16x8*)(b + 16);
    }
    zero_o(o);
    float ls = 0.f;
    a.dofs = c * 64;
    attn_loop<3, 2>(tid, a, qf, o, ls, smem);
    ls += __shfl_xor(ls, 32);
    if (c == 0) {
      const float i0 = 1.f / ls;
#pragma unroll
      for (int dt = 0; dt < 2; ++dt)
#pragma unroll
        for (int i = 0; i < 16; ++i) stash[(dt * 16 + i) * 256] = o[dt][i] * i0;
    } else {
      const float i1 = lam / ls;
      float ss = 0.f;
#pragma unroll
      for (int dt = 0; dt < 2; ++dt)
#pragma unroll
        for (int i = 0; i < 16; ++i) { const float v = stash[(dt * 16 + i) * 256] - o[dt][i] * i1; o[dt][i] = v; ss += v * v; }
      ss += __shfl_xor(ss, 32);
      const float rn = rsqrtf(ss * (1.f / 64.f) + 1e-6f) * (1.f - lam_init);
      const float* sw = P.diff_subln_w + l * 64;
      u16* dst = P.mix + (size_t)q * 1024 + 768 + hd * 64 + 4 * h;
#pragma unroll
      for (int dt = 0; dt < 2; ++dt)
#pragma unroll
        for (int rg = 0; rg < 4; ++rg) {
          const int d0 = 32 * dt + 8 * rg + 4 * h;
          *(u32x2*)(dst + 32 * dt + 8 * rg) = mk2(pack2(o[dt][4 * rg] * rn * sw[d0], o[dt][4 * rg + 1] * rn * sw[d0 + 1]),
                                                 pack2(o[dt][4 * rg + 2] * rn * sw[d0 + 2], o[dt][4 * rg + 3] * rn * sw[d0 + 3]));
        }
    }
  }
}

struct SelFrags { u32x2 k[8]; u32x2 v[8]; };

DI void sel_load(int tid, SelFrags& f, const unsigned char* __restrict__ Kg, const unsigned char* __restrict__ Vtg, int b) {
  const int lane = tid & 63, i = lane & 15, h4 = lane >> 4;
  const int bu = __builtin_amdgcn_readfirstlane(b);
  const unsigned char* kb = Kg + (size_t)bu * 4096 + lane * 8;
  const unsigned char* vb = Vtg + (size_t)bu * 4096 + lane * 8;
  (void)i; (void)h4;
#pragma unroll
  for (int L = 0; L < 8; ++L) f.k[L] = *(const u32x2*)(kb + L * 512);
#pragma unroll
  for (int L = 0; L < 8; ++L) f.v[L] = *(const u32x2*)(vb + L * 512);
}
template <bool MASK>
DI void sel_compute_t(int tid, const SelFrags& f, const u32x2 (&qb)[2], int b, int qpos, float M2, f32x4 (&o)[4], f32x4& ol) {
  const int lane = tid & 63, h4 = lane >> 4;
  const float c0 = 8.f - M2;
  const u32x2 ones = mk2(0x38383838u, 0x38383838u);
#pragma unroll
  for (int G = 0; G < 2; ++G) {
    f32x4 s[2];
#pragma unroll
    for (int t = 0; t < 2; ++t) {
      s[t] = (f32x4){0.f, 0.f, 0.f, 0.f};
#pragma unroll
      for (int ks = 0; ks < 2; ++ks)
        s[t] = __builtin_amdgcn_mfma_f32_16x16x32_fp8_fp8(__builtin_bit_cast(long, f.k[G * 4 + t * 2 + ks]), __builtin_bit_cast(long, qb[ks]), s[t], 0, 0, 0);
    }
#pragma unroll
    for (int t = 0; t < 2; ++t)
#pragma unroll
      for (int r = 0; r < 4; ++r) {
        float p = __builtin_amdgcn_exp2f(s[t][r] * 0.0625f + c0);
        if (MASK) { const int key = b * 64 + 32 * G + 8 * h4 + 4 * t + r; if (key > qpos) p = 0.f; }
        s[t][r] = p;
      }
    int w0 = 0, w1 = 0;
    w0 = __builtin_amdgcn_cvt_pk_bf8_f32(s[0][0], s[0][1], w0, false);
    w0 = __builtin_amdgcn_cvt_pk_bf8_f32(s[0][2], s[0][3], w0, true);
    w1 = __builtin_amdgcn_cvt_pk_bf8_f32(s[1][0], s[1][1], w1, false);
    w1 = __builtin_amdgcn_cvt_pk_bf8_f32(s[1][2], s[1][3], w1, true);
    const u32x2 pb = mk2((u32)w0, (u32)w1);
#pragma unroll
    for (int dt = 0; dt < 4; ++dt)
      o[dt] = __builtin_amdgcn_mfma_f32_16x16x32_fp8_bf8(__builtin_bit_cast(long, f.v[G * 4 + dt]), __builtin_bit_cast(long, pb), o[dt], 0, 0, 0);
    ol = __builtin_amdgcn_mfma_f32_16x16x32_fp8_bf8(__builtin_bit_cast(long, ones), __builtin_bit_cast(long, pb), ol, 0, 0, 0);
  }
}
DI void sel_compute(int tid, const SelFrags& f, const u32x2 (&qb)[2], int b, int cur, int qpos, float M2, f32x4 (&o)[4], f32x4& ol) {
  if (__builtin_amdgcn_readfirstlane(b) == __builtin_amdgcn_readfirstlane(cur)) sel_compute_t<true>(tid, f, qb, b, qpos, M2, o, ol);
  else sel_compute_t<false>(tid, f, qb, b, qpos, M2, o, ol);
}

__device__ void nsa_item(const Params& P, int l, int g, int qb, char* smem, int secmask = 7) {
  const int tid = opaque_tid(), lane = tid & 63, wave = tid >> 6, h = lane >> 5;
  const int q0 = qb * 128, wq0 = q0 + wave * 32, q = wq0 + (lane & 31), ql = wave * 32 + (lane & 31);
  const int item = g * 128 + qb;
  const float M2 = 8.f * max_abs64(tid, P.nsa_q_norm_w + l * 64) * max_abs64(tid, P.nsa_k_norm_w + l * 64) * LOG2E * 1.01f + 0.1f;
  unsigned char* sel = (unsigned char*)(smem + AT_MISC);
  unsigned char* nsel = sel + 2048;
  float* impA = P.impA + (size_t)item * 256 * 128;
  float* impB = P.impB + (size_t)item * 256 * 128;
  const u16* Kc = P.KCC + (size_t)g * 1024 * 64;
  const int ntc = ((q0 + 96) >> 10) + 1;
  const int nmaxq = (q >= 31) ? ((q - 31) >> 4) : -1;
  const int nmax_w = wq0 >> 4;

  {
    float lh[4] = {0.f, 0.f, 0.f, 0.f};
#pragma unroll 1
    for (int pass = 0; pass < 2; ++pass) {
      float inv[4];
      if (pass == 1) {
#pragma unroll
        for (int hh = 0; hh < 4; ++hh) { float t = lh[hh] + __shfl_xor(lh[hh], 32); inv[hh] = (t > 0.f) ? 1.f / t : 0.f; }
      }
      TileRegs r;
      tile_load(tid, r, Kc, nullptr, 0, 0, false);
      tile_store(tid, r, smem, false);
      __syncthreads();
      for (int t = 0; t < ntc; ++t) {
        char* cur = smem + (t & 1) * AT_STAGE;
        char* nxt = smem + ((t + 1) & 1) * AT_STAGE;
        const bool more = (t + 1 < ntc);
        if (more) tile_load(tid, r, Kc, nullptr, 0, (t + 1) * 64, false);
        const int key0 = t * 64;
        f32x16 ps[2];
#pragma unroll
        for (int kt = 0; kt < 2; ++kt)
#pragma unroll
          for (int i = 0; i < 16; ++i) ps[kt][i] = 0.f;
        if (key0 <= nmax_w) {
#pragma unroll
          for (int hh = 0; hh < 4; ++hh) {
            f32x16 s[2];
            bf16x8 qf[4];
            load_q4(tid, qf, P.QN + (size_t)(g * 4 + hh) * S * 64, q);
            qk_half<4, true>(tid, cur, 0, 0, qf, s[0]);
            qk_half<4, true>(tid, cur, 0, 1, qf, s[1]);
#pragma unroll
            for (int kt = 0; kt < 2; ++kt)
#pragma unroll
              for (int i = 0; i < 16; ++i) {
                float p = __builtin_amdgcn_exp2f(s[kt][i]);
                const int key = key0 + 32 * kt + crow(i, h);
                if (key > nmaxq) p = 0.f;
                if (pass == 0) lh[hh] += p; else ps[kt][i] += p * inv[hh];
              }
          }
        }
        if (pass == 1) {
#pragma unroll
          for (int kt = 0; kt < 2; ++kt)
#pragma unroll
            for (int rg = 0; rg < 4; ++rg) {
              const int j = 16 * t + 8 * kt + 2 * rg + h;
              impA[(size_t)j * 128 + ql] = ps[kt][4 * rg] + ps[kt][4 * rg + 1] + ps[kt][4 * rg + 2] + ps[kt][4 * rg + 3];
              impB[(size_t)j * 128 + ql] = ps[kt][4 * rg + 3];
            }
        }
        if (more) tile_store(tid, r, nxt, false);
        __syncthreads();
      }
    }
  }
  __threadfence_block();
  __syncthreads();
  {
    const int qt = tid >> 1, half = tid & 1;
    const int qp = q0 + qt, cur = qp >> 6;
    u32 lst[13];
#pragma unroll
    for (int i = 0; i < 13; ++i) lst[i] = 0u;
    for (int j0 = 1 + half; j0 <= cur - 2; j0 += 8) {
      float sc[4];
#pragma unroll
      for (int u = 0; u < 4; ++u) {
        const int j = j0 + 2 * u, jc = j <= cur - 2 ? j : 1;
        sc[u] = impA[(size_t)jc * 128 + qt] + impB[(size_t)(jc - 1) * 128 + qt];
      }
#pragma unroll
      for (int u = 0; u < 4; ++u) {
        const int j = j0 + 2 * u;
        u32 x = (j <= cur - 2) ? ((__float_as_uint(sc[u]) & 0xffffff00u) | (u32)j) : 0u;
#pragma unroll
        for (int i = 0; i < 13; ++i) { const u32 hi = max(lst[i], x); x = min(lst[i], x); lst[i] = hi; }
      }
    }
    u32 oth[13];
#pragma unroll
    for (int i = 0; i < 13; ++i) oth[i] = (u32)__shfl_xor((int)lst[i], 1);
#pragma unroll
    for (int k = 0; k < 13; ++k) {
      u32 x = oth[k];
#pragma unroll
      for (int i = 0; i < 13; ++i) { const u32 hi = max(lst[i], x); x = min(lst[i], x); lst[i] = hi; }
    }
    if (half == 0) {
      unsigned char* sp = sel + qt * 16;
      int n = 0;
      sp[n++] = 0;
      if (cur >= 1) sp[n++] = (unsigned char)cur;
      if (cur >= 2) sp[n++] = (unsigned char)(cur - 1);
      const int ncand = cur - 2 < 13 ? cur - 2 : 13;
#pragma unroll
      for (int i = 0; i < 13; ++i) if (i < ncand) sp[n++] = (unsigned char)(lst[i] & 0xffu);
      nsel[qt] = (unsigned char)n;
    }
  }
  __syncthreads();
  if (secmask & 2) {
    const unsigned char* Kg = P.KS8 + (size_t)g * S * 64; const unsigned char* Vtg = P.VS8t + (size_t)g * 64 * S;
    const int col = lane & 15, h4 = lane >> 4, hd = col & 3;
    const unsigned char* selw = sel + wave * 32 * 16;
    const unsigned char* nselw = nsel + wave * 32;
    auto loadq = [&](u32x2 (&qq)[2], int qi) {
      const int qp = wq0 + (qi < 32 ? qi : 31);
      const u16* b = P.QR + ((size_t)(g * 4 + hd) * S + qp) * 64 + 8 * h4;
#pragma unroll
      for (int ks = 0; ks < 2; ++ks) {
        const u32x4 qv = *(const u32x4*)(b + 32 * ks);
        int w0 = 0, w1 = 0;
        w0 = __builtin_amdgcn_cvt_pk_fp8_f32(bflo(qv.x) * 16.f, bfhi(qv.x) * 16.f, w0, false);
        w0 = __builtin_amdgcn_cvt_pk_fp8_f32(bflo(qv.y) * 16.f, bfhi(qv.y) * 16.f, w0, true);
        w1 = __builtin_amdgcn_cvt_pk_fp8_f32(bflo(qv.z) * 16.f, bfhi(qv.z) * 16.f, w1, false);
        w1 = __builtin_amdgcn_cvt_pk_fp8_f32(bflo(qv.w) * 16.f, bfhi(qv.w) * 16.f, w1, true);
        qq[ks] = mk2((u32)w0, (u32)w1);
      }
    };
    SelFrags fr[3];
    int lq = 0, lb = 0;
    auto issue = [&](SelFrags& f) {
      if (lq < 32) {
        sel_load(tid, f, Kg, Vtg, selw[lq * 16 + lb]);
        if (++lb == (int)nselw[lq]) { lb = 0; ++lq; }
      }
    };
    issue(fr[0]); issue(fr[1]);
    u32x2 qcur[2], qnext[2];
    loadq(qcur, 0); loadq(qnext, 1);
    f32x4 o[4];
#pragma unroll
    for (int dt = 0; dt < 4; ++dt) o[dt] = (f32x4){0.f, 0.f, 0.f, 0.f};
    f32x4 ol = (f32x4){0.f, 0.f, 0.f, 0.f};
    int cq = 0, cb = 0;
    while (cq < 32) {
#pragma unroll
      for (int slot = 0; slot < 3; ++slot) {
        if (cq < 32) {
          issue(fr[(slot + 2) % 3]);
          const int qp = wq0 + cq;
          sel_compute(tid, fr[slot], qcur, selw[cq * 16 + cb], qp >> 6, qp, M2, o, ol);
          if (++cb == (int)nselw[cq]) {
            const float lsum = ol[0];
            if (col < 4 && (!(secmask & 8) || lsum == 1.2345e33f)) {
              const float gs = (ABLATE & 4) ? 0.f : P.gates[(size_t)qp * 24 + (g * 4 + col) * 3 + 1] / lsum;
              u16* dst = P.mix + (size_t)qp * 1024 + 256 + (g * 4 + col) * 64 + 4 * h4;
#pragma unroll
              for (int dt = 0; dt < 4; ++dt)
                *(u32x2*)(dst + 16 * dt) = mk2(pack2(o[dt][0] * gs, o[dt][1] * gs), pack2(o[dt][2] * gs, o[dt][3] * gs));
            }
#pragma unroll
            for (int dt = 0; dt < 4; ++dt) o[dt] = (f32x4){0.f, 0.f, 0.f, 0.f};
            ol = (f32x4){0.f, 0.f, 0.f, 0.f}; cb = 0; ++cq;
            qcur[0] = qnext[0]; qcur[1] = qnext[1];
            loadq(qnext, cq + 1);
          }
        }
      }
    }
  }
  __threadfence_block();
  __syncthreads();
#pragma unroll 1
  for (int hh = 0; hh < ((secmask & 4) ? 4 : 0); ++hh) {
    const int H = g * 4 + hh;
#pragma unroll 1
    for (int br = 0; br < 2; ++br) {
      AttnArgs a;
      a.q = q; a.wq0 = wq0; a.M2 = M2; a.cq = 0.f; a.cloc = nullptr; a.base = nullptr; a.dofs = 0;
      bf16x8 qf[4];
      f32x16 o[2]; zero_o(o);
      float ls = 0.f;
      if (br == 0) {
        load_q4(tid, qf, P.QN + (size_t)H * S * 64, q);
        a.K = Kc; a.Vt = P.VCCt + (size_t)g * 64 * 1024; a.ldv = 1024; a.t0 = 0; a.t1 = ntc;
        a.lim_hi = nmaxq; a.lim_lo = 0; a.whi = nmax_w; a.wlo = 0; a.mask_hi = (wq0 >= 31) ? ((wq0 - 31) >> 4) : -1; a.mask_lo = 0;
      } else {
        load_q4(tid, qf, P.QR + (size_t)H * S * 64, q);
        a.K = P.KW + (size_t)g * S * 64; a.Vt = P.VWt + (size_t)g * 64 * S; a.ldv = S;
        a.t0 = (q0 >> 6) - 8 < 0 ? 0 : (q0 >> 6) - 8; a.t1 = (q0 >> 6) + 2;
        a.lim_hi = q; a.lim_lo = q - 511; a.whi = wq0 + 31; a.wlo = wq0 - 511; a.mask_hi = wq0; a.mask_lo = wq0 + 31 - 511;
      }
      attn_loop<4, 4, true>(tid, a, qf, o, ls, smem);
      ls += __shfl_xor(ls, 32);
      float gt = (ls > 0.f) ? P.gates[(size_t)q * 24 + H * 3 + (br == 0 ? 0 : 2)] / ls : 0.f;
      if ((ABLATE & 2) && br == 0) gt = 0.f;
      if ((ABLATE & 8) && br == 1) gt = 0.f;
      u16* dst = P.mix + (size_t)q * 1024 + 256 + H * 64 + 4 * h;
      if (!(secmask & 8) || ls == 1.2345e33f)
#pragma unroll
      for (int dt = 0; dt < 2; ++dt)
#pragma unroll
        for (int rg = 0; rg < 4; ++rg) {
          u32x2* pp = (u32x2*)(dst + 32 * dt + 8 * rg);
          const u32x2 old = *pp;
          const float r0 = bflo(old.x) + gt * o[dt][4 * rg];
          const float r1 = bfhi(old.x) + gt * o[dt][4 * rg + 1];
          const float r2 = bflo(old.y) + gt * o[dt][4 * rg + 2];
          const float r3 = bfhi(old.y) + gt * o[dt][4 * rg + 3];
          *pp = mk2(pack2(r0, r1), pack2(r2, r3));
        }
    }
  }
}

DI unsigned xcc_id() { return (unsigned)__builtin_amdgcn_s_getreg((3 << 11) | 20) & 0xFu; }

__device__ void phase_attention(const Params& P, int l, char* smem, unsigned* counter, int secmask = 7, bool nsa_only = false) {
  int* slot = (int*)(smem + AT_MISC + 4096);
  const int mygrp = (int)(xcc_id() & 1u);
#pragma unroll 1
  for (int pass = 0; pass < 2; ++pass) {
    const int g = pass == 0 ? mygrp : 1 - mygrp;
    for (;;) {
      __syncthreads();
      if (threadIdx.x == 0) *slot = (int)atomicAdd(counter + g, 1u);
      __syncthreads();
      const int it = *slot;
      if (it >= 128) break;
      nsa_item(P, l, g, 127 - it, smem, secmask);
    }
  }
  for (;;) {
    __syncthreads();
    if (threadIdx.x == 0) *slot = (int)atomicAdd(counter + 2, 1u);
    __syncthreads();
    const int it = *slot;
    if (it >= 1024 || nsa_only) break;
    const int qb = 127 - (it >> 3), k = it & 7;
    if (k < 4) diff_item(P, l, k, qb, smem); else fox_item(P, l, k - 4, qb, smem);
  }
}

__device__ void phase_outproj(const Params& P, int l, char* smem, bool dry = false) {
  const u16* Wt = P.WoutT + (size_t)l * D * D;
  float* tile = (float*)smem;
  const int tid = threadIdx.x;
  for (int it = blockIdx.x; it < 128 * 8; it += gridDim.x) {
    const int mt = it >> 3, nt = it & 7;
    f32x16 acc[2][2];
    zero_acc(acc);
    gemm_mainloop<false>(P.mix + (size_t)mt * 128 * D, D, Wt + (size_t)nt * 128 * D, D, D, smem, acc);
    acc_to_lds(acc, tile);
    __syncthreads();
    const int c4 = (tid & 31) * 4, r0 = tid >> 5;
#pragma unroll 4
    for (int i = 0; i < 16; ++i) {
      const int row = r0 + 8 * i;
      const size_t idx = (size_t)(mt * 128 + row) * D + nt * 128 + c4;
      const f32x4 a4 = *(const f32x4*)(tile + row * EPS_LD + c4);
      f32x4 h4 = *(const f32x4*)(P.out + idx);
      h4 += a4;
      if (!dry || h4[0] == 1.2345e33f) {
        *(f32x4*)(P.out + idx) = h4;
        *(u32x2*)(P.hb2 + idx) = mk2(pack2(h4[0], h4[1]), pack2(h4[2], h4[3]));
      }
    }
  }
}

constexpr int QT_ST = 272;
DI u32 ord_key(float x, u32 idx) {
  u32 u = __float_as_uint(x);
  u = (u & 0x80000000u) ? ~u : (u | 0x80000000u);
  return (u & 0xffffff80u) | idx;
}
DI float ord_val(u32 k) {
  return (k & 0x80000000u) ? __uint_as_float(k & 0x7fffff80u) : __uint_as_float((~k) & 0xffffff80u);
}
DI void merge16(u32 (&lst)[16], int xm) {
  u32 c[16];
#pragma unroll
  for (int i = 0; i < 16; ++i) { const u32 o = (u32)__shfl_xor((int)lst[15 - i], xm); c[i] = max(lst[i], o); }
#pragma unroll
  for (int st = 8; st > 0; st >>= 1)
#pragma unroll
    for (int i = 0; i < 16; ++i)
      if ((i & st) == 0) { const u32 a = max(c[i], c[i + st]), b = min(c[i], c[i + st]); c[i] = a; c[i + st] = b; }
#pragma unroll
  for (int i = 0; i < 16; ++i) lst[i] = c[i];
}

__device__ void phase_peerq(const Params& P, int l, char* smem) {
  const u16* Wt = P.WqT + (size_t)l * 2048 * D;
  const int tid = threadIdx.x, lane = tid & 63, wave = tid >> 6, wr = wave >> 1, wc = wave & 1, h = lane >> 5;
  const float* rs = (const float*)(smem + G_RS_OFF);
  float* tile = (float*)smem;
  for (int it = blockIdx.x; it < 128 * 16; it += gridDim.x) {
    const int mt = it >> 4, nt = it & 15;
    f32x16 acc[2][2];
    zero_acc(acc);
    gemm_mainloop<true>(P.hb2 + (size_t)mt * 128 * D, D, Wt + (size_t)nt * 128 * D, D, D, smem, acc);
    __syncthreads();
#pragma unroll
    for (int i = 0; i < 2; ++i)
#pragma unroll
      for (int j = 0; j < 2; ++j)
#pragma unroll
        for (int r = 0; r < 16; ++r) {
          const int row = wr * 64 + i * 32 + crow(r, h);
          *(u16*)(smem + row * QT_ST + (wc * 64 + j * 32 + (lane & 31)) * 2) = f2bf(acc[i][j][r] * rs[row]);
        }
    __syncthreads();
    zero_acc(acc);
    {
      const u16* Bk = P.SubK + ((size_t)(l * 16 + nt) * 128 + wc * 64 + (lane & 31)) * 128 + h * 8;
      const char* Aq = smem + (wr * 64 + (lane & 31)) * QT_ST + h * 16;
#pragma unroll
      for (int ks = 0; ks < 8; ++ks) {
        bf16x8 af[2], bfr[2];
#pragma unroll
        for (int i = 0; i < 2; ++i) af[i] = *(const bf16x8*)(Aq + i * 32 * QT_ST + ks * 32);
#pragma unroll
        for (int j = 0; j < 2; ++j) bfr[j] = *(const bf16x8*)(Bk + (size_t)j * 32 * 128 + ks * 16);
#pragma unroll
        for (int i = 0; i < 2; ++i)
#pragma unroll
          for (int j = 0; j < 2; ++j) acc[i][j] = MFMA32(af[i], bfr[j], acc[i][j]);
      }
    }
    __syncthreads();
    acc_to_lds(acc, tile);
    __syncthreads();
#pragma unroll 1
    for (int half = 0; half < 2; ++half) {
      {
        const int row = half * 64 + (tid >> 2), part = tid & 3;
        u32 lst[16];
#pragma unroll
        for (int i = 0; i < 16; ++i) lst[i] = 0u;
        const f32x4* src = (const f32x4*)(tile + row * EPS_LD + part * 32);
#pragma unroll
        for (int c4 = 0; c4 < 8; ++c4) {
          const f32x4 v = src[c4];
#pragma unroll
          for (int e = 0; e < 4; ++e) {
            u32 x = ord_key(v[e], (u32)(part * 32 + c4 * 4 + e));
#pragma unroll
            for (int i = 0; i < 16; ++i) { const u32 hi = max(lst[i], x); x = min(lst[i], x); lst[i] = hi; }
          }
        }
        merge16(lst, 1);
        merge16(lst, 2);
        if (part == 0) {
          u32x4* dp = (u32x4*)(P.topk + ((size_t)(mt * 128 + row) * 16 + nt) * 16);
          dp[0] = mk4(lst[0], lst[1], lst[2], lst[3]); dp[1] = mk4(lst[4], lst[5], lst[6], lst[7]);
          dp[2] = mk4(lst[8], lst[9], lst[10], lst[11]); dp[3] = mk4(lst[12], lst[13], lst[14], lst[15]);
        }
      }
    }
  }
}

__device__ const unsigned char kCandIJ[50] = {
  0x00,0x01,0x02,0x03,0x04,0x05,0x06,0x07,0x08,0x09,0x0a,0x0b,0x0c,0x0d,0x0e,0x0f,
  0x10,0x11,0x12,0x13,0x14,0x15,0x16,0x17,
  0x20,0x21,0x22,0x23,0x24,
  0x30,0x31,0x32,0x33,
  0x40,0x41,0x42,
  0x50,0x51, 0x60,0x61, 0x70,0x71,
  0x80,0x90,0xa0,0xb0,0xc0,0xd0,0xe0,0xf0};
DI float gelu_exact(float x) { return 0.5f * x * (1.f + erff(x * 0.7071067811865476f)); }

__device__ void phase_peer(const Params& P, int l, char* smem, bool dry = false) {
  const int tid = threadIdx.x, lane = tid & 63, wave = tid >> 6;
  char* wsm = smem + wave * 8192;
  u32* keys = (u32*)wsm;
  float* cv = (float*)(wsm + 1024);
  int* exps = (int*)(wsm + 1024 + 1664);
  float* esc = (float*)(wsm + 3200);
  float* wts = (float*)(wsm + 3712);
  float* uinv = (float*)(wsm + 4224);
  float* vinv = (float*)(wsm + 4736);
  unsigned char* xrow8 = (unsigned char*)(wsm + 5248);
  const unsigned char* U8 = P.U8 + (size_t)l * S * D;
  const unsigned char* V8 = P.V8 + (size_t)l * S * D;
  const float* Uinv = P.Uinv + l * S; const float* Vinv = P.Vinv + l * S;
  for (int it = blockIdx.x; it < S / 4; it += gridDim.x) {
    const int tok = it * 4 + wave;
    *(u32x4*)(keys + lane * 4) = *(const u32x4*)(P.topk + (size_t)tok * 256 + lane * 4);
    const u32x4 xa = *(const u32x4*)(P.hb2 + (size_t)tok * D + lane * 16), xb = *(const u32x4*)(P.hb2 + (size_t)tok * D + lane * 16 + 8);
    float rstd = wave_sum(ssq8(xa) + ssq8(xb));
    rstd = rsqrtf(rstd * (1.f / 1024.f) + 1e-6f);
    float xinv;
    {
      float xv[16] = {bflo(xa.x), bfhi(xa.x), bflo(xa.y), bfhi(xa.y), bflo(xa.z), bfhi(xa.z), bflo(xa.w), bfhi(xa.w),
                      bflo(xb.x), bfhi(xb.x), bflo(xb.y), bfhi(xb.y), bflo(xb.z), bfhi(xb.z), bflo(xb.w), bfhi(xb.w)};
      float m = 0.f;
#pragma unroll
      for (int i = 0; i < 16; ++i) m = fmaxf(m, fabsf(xv[i]));
      m = wave_max(m);
      const float sx = (m > 0.f) ? 240.f / m : 0.f;
      xinv = m * (1.f / 240.f);
      u32 o4[4];
#pragma unroll
      for (int i = 0; i < 4; ++i) {
        int wd = 0;
        wd = __builtin_amdgcn_cvt_pk_fp8_f32(xv[4 * i] * sx, xv[4 * i + 1] * sx, wd, false);
        wd = __builtin_amdgcn_cvt_pk_fp8_f32(xv[4 * i + 2] * sx, xv[4 * i + 3] * sx, wd, true);
        o4[i] = (u32)wd;
      }
      *(u32x4*)(xrow8 + lane * 16) = mk4(o4[0], o4[1], o4[2], o4[3]);
    }
    __builtin_amdgcn_s_waitcnt(0xc07f);
    const int hd = lane >> 3, sub = lane & 7;
    float myv[7]; int mye[7];
#pragma unroll
    for (int m = 0; m < 7; ++m) {
      const int c = sub + 8 * m;
      myv[m] = -3.0e38f; mye[m] = 0;
      if (c < 50) {
        const int ij = kCandIJ[c], i = ij >> 4, j = ij & 15;
        const u32 k1 = keys[(hd * 2) * 16 + i], k2 = keys[(hd * 2 + 1) * 16 + j];
        myv[m] = ord_val(k1) + ord_val(k2);
        mye[m] = (int)((k1 & 127u) * 128u + (k2 & 127u));
        cv[hd * 52 + c] = myv[m];
      }
    }
    __builtin_amdgcn_s_waitcnt(0xc07f);
#pragma unroll
    for (int m = 0; m < 7; ++m) {
      const int c = sub + 8 * m;
      if (c < 50) {
        int rank = 0;
        for (int c2 = 0; c2 < 50; ++c2) { const float o = cv[hd * 52 + c2]; rank += (o > myv[m]) || (o == myv[m] && c2 < c); }
        if (rank < 16) {
          exps[hd * 16 + rank] = mye[m]; esc[hd * 16 + rank] = myv[m];
          uinv[hd * 16 + rank] = Uinv[mye[m]]; vinv[hd * 16 + rank] = Vinv[mye[m]];
        }
      }
    }
    __builtin_amdgcn_s_waitcnt(0xc07f);
    float g0, g1;
    {
      const float mx = esc[hd * 16];
      const float e0 = expf(esc[hd * 16 + 2 * sub] - mx), e1 = expf(esc[hd * 16 + 2 * sub + 1] - mx);
      float sm = e0 + e1;
      sm += __shfl_xor(sm, 1); sm += __shfl_xor(sm, 2); sm += __shfl_xor(sm, 4);
      g0 = e0 / sm; g1 = e1 / sm;
    }
    wts[hd * 16 + 2 * sub] = g0; wts[hd * 16 + 2 * sub + 1] = g1;
    __builtin_amdgcn_s_waitcnt(0xc07f);
    {
      const int i16 = lane & 15, h4 = lane >> 4;
      u32x4 a0[8], a1[8];
      auto uload = [&](u32x4 (&a)[8], int c) {
        const unsigned char* urow = U8 + (size_t)exps[(c >> 1) * 16 + i16] * D + 32 * h4 + (c & 1) * 512;
#pragma unroll
        for (int i = 0; i < 4; ++i) { a[2 * i] = *(const u32x4*)(urow + i * 128); a[2 * i + 1] = *(const u32x4*)(urow + i * 128 + 16); }
      };
      f32x4 acc = (f32x4){0.f, 0.f, 0.f, 0.f};
      auto umma = [&](const u32x4 (&a)[8], int c) {
#pragma unroll
        for (int i = 0; i < 8; ++i) {
          const u32x4 b = *(const u32x4*)(xrow8 + (c & 1) * 512 + (i >> 1) * 128 + 32 * h4 + (i & 1) * 16);
          acc = __builtin_amdgcn_mfma_f32_16x16x32_fp8_fp8(__builtin_bit_cast(long, mk2(a[i].x, a[i].y)), __builtin_bit_cast(long, mk2(b.x, b.y)), acc, 0, 0, 0);
          acc = __builtin_amdgcn_mfma_f32_16x16x32_fp8_fp8(__builtin_bit_cast(long, mk2(a[i].z, a[i].w)), __builtin_bit_cast(long, mk2(b.z, b.w)), acc, 0, 0, 0);
        }
        if (c & 1) {
          if (i16 == 0) {
            const int eg = c >> 1;
#pragma unroll
            for (int r = 0; r < 4; ++r) {
              const int k = eg * 16 + 4 * h4 + r;
              wts[k] = wts[k] * gelu_exact(rstd * acc[r] * uinv[k] * xinv) * vinv[k];
            }
          }
          acc = (f32x4){0.f, 0.f, 0.f, 0.f};
        }
      };
      uload(a0, 0);
#pragma unroll 1
      for (int c = 0; c < 16; c += 2) {
        uload(a1, c + 1);
        umma(a0, c);
        if (c + 2 < 16) uload(a0, c + 2);
        umma(a1, c + 1);
      }
    }
    __builtin_amdgcn_s_waitcnt(0xc07f);
    float o[16];
#pragma unroll
    for (int i = 0; i < 16; ++i) o[i] = 0.f;
    {
      u32x4 va[8], vb2[8];
      auto vload = [&](u32x4 (&x0)[8], int k) {
#pragma unroll
        for (int u = 0; u < 8; ++u) x0[u] = *(const u32x4*)(V8 + (size_t)exps[k + u] * D + lane * 16);
      };
      auto vacc = [&](const u32x4 (&x0)[8], int k) {
#pragma unroll
        for (int u = 0; u < 8; ++u) {
          const float w = wts[k + u];
#pragma unroll
          for (int c = 0; c < 4; ++c) {
            const f32x2 lo = __builtin_amdgcn_cvt_pk_f32_fp8((int)x0[u][c], false), hi = __builtin_amdgcn_cvt_pk_f32_fp8((int)x0[u][c], true);
            o[4 * c] += w * lo[0]; o[4 * c + 1] += w * lo[1]; o[4 * c + 2] += w * hi[0]; o[4 * c + 3] += w * hi[1];
          }
        }
      };
      vload(va, 0);
#pragma unroll 1
      for (int k = 0; k < 128; k += 16) {
        vload(vb2, k + 8);
        vacc(va, k);
        if (k + 16 < 128) vload(va, k + 16);
        vacc(vb2, k + 8);
      }
    }
    if (!dry || o[0] == 1.2345e33f) {
      f32x4* op = (f32x4*)(P.out + (size_t)tok * D + lane * 16);
      float r[16];
#pragma unroll
      for (int i = 0; i < 4; ++i) { f32x4 t = op[i]; t.x += o[4 * i]; t.y += o[4 * i + 1]; t.z += o[4 * i + 2]; t.w += o[4 * i + 3]; op[i] = t; r[4 * i] = t.x; r[4 * i + 1] = t.y; r[4 * i + 2] = t.z; r[4 * i + 3] = t.w; }
      u32x4* hp = (u32x4*)(P.hb2 + (size_t)tok * D + lane * 16);
      hp[0] = mk4(pack2(r[0], r[1]), pack2(r[2], r[3]), pack2(r[4], r[5]), pack2(r[6], r[7]));
      hp[1] = mk4(pack2(r[8], r[9]), pack2(r[10], r[11]), pack2(r[12], r[13]), pack2(r[14], r[15]));
    }
  }
}

__device__ void phase_ple(const Params& P, int l, char* smem, bool dry = false) {
  const u16* Wg = P.WgT + (size_t)l * D * D;
  const u16* Wp = P.WpT + (size_t)l * D * 256;
  const u16* pb = P.pb + (size_t)l * S * 256;
  const int tid = threadIdx.x, lane = tid & 63, wave = tid >> 6, wr = wave >> 1, h = lane >> 5;
  const float* rs = (const float*)(smem + G_RS_OFF);
  float* tile = (float*)smem;
  for (int it = blockIdx.x; it < 128 * 8; it += gridDim.x) {
    const int mt = it >> 3, nt = it & 7;
    f32x16 acc[2][2];
    zero_acc(acc);
    gemm_mainloop<false>(pb + (size_t)mt * 128 * 256, 256, Wp + (size_t)nt * 128 * 256, 256, 256, smem, acc);
    u16* side = (u16*)(smem + 36864);
    const int wc = wave & 1;
#pragma unroll
    for (int i = 0; i < 2; ++i)
#pragma unroll
      for (int j = 0; j < 2; ++j)
#pragma unroll
        for (int r = 0; r < 16; ++r)
          side[(wr * 64 + i * 32 + crow(r, h)) * 136 + wc * 64 + j * 32 + (lane & 31)] = f2bf(acc[i][j][r]);
    zero_acc(acc);
    gemm_mainloop<true>(P.hb2 + (size_t)mt * 128 * D, D, Wg + (size_t)nt * 128 * D, D, D, smem, acc);
    __syncthreads();
#pragma unroll
    for (int i = 0; i < 2; ++i)
#pragma unroll
      for (int j = 0; j < 2; ++j)
#pragma unroll
        for (int r = 0; r < 16; ++r) {
          const int row = wr * 64 + i * 32 + crow(r, h);
          const float pv = bf2f(side[row * 136 + wc * 64 + j * 32 + (lane & 31)]);
          acc[i][j][r] = sigmoidf_(acc[i][j][r] * rs[row]) * pv;
        }
    __syncthreads();
    acc_to_lds(acc, tile);
    __syncthreads();
    const int c4 = (tid & 31) * 4, r0 = tid >> 5;
#pragma unroll 4
    for (int i = 0; i < 16; ++i) {
      const int row = r0 + 8 * i;
      const size_t idx = (size_t)(mt * 128 + row) * D + nt * 128 + c4;
      const f32x4 a4 = *(const f32x4*)(tile + row * EPS_LD + c4);
      f32x4 h4 = *(const f32x4*)(P.out + idx);
      h4 += a4;
      if (!dry || h4[0] == 1.2345e33f) {
        *(f32x4*)(P.out + idx) = h4;
        *(u32x2*)(P.hb + idx) = mk2(pack2(h4[0], h4[1]), pack2(h4[2], h4[3]));
      }
    }
  }
}

constexpr int N_PHASES = 15;
DI void grid_barrier(unsigned* ctr, unsigned target) {
  asm volatile("s_waitcnt vmcnt(0)" ::: "memory");
  __syncthreads();
  if (threadIdx.x == 0) {
    __builtin_amdgcn_fence(__ATOMIC_RELEASE, "agent");
    asm volatile("s_waitcnt vmcnt(0)" ::: "memory");
    __hip_atomic_fetch_add(ctr, 1u, __ATOMIC_RELAXED, __HIP_MEMORY_SCOPE_AGENT);
    while (__hip_atomic_load(ctr, __ATOMIC_RELAXED, __HIP_MEMORY_SCOPE_AGENT) < target) __builtin_amdgcn_s_sleep(1);
    __builtin_amdgcn_fence(__ATOMIC_ACQUIRE, "agent");
    asm volatile("s_waitcnt vmcnt(0)" ::: "memory");
  }
  __syncthreads();
}
__global__ void __launch_bounds__(NT, 2) hymba_mega(Params P, unsigned* counters) {
  __shared__ __attribute__((aligned(16))) char smem[SMEM_BYTES];
  cg::grid_group grid = cg::this_grid();
  const int lo = P.phase_lo, hi = P.phase_hi;
#ifndef ONLY_PHASE
#define ONLY_PHASE -1
#endif
#define PH_ON(k) (ONLY_PHASE < 0 || ONLY_PHASE == (k))
  unsigned bar_n = 0;
#define RUN(ph, kind, call) if (lo <= (ph) && (ph) < hi) { const bool dry = false; const int rep = 0; (void)dry; (void)rep; if (PH_ON(kind)) { call; } if ((ph) + 1 < hi) { if ((ph) == 0) grid.sync(); else grid_barrier(counters + 32, (++bar_n) * gridDim.x); } }
#define RUNREP(ph, kind, call) if (lo <= (ph) && (ph) < hi) { \
    const int nrep = ((ph) == P.rep_ph) ? P.rep_n : 1; \
    for (int rep = 0; rep < nrep; ++rep) { const bool dry = rep > 0; (void)dry; \
      if (PH_ON(kind)) { call; } \
      if ((ph) + 1 < hi || rep + 1 < nrep) { grid_barrier(counters + 32, (++bar_n) * gridDim.x); } } }
#ifndef REPEAT
#define REPEAT -1
#define RSEC 7
#endif
  RUN(0, 7, phase_prep(P, smem))
  RUN(1, 0, phase_inproj(P, 0, smem))
  RUN(2, 1, phase_compress(P, 0, smem))
  RUNREP(3, 2, phase_attention(P, 0, smem, counters + 4 * rep, dry ? (P.rep_sec | 8) : 7, dry && P.rep_nsa_only))
  RUN(4, 3, phase_outproj(P, 0, smem, dry))
  RUN(5, 4, phase_peerq(P, 0, smem))
  RUN(6, 5, phase_peer(P, 0, smem, dry))
  RUN(7, 6, phase_ple(P, 0, smem, dry))
  RUN(8, 0, phase_inproj(P, 1, smem))
  RUN(9, 1, phase_compress(P, 1, smem))
  RUN(10, 2, phase_attention(P, 1, smem, counters + 16))
  RUN(11, 3, phase_outproj(P, 1, smem))
  RUN(12, 4, phase_peerq(P, 1, smem))
  RUN(13, 5, phase_peer(P, 1, smem))
  RUN(14, 6, phase_ple(P, 1, smem))
}

static size_t align_up(size_t x, size_t a) { return (x + a - 1) / a * a; }

extern "C" void kernel_launch(void* const* d_in, const int* in_sizes, int n_in, void* d_out, int out_size, void* d_ws, size_t ws_size, hipStream_t stream) {
  static int grid_blocks = 0;
  if (!grid_blocks) {
    int dev = 0, cus = 0, per_cu = 0;
    hipGetDevice(&dev);
    hipDeviceGetAttribute(&cus, hipDeviceAttributeMultiprocessorCount, dev);
    hipOccupancyMaxActiveBlocksPerMultiprocessor(&per_cu, hymba_mega, NT, 0);
    if (per_cu > 2) per_cu = 2;
    if (per_cu < 1) per_cu = 1;
    grid_blocks = cus * per_cu;
  }
  Params P;
  memset(&P, 0, sizeof(P));
  P.x = (const float*)d_in[0]; P.p = (const float*)d_in[1]; P.positions = (const int*)d_in[2];
  P.attn_norm_w = (const float*)d_in[3]; P.w_in = (const float*)d_in[4]; P.fox_f_bias = (const float*)d_in[5];
  P.fox_q_norm_w = (const float*)d_in[6]; P.fox_k_norm_w = (const float*)d_in[7];
  P.nsa_q_norm_w = (const float*)d_in[8]; P.nsa_k_norm_w = (const float*)d_in[9]; P.nsa_cmp_pos = (const float*)d_in[10]; P.nsa_cmp_w = (const float*)d_in[11];
  P.diff_q_norm_w = (const float*)d_in[12]; P.diff_k_norm_w = (const float*)d_in[13]; P.diff_lambda = (const float*)d_in[14]; P.diff_subln_w = (const float*)d_in[15];
  P.w_out = (const float*)d_in[16]; P.ffn_norm_w = (const float*)d_in[17]; P.peer_w_q = (const float*)d_in[18]; P.peer_sub_keys = (const float*)d_in[19];
  P.peer_u = (const float*)d_in[20]; P.peer_v = (const float*)d_in[21]; P.ple_norm_w = (const float*)d_in[22]; P.ple_w_gate = (const float*)d_in[23]; P.ple_w_proj = (const float*)d_in[24];
  P.out = (float*)d_out;
  char* w = (char*)d_ws; size_t off = 0;
  auto take = [&](size_t bytes) { char* p = w + off; off = align_up(off + bytes, 256); return p; };
  unsigned* counters = (unsigned*)take(256);
  P.WinT = (u16*)take((size_t)2 * NINP * D * 2);
  P.WoutT = (u16*)take((size_t)2 * D * D * 2);
  P.WqT = (u16*)take((size_t)2 * 2048 * D * 2);
  P.WgT = (u16*)take((size_t)2 * D * D * 2);
  P.WpT = (u16*)take((size_t)2 * D * 256 * 2);
  P.SubK = (u16*)take((size_t)2 * 16 * 128 * 128 * 2);
  P.CmpWT = (u16*)take((size_t)2 * 2 * 128 * 2048 * 2);
  P.cmpbias = (float*)take(2 * 2 * 64 * 4);
  P.U8 = (unsigned char*)take((size_t)2 * S * D);
  P.V8 = (unsigned char*)take((size_t)2 * S * D);
  P.Uinv = (float*)take((size_t)2 * S * 4); P.Vinv = (float*)take((size_t)2 * S * 4);
  P.hb = (u16*)take((size_t)S * D * 2);
  P.hb2 = (u16*)take((size_t)S * D * 2);
  P.pb = (u16*)take((size_t)2 * S * 256 * 2);
  P.ropeN = (float*)take((size_t)S * 64 * 4);
  P.ropeD = (float*)take((size_t)S * 32 * 4);
  P.QF = (u16*)take((size_t)4 * S * 64 * 2); P.KF = (u16*)take((size_t)4 * S * 64 * 2); P.VFt = (u16*)take((size_t)4 * S * 64 * 2);
  P.cloc = (float*)take((size_t)4 * S * 4); P.ctot = (float*)take(256 * 4 * 4);
  P.QN = (u16*)take((size_t)8 * S * 64 * 2); P.QR = (u16*)take((size_t)8 * S * 64 * 2);
  P.KC = (u16*)take((size_t)2 * (S + 64) * 64 * 2); P.VC = (u16*)take((size_t)2 * (S + 64) * 64 * 2);
  P.KCC = (u16*)take((size_t)2 * 1024 * 64 * 2); P.VCCt = (u16*)take((size_t)2 * 64 * 1024 * 2);
  P.KS8 = (unsigned char*)take((size_t)2 * S * 64); P.VS8t = (unsigned char*)take((size_t)2 * S * 64);
  P.KW = (u16*)take((size_t)2 * S * 64 * 2); P.VWt = (u16*)take((size_t)2 * S * 64 * 2);
  P.gates = (float*)take((size_t)S * 24 * 4);
  P.QD = (u16*)take((size_t)4 * S * 64 * 2); P.KD = (u16*)take((size_t)4 * S * 64 * 2); P.VDt = (u16*)take((size_t)4 * S * 64 * 2);
  P.mix = (u16*)take((size_t)S * D * 2);
  P.dstash = (float*)take((size_t)grid_blocks * 128 * 64 * 4);
  P.impA = (float*)take((size_t)256 * 256 * 128 * 4); P.impB = (float*)take((size_t)256 * 256 * 128 * 4);
  P.topk = (u32*)take((size_t)S * 256 * 4);
  if (off > ws_size) { fprintf(stderr, "kernel_launch: workspace too small: need %zu, have %zu\n", off, ws_size); return; }
  hipMemsetAsync(counters, 0, 256, stream);
#ifndef SINGLE_LAUNCH
#define SINGLE_LAUNCH 1
#endif
#ifndef REP_PH
#define REP_PH -1
#endif
#ifndef REP_N
#define REP_N 1
#endif
#ifndef REP_SEC
#define REP_SEC 7
#endif
#ifndef REP_NSA_ONLY
#define REP_NSA_ONLY 0
#endif
  P.rep_ph = REP_PH; P.rep_n = REP_N; P.rep_sec = REP_SEC; P.rep_nsa_only = REP_NSA_ONLY;
  if (SINGLE_LAUNCH) {
    P.phase_lo = 0; P.phase_hi = N_PHASES;
    void* args[] = {&P, &counters};
    hipError_t e = hipLaunchCooperativeKernel((void*)hymba_mega, dim3(grid_blocks), dim3(NT), args, 0, stream);
    if (e != hipSuccess) fprintf(stderr, "cooperative launch failed: %s (grid %d)\n", hipGetErrorString(e), grid_blocks);
  } else {
    for (int ph = 0; ph < N_PHASES; ++ph) {
      P.phase_lo = ph; P.phase_hi = ph + 1;
      void* args[] = {&P, &counters};
      hipError_t e = hipLaunchCooperativeKernel((void*)hymba_mega, dim3(grid_blocks), dim3(NT), args, 0, stream);
      if (e != hipSuccess) { fprintf(stderr, "cooperative launch failed: %s (grid %d, phase %d)\n", hipGetErrorString(e), grid_blocks, ph); break; }
    }
  }
}
```

```cpp
#include <hip/hip_runtime.h>
#include <hip/hip_cooperative_groups.h>
#include <cstdio>
#include <cstdint>
#include <cstring>
namespace cg = cooperative_groups;

typedef __attribute__((ext_vector_type(8))) short bf16x8;
typedef __attribute__((ext_vector_type(4))) short bf16x4;
typedef __attribute__((ext_vector_type(16))) float f32x16;
typedef __attribute__((ext_vector_type(4))) float f32x4;
typedef __attribute__((ext_vector_type(2))) float f32x2;
typedef __attribute__((ext_vector_type(2))) __bf16 bf2_t;
typedef unsigned short u16;
typedef unsigned int u32;
typedef __attribute__((ext_vector_type(4))) unsigned int u32x4;
typedef __attribute__((ext_vector_type(2))) unsigned int u32x2;

#define DI __device__ __forceinline__
#define MFMA32(a, b, c) __builtin_amdgcn_mfma_f32_32x32x16_bf16((a), (b), (c), 0, 0, 0)
#define MFMA16(a, b, c) __builtin_amdgcn_mfma_f32_16x16x32_bf16((a), (b), (c), 0, 0, 0)

constexpr int S = 16384;
constexpr int D = 1024;
constexpr int NT = 256;
constexpr int NIN = 2844;
constexpr int NINP = 2944;
constexpr int SMEM_BYTES = 72704;
constexpr float LOG2E = 1.4426950408889634f;
#ifndef ABLATE
#define ABLATE 0
#endif

struct Params {
  const float* x; const float* p; const int* positions;
  const float* attn_norm_w; const float* w_in; const float* fox_f_bias; const float* fox_q_norm_w; const float* fox_k_norm_w;
  const float* nsa_q_norm_w; const float* nsa_k_norm_w; const float* nsa_cmp_pos; const float* nsa_cmp_w;
  const float* diff_q_norm_w; const float* diff_k_norm_w; const float* diff_lambda; const float* diff_subln_w;
  const float* w_out; const float* ffn_norm_w; const float* peer_w_q; const float* peer_sub_keys; const float* peer_u; const float* peer_v;
  const float* ple_norm_w; const float* ple_w_gate; const float* ple_w_proj;
  float* out;
  u16* WinT;
  u16* WoutT;
  u16* WqT;
  u16* WgT;
  u16* WpT;
  u16* SubK;
  u16* CmpWT;
  float* cmpbias;
  unsigned char* U8;
  unsigned char* V8;
  float* Uinv; float* Vinv;
  u16* hb;
  u16* hb2;
  u16* pb;
  float* ropeN;
  float* ropeD;
  u16* QF; u16* KF; u16* VFt;
  float* cloc; float* ctot;
  u16* QN; u16* QR;
  u16* KC; u16* VC;
  u16* KCC; u16* VCCt;
  unsigned char* KS8; unsigned char* VS8t;
  u16* KW; u16* VWt;
  float* gates;
  u16* QD; u16* KD; u16* VDt;
  u16* mix;
  float* dstash;
  float* impA; float* impB;
  u32* topk;
  int phase_lo, phase_hi;
  int rep_ph, rep_n, rep_sec, rep_nsa_only;
};

DI u32x4 mk4(u32 a, u32 b, u32 c, u32 d) { return (u32x4){a, b, c, d}; }
DI u32x2 mk2(u32 a, u32 b) { return (u32x2){a, b}; }
DI u32 pack2(float a, float b) { f32x2 v = {a, b}; bf2_t r = __builtin_convertvector(v, bf2_t); return __builtin_bit_cast(u32, r); }
DI u16 f2bf(float a) { return (u16)(pack2(a, 0.f) & 0xffffu); }
DI float bf2f(u16 x) { return __uint_as_float(((u32)x) << 16); }
DI float bflo(u32 x) { return __uint_as_float(x << 16); }
DI float bfhi(u32 x) { return __uint_as_float(x & 0xffff0000u); }
DI int opaque_tid() { int t = threadIdx.x; asm volatile("" : "+v"(t)); return t; }
DI int crow(int reg, int h) { return (reg & 3) + 8 * (reg >> 2) + 4 * h; }
DI float wave_sum(float v) {
#pragma unroll
  for (int o = 32; o > 0; o >>= 1) v += __shfl_xor(v, o);
  return v;
}
DI float wave_max(float v) {
#pragma unroll
  for (int o = 32; o > 0; o >>= 1) v = fmaxf(v, __shfl_xor(v, o));
  return v;
}

DI int inproj_old_col(int j) {
  if (j < 768) return j;
  if (j < 2048) return j + 4;
  if (j < 2816) return j + 28;
  if (j < 2820) return j - 2048;
  if (j < 2844) return j - 768;
  return -1;
}
DI void transpose_tile(const float* __restrict__ src, int ldsrc, u16* __restrict__ dst, int K, const float* __restrict__ scale,
                       int n0, int k0, int mode, int nvalid, float* tile) {
  const int t = threadIdx.x;
  const int nn = t & 63, kq = t >> 6;
  int col = n0 + nn;
  if (mode == 1) col = inproj_old_col(col); else if (col >= nvalid) col = -1;
  float v[16];
#pragma unroll
  for (int i = 0; i < 16; ++i) v[i] = (col >= 0) ? src[(size_t)(k0 + kq + 4 * i) * ldsrc + col] : 0.f;
  if (scale) {
#pragma unroll
    for (int i = 0; i < 16; ++i) v[i] *= scale[k0 + kq + 4 * i];
  }
#pragma unroll
  for (int i = 0; i < 16; ++i) tile[(kq + 4 * i) * 65 + nn] = v[i];
  __syncthreads();
  const int n2 = t >> 2, kc = (t & 3) * 16;
  u32 o[8];
#pragma unroll
  for (int i = 0; i < 8; ++i) o[i] = pack2(tile[(kc + 2 * i) * 65 + n2], tile[(kc + 2 * i + 1) * 65 + n2]);
  u32x4* dp = (u32x4*)(dst + (size_t)(n0 + n2) * K + k0 + kc);
  dp[0] = mk4(o[0], o[1], o[2], o[3]);
  dp[1] = mk4(o[4], o[5], o[6], o[7]);
  __syncthreads();
}

DI void convert_rows(const float* __restrict__ src, u16* __restrict__ dst, size_t n8, float* __restrict__ copy) {
  const size_t stride = (size_t)gridDim.x * NT;
  for (size_t i0 = (size_t)blockIdx.x * NT + threadIdx.x; i0 < n8; i0 += 4 * stride) {
    f32x4 a[4], b[4];
#pragma unroll
    for (int u = 0; u < 4; ++u) {
      const size_t i = i0 + u * stride;
      if (i < n8) { a[u] = ((const f32x4*)src)[2 * i]; b[u] = ((const f32x4*)src)[2 * i + 1]; }
    }
#pragma unroll
    for (int u = 0; u < 4; ++u) {
      const size_t i = i0 + u * stride;
      if (i < n8) {
        if (copy) { ((f32x4*)copy)[2 * i] = a[u]; ((f32x4*)copy)[2 * i + 1] = b[u]; }
        ((u32x4*)dst)[i] = mk4(pack2(a[u][0], a[u][1]), pack2(a[u][2], a[u][3]), pack2(b[u][0], b[u][1]), pack2(b[u][2], b[u][3]));
      }
    }
  }
}

__device__ __forceinline__ void phase_prep(const Params& P, char* smem) {
  float* tile = (float*)smem;
  const int bid = blockIdx.x, nb = gridDim.x, t = threadIdx.x;
  for (int it0 = bid; it0 < 2 * 1952; it0 += nb) {
    const int l = it0 / 1952;
    int it = it0 % 1952;
    if (it < 736) { transpose_tile(P.w_in + (size_t)l * D * NIN, NIN, P.WinT + (size_t)l * NINP * D, D, P.attn_norm_w + l * D, (it >> 4) * 64, (it & 15) * 64, 1, 0, tile); continue; }
    it -= 736;
    if (it < 256) { transpose_tile(P.w_out + (size_t)l * D * D, D, P.WoutT + (size_t)l * D * D, D, nullptr, (it >> 4) * 64, (it & 15) * 64, 0, D, tile); continue; }
    it -= 256;
    if (it < 512) { transpose_tile(P.peer_w_q + (size_t)l * D * 2048, 2048, P.WqT + (size_t)l * 2048 * D, D, P.ffn_norm_w + l * D, (it >> 4) * 64, (it & 15) * 64, 0, 2048, tile); continue; }
    it -= 512;
    if (it < 256) { transpose_tile(P.ple_w_gate + (size_t)l * D * D, D, P.WgT + (size_t)l * D * D, D, P.ple_norm_w + l * D, (it >> 4) * 64, (it & 15) * 64, 0, D, tile); continue; }
    it -= 256;
    if (it < 64) { transpose_tile(P.ple_w_proj + (size_t)l * 256 * D, D, P.WpT + (size_t)l * D * 256, 256, nullptr, (it >> 2) * 64, (it & 3) * 64, 0, D, tile); continue; }
    it -= 64;
    { const int kv = it >> 6, i2 = it & 63;
      transpose_tile(P.nsa_cmp_w + (size_t)(l * 2 + kv) * 2048 * 64, 64, P.CmpWT + (size_t)(l * 2 + kv) * 128 * 2048, 2048, nullptr, (i2 >> 5) * 64, (i2 & 31) * 64, 0, 64, tile); }
  }
  convert_rows(P.peer_sub_keys, P.SubK, (size_t)2 * 16 * 128 * 128 / 8, nullptr);
  {
    const int lane = t & 63, gw = bid * 4 + (t >> 6), ngw = nb * 4;
    for (int r = gw; r < 4 * S; r += ngw) {
      const int tbl = r / (2 * S), l = (r / S) & 1, e = r % S;
      const float* src = (tbl ? P.peer_v : P.peer_u) + ((size_t)l * S + e) * D + lane * 16;
      float v[16];
#pragma unroll
      for (int i = 0; i < 4; ++i) { const f32x4 q4 = ((const f32x4*)src)[i]; v[4 * i] = q4[0]; v[4 * i + 1] = q4[1]; v[4 * i + 2] = q4[2]; v[4 * i + 3] = q4[3]; }
      if (tbl == 0) {
        const float* w = P.ffn_norm_w + l * D + lane * 16;
#pragma unroll
        for (int i = 0; i < 16; ++i) v[i] *= w[i];
      }
      float m = 0.f;
#pragma unroll
      for (int i = 0; i < 16; ++i) m = fmaxf(m, fabsf(v[i]));
      m = wave_max(m);
      const float sc = (m > 0.f) ? 240.f / m : 0.f;
      u32 o[4];
#pragma unroll
      for (int i = 0; i < 4; ++i) {
        int wd = 0;
        wd = __builtin_amdgcn_cvt_pk_fp8_f32(v[4 * i] * sc, v[4 * i + 1] * sc, wd, false);
        wd = __builtin_amdgcn_cvt_pk_fp8_f32(v[4 * i + 2] * sc, v[4 * i + 3] * sc, wd, true);
        o[i] = (u32)wd;
      }
      unsigned char* dst = (tbl ? P.V8 : P.U8) + ((size_t)l * S + e) * D + lane * 16;
      *(u32x4*)dst = mk4(o[0], o[1], o[2], o[3]);
      if (lane == 0) (tbl ? P.Vinv : P.Uinv)[l * S + e] = m * (1.f / 240.f);
    }
  }
  convert_rows(P.p, P.pb, (size_t)2 * S * 256 / 8, nullptr);
  convert_rows(P.x, P.hb, (size_t)S * D / 8, P.out);
  const size_t gtid = (size_t)bid * NT + t, gstride = (size_t)nb * NT;
  __syncthreads();
  if (t < 48) tile[t] = (t < 32) ? powf(10000.f, -(float)t / 32.f) : powf(10000.f, -(float)(t - 32) / 16.f);
  __syncthreads();
  for (size_t i = gtid; i < (size_t)S * 48; i += gstride) {
    const int tok = (int)(i / 48), r = (int)(i % 48);
    const float pos = (float)P.positions[tok];
    const float invf = tile[r];
    const float ang = pos * invf;
    const double rev = (double)ang * 0.15915494309189535;
    const float fr = (float)(rev - floor(rev));
    const float c = __builtin_amdgcn_cosf(fr), s = __builtin_amdgcn_sinf(fr);
    if (r < 32) { P.ropeN[(size_t)tok * 64 + r] = c; P.ropeN[(size_t)tok * 64 + 32 + r] = s; }
    else { P.ropeD[(size_t)tok * 32 + (r - 32)] = c; P.ropeD[(size_t)tok * 32 + 16 + (r - 32)] = s; }
  }
  {
    const int lane = t & 63, gw = bid * 4 + (t >> 6), ngw = nb * 4;
    for (int i = gw; i < 2 * 2 * 64; i += ngw) {
      const int lk = i >> 6, e = i & 63;
      const float* pos = P.nsa_cmp_pos + (size_t)lk * 2048;
      const float* w = P.nsa_cmp_w + (size_t)lk * 2048 * 64;
      float a = 0.f;
#pragma unroll 8
      for (int k = lane; k < 2048; k += 64) a += pos[k] * w[(size_t)k * 64 + e];
      a = wave_sum(a);
      if (lane == 0) P.cmpbias[i] = a;
    }
  }
  for (size_t i = gtid; i < 2 * 2 * 64 * 64; i += gstride) {
    const int which = (int)(i / (2 * 64 * 64)), r = (int)(i % (2 * 64 * 64));
    const int g = r / (64 * 64), o = r % (64 * 64);
    u16* base = which ? P.VC : P.KC;
    base[(size_t)g * (S + 64) * 64 + (size_t)S * 64 + o] = 0;
  }
}

constexpr int GST = 144;
constexpr int G_BOFF = 128 * GST;
constexpr int G_RS_OFF = 71680;

DI float ssq8(const u32x4& v) {
  float s = 0.f;
  float a;
  a = bflo(v.x); s += a * a; a = bfhi(v.x); s += a * a;
  a = bflo(v.y); s += a * a; a = bfhi(v.y); s += a * a;
  a = bflo(v.z); s += a * a; a = bfhi(v.z); s += a * a;
  a = bflo(v.w); s += a * a; a = bfhi(v.w); s += a * a;
  return s;
}

template <bool SSQ>
DI void gemm_mainloop(const u16* __restrict__ A, int lda, const u16* __restrict__ Bt, int ldb, int K, char* sm, f32x16 (&acc)[2][2]) {
  const int tid = threadIdx.x, lane = tid & 63, wave = tid >> 6;
  const int wr = wave >> 1, wc = wave & 1;
  const int lrow = tid >> 3, lcol = (tid & 7) * 8;
  char* As = sm; char* Bs = sm + G_BOFF;
  u32x4 ra[4], rb[4];
  float ssq[4] = {0.f, 0.f, 0.f, 0.f};
#pragma unroll
  for (int i = 0; i < 4; ++i) {
    ra[i] = *(const u32x4*)(A + (size_t)(lrow + 32 * i) * lda + lcol);
    rb[i] = *(const u32x4*)(Bt + (size_t)(lrow + 32 * i) * ldb + lcol);
  }
  const int aoff = (wr * 64 + (lane & 31)) * GST + (lane >> 5) * 16;
  const int boff = (wc * 64 + (lane & 31)) * GST + (lane >> 5) * 16;
  for (int k0 = 0; k0 < K; k0 += 64) {
    __syncthreads();
#pragma unroll
    for (int i = 0; i < 4; ++i) {
      *(u32x4*)(As + (lrow + 32 * i) * GST + lcol * 2) = ra[i];
      *(u32x4*)(Bs + (lrow + 32 * i) * GST + lcol * 2) = rb[i];
      if (SSQ) ssq[i] += ssq8(ra[i]);
    }
    __syncthreads();
    if (k0 + 64 < K) {
#pragma unroll
      for (int i = 0; i < 4; ++i) {
        ra[i] = *(const u32x4*)(A + (size_t)(lrow + 32 * i) * lda + k0 + 64 + lcol);
        rb[i] = *(const u32x4*)(Bt + (size_t)(lrow + 32 * i) * ldb + k0 + 64 + lcol);
      }
    }
#pragma unroll
    for (int ks = 0; ks < 4; ++ks) {
      bf16x8 af[2], bfr[2];
#pragma unroll
      for (int i = 0; i < 2; ++i) af[i] = *(const bf16x8*)(As + aoff + i * 32 * GST + ks * 32);
#pragma unroll
      for (int j = 0; j < 2; ++j) bfr[j] = *(const bf16x8*)(Bs + boff + j * 32 * GST + ks * 32);
#pragma unroll
      for (int i = 0; i < 2; ++i)
#pragma unroll
        for (int j = 0; j < 2; ++j) acc[i][j] = MFMA32(af[i], bfr[j], acc[i][j]);
    }
  }
  __syncthreads();
  if (SSQ) {
    float* rs = (float*)(sm + G_RS_OFF);
#pragma unroll
    for (int i = 0; i < 4; ++i) {
      float s = ssq[i];
      s += __shfl_xor(s, 1); s += __shfl_xor(s, 2); s += __shfl_xor(s, 4);
      if ((tid & 7) == 0) rs[lrow + 32 * i] = rsqrtf(s * (1.f / (float)K) + 1e-6f);
    }
  }
}

DI void zero_acc(f32x16 (&acc)[2][2]) {
#pragma unroll
  for (int i = 0; i < 2; ++i)
#pragma unroll
    for (int j = 0; j < 2; ++j)
#pragma unroll
      for (int r = 0; r < 16; ++r) acc[i][j][r] = 0.f;
}

constexpr int EPS_LD = 132;
DI void acc_to_lds(const f32x16 (&acc)[2][2], float* tile) {
  const int lane = threadIdx.x & 63, wave = threadIdx.x >> 6;
  const int wr = wave >> 1, wc = wave & 1;
#pragma unroll
  for (int i = 0; i < 2; ++i)
#pragma unroll
    for (int j = 0; j < 2; ++j)
#pragma unroll
      for (int r = 0; r < 16; ++r)
        tile[(wr * 64 + i * 32 + crow(r, lane >> 5)) * EPS_LD + wc * 64 + j * 32 + (lane & 31)] = acc[i][j][r];
}

DI float log_sigmoid(float x) { return fminf(x, 0.f) - log1pf(expf(-fabsf(x))); }
DI float sigmoidf_(float x) { return 1.f / (1.f + expf(-x)); }

DI void store32_bf16(u16* dst, const float* o) {
  u32x4* d4 = (u32x4*)dst;
#pragma unroll
  for (int i = 0; i < 4; ++i)
    d4[i] = mk4(pack2(o[8 * i], o[8 * i + 1]), pack2(o[8 * i + 2], o[8 * i + 3]), pack2(o[8 * i + 4], o[8 * i + 5]), pack2(o[8 * i + 6], o[8 * i + 7]));
}

__device__ __forceinline__ void inproj_epilogue_half(const Params& P, int l, int mt, int nt, int half, const float* tile, const float* rs) {
  const int tid = threadIdx.x, lane = tid & 63, wave = tid >> 6;
  const int hl = wave >> 1, h32 = wave & 1;
  const int sg = 2 * nt + hl;
  const int rloc = half * 64 + lane;
  const int tok = mt * 128 + rloc;
  const float rstd = rs[rloc];
  if (sg >= 45) return;
  float v[64];
  {
    const f32x4* src = (const f32x4*)(tile + rloc * EPS_LD + hl * 64);
#pragma unroll
    for (int i = 0; i < 16; ++i) { f32x4 t = src[i]; v[4 * i] = t[0] * rstd; v[4 * i + 1] = t[1] * rstd; v[4 * i + 2] = t[2] * rstd; v[4 * i + 3] = t[3] * rstd; }
  }
  const u32 hmask = (u32)(-(int)h32);
#define VO(i) __uint_as_float((__float_as_uint(v[32 + (i)]) & hmask) | (__float_as_uint(v[(i)]) & ~hmask))
  if (sg == 44) {
    if (h32 == 0) {
      const int chunk = tok >> 6;
#pragma unroll
      for (int hd = 0; hd < 4; ++hd) {
        float x = log_sigmoid(v[hd] + P.fox_f_bias[l * 4 + hd]);
#pragma unroll
        for (int o = 1; o < 64; o <<= 1) { float t = __shfl_up(x, o); if (lane >= o) x += t; }
        P.cloc[(size_t)hd * S + tok] = x;
        if (lane == 63) P.ctot[chunk * 4 + hd] = x;
      }
    } else {
      float* g = P.gates + (size_t)tok * 24;
#pragma unroll
      for (int i = 0; i < 24; ++i) g[i] = sigmoidf_(v[4 + i]);
    }
    return;
  }
  float o[32];
  const bool is_vt = (sg >= 8 && sg < 12) || (sg == 26 || sg == 27) || (sg == 30 || sg == 31) || (sg >= 40);
  const bool is_raw = (sg >= 20 && sg < 24);
  const bool is_diff = (sg >= 32 && sg < 40);
  if (is_vt) {
    if (sg == 26 || sg == 27) {
      const int key = tok & 63, G = key >> 5, h4 = (key & 31) >> 3, j = key & 7;
      unsigned char* b8 = P.VS8t + (size_t)(sg - 26) * 64 * S + (size_t)(tok >> 6) * 4096 + G * 2048 + h4 * 128 + j;
#pragma unroll
      for (int i = 0; i < 32; i += 2) {
        const int wd = __builtin_amdgcn_cvt_pk_fp8_f32(VO(i), VO(i + 1), 0, false);
        const int d0 = h32 * 32 + i, d1 = d0 + 1;
        b8[(d0 >> 4) * 512 + (d0 & 15) * 8] = (unsigned char)(wd & 0xff);
        b8[(d1 >> 4) * 512 + (d1 & 15) * 8] = (unsigned char)((wd >> 8) & 0xff);
      }
      return;
    }
    u16* base;
    if (sg < 12) base = P.VFt + (size_t)(sg - 8) * 64 * S;
    else if (sg < 32) base = P.VWt + (size_t)(sg - 30) * 64 * S;
    else base = P.VDt + (size_t)(sg - 40) * 64 * S;
#pragma unroll
    for (int i = 0; i < 32; ++i) base[(size_t)(h32 * 32 + i) * S + tok] = f2bf(VO(i));
    return;
  }
  if (is_raw) {
    u16* base = (sg < 22) ? P.KC + (size_t)(sg - 20) * (S + 64) * 64 : P.VC + (size_t)(sg - 22) * (S + 64) * 64;
#pragma unroll
    for (int i = 0; i < 32; ++i) o[i] = VO(i);
    store32_bf16(base + (size_t)tok * 64 + h32 * 32, o);
    return;
  }
  if (is_diff) {
    const float* w = (sg < 36 ? P.diff_q_norm_w : P.diff_k_norm_w) + l * 32;
    float ss = 0.f;
#pragma unroll
    for (int i = 0; i < 32; ++i) ss += VO(i) * VO(i);
    const float rn = rsqrtf(ss * (1.f / 32.f) + 1e-6f);
    const float sc = (sg < 36) ? 0.17677669529663687f * LOG2E : 1.f;
    const float* rp = P.ropeD + (size_t)tok * 32;
#pragma unroll
    for (int i = 0; i < 16; ++i) {
      const float y1 = VO(i) * rn * w[i], y2 = VO(16 + i) * rn * w[16 + i];
      const float c = rp[i], s = rp[16 + i];
      o[i] = (y1 * c - y2 * s) * sc;
      o[16 + i] = (y2 * c + y1 * s) * sc;
    }
    u16* base = (sg < 36) ? P.QD + (size_t)(sg - 32) * S * 64 : P.KD + (size_t)(sg - 36) * S * 64;
    store32_bf16(base + (size_t)tok * 64 + h32 * 32, o);
    return;
  }
  const float* w;
  if (sg < 4) w = P.fox_q_norm_w + l * 64; else if (sg < 8) w = P.fox_k_norm_w + l * 64; else if (sg < 20) w = P.nsa_q_norm_w + l * 64; else w = P.nsa_k_norm_w + l * 64;
  float ss = 0.f;
#pragma unroll
  for (int i = 0; i < 64; ++i) ss += v[i] * v[i];
  const float rn = rsqrtf(ss * (1.f / 64.f) + 1e-6f);
  const float qs = 0.125f * LOG2E;
  if (sg < 8) {
    const float sc = (sg < 4) ? qs : 1.f;
#pragma unroll
    for (int i = 0; i < 32; ++i) o[i] = VO(i) * rn * w[h32 * 32 + i] * sc;
    u16* base = (sg < 4) ? P.QF + (size_t)sg * S * 64 : P.KF + (size_t)(sg - 4) * S * 64;
    store32_bf16(base + (size_t)tok * 64 + h32 * 32, o);
    return;
  }
  const float* rp = P.ropeN + (size_t)tok * 64;
  const float sc = (sg < 20) ? qs : 1.f;
  if (sg < 20) {
#pragma unroll
    for (int i = 0; i < 32; ++i) o[i] = VO(i) * rn * w[h32 * 32 + i] * sc;
    store32_bf16(P.QN + ((size_t)(sg - 12) * S + tok) * 64 + h32 * 32, o);
  }
#pragma unroll
  for (int i = 0; i < 32; ++i) {
    const float y1 = v[i] * rn * w[i], y2 = v[32 + i] * rn * w[32 + i];
    const float c = rp[i], s = rp[32 + i];
    o[i] = (h32 == 0 ? (y1 * c - y2 * s) : (y2 * c + y1 * s)) * sc;
  }
  if (sg == 24 || sg == 25) {
    const int key = tok & 63, G = key >> 5, r32 = key & 31, t = (r32 >> 2) & 1, i = ((r32 >> 3) << 2) | (r32 & 3);
    unsigned char* d8 = P.KS8 + (size_t)(sg - 24) * S * 64 + (size_t)(tok >> 6) * 4096 + ((G * 2 + t) * 2 + h32) * 512 + i * 8;
#pragma unroll
    for (int h4 = 0; h4 < 4; ++h4) {
      int w0 = 0, w1 = 0;
      w0 = __builtin_amdgcn_cvt_pk_fp8_f32(o[8 * h4], o[8 * h4 + 1], w0, false);
      w0 = __builtin_amdgcn_cvt_pk_fp8_f32(o[8 * h4 + 2], o[8 * h4 + 3], w0, true);
      w1 = __builtin_amdgcn_cvt_pk_fp8_f32(o[8 * h4 + 4], o[8 * h4 + 5], w1, false);
      w1 = __builtin_amdgcn_cvt_pk_fp8_f32(o[8 * h4 + 6], o[8 * h4 + 7], w1, true);
      *(u32x2*)(d8 + h4 * 128) = mk2((u32)w0, (u32)w1);
    }
    return;
  }
  u16* base;
  if (sg < 20) base = P.QR + (size_t)(sg - 12) * S * 64;
  else base = P.KW + (size_t)(sg - 28) * S * 64;
  store32_bf16(base + (size_t)tok * 64 + h32 * 32, o);
}

#undef VO
__device__ __forceinline__ void phase_inproj(const Params& P, int l, char* smem) {
  const u16* Wt = P.WinT + (size_t)l * NINP * D;
  float* tile = (float*)smem;
  const float* rs = (const float*)(smem + G_RS_OFF);
  for (int it = blockIdx.x; it < 128 * 23; it += gridDim.x) {
    const int mt = it / 23, nt = it % 23;
    f32x16 acc[2][2];
    zero_acc(acc);
    gemm_mainloop<true>(P.hb + (size_t)mt * 128 * D, D, Wt + (size_t)nt * 128 * D, D, D, smem, acc);
    acc_to_lds(acc, tile);
    __syncthreads();
#pragma unroll 1
    for (int half = 0; half < 2; ++half) inproj_epilogue_half(P, l, mt, nt, half, tile, rs);
  }
}

__device__ __forceinline__ void phase_compress(const Params& P, int l, char* smem) {
  float* tile = (float*)smem;
  for (int it = blockIdx.x; it < 32; it += gridDim.x) {
    const int kv = it >> 4, g = (it >> 3) & 1, mt = it & 7;
    const u16* A = (kv ? P.VC : P.KC) + (size_t)g * (S + 64) * 64 + (size_t)mt * 128 * 1024;
    const u16* Bt = P.CmpWT + (size_t)(l * 2 + kv) * 128 * 2048;
    const float* bias = P.cmpbias + (l * 2 + kv) * 64;
    f32x16 acc[2][2];
    zero_acc(acc);
    gemm_mainloop<false>(A, 1024, Bt, 2048, 2048, smem, acc);
    acc_to_lds(acc, tile);
    __syncthreads();
#pragma unroll 1
    for (int half = 0; half < 2; ++half) {
      {
        const int lane = threadIdx.x & 63, wave = threadIdx.x >> 6;
        const int idx = mt * 128 + half * 64 + lane;
        float v[64];
        const f32x4* src = (const f32x4*)(tile + (half * 64 + lane) * EPS_LD);
#pragma unroll
        for (int i = 0; i < 16; ++i) { f32x4 t = src[i]; v[4 * i] = t[0] + bias[4 * i]; v[4 * i + 1] = t[1] + bias[4 * i + 1]; v[4 * i + 2] = t[2] + bias[4 * i + 2]; v[4 * i + 3] = t[3] + bias[4 * i + 3]; }
        float vo[16];
#pragma unroll
        for (int i = 0; i < 4; ++i) { f32x4 t = src[wave * 4 + i]; const float* bb = bias + wave * 16 + 4 * i; vo[4 * i] = t[0] + bb[0]; vo[4 * i + 1] = t[1] + bb[1]; vo[4 * i + 2] = t[2] + bb[2]; vo[4 * i + 3] = t[3] + bb[3]; }
        if (kv == 0) {
          const float* w = P.nsa_k_norm_w + l * 64;
          float ss = 0.f;
#pragma unroll
          for (int i = 0; i < 64; ++i) ss += v[i] * v[i];
          const float rn = rsqrtf(ss * (1.f / 64.f) + 1e-6f);
          u32 o[8];
#pragma unroll
          for (int i = 0; i < 8; ++i) o[i] = pack2(vo[2 * i] * rn * w[wave * 16 + 2 * i], vo[2 * i + 1] * rn * w[wave * 16 + 2 * i + 1]);
          u32x4* dp = (u32x4*)(P.KCC + ((size_t)g * 1024 + idx) * 64 + wave * 16);
          dp[0] = mk4(o[0], o[1], o[2], o[3]);
          dp[1] = mk4(o[4], o[5], o[6], o[7]);
        } else {
#pragma unroll
          for (int i = 0; i < 16; ++i) P.VCCt[((size_t)g * 64 + wave * 16 + i) * 1024 + idx] = f2bf(vo[i]);
        }
      }
    }
  }
}

constexpr int AK_ST = 144;
constexpr int AV_ST = 136;
constexpr int AT_VOFF = 64 * AK_ST;
constexpr int AT_COFF = AT_VOFF + 64 * AV_ST;
constexpr int AT_STAGE = AT_COFF + 256;
constexpr int AT_MISC = 2 * AT_STAGE;

struct TileRegs { u32x4 k[2]; u32x4 v[2]; };

DI void tile_load(int t, TileRegs& r, const u16* __restrict__ K, const u16* __restrict__ Vt, size_t ldv, int key0, bool with_v) {
#pragma unroll
  for (int i = 0; i < 2; ++i) {
    const int c = t + 256 * i, row = c >> 3, part = c & 7;
    r.k[i] = *(const u32x4*)(K + (size_t)(key0 + row) * 64 + part * 8);
    if (with_v) r.v[i] = *(const u32x4*)(Vt + (size_t)row * ldv + key0 + part * 8);
  }
}
DI void tile_store(int t, const TileRegs& r, char* st, bool with_v) {
#pragma unroll
  for (int i = 0; i < 2; ++i) {
    const int c = t + 256 * i, row = c >> 3, part = c & 7;
    *(u32x4*)(st + row * AK_ST + part * 16) = r.k[i];
    if (with_v) {
      u32x2* d = (u32x2*)(st + AT_VOFF + row * AV_ST + part * 16);
      d[0] = mk2(r.v[i].x, r.v[i].y);
      d[1] = mk2(r.v[i].z, r.v[i].w);
    }
  }
}
DI bf16x8 pack_p(const f32x16& p, int sp) {
  u32x4 u = mk4(pack2(p[8 * sp], p[8 * sp + 1]), pack2(p[8 * sp + 2], p[8 * sp + 3]), pack2(p[8 * sp + 4], p[8 * sp + 5]), pack2(p[8 * sp + 6], p[8 * sp + 7]));
  return __builtin_bit_cast(bf16x8, u);
}
template <int NKS, bool ZINIT>
DI void qk_half(int tid, const char* st, int dofs_bytes, int kt, const bf16x8 (&qf)[NKS], f32x16& s) {
  const int lane = tid & 63;
  const char* base = st + (kt * 32 + (lane & 31)) * AK_ST + (lane >> 5) * 16 + dofs_bytes;
#pragma unroll
  for (int ks = 0; ks < NKS; ++ks) {
    const bf16x8 a = *(const bf16x8*)(base + ks * 32);
    if (ZINIT && ks == 0) { const f32x16 z = {0.f, 0.f, 0.f, 0.f, 0.f, 0.f, 0.f, 0.f, 0.f, 0.f, 0.f, 0.f, 0.f, 0.f, 0.f, 0.f}; s = MFMA32(a, qf[ks], z); }
    else s = MFMA32(a, qf[ks], s);
  }
}
DI void pv_half(int tid, const char* st, int kt, const f32x16& p, f32x16 (&o)[2]) {
  const int lane = tid & 63;
  const char* vb = st + AT_VOFF + (lane & 31) * AV_ST + (lane >> 5) * 8 + kt * 64;
#pragma unroll
  for (int sp = 0; sp < 2; ++sp) {
    const bf16x8 pb = pack_p(p, sp);
#pragma unroll
    for (int dt = 0; dt < 2; ++dt) {
      const char* a = vb + dt * 32 * AV_ST + sp * 32;
      const u32x2 lo = *(const u32x2*)a, hi = *(const u32x2*)(a + 16);
      const u32x4 u = mk4(lo.x, lo.y, hi.x, hi.y);
      o[dt] = MFMA32(__builtin_bit_cast(bf16x8, u), pb, o[dt]);
    }
  }
}
DI void load_q4(int tid, bf16x8 (&qf)[4], const u16* __restrict__ Q, int tok) {
  const int lane = tid & 63;
  const u16* b = Q + (size_t)tok * 64 + (lane >> 5) * 8;
#pragma unroll
  for (int ks = 0; ks < 4; ++ks) qf[ks] = *(const bf16x8*)(b + ks * 16);
}
DI float max_abs64(int tid, const float* w) {
  return wave_max(fabsf(w[tid & 63]));
}

struct AttnArgs {
  const u16* K; const u16* Vt; size_t ldv;
  int t0, t1;
  int q;
  int wq0;
  float M2;
  int dofs;
  int lim_hi, lim_lo, whi, wlo;
  int mask_hi, mask_lo;
  float cq; const float* cloc; const float* base;
};

template <int MODE, int NKS, bool MASK>
DI void attn_tile(int tid, const AttnArgs& a, const char* cur, int key0, int lim_hi, int lim_lo, const bf16x8 (&qf)[NKS], f32x16 (&o)[2], float& l) {
  const int h = (tid & 63) >> 5;
#pragma unroll
  for (int kt = 0; kt < 2; ++kt) {
    f32x16 s;
    if (MODE == 0) {
      const float* ckb = (const float*)(cur + AT_COFF);
#pragma unroll
      for (int rg = 0; rg < 4; ++rg) {
        const f32x4 c4 = *(const f32x4*)(ckb + 32 * kt + 8 * rg + 4 * h);
#pragma unroll
        for (int i = 0; i < 4; ++i) s[4 * rg + i] = a.cq - c4[i];
      }
      qk_half<NKS, false>(tid, cur, a.dofs, kt, qf, s);
    } else {
      qk_half<NKS, true>(tid, cur, a.dofs, kt, qf, s);
    }
#pragma unroll
    for (int i = 0; i < 16; ++i) {
      float p = __builtin_amdgcn_exp2f(s[i]);
      if (MASK) { const int key = key0 + 32 * kt + crow(i, h); if (key > lim_hi || key < lim_lo) p = 0.f; }
      s[i] = p; l += p;
    }
    pv_half(tid, cur, kt, s, o);
  }
}
template <int MODE, int NKS, bool PF2 = false>
DI void attn_loop(int tid, const AttnArgs& a, const bf16x8 (&qf)[NKS], f32x16 (&o)[2], float& l, char* smem) {
  TileRegs rA, rB; float cbA = 0.f, cbB = 0.f;
  if (a.t0 >= a.t1) return;
  tile_load(tid, rA, a.K, a.Vt, a.ldv, a.t0 * 64, true);
  if (MODE == 0 && tid < 64) cbA = a.cloc[a.t0 * 64 + tid];
  tile_store(tid, rA, smem, true);
  if (MODE == 0 && tid < 64) ((float*)(smem + AT_COFF))[tid] = (a.base[a.t0] + cbA) * LOG2E;
  __syncthreads();
  auto step = [&](int t, TileRegs& rs, float& cbs, TileRegs& rl, float& cbl, int dist) {
    char* cur = smem + ((t - a.t0) & 1) * AT_STAGE;
    char* nxt = smem + ((t - a.t0 + 1) & 1) * AT_STAGE;
    if (t + dist < a.t1) {
      tile_load(tid, rl, a.K, a.Vt, a.ldv, (t + dist) * 64, true);
      if (MODE == 0 && tid < 64) cbl = a.cloc[(t + dist) * 64 + tid];
    }
    const int key0 = t * 64;
    bool active, need_mask;
    if (MODE == 0 || MODE == 3) { active = key0 <= a.wq0 + 31; need_mask = key0 + 63 > a.wq0; }
    else if (MODE == 1) { const int nmax_w = (a.wq0 + 31 - 31) >> 4; active = (a.wq0 + 31 >= 31) && key0 <= nmax_w; need_mask = true; }
    else if (MODE == 2) { active = (key0 <= a.wq0 + 31) && (key0 + 63 >= a.wq0 - 511); need_mask = (key0 + 63 > a.wq0) || (key0 < a.wq0 + 31 - 511); }
    else { active = (key0 <= a.whi) && (key0 + 63 >= a.wlo); need_mask = (key0 + 63 > a.mask_hi) || (key0 < a.mask_lo); }
    if (active) {
      int lim_hi, lim_lo;
      if (MODE == 0 || MODE == 3) { lim_hi = a.q; lim_lo = 0; }
      else if (MODE == 1) { lim_hi = (a.q >= 31) ? ((a.q - 31) >> 4) : -1; lim_lo = 0; }
      else if (MODE == 2) { lim_hi = a.q; lim_lo = a.q - 511; }
      else { lim_hi = a.lim_hi; lim_lo = a.lim_lo; }
      if (__builtin_amdgcn_readfirstlane((int)need_mask)) attn_tile<MODE, NKS, true>(tid, a, cur, key0, lim_hi, lim_lo, qf, o, l);
      else attn_tile<MODE, NKS, false>(tid, a, cur, key0, lim_hi, lim_lo, qf, o, l);
    }
    if (t + 1 < a.t1) {
      tile_store(tid, rs, nxt, true);
      if (MODE == 0 && tid < 64) ((float*)(nxt + AT_COFF))[tid] = (a.base[t + 1] + cbs) * LOG2E;
    }
    __syncthreads();
  };
  if (!PF2) {
    for (int t = a.t0; t < a.t1; ++t) step(t, rA, cbA, rA, cbA, 1);
  } else {
    if (a.t0 + 1 < a.t1) { tile_load(tid, rA, a.K, a.Vt, a.ldv, (a.t0 + 1) * 64, true); if (MODE == 0 && tid < 64) cbA = a.cloc[(a.t0 + 1) * 64 + tid]; }
    for (int t = a.t0; t < a.t1; t += 2) {
      step(t, rA, cbA, rB, cbB, 2);
      if (t + 1 >= a.t1) break;
      step(t + 1, rB, cbB, rA, cbA, 2);
    }
  }
}

DI void zero_o(f32x16 (&o)[2]) {
#pragma unroll
  for (int d = 0; d < 2; ++d)
#pragma unroll
    for (int i = 0; i < 16; ++i) o[d][i] = 0.f;
}

DI void fox_chunk_bases(int tid, const Params& P, int hd, float* base, float* wtot) {
  const int lane = tid & 63, wave = tid >> 6;
  const float x = P.ctot[tid * 4 + hd];
  float inc = x;
#pragma unroll
  for (int o = 1; o < 64; o <<= 1) { float t = __shfl_up(inc, o); if (lane >= o) inc += t; }
  if (lane == 63) wtot[wave] = inc;
  __syncthreads();
  float off = 0.f;
  for (int w = 0; w < wave; ++w) off += wtot[w];
  base[tid] = inc - x + off;
  __syncthreads();
}

__device__ __forceinline__ void fox_item(const Params& P, int l, int hd, int qb, char* smem) {
  const int tid = opaque_tid(), lane = tid & 63, wave = tid >> 6, h = lane >> 5;
  float* base = (float*)(smem + AT_MISC);
  float* wtot = base + 256;
  fox_chunk_bases(tid, P, hd, base, wtot);
  const float M2 = 8.f * max_abs64(tid, P.fox_q_norm_w + l * 64) * max_abs64(tid, P.fox_k_norm_w + l * 64) * LOG2E * 1.01f + 0.1f;
  const int wq0 = qb * 128 + wave * 32, q = wq0 + (lane & 31);
  AttnArgs a;
  a.K = P.KF + (size_t)hd * S * 64; a.Vt = P.VFt + (size_t)hd * 64 * S; a.ldv = S;
  a.t1 = 2 * qb + 2; a.q = q; a.wq0 = wq0; a.M2 = M2;
  a.cloc = P.cloc + (size_t)hd * S; a.base = base;
  {
    const bool skip = (tid + 1 < 2 * qb) && ((base[2 * qb] - base[tid + 1]) * LOG2E < -160.f);
    a.t0 = __syncthreads_count(skip ? 1 : 0);
  }
  a.cq = (base[q >> 6] + a.cloc[q]) * LOG2E - M2;
  bf16x8 qf[4];
  load_q4(tid, qf, P.QF + (size_t)hd * S * 64, q);
  f32x16 o[2]; zero_o(o);
  float ls = 0.f;
  a.dofs = 0;
  attn_loop<0, 4, true>(tid, a, qf, o, ls, smem);
  ls += __shfl_xor(ls, 32);
  const float inv = (ABLATE & 1) ? 0.f : 1.f / ls;
  u16* dst = P.mix + (size_t)q * 1024 + hd * 64 + 4 * h;
#pragma unroll
  for (int dt = 0; dt < 2; ++dt)
#pragma unroll
    for (int rg = 0; rg < 4; ++rg)
      *(u32x2*)(dst + 32 * dt + 8 * rg) = mk2(pack2(o[dt][4 * rg] * inv, o[dt][4 * rg + 1] * inv), pack2(o[dt][4 * rg + 2] * inv, o[dt][4 * rg + 3] * inv));
}

__device__ __forceinline__ void diff_item(const Params& P, int l, int hd, int qb, char* smem) {
  const int tid = opaque_tid(), lane = tid & 63, wave = tid >> 6, h = lane >> 5;
  const float mq = wave_max(fabsf(P.diff_q_norm_w[l * 32 + (lane & 31)])), mk = wave_max(fabsf(P.diff_k_norm_w[l * 32 + (lane & 31)]));
  const float M2 = 5.656854249f * mq * mk * LOG2E * 1.01f + 0.1f;
  const float* lv = P.diff_lambda + l * 128;
  float d1 = (lane < 32) ? lv[lane] * lv[32 + lane] : 0.f, d2 = (lane < 32) ? lv[64 + lane] * lv[96 + lane] : 0.f;
  d1 = wave_sum(d1); d2 = wave_sum(d2);
  const float lam_init = 0.8f - 0.6f * expf(-0.3f * (float)l);
  const float lam = expf(d1) - expf(d2) + lam_init;
  const int wq0 = qb * 128 + wave * 32, q = wq0 + (lane & 31);
  AttnArgs a;
  a.K = P.KD + (size_t)hd * S * 64; a.Vt = P.VDt + (size_t)hd * 64 * S; a.ldv = S;
  a.t0 = 0; a.t1 = 2 * qb + 2; a.q = q; a.wq0 = wq0; a.M2 = M2; a.cq = 0.f; a.cloc = nullptr; a.base = nullptr;
  float* stash = P.dstash + (size_t)blockIdx.x * (128 * 64) + tid;
  f32x16 o[2];
#pragma unroll 1
  for (int c = 0; c < 2; ++c) {
    const int tid = opaque_tid(), lane = tid & 63, h = lane >> 5;
    bf16x8 qf[2];
    {
      const u16* b = P.QD + ((size_t)hd * S + q) * 64 + c * 32 + h * 8;
      qf[0] = *(const bf16x8*)b; qf[1] = *(const bf16x8*)(b + 16);
    }
    zero_o(o);
    float ls = 0.f;
    a.dofs = c * 64;
    attn_loop<3, 2>(tid, a, qf, o, ls, smem);
    ls += __shfl_xor(ls, 32);
    if (c == 0) {
      const float i0 = 1.f / ls;
#pragma unroll
      for (int dt = 0; dt < 2; ++dt)
#pragma unroll
        for (int i = 0; i < 16; ++i) stash[(dt * 16 + i) * 256] = o[dt][i] * i0;
    } else {
      const float i1 = lam / ls;
      float ss = 0.f;
#pragma unroll
      for (int dt = 0; dt < 2; ++dt)
#pragma unroll
        for (int i = 0; i < 16; ++i) { const float v = stash[(dt * 16 + i) * 256] - o[dt][i] * i1; o[dt][i] = v; ss += v * v; }
      ss += __shfl_xor(ss, 32);
      const float rn = rsqrtf(ss * (1.f / 64.f) + 1e-6f) * (1.f - lam_init);
      const float* sw = P.diff_subln_w + l * 64;
      u16* dst = P.mix + (size_t)q * 1024 + 768 + hd * 64 + 4 * h;
#pragma unroll
      for (int dt = 0; dt < 2; ++dt)
#pragma unroll
        for (int rg = 0; rg < 4; ++rg) {
          const int d0 = 32 * dt + 8 * rg + 4 * h;
          *(u32x2*)(dst + 32 * dt + 8 * rg) = mk2(pack2(o[dt][4 * rg] * rn * sw[d0], o[dt][4 * rg + 1] * rn * sw[d0 + 1]),
                                                 pack2(o[dt][4 * rg + 2] * rn * sw[d0 + 2], o[dt][4 * rg + 3] * rn * sw[d0 + 3]));
        }
    }
  }
}

struct SelFrags { u32x2 k[8]; u32x2 v[8]; };

DI void sel_load(int tid, SelFrags& f, const unsigned char* __restrict__ Kg, const unsigned char* __restrict__ Vtg, int b) {
  const int lane = tid & 63, i = lane & 15, h4 = lane >> 4;
  const int bu = __builtin_amdgcn_readfirstlane(b);
  const unsigned char* kb = Kg + (size_t)bu * 4096 + lane * 8;
  const unsigned char* vb = Vtg + (size_t)bu * 4096 + lane * 8;
  (void)i; (void)h4;
#pragma unroll
  for (int L = 0; L < 8; ++L) f.k[L] = *(const u32x2*)(kb + L * 512);
#pragma unroll
  for (int L = 0; L < 8; ++L) f.v[L] = *(const u32x2*)(vb + L * 512);
}
template <bool MASK>
DI void sel_compute_t(int tid, const SelFrags& f, const u32x2 (&qb)[2], int b, int qpos, float M2, f32x4 (&o)[4], f32x4& ol) {
  const int lane = tid & 63, h4 = lane >> 4;
  const float c0 = 8.f - M2;
  const u32x2 ones = mk2(0x38383838u, 0x38383838u);
#pragma unroll
  for (int G = 0; G < 2; ++G) {
    f32x4 s[2];
#pragma unroll
    for (int t = 0; t < 2; ++t) {
      s[t] = (f32x4){0.f, 0.f, 0.f, 0.f};
#pragma unroll
      for (int ks = 0; ks < 2; ++ks)
        s[t] = __builtin_amdgcn_mfma_f32_16x16x32_fp8_fp8(__builtin_bit_cast(long, f.k[G * 4 + t * 2 + ks]), __builtin_bit_cast(long, qb[ks]), s[t], 0, 0, 0);
    }
#pragma unroll
    for (int t = 0; t < 2; ++t)
#pragma unroll
      for (int r = 0; r < 4; ++r) {
        float p = __builtin_amdgcn_exp2f(s[t][r] * 0.0625f + c0);
        if (MASK) { const int key = b * 64 + 32 * G + 8 * h4 + 4 * t + r; if (key > qpos) p = 0.f; }
        s[t][r] = p;
      }
    int w0 = 0, w1 = 0;
    w0 = __builtin_amdgcn_cvt_pk_bf8_f32(s[0][0], s[0][1], w0, false);
    w0 = __builtin_amdgcn_cvt_pk_bf8_f32(s[0][2], s[0][3], w0, true);
    w1 = __builtin_amdgcn_cvt_pk_bf8_f32(s[1][0], s[1][1], w1, false);
    w1 = __builtin_amdgcn_cvt_pk_bf8_f32(s[1][2], s[1][3], w1, true);
    const u32x2 pb = mk2((u32)w0, (u32)w1);
#pragma unroll
    for (int dt = 0; dt < 4; ++dt)
      o[dt] = __builtin_amdgcn_mfma_f32_16x16x32_fp8_bf8(__builtin_bit_cast(long, f.v[G * 4 + dt]), __builtin_bit_cast(long, pb), o[dt], 0, 0, 0);
    ol = __builtin_amdgcn_mfma_f32_16x16x32_fp8_bf8(__builtin_bit_cast(long, ones), __builtin_bit_cast(long, pb), ol, 0, 0, 0);
  }
}
DI void sel_compute(int tid, const SelFrags& f, const u32x2 (&qb)[2], int b, int cur, int qpos, float M2, f32x4 (&o)[4], f32x4& ol) {
  if (__builtin_amdgcn_readfirstlane(b) == __builtin_amdgcn_readfirstlane(cur)) sel_compute_t<true>(tid, f, qb, b, qpos, M2, o, ol);
  else sel_compute_t<false>(tid, f, qb, b, qpos, M2, o, ol);
}

__device__ __forceinline__ void nsa_item(const Params& P, int l, int g, int qb, char* smem, int secmask = 7) {
  const int tid = opaque_tid(), lane = tid & 63, wave = tid >> 6, h = lane >> 5;
  const int q0 = qb * 128, wq0 = q0 + wave * 32, q = wq0 + (lane & 31), ql = wave * 32 + (lane & 31);
  const int item = g * 128 + qb;
  const float M2 = 8.f * max_abs64(tid, P.nsa_q_norm_w + l * 64) * max_abs64(tid, P.nsa_k_norm_w + l * 64) * LOG2E * 1.01f + 0.1f;
  unsigned char* sel = (unsigned char*)(smem + AT_MISC);
  unsigned char* nsel = sel + 2048;
  float* impA = P.impA + (size_t)item * 256 * 128;
  float* impB = P.impB + (size_t)item * 256 * 128;
  const u16* Kc = P.KCC + (size_t)g * 1024 * 64;
  const int ntc = ((q0 + 96) >> 10) + 1;
  const int nmaxq = (q >= 31) ? ((q - 31) >> 4) : -1;
  const int nmax_w = wq0 >> 4;

  {
    float lh[4] = {0.f, 0.f, 0.f, 0.f};
#pragma unroll 1
    for (int pass = 0; pass < 2; ++pass) {
      float inv[4];
      if (pass == 1) {
#pragma unroll
        for (int hh = 0; hh < 4; ++hh) { float t = lh[hh] + __shfl_xor(lh[hh], 32); inv[hh] = (t > 0.f) ? 1.f / t : 0.f; }
      }
      TileRegs r;
      tile_load(tid, r, Kc, nullptr, 0, 0, false);
      tile_store(tid, r, smem, false);
      __syncthreads();
      for (int t = 0; t < ntc; ++t) {
        char* cur = smem + (t & 1) * AT_STAGE;
        char* nxt = smem + ((t + 1) & 1) * AT_STAGE;
        const bool more = (t + 1 < ntc);
        if (more) tile_load(tid, r, Kc, nullptr, 0, (t + 1) * 64, false);
        const int key0 = t * 64;
        f32x16 ps[2];
#pragma unroll
        for (int kt = 0; kt < 2; ++kt)
#pragma unroll
          for (int i = 0; i < 16; ++i) ps[kt][i] = 0.f;
        if (key0 <= nmax_w) {
#pragma unroll
          for (int hh = 0; hh < 4; ++hh) {
            f32x16 s[2];
            bf16x8 qf[4];
            load_q4(tid, qf, P.QN + (size_t)(g * 4 + hh) * S * 64, q);
            qk_half<4, true>(tid, cur, 0, 0, qf, s[0]);
            qk_half<4, true>(tid, cur, 0, 1, qf, s[1]);
#pragma unroll
            for (int kt = 0; kt < 2; ++kt)
#pragma unroll
              for (int i = 0; i < 16; ++i) {
                float p = __builtin_amdgcn_exp2f(s[kt][i]);
                const int key = key0 + 32 * kt + crow(i, h);
                if (key > nmaxq) p = 0.f;
                if (pass == 0) lh[hh] += p; else ps[kt][i] += p * inv[hh];
              }
          }
        }
        if (pass == 1) {
#pragma unroll
          for (int kt = 0; kt < 2; ++kt)
#pragma unroll
            for (int rg = 0; rg < 4; ++rg) {
              const int j = 16 * t + 8 * kt + 2 * rg + h;
              impA[(size_t)j * 128 + ql] = ps[kt][4 * rg] + ps[kt][4 * rg + 1] + ps[kt][4 * rg + 2] + ps[kt][4 * rg + 3];
              impB[(size_t)j * 128 + ql] = ps[kt][4 * rg + 3];
            }
        }
        if (more) tile_store(tid, r, nxt, false);
        __syncthreads();
      }
    }
  }
  __threadfence_block();
  __syncthreads();
  {
    const int qt = tid >> 1, half = tid & 1;
    const int qp = q0 + qt, cur = qp >> 6;
    u32 lst[13];
#pragma unroll
    for (int i = 0; i < 13; ++i) lst[i] = 0u;
    for (int j0 = 1 + half; j0 <= cur - 2; j0 += 8) {
      float sc[4];
#pragma unroll
      for (int u = 0; u < 4; ++u) {
        const int j = j0 + 2 * u, jc = j <= cur - 2 ? j : 1;
        sc[u] = impA[(size_t)jc * 128 + qt] + impB[(size_t)(jc - 1) * 128 + qt];
      }
#pragma unroll
      for (int u = 0; u < 4; ++u) {
        const int j = j0 + 2 * u;
        u32 x = (j <= cur - 2) ? ((__float_as_uint(sc[u]) & 0xffffff00u) | (u32)j) : 0u;
#pragma unroll
        for (int i = 0; i < 13; ++i) { const u32 hi = max(lst[i], x); x = min(lst[i], x); lst[i] = hi; }
      }
    }
    u32 oth[13];
#pragma unroll
    for (int i = 0; i < 13; ++i) oth[i] = (u32)__shfl_xor((int)lst[i], 1);
#pragma unroll
    for (int k = 0; k < 13; ++k) {
      u32 x = oth[k];
#pragma unroll
      for (int i = 0; i < 13; ++i) { const u32 hi = max(lst[i], x); x = min(lst[i], x); lst[i] = hi; }
    }
    if (half == 0) {
      unsigned char* sp = sel + qt * 16;
      int n = 0;
      sp[n++] = 0;
      if (cur >= 1) sp[n++] = (unsigned char)cur;
      if (cur >= 2) sp[n++] = (unsigned char)(cur - 1);
      const int ncand = cur - 2 < 13 ? cur - 2 : 13;
#pragma unroll
      for (int i = 0; i < 13; ++i) if (i < ncand) sp[n++] = (unsigned char)(lst[i] & 0xffu);
      nsel[qt] = (unsigned char)n;
    }
  }
  __syncthreads();
  if (secmask & 2) {
    const unsigned char* Kg = P.KS8 + (size_t)g * S * 64; const unsigned char* Vtg = P.VS8t + (size_t)g * 64 * S;
    const int col = lane & 15, h4 = lane >> 4, hd = col & 3;
    const unsigned char* selw = sel + wave * 32 * 16;
    const unsigned char* nselw = nsel + wave * 32;
    auto loadq = [&](u32x2 (&qq)[2], int qi) {
      const int qp = wq0 + (qi < 32 ? qi : 31);
      const u16* b = P.QR + ((size_t)(g * 4 + hd) * S + qp) * 64 + 8 * h4;
#pragma unroll
      for (int ks = 0; ks < 2; ++ks) {
        const u32x4 qv = *(const u32x4*)(b + 32 * ks);
        int w0 = 0, w1 = 0;
        w0 = __builtin_amdgcn_cvt_pk_fp8_f32(bflo(qv.x) * 16.f, bfhi(qv.x) * 16.f, w0, false);
        w0 = __builtin_amdgcn_cvt_pk_fp8_f32(bflo(qv.y) * 16.f, bfhi(qv.y) * 16.f, w0, true);
        w1 = __builtin_amdgcn_cvt_pk_fp8_f32(bflo(qv.z) * 16.f, bfhi(qv.z) * 16.f, w1, false);
        w1 = __builtin_amdgcn_cvt_pk_fp8_f32(bflo(qv.w) * 16.f, bfhi(qv.w) * 16.f, w1, true);
        qq[ks] = mk2((u32)w0, (u32)w1);
      }
    };
    SelFrags fr[3];
    int lq = 0, lb = 0;
    auto issue = [&](SelFrags& f) {
      if (lq < 32) {
        sel_load(tid, f, Kg, Vtg, selw[lq * 16 + lb]);
        if (++lb == (int)nselw[lq]) { lb = 0; ++lq; }
      }
    };
    issue(fr[0]); issue(fr[1]);
    u32x2 qcur[2], qnext[2];
    loadq(qcur, 0); loadq(qnext, 1);
    f32x4 o[4];
#pragma unroll
    for (int dt = 0; dt < 4; ++dt) o[dt] = (f32x4){0.f, 0.f, 0.f, 0.f};
    f32x4 ol = (f32x4){0.f, 0.f, 0.f, 0.f};
    int cq = 0, cb = 0;
    while (cq < 32) {
#pragma unroll
      for (int slot = 0; slot < 3; ++slot) {
        if (cq < 32) {
          issue(fr[(slot + 2) % 3]);
          const int qp = wq0 + cq;
          sel_compute(tid, fr[slot], qcur, selw[cq * 16 + cb], qp >> 6, qp, M2, o, ol);
          if (++cb == (int)nselw[cq]) {
            const float lsum = ol[0];
            if (col < 4 && (!(secmask & 8) || lsum == 1.2345e33f)) {
              const float gs = (ABLATE & 4) ? 0.f : P.gates[(size_t)qp * 24 + (g * 4 + col) * 3 + 1] / lsum;
              u16* dst = P.mix + (size_t)qp * 1024 + 256 + (g * 4 + col) * 64 + 4 * h4;
#pragma unroll
              for (int dt = 0; dt < 4; ++dt)
                *(u32x2*)(dst + 16 * dt) = mk2(pack2(o[dt][0] * gs, o[dt][1] * gs), pack2(o[dt][2] * gs, o[dt][3] * gs));
            }
#pragma unroll
            for (int dt = 0; dt < 4; ++dt) o[dt] = (f32x4){0.f, 0.f, 0.f, 0.f};
            ol = (f32x4){0.f, 0.f, 0.f, 0.f}; cb = 0; ++cq;
            qcur[0] = qnext[0]; qcur[1] = qnext[1];
            loadq(qnext, cq + 1);
          }
        }
      }
    }
  }
  __threadfence_block();
  __syncthreads();
#pragma unroll 1
  for (int hh = 0; hh < ((secmask & 4) ? 4 : 0); ++hh) {
    const int H = g * 4 + hh;
#pragma unroll 1
    for (int br = 0; br < 2; ++br) {
      AttnArgs a;
      a.q = q; a.wq0 = wq0; a.M2 = M2; a.cq = 0.f; a.cloc = nullptr; a.base = nullptr; a.dofs = 0;
      bf16x8 qf[4];
      f32x16 o[2]; zero_o(o);
      float ls = 0.f;
      if (br == 0) {
        load_q4(tid, qf, P.QN + (size_t)H * S * 64, q);
        a.K = Kc; a.Vt = P.VCCt + (size_t)g * 64 * 1024; a.ldv = 1024; a.t0 = 0; a.t1 = ntc;
        a.lim_hi = nmaxq; a.lim_lo = 0; a.whi = nmax_w; a.wlo = 0; a.mask_hi = (wq0 >= 31) ? ((wq0 - 31) >> 4) : -1; a.mask_lo = 0;
      } else {
        load_q4(tid, qf, P.QR + (size_t)H * S * 64, q);
        a.K = P.KW + (size_t)g * S * 64; a.Vt = P.VWt + (size_t)g * 64 * S; a.ldv = S;
        a.t0 = (q0 >> 6) - 8 < 0 ? 0 : (q0 >> 6) - 8; a.t1 = (q0 >> 6) + 2;
        a.lim_hi = q; a.lim_lo = q - 511; a.whi = wq0 + 31; a.wlo = wq0 - 511; a.mask_hi = wq0; a.mask_lo = wq0 + 31 - 511;
      }
      attn_loop<4, 4, true>(tid, a, qf, o, ls, smem);
      ls += __shfl_xor(ls, 32);
      float gt = (ls > 0.f) ? P.gates[(size_t)q * 24 + H * 3 + (br == 0 ? 0 : 2)] / ls : 0.f;
      if ((ABLATE & 2) && br == 0) gt = 0.f;
      if ((ABLATE & 8) && br == 1) gt = 0.f;
      u16* dst = P.mix + (size_t)q * 1024 + 256 + H * 64 + 4 * h;
      if (!(secmask & 8) || ls == 1.2345e33f)
#pragma unroll
      for (int dt = 0; dt < 2; ++dt)
#pragma unroll
        for (int rg = 0; rg < 4; ++rg) {
          u32x2* pp = (u32x2*)(dst + 32 * dt + 8 * rg);
          const u32x2 old = *pp;
          const float r0 = bflo(old.x) + gt * o[dt][4 * rg];
          const float r1 = bfhi(old.x) + gt * o[dt][4 * rg + 1];
          const float r2 = bflo(old.y) + gt * o[dt][4 * rg + 2];
          const float r3 = bfhi(old.y) + gt * o[dt][4 * rg + 3];
          *pp = mk2(pack2(r0, r1), pack2(r2, r3));
        }
    }
  }
}

DI unsigned xcc_id() { return (unsigned)__builtin_amdgcn_s_getreg((3 << 11) | 20) & 0xFu; }

__device__ __forceinline__ void phase_attention(const Params& P, int l, char* smem, unsigned* counter, int secmask = 7, bool nsa_only = false) {
  int* slot = (int*)(smem + AT_MISC + 4096);
  const int mygrp = (int)(xcc_id() & 1u);
#pragma unroll 1
  for (int pass = 0; pass < 2; ++pass) {
    const int g = pass == 0 ? mygrp : 1 - mygrp;
    for (;;) {
      __syncthreads();
      if (threadIdx.x == 0) *slot = (int)atomicAdd(counter + g, 1u);
      __syncthreads();
      const int it = *slot;
      if (it >= 128) break;
      nsa_item(P, l, g, 127 - it, smem, secmask);
    }
  }
  for (;;) {
    __syncthreads();
    if (threadIdx.x == 0) *slot = (int)atomicAdd(counter + 2, 1u);
    __syncthreads();
    const int it = *slot;
    if (it >= 1024 || nsa_only) break;
    const int qb = 127 - (it >> 3), k = it & 7;
    if (k < 4) diff_item(P, l, k, qb, smem); else fox_item(P, l, k - 4, qb, smem);
  }
}

__device__ __forceinline__ void phase_outproj(const Params& P, int l, char* smem, bool dry = false) {
  const u16* Wt = P.WoutT + (size_t)l * D * D;
  float* tile = (float*)smem;
  const int tid = threadIdx.x;
  for (int it = blockIdx.x; it < 128 * 8; it += gridDim.x) {
    const int mt = it >> 3, nt = it & 7;
    f32x16 acc[2][2];
    zero_acc(acc);
    gemm_mainloop<false>(P.mix + (size_t)mt * 128 * D, D, Wt + (size_t)nt * 128 * D, D, D, smem, acc);
    acc_to_lds(acc, tile);
    __syncthreads();
    const int c4 = (tid & 31) * 4, r0 = tid >> 5;
#pragma unroll 4
    for (int i = 0; i < 16; ++i) {
      const int row = r0 + 8 * i;
      const size_t idx = (size_t)(mt * 128 + row) * D + nt * 128 + c4;
      const f32x4 a4 = *(const f32x4*)(tile + row * EPS_LD + c4);
      f32x4 h4 = *(const f32x4*)(P.out + idx);
      h4 += a4;
      if (!dry || h4[0] == 1.2345e33f) {
        *(f32x4*)(P.out + idx) = h4;
        *(u32x2*)(P.hb2 + idx) = mk2(pack2(h4[0], h4[1]), pack2(h4[2], h4[3]));
      }
    }
  }
}

constexpr int QT_ST = 272;
DI u32 ord_key(float x, u32 idx) {
  u32 u = __float_as_uint(x);
  u = (u & 0x80000000u) ? ~u : (u | 0x80000000u);
  return (u & 0xffffff80u) | idx;
}
DI float ord_val(u32 k) {
  return (k & 0x80000000u) ? __uint_as_float(k & 0x7fffff80u) : __uint_as_float((~k) & 0xffffff80u);
}
DI void merge16(u32 (&lst)[16], int xm) {
  u32 c[16];
#pragma unroll
  for (int i = 0; i < 16; ++i) { const u32 o = (u32)__shfl_xor((int)lst[15 - i], xm); c[i] = max(lst[i], o); }
#pragma unroll
  for (int st = 8; st > 0; st >>= 1)
#pragma unroll
    for (int i = 0; i < 16; ++i)
      if ((i & st) == 0) { const u32 a = max(c[i], c[i + st]), b = min(c[i], c[i + st]); c[i] = a; c[i + st] = b; }
#pragma unroll
  for (int i = 0; i < 16; ++i) lst[i] = c[i];
}

__device__ __forceinline__ void phase_peerq(const Params& P, int l, char* smem) {
  const u16* Wt = P.WqT + (size_t)l * 2048 * D;
  const int tid = threadIdx.x, lane = tid & 63, wave = tid >> 6, wr = wave >> 1, wc = wave & 1, h = lane >> 5;
  const float* rs = (const float*)(smem + G_RS_OFF);
  float* tile = (float*)smem;
  for (int it = blockIdx.x; it < 128 * 16; it += gridDim.x) {
    const int mt = it >> 4, nt = it & 15;
    f32x16 acc[2][2];
    zero_acc(acc);
    gemm_mainloop<true>(P.hb2 + (size_t)mt * 128 * D, D, Wt + (size_t)nt * 128 * D, D, D, smem, acc);
    __syncthreads();
#pragma unroll
    for (int i = 0; i < 2; ++i)
#pragma unroll
      for (int j = 0; j < 2; ++j)
#pragma unroll
        for (int r = 0; r < 16; ++r) {
          const int row = wr * 64 + i * 32 + crow(r, h);
          *(u16*)(smem + row * QT_ST + (wc * 64 + j * 32 + (lane & 31)) * 2) = f2bf(acc[i][j][r] * rs[row]);
        }
    __syncthreads();
    zero_acc(acc);
    {
      const u16* Bk = P.SubK + ((size_t)(l * 16 + nt) * 128 + wc * 64 + (lane & 31)) * 128 + h * 8;
      const char* Aq = smem + (wr * 64 + (lane & 31)) * QT_ST + h * 16;
#pragma unroll
      for (int ks = 0; ks < 8; ++ks) {
        bf16x8 af[2], bfr[2];
#pragma unroll
        for (int i = 0; i < 2; ++i) af[i] = *(const bf16x8*)(Aq + i * 32 * QT_ST + ks * 32);
#pragma unroll
        for (int j = 0; j < 2; ++j) bfr[j] = *(const bf16x8*)(Bk + (size_t)j * 32 * 128 + ks * 16);
#pragma unroll
        for (int i = 0; i < 2; ++i)
#pragma unroll
          for (int j = 0; j < 2; ++j) acc[i][j] = MFMA32(af[i], bfr[j], acc[i][j]);
      }
    }
    __syncthreads();
    acc_to_lds(acc, tile);
    __syncthreads();
#pragma unroll 1
    for (int half = 0; half < 2; ++half) {
      {
        const int row = half * 64 + (tid >> 2), part = tid & 3;
        u32 lst[16];
#pragma unroll
        for (int i = 0; i < 16; ++i) lst[i] = 0u;
        const f32x4* src = (const f32x4*)(tile + row * EPS_LD + part * 32);
#pragma unroll
        for (int c4 = 0; c4 < 8; ++c4) {
          const f32x4 v = src[c4];
#pragma unroll
          for (int e = 0; e < 4; ++e) {
            u32 x = ord_key(v[e], (u32)(part * 32 + c4 * 4 + e));
#pragma unroll
            for (int i = 0; i < 16; ++i) { const u32 hi = max(lst[i], x); x = min(lst[i], x); lst[i] = hi; }
          }
        }
        merge16(lst, 1);
        merge16(lst, 2);
        if (part == 0) {
          u32x4* dp = (u32x4*)(P.topk + ((size_t)(mt * 128 + row) * 16 + nt) * 16);
          dp[0] = mk4(lst[0], lst[1], lst[2], lst[3]); dp[1] = mk4(lst[4], lst[5], lst[6], lst[7]);
          dp[2] = mk4(lst[8], lst[9], lst[10], lst[11]); dp[3] = mk4(lst[12], lst[13], lst[14], lst[15]);
        }
      }
    }
  }
}

__device__ const unsigned char kCandIJ[50] = {
  0x00,0x01,0x02,0x03,0x04,0x05,0x06,0x07,0x08,0x09,0x0a,0x0b,0x0c,0x0d,0x0e,0x0f,
  0x10,0x11,0x12,0x13,0x14,0x15,0x16,0x17,
  0x20,0x21,0x22,0x23,0x24,
  0x30,0x31,0x32,0x33,
  0x40,0x41,0x42,
  0x50,0x51, 0x60,0x61, 0x70,0x71,
  0x80,0x90,0xa0,0xb0,0xc0,0xd0,0xe0,0xf0};
DI float gelu_exact(float x) { return 0.5f * x * (1.f + erff(x * 0.7071067811865476f)); }

__device__ __forceinline__ void phase_peer(const Params& P, int l, char* smem, bool dry = false) {
  const int tid = threadIdx.x, lane = tid & 63, wave = tid >> 6;
  char* wsm = smem + wave * 8192;
  u32* keys = (u32*)wsm;
  float* cv = (float*)(wsm + 1024);
  int* exps = (int*)(wsm + 1024 + 1664);
  float* esc = (float*)(wsm + 3200);
  float* wts = (float*)(wsm + 3712);
  float* uinv = (float*)(wsm + 4224);
  float* vinv = (float*)(wsm + 4736);
  unsigned char* xrow8 = (unsigned char*)(wsm + 5248);
  const unsigned char* U8 = P.U8 + (size_t)l * S * D;
  const unsigned char* V8 = P.V8 + (size_t)l * S * D;
  const float* Uinv = P.Uinv + l * S; const float* Vinv = P.Vinv + l * S;
  for (int it = blockIdx.x; it < S / 4; it += gridDim.x) {
    const int tok = it * 4 + wave;
    *(u32x4*)(keys + lane * 4) = *(const u32x4*)(P.topk + (size_t)tok * 256 + lane * 4);
    const u32x4 xa = *(const u32x4*)(P.hb2 + (size_t)tok * D + lane * 16), xb = *(const u32x4*)(P.hb2 + (size_t)tok * D + lane * 16 + 8);
    float rstd = wave_sum(ssq8(xa) + ssq8(xb));
    rstd = rsqrtf(rstd * (1.f / 1024.f) + 1e-6f);
    float xinv;
    {
      float xv[16] = {bflo(xa.x), bfhi(xa.x), bflo(xa.y), bfhi(xa.y), bflo(xa.z), bfhi(xa.z), bflo(xa.w), bfhi(xa.w),
                      bflo(xb.x), bfhi(xb.x), bflo(xb.y), bfhi(xb.y), bflo(xb.z), bfhi(xb.z), bflo(xb.w), bfhi(xb.w)};
      float m = 0.f;
#pragma unroll
      for (int i = 0; i < 16; ++i) m = fmaxf(m, fabsf(xv[i]));
      m = wave_max(m);
      const float sx = (m > 0.f) ? 240.f / m : 0.f;
      xinv = m * (1.f / 240.f);
      u32 o4[4];
#pragma unroll
      for (int i = 0; i < 4; ++i) {
        int wd = 0;
        wd = __builtin_amdgcn_cvt_pk_fp8_f32(xv[4 * i] * sx, xv[4 * i + 1] * sx, wd, false);
        wd = __builtin_amdgcn_cvt_pk_fp8_f32(xv[4 * i + 2] * sx, xv[4 * i + 3] * sx, wd, true);
        o4[i] = (u32)wd;
      }
      *(u32x4*)(xrow8 + lane * 16) = mk4(o4[0], o4[1], o4[2], o4[3]);
    }
    __builtin_amdgcn_s_waitcnt(0xc07f);
    const int hd = lane >> 3, sub = lane & 7;
    float myv[7]; int mye[7];
#pragma unroll
    for (int m = 0; m < 7; ++m) {
      const int c = sub + 8 * m;
      myv[m] = -3.0e38f; mye[m] = 0;
      if (c < 50) {
        const int ij = kCandIJ[c], i = ij >> 4, j = ij & 15;
        const u32 k1 = keys[(hd * 2) * 16 + i], k2 = keys[(hd * 2 + 1) * 16 + j];
        myv[m] = ord_val(k1) + ord_val(k2);
        mye[m] = (int)((k1 & 127u) * 128u + (k2 & 127u));
        cv[hd * 52 + c] = myv[m];
      }
    }
    __builtin_amdgcn_s_waitcnt(0xc07f);
#pragma unroll
    for (int m = 0; m < 7; ++m) {
      const int c = sub + 8 * m;
      if (c < 50) {
        int rank = 0;
        for (int c2 = 0; c2 < 50; ++c2) { const float o = cv[hd * 52 + c2]; rank += (o > myv[m]) || (o == myv[m] && c2 < c); }
        if (rank < 16) {
          exps[hd * 16 + rank] = mye[m]; esc[hd * 16 + rank] = myv[m];
          uinv[hd * 16 + rank] = Uinv[mye[m]]; vinv[hd * 16 + rank] = Vinv[mye[m]];
        }
      }
    }
    __builtin_amdgcn_s_waitcnt(0xc07f);
    float g0, g1;
    {
      const float mx = esc[hd * 16];
      const float e0 = expf(esc[hd * 16 + 2 * sub] - mx), e1 = expf(esc[hd * 16 + 2 * sub + 1] - mx);
      float sm = e0 + e1;
      sm += __shfl_xor(sm, 1); sm += __shfl_xor(sm, 2); sm += __shfl_xor(sm, 4);
      g0 = e0 / sm; g1 = e1 / sm;
    }
    wts[hd * 16 + 2 * sub] = g0; wts[hd * 16 + 2 * sub + 1] = g1;
    __builtin_amdgcn_s_waitcnt(0xc07f);
    {
      const int i16 = lane & 15, h4 = lane >> 4;
      u32x4 a0[8], a1[8];
      auto uload = [&](u32x4 (&a)[8], int c) {
        const unsigned char* urow = U8 + (size_t)exps[(c >> 1) * 16 + i16] * D + 32 * h4 + (c & 1) * 512;
#pragma unroll
        for (int i = 0; i < 4; ++i) { a[2 * i] = *(const u32x4*)(urow + i * 128); a[2 * i + 1] = *(const u32x4*)(urow + i * 128 + 16); }
      };
      f32x4 acc = (f32x4){0.f, 0.f, 0.f, 0.f};
      auto umma = [&](const u32x4 (&a)[8], int c) {
#pragma unroll
        for (int i = 0; i < 8; ++i) {
          const u32x4 b = *(const u32x4*)(xrow8 + (c & 1) * 512 + (i >> 1) * 128 + 32 * h4 + (i & 1) * 16);
          acc = __builtin_amdgcn_mfma_f32_16x16x32_fp8_fp8(__builtin_bit_cast(long, mk2(a[i].x, a[i].y)), __builtin_bit_cast(long, mk2(b.x, b.y)), acc, 0, 0, 0);
          acc = __builtin_amdgcn_mfma_f32_16x16x32_fp8_fp8(__builtin_bit_cast(long, mk2(a[i].z, a[i].w)), __builtin_bit_cast(long, mk2(b.z, b.w)), acc, 0, 0, 0);
        }
        if (c & 1) {
          if (i16 == 0) {
            const int eg = c >> 1;
#pragma unroll
            for (int r = 0; r < 4; ++r) {
              const int k = eg * 16 + 4 * h4 + r;
              wts[k] = wts[k] * gelu_exact(rstd * acc[r] * uinv[k] * xinv) * vinv[k];
            }
          }
          acc = (f32x4){0.f, 0.f, 0.f, 0.f};
        }
      };
      uload(a0, 0);
#pragma unroll 1
      for (int c = 0; c < 16; c += 2) {
        uload(a1, c + 1);
        umma(a0, c);
        if (c + 2 < 16) uload(a0, c + 2);
        umma(a1, c + 1);
      }
    }
    __builtin_amdgcn_s_waitcnt(0xc07f);
    float o[16];
#pragma unroll
    for (int i = 0; i < 16; ++i) o[i] = 0.f;
    {
      u32x4 va[8], vb2[8];
      auto vload = [&](u32x4 (&x0)[8], int k) {
#pragma unroll
        for (int u = 0; u < 8; ++u) x0[u] = *(const u32x4*)(V8 + (size_t)exps[k + u] * D + lane * 16);
      };
      auto vacc = [&](const u32x4 (&x0)[8], int k) {
#pragma unroll
        for (int u = 0; u < 8; ++u) {
          const float w = wts[k + u];
#pragma unroll
          for (int c = 0; c < 4; ++c) {
            const f32x2 lo = __builtin_amdgcn_cvt_pk_f32_fp8((int)x0[u][c], false), hi = __builtin_amdgcn_cvt_pk_f32_fp8((int)x0[u][c], true);
            o[4 * c] += w * lo[0]; o[4 * c + 1] += w * lo[1]; o[4 * c + 2] += w * hi[0]; o[4 * c + 3] += w * hi[1];
          }
        }
      };
      vload(va, 0);
#pragma unroll 1
      for (int k = 0; k < 128; k += 16) {
        vload(vb2, k + 8);
        vacc(va, k);
        if (k + 16 < 128) vload(va, k + 16);
        vacc(vb2, k + 8);
      }
    }
    if (!dry || o[0] == 1.2345e33f) {
      f32x4* op = (f32x4*)(P.out + (size_t)tok * D + lane * 16);
      float r[16];
#pragma unroll
      for (int i = 0; i < 4; ++i) { f32x4 t = op[i]; t.x += o[4 * i]; t.y += o[4 * i + 1]; t.z += o[4 * i + 2]; t.w += o[4 * i + 3]; op[i] = t; r[4 * i] = t.x; r[4 * i + 1] = t.y; r[4 * i + 2] = t.z; r[4 * i + 3] = t.w; }
      u32x4* hp = (u32x4*)(P.hb2 + (size_t)tok * D + lane * 16);
      hp[0] = mk4(pack2(r[0], r[1]), pack2(r[2], r[3]), pack2(r[4], r[5]), pack2(r[6], r[7]));
      hp[1] = mk4(pack2(r[8], r[9]), pack2(r[10], r[11]), pack2(r[12], r[13]), pack2(r[14], r[15]));
    }
  }
}

__device__ __forceinline__ void phase_ple(const Params& P, int l, char* smem, bool dry = false) {
  const u16* Wg = P.WgT + (size_t)l * D * D;
  const u16* Wp = P.WpT + (size_t)l * D * 256;
  const u16* pb = P.pb + (size_t)l * S * 256;
  const int tid = threadIdx.x, lane = tid & 63, wave = tid >> 6, wr = wave >> 1, h = lane >> 5;
  const float* rs = (const float*)(smem + G_RS_OFF);
  float* tile = (float*)smem;
  for (int it = blockIdx.x; it < 128 * 8; it += gridDim.x) {
    const int mt = it >> 3, nt = it & 7;
    f32x16 acc[2][2];
    zero_acc(acc);
    gemm_mainloop<false>(pb + (size_t)mt * 128 * 256, 256, Wp + (size_t)nt * 128 * 256, 256, 256, smem, acc);
    u16* side = (u16*)(smem + 36864);
    const int wc = wave & 1;
#pragma unroll
    for (int i = 0; i < 2; ++i)
#pragma unroll
      for (int j = 0; j < 2; ++j)
#pragma unroll
        for (int r = 0; r < 16; ++r)
          side[(wr * 64 + i * 32 + crow(r, h)) * 136 + wc * 64 + j * 32 + (lane & 31)] = f2bf(acc[i][j][r]);
    zero_acc(acc);
    gemm_mainloop<true>(P.hb2 + (size_t)mt * 128 * D, D, Wg + (size_t)nt * 128 * D, D, D, smem, acc);
    __syncthreads();
#pragma unroll
    for (int i = 0; i < 2; ++i)
#pragma unroll
      for (int j = 0; j < 2; ++j)
#pragma unroll
        for (int r = 0; r < 16; ++r) {
          const int row = wr * 64 + i * 32 + crow(r, h);
          const float pv = bf2f(side[row * 136 + wc * 64 + j * 32 + (lane & 31)]);
          acc[i][j][r] = sigmoidf_(acc[i][j][r] * rs[row]) * pv;
        }
    __syncthreads();
    acc_to_lds(acc, tile);
    __syncthreads();
    const int c4 = (tid & 31) * 4, r0 = tid >> 5;
#pragma unroll 4
    for (int i = 0; i < 16; ++i) {
      const int row = r0 + 8 * i;
      const size_t idx = (size_t)(mt * 128 + row) * D + nt * 128 + c4;
      const f32x4 a4 = *(const f32x4*)(tile + row * EPS_LD + c4);
      f32x4 h4 = *(const f32x4*)(P.out + idx);
      h4 += a4;
      if (!dry || h4[0] == 1.2345e33f) {
        *(f32x4*)(P.out + idx) = h4;
        *(u32x2*)(P.hb + idx) = mk2(pack2(h4[0], h4[1]), pack2(h4[2], h4[3]));
      }
    }
  }
}

constexpr int N_PHASES = 15;
#define XB_TMO      128
#define XB_XCNT(j)  (256  + 64 * (j))
#define XB_XSUB(j)  (1280 + 64 * (j))
#define XB_XGEN(j)  (2304 + 64 * (j))
#define XB_TOP      3328
#define XB_TOPGEN   3392
#define XCD_BAR_WORDS 3456
#define XB_SPIN_CAP (1u << 24)
typedef __attribute__((address_space(3))) unsigned las_u32;
DI unsigned xb_ld(unsigned* p) { return __hip_atomic_load(p, __ATOMIC_RELAXED, __HIP_MEMORY_SCOPE_AGENT); }
DI unsigned xb_add(unsigned* p, unsigned v) { return __hip_atomic_fetch_add(p, v, __ATOMIC_RELAXED, __HIP_MEMORY_SCOPE_AGENT); }
#define XB_SPIN(cond, bar) do { unsigned _sp = 0; while (cond) { __builtin_amdgcn_s_sleep(1); \
    if ((++_sp & 255u) == 0u) { if (xb_ld(&(bar)[XB_TMO])) break; if (_sp > XB_SPIN_CAP) { (void)xb_add(&(bar)[XB_TMO], 1u); break; } } } } while (0)
struct XcdBarrier { unsigned* bar; unsigned x; volatile las_u32* st; };
DI XcdBarrier xcd_barrier_post(unsigned* bar, volatile las_u32* st) {
  XcdBarrier b; b.bar = bar; b.x = (unsigned)__builtin_amdgcn_s_getreg((3 << 11) | 20) & 0xFu; b.st = st;
  if (threadIdx.x == 0) (void)xb_add(&bar[XB_XCNT(b.x)], 1u);
  return b;
}
DI void xcd_barrier_complete(unsigned* bar, unsigned x, unsigned& nloc, unsigned& nx) {
  const unsigned G = gridDim.x * gridDim.y * gridDim.z;
  unsigned sum, cnt, mine, sp = 0u;
  for (;;) {
    sum = 0u; cnt = 0u; mine = 0u;
#pragma unroll
    for (unsigned j = 0; j < 16; ++j) { const unsigned c = xb_ld(&bar[XB_XCNT(j)]); sum += c; cnt += (c > 0u) ? 1u : 0u; mine = (j == x) ? c : mine; }
    if (sum == G) break;
    __builtin_amdgcn_s_sleep(1);
    if ((++sp & 255u) == 0u) { if (xb_ld(&bar[XB_TMO])) break; if (sp > XB_SPIN_CAP) { (void)xb_add(&bar[XB_TMO], 1u); break; } }
  }
  nloc = mine > 0u ? mine : 1u; nx = cnt > 0u ? cnt : 1u;
}
DI void xcd_barrier(unsigned* xbar, unsigned xx, volatile las_u32* xst_) {
  XcdBarrier b; b.bar = xbar; b.x = xx; b.st = xst_;
  asm volatile("s_waitcnt vmcnt(0)" ::: "memory");
  __syncthreads();
  if (threadIdx.x == 0) {
    unsigned* bar = b.bar;
    __builtin_amdgcn_s_waitcnt(0);
    unsigned nloc = b.st[0], nx = b.st[1];
    if (nloc == 0u) { xcd_barrier_complete(bar, b.x, nloc, nx); b.st[0] = nloc; b.st[1] = nx; }
    const unsigned old = xb_add(&bar[XB_XSUB(b.x)], 1u);
    const unsigned gen = old / nloc;
    if (old + 1u == (gen + 1u) * nloc) {
      __builtin_amdgcn_fence(__ATOMIC_RELEASE, "agent");
      asm volatile("s_waitcnt vmcnt(0)" ::: "memory");
      const unsigned og = xb_add(&bar[XB_TOP], 1u);
      const unsigned tg = og / nx;
      if (og + 1u == (tg + 1u) * nx) xb_add(&bar[XB_TOPGEN], 1u);
      else XB_SPIN(xb_ld(&bar[XB_TOPGEN]) == tg, bar);
      __builtin_amdgcn_fence(__ATOMIC_ACQUIRE, "agent");
      xb_add(&bar[XB_XGEN(b.x)], 1u);
      asm volatile("s_waitcnt vmcnt(0)" ::: "memory");
    } else {
      XB_SPIN(xb_ld(&bar[XB_XGEN(b.x)]) == gen, bar);
      __builtin_amdgcn_fence(__ATOMIC_ACQUIRE, "agent");
      asm volatile("s_waitcnt vmcnt(0)" ::: "memory");
    }
  }
  __syncthreads();
}
__global__ void __launch_bounds__(NT, 2) hymba_mega(Params P, unsigned* counters) {
  __shared__ __attribute__((aligned(16))) char smem[SMEM_BYTES];
  cg::grid_group grid = cg::this_grid();
  const int lo = P.phase_lo, hi = P.phase_hi;
#ifndef ONLY_PHASE
#define ONLY_PHASE -1
#endif
#define PH_ON(k) (ONLY_PHASE < 0 || ONLY_PHASE == (k))
  volatile las_u32* xst = (volatile las_u32*)(smem + SMEM_BYTES - 16);
  if (threadIdx.x < 4) xst[threadIdx.x] = 0u;
  __syncthreads();
  unsigned* const xbar = counters + 64;
  const unsigned xcc = xcd_barrier_post(xbar, xst).x;
#define RUN(ph, kind, call) if (lo <= (ph) && (ph) < hi) { const bool dry = false; const int rep = 0; (void)dry; (void)rep; if (PH_ON(kind)) { call; } if ((ph) + 1 < hi) { if ((ph) == 0) grid.sync(); else xcd_barrier(xbar, xcc, xst); } }
#define RUNREP(ph, kind, call) if (lo <= (ph) && (ph) < hi) { \
    const int nrep = ((ph) == P.rep_ph) ? P.rep_n : 1; \
    for (int rep = 0; rep < nrep; ++rep) { const bool dry = rep > 0; (void)dry; \
      if (PH_ON(kind)) { call; } \
      if ((ph) + 1 < hi || rep + 1 < nrep) { xcd_barrier(xbar, xcc, xst); } } }
#ifndef REPEAT
#define REPEAT -1
#define RSEC 7
#endif
  RUN(0, 7, phase_prep(P, smem))
  RUN(1, 0, phase_inproj(P, 0, smem))
  RUN(2, 1, phase_compress(P, 0, smem))
  RUNREP(3, 2, phase_attention(P, 0, smem, counters + 4 * rep, dry ? (P.rep_sec | 8) : 7, dry && P.rep_nsa_only))
  RUN(4, 3, phase_outproj(P, 0, smem, dry))
  RUN(5, 4, phase_peerq(P, 0, smem))
  RUN(6, 5, phase_peer(P, 0, smem, dry))
  RUN(7, 6, phase_ple(P, 0, smem, dry))
  RUN(8, 0, phase_inproj(P, 1, smem))
  RUN(9, 1, phase_compress(P, 1, smem))
  RUN(10, 2, phase_attention(P, 1, smem, counters + 16))
  RUN(11, 3, phase_outproj(P, 1, smem))
  RUN(12, 4, phase_peerq(P, 1, smem))
  RUN(13, 5, phase_peer(P, 1, smem))
  RUN(14, 6, phase_ple(P, 1, smem))
}

static size_t align_up(size_t x, size_t a) { return (x + a - 1) / a * a; }

extern "C" void kernel_launch(void* const* d_in, const int* in_sizes, int n_in, void* d_out, int out_size, void* d_ws, size_t ws_size, hipStream_t stream) {
  static int grid_blocks = 0;
  if (!grid_blocks) {
    int dev = 0, cus = 0, per_cu = 0;
    hipGetDevice(&dev);
    hipDeviceGetAttribute(&cus, hipDeviceAttributeMultiprocessorCount, dev);
    hipOccupancyMaxActiveBlocksPerMultiprocessor(&per_cu, hymba_mega, NT, 0);
    if (per_cu > 2) per_cu = 2;
    if (per_cu < 1) per_cu = 1;
    grid_blocks = cus * per_cu;
  }
  Params P;
  memset(&P, 0, sizeof(P));
  P.x = (const float*)d_in[0]; P.p = (const float*)d_in[1]; P.positions = (const int*)d_in[2];
  P.attn_norm_w = (const float*)d_in[3]; P.w_in = (const float*)d_in[4]; P.fox_f_bias = (const float*)d_in[5];
  P.fox_q_norm_w = (const float*)d_in[6]; P.fox_k_norm_w = (const float*)d_in[7];
  P.nsa_q_norm_w = (const float*)d_in[8]; P.nsa_k_norm_w = (const float*)d_in[9]; P.nsa_cmp_pos = (const float*)d_in[10]; P.nsa_cmp_w = (const float*)d_in[11];
  P.diff_q_norm_w = (const float*)d_in[12]; P.diff_k_norm_w = (const float*)d_in[13]; P.diff_lambda = (const float*)d_in[14]; P.diff_subln_w = (const float*)d_in[15];
  P.w_out = (const float*)d_in[16]; P.ffn_norm_w = (const float*)d_in[17]; P.peer_w_q = (const float*)d_in[18]; P.peer_sub_keys = (const float*)d_in[19];
  P.peer_u = (const float*)d_in[20]; P.peer_v = (const float*)d_in[21]; P.ple_norm_w = (const float*)d_in[22]; P.ple_w_gate = (const float*)d_in[23]; P.ple_w_proj = (const float*)d_in[24];
  P.out = (float*)d_out;
  char* w = (char*)d_ws; size_t off = 0;
  auto take = [&](size_t bytes) { char* p = w + off; off = align_up(off + bytes, 256); return p; };
  unsigned* counters = (unsigned*)take(256 + XCD_BAR_WORDS * 4);
  P.WinT = (u16*)take((size_t)2 * NINP * D * 2);
  P.WoutT = (u16*)take((size_t)2 * D * D * 2);
  P.WqT = (u16*)take((size_t)2 * 2048 * D * 2);
  P.WgT = (u16*)take((size_t)2 * D * D * 2);
  P.WpT = (u16*)take((size_t)2 * D * 256 * 2);
  P.SubK = (u16*)take((size_t)2 * 16 * 128 * 128 * 2);
  P.CmpWT = (u16*)take((size_t)2 * 2 * 128 * 2048 * 2);
  P.cmpbias = (float*)take(2 * 2 * 64 * 4);
  P.U8 = (unsigned char*)take((size_t)2 * S * D);
  P.V8 = (unsigned char*)take((size_t)2 * S * D);
  P.Uinv = (float*)take((size_t)2 * S * 4); P.Vinv = (float*)take((size_t)2 * S * 4);
  P.hb = (u16*)take((size_t)S * D * 2);
  P.hb2 = (u16*)take((size_t)S * D * 2);
  P.pb = (u16*)take((size_t)2 * S * 256 * 2);
  P.ropeN = (float*)take((size_t)S * 64 * 4);
  P.ropeD = (float*)take((size_t)S * 32 * 4);
  P.QF = (u16*)take((size_t)4 * S * 64 * 2); P.KF = (u16*)take((size_t)4 * S * 64 * 2); P.VFt = (u16*)take((size_t)4 * S * 64 * 2);
  P.cloc = (float*)take((size_t)4 * S * 4); P.ctot = (float*)take(256 * 4 * 4);
  P.QN = (u16*)take((size_t)8 * S * 64 * 2); P.QR = (u16*)take((size_t)8 * S * 64 * 2);
  P.KC = (u16*)take((size_t)2 * (S + 64) * 64 * 2); P.VC = (u16*)take((size_t)2 * (S + 64) * 64 * 2);
  P.KCC = (u16*)take((size_t)2 * 1024 * 64 * 2); P.VCCt = (u16*)take((size_t)2 * 64 * 1024 * 2);
  P.KS8 = (unsigned char*)take((size_t)2 * S * 64); P.VS8t = (unsigned char*)take((size_t)2 * S * 64);
  P.KW = (u16*)take((size_t)2 * S * 64 * 2); P.VWt = (u16*)take((size_t)2 * S * 64 * 2);
  P.gates = (float*)take((size_t)S * 24 * 4);
  P.QD = (u16*)take((size_t)4 * S * 64 * 2); P.KD = (u16*)take((size_t)4 * S * 64 * 2); P.VDt = (u16*)take((size_t)4 * S * 64 * 2);
  P.mix = (u16*)take((size_t)S * D * 2);
  P.dstash = (float*)take((size_t)grid_blocks * 128 * 64 * 4);
  P.impA = (float*)take((size_t)256 * 256 * 128 * 4); P.impB = (float*)take((size_t)256 * 256 * 128 * 4);
  P.topk = (u32*)take((size_t)S * 256 * 4);
  if (off > ws_size) { fprintf(stderr, "kernel_launch: workspace too small: need %zu, have %zu\n", off, ws_size); return; }
  hipMemsetAsync(counters, 0, 256 + XCD_BAR_WORDS * 4, stream);
#ifndef SINGLE_LAUNCH
#define SINGLE_LAUNCH 1
#endif
#ifndef REP_PH
#define REP_PH -1
#endif
#ifndef REP_N
#define REP_N 1
#endif
#ifndef REP_SEC
#define REP_SEC 7
#endif
#ifndef REP_NSA_ONLY
#define REP_NSA_ONLY 0
#endif
  P.rep_ph = REP_PH; P.rep_n = REP_N; P.rep_sec = REP_SEC; P.rep_nsa_only = REP_NSA_ONLY;
  if (SINGLE_LAUNCH) {
    P.phase_lo = 0; P.phase_hi = N_PHASES;
    void* args[] = {&P, &counters};
    hipError_t e = hipLaunchCooperativeKernel((void*)hymba_mega, dim3(grid_blocks), dim3(NT), args, 0, stream);
    if (e != hipSuccess) fprintf(stderr, "cooperative launch failed: %s (grid %d)\n", hipGetErrorString(e), grid_blocks);
  } else {
    for (int ph = 0; ph < N_PHASES; ++ph) {
      P.phase_lo = ph; P.phase_hi = ph + 1;
      void* args[] = {&P, &counters};
      hipError_t e = hipLaunchCooperativeKernel((void*)hymba_mega, dim3(grid_blocks), dim3(NT), args, 0, stream);
      if (e != hipSuccess) { fprintf(stderr, "cooperative launch failed: %s (grid %d, phase %d)\n", hipGetErrorString(e), grid_blocks, ph); break; }
    }
  }
}
```

```cpp
#include <hip/hip_runtime.h>
#include <hip/hip_cooperative_groups.h>
#include <cstdio>
#include <cstdint>
#include <cstring>
namespace cg = cooperative_groups;

typedef __attribute__((ext_vector_type(8))) short bf16x8;
typedef __attribute__((ext_vector_type(4))) short bf16x4;
typedef __attribute__((ext_vector_type(16))) float f32x16;
typedef __attribute__((ext_vector_type(4))) float f32x4;
typedef __attribute__((ext_vector_type(2))) float f32x2;
typedef __attribute__((ext_vector_type(2))) __bf16 bf2_t;
typedef unsigned short u16;
typedef unsigned int u32;
typedef __attribute__((ext_vector_type(4))) unsigned int u32x4;
typedef __attribute__((ext_vector_type(2))) unsigned int u32x2;

#define DI __device__ __forceinline__
#define MFMA32(a, b, c) __builtin_amdgcn_mfma_f32_32x32x16_bf16((a), (b), (c), 0, 0, 0)
#define MFMA16(a, b, c) __builtin_amdgcn_mfma_f32_16x16x32_bf16((a), (b), (c), 0, 0, 0)

constexpr int S = 16384;
constexpr int D = 1024;
constexpr int NT = 256;
constexpr int NIN = 2844;
constexpr int NINP = 2944;
constexpr int SMEM_BYTES = 72704;
constexpr float LOG2E = 1.4426950408889634f;
#ifndef ABLATE
#define ABLATE 0
#endif

struct Params {
  const float* x; const float* p; const int* positions;
  const float* attn_norm_w; const float* w_in; const float* fox_f_bias; const float* fox_q_norm_w; const float* fox_k_norm_w;
  const float* nsa_q_norm_w; const float* nsa_k_norm_w; const float* nsa_cmp_pos; const float* nsa_cmp_w;
  const float* diff_q_norm_w; const float* diff_k_norm_w; const float* diff_lambda; const float* diff_subln_w;
  const float* w_out; const float* ffn_norm_w; const float* peer_w_q; const float* peer_sub_keys; const float* peer_u; const float* peer_v;
  const float* ple_norm_w; const float* ple_w_gate; const float* ple_w_proj;
  float* out;
  u16* WinT;
  u16* WoutT;
  u16* WqT;
  u16* WgT;
  u16* WpT;
  u16* SubK;
  u16* CmpWT;
  float* cmpbias;
  unsigned char* U8;
  unsigned char* V8;
  float* Uinv; float* Vinv;
  u16* hb;
  u16* hb2;
  u16* pb;
  float* ropeN;
  float* ropeD;
  u16* QF; u16* KF; u16* VFt;
  float* cloc; float* ctot;
  u16* QN; u16* QR;
  u16* KC; u16* VC;
  u16* KCC; u16* VCCt;
  unsigned char* KS8; unsigned char* VS8t;
  u16* KW; u16* VWt;
  float* gates;
  u16* QD; u16* KD; u16* VDt;
  u16* mix;
  float* dstash;
  float* impA; float* impB;
  u32* topk;
  int phase_lo, phase_hi;
  int rep_ph, rep_n, rep_sec, rep_nsa_only;
};

DI u32x4 mk4(u32 a, u32 b, u32 c, u32 d) { return (u32x4){a, b, c, d}; }
DI u32x2 mk2(u32 a, u32 b) { return (u32x2){a, b}; }
DI u32 pack2(float a, float b) { f32x2 v = {a, b}; bf2_t r = __builtin_convertvector(v, bf2_t); return __builtin_bit_cast(u32, r); }
DI u16 f2bf(float a) { return (u16)(pack2(a, 0.f) & 0xffffu); }
DI float bf2f(u16 x) { return __uint_as_float(((u32)x) << 16); }
DI float bflo(u32 x) { return __uint_as_float(x << 16); }
DI float bfhi(u32 x) { return __uint_as_float(x & 0xffff0000u); }
DI int opaque_tid() { int t = threadIdx.x; asm volatile("" : "+v"(t)); return t; }
DI int crow(int reg, int h) { return (reg & 3) + 8 * (reg >> 2) + 4 * h; }
DI float wave_sum(float v) {
#pragma unroll
  for (int o = 32; o > 0; o >>= 1) v += __shfl_xor(v, o);
  return v;
}
DI float wave_max(float v) {
#pragma unroll
  for (int o = 32; o > 0; o >>= 1) v = fmaxf(v, __shfl_xor(v, o));
  return v;
}

DI int inproj_old_col(int j) {
  if (j < 768) return j;
  if (j < 2048) return j + 4;
  if (j < 2816) return j + 28;
  if (j < 2820) return j - 2048;
  if (j < 2844) return j - 768;
  return -1;
}
DI void transpose_tile(const float* __restrict__ src, int ldsrc, u16* __restrict__ dst, int K, const float* __restrict__ scale,
                       int n0, int k0, int mode, int nvalid, float* tile) {
  const int t = threadIdx.x;
  const int nn = t & 63, kq = t >> 6;
  int col = n0 + nn;
  if (mode == 1) col = inproj_old_col(col); else if (col >= nvalid) col = -1;
  float v[16];
#pragma unroll
  for (int i = 0; i < 16; ++i) v[i] = (col >= 0) ? src[(size_t)(k0 + kq + 4 * i) * ldsrc + col] : 0.f;
  if (scale) {
#pragma unroll
    for (int i = 0; i < 16; ++i) v[i] *= scale[k0 + kq + 4 * i];
  }
#pragma unroll
  for (int i = 0; i < 16; ++i) tile[(kq + 4 * i) * 65 + nn] = v[i];
  __syncthreads();
  const int n2 = t >> 2, kc = (t & 3) * 16;
  u32 o[8];
#pragma unroll
  for (int i = 0; i < 8; ++i) o[i] = pack2(tile[(kc + 2 * i) * 65 + n2], tile[(kc + 2 * i + 1) * 65 + n2]);
  u32x4* dp = (u32x4*)(dst + (size_t)(n0 + n2) * K + k0 + kc);
  dp[0] = mk4(o[0], o[1], o[2], o[3]);
  dp[1] = mk4(o[4], o[5], o[6], o[7]);
  __syncthreads();
}

DI void convert_rows(const float* __restrict__ src, u16* __restrict__ dst, size_t n8, float* __restrict__ copy) {
  const size_t stride = (size_t)gridDim.x * NT;
  for (size_t i0 = (size_t)blockIdx.x * NT + threadIdx.x; i0 < n8; i0 += 4 * stride) {
    f32x4 a[4], b[4];
#pragma unroll
    for (int u = 0; u < 4; ++u) {
      const size_t i = i0 + u * stride;
      if (i < n8) { a[u] = ((const f32x4*)src)[2 * i]; b[u] = ((const f32x4*)src)[2 * i + 1]; }
    }
#pragma unroll
    for (int u = 0; u < 4; ++u) {
      const size_t i = i0 + u * stride;
      if (i < n8) {
        if (copy) { ((f32x4*)copy)[2 * i] = a[u]; ((f32x4*)copy)[2 * i + 1] = b[u]; }
        ((u32x4*)dst)[i] = mk4(pack2(a[u][0], a[u][1]), pack2(a[u][2], a[u][3]), pack2(b[u][0], b[u][1]), pack2(b[u][2], b[u][3]));
      }
    }
  }
}

__device__ __forceinline__ void phase_prep(const Params& P, char* smem) {
  float* tile = (float*)smem;
  const int bid = blockIdx.x, nb = gridDim.x, t = threadIdx.x;
  for (int it0 = bid; it0 < 2 * 1952; it0 += nb) {
    const int l = it0 / 1952;
    int it = it0 % 1952;
    if (it < 736) { transpose_tile(P.w_in + (size_t)l * D * NIN, NIN, P.WinT + (size_t)l * NINP * D, D, P.attn_norm_w + l * D, (it >> 4) * 64, (it & 15) * 64, 1, 0, tile); continue; }
    it -= 736;
    if (it < 256) { transpose_tile(P.w_out + (size_t)l * D * D, D, P.WoutT + (size_t)l * D * D, D, nullptr, (it >> 4) * 64, (it & 15) * 64, 0, D, tile); continue; }
    it -= 256;
    if (it < 512) { transpose_tile(P.peer_w_q + (size_t)l * D * 2048, 2048, P.WqT + (size_t)l * 2048 * D, D, P.ffn_norm_w + l * D, (it >> 4) * 64, (it & 15) * 64, 0, 2048, tile); continue; }
    it -= 512;
    if (it < 256) { transpose_tile(P.ple_w_gate + (size_t)l * D * D, D, P.WgT + (size_t)l * D * D, D, P.ple_norm_w + l * D, (it >> 4) * 64, (it & 15) * 64, 0, D, tile); continue; }
    it -= 256;
    if (it < 64) { transpose_tile(P.ple_w_proj + (size_t)l * 256 * D, D, P.WpT + (size_t)l * D * 256, 256, nullptr, (it >> 2) * 64, (it & 3) * 64, 0, D, tile); continue; }
    it -= 64;
    { const int kv = it >> 6, i2 = it & 63;
      transpose_tile(P.nsa_cmp_w + (size_t)(l * 2 + kv) * 2048 * 64, 64, P.CmpWT + (size_t)(l * 2 + kv) * 128 * 2048, 2048, nullptr, (i2 >> 5) * 64, (i2 & 31) * 64, 0, 64, tile); }
  }
  convert_rows(P.peer_sub_keys, P.SubK, (size_t)2 * 16 * 128 * 128 / 8, nullptr);
  {
    const int lane = t & 63, gw = bid * 4 + (t >> 6), ngw = nb * 4;
    for (int r = gw; r < 4 * S; r += ngw) {
      const int tbl = r / (2 * S), l = (r / S) & 1, e = r % S;
      const float* src = (tbl ? P.peer_v : P.peer_u) + ((size_t)l * S + e) * D + lane * 16;
      float v[16];
#pragma unroll
      for (int i = 0; i < 4; ++i) { const f32x4 q4 = ((const f32x4*)src)[i]; v[4 * i] = q4[0]; v[4 * i + 1] = q4[1]; v[4 * i + 2] = q4[2]; v[4 * i + 3] = q4[3]; }
      if (tbl == 0) {
        const float* w = P.ffn_norm_w + l * D + lane * 16;
#pragma unroll
        for (int i = 0; i < 16; ++i) v[i] *= w[i];
      }
      float m = 0.f;
#pragma unroll
      for (int i = 0; i < 16; ++i) m = fmaxf(m, fabsf(v[i]));
      m = wave_max(m);
      const float sc = (m > 0.f) ? 240.f / m : 0.f;
      u32 o[4];
#pragma unroll
      for (int i = 0; i < 4; ++i) {
        int wd = 0;
        wd = __builtin_amdgcn_cvt_pk_fp8_f32(v[4 * i] * sc, v[4 * i + 1] * sc, wd, false);
        wd = __builtin_amdgcn_cvt_pk_fp8_f32(v[4 * i + 2] * sc, v[4 * i + 3] * sc, wd, true);
        o[i] = (u32)wd;
      }
      unsigned char* dst = (tbl ? P.V8 : P.U8) + ((size_t)l * S + e) * D + lane * 16;
      *(u32x4*)dst = mk4(o[0], o[1], o[2], o[3]);
      if (lane == 0) (tbl ? P.Vinv : P.Uinv)[l * S + e] = m * (1.f / 240.f);
    }
  }
  convert_rows(P.p, P.pb, (size_t)2 * S * 256 / 8, nullptr);
  convert_rows(P.x, P.hb, (size_t)S * D / 8, P.out);
  const size_t gtid = (size_t)bid * NT + t, gstride = (size_t)nb * NT;
  __syncthreads();
  if (t < 48) tile[t] = (t < 32) ? powf(10000.f, -(float)t / 32.f) : powf(10000.f, -(float)(t - 32) / 16.f);
  __syncthreads();
  for (size_t i = gtid; i < (size_t)S * 48; i += gstride) {
    const int tok = (int)(i / 48), r = (int)(i % 48);
    const float pos = (float)P.positions[tok];
    const float invf = tile[r];
    const float ang = pos * invf;
    const double rev = (double)ang * 0.15915494309189535;
    const float fr = (float)(rev - floor(rev));
    const float c = __builtin_amdgcn_cosf(fr), s = __builtin_amdgcn_sinf(fr);
    if (r < 32) { P.ropeN[(size_t)tok * 64 + r] = c; P.ropeN[(size_t)tok * 64 + 32 + r] = s; }
    else { P.ropeD[(size_t)tok * 32 + (r - 32)] = c; P.ropeD[(size_t)tok * 32 + 16 + (r - 32)] = s; }
  }
  {
    const int lane = t & 63, gw = bid * 4 + (t >> 6), ngw = nb * 4;
    for (int i = gw; i < 2 * 2 * 64; i += ngw) {
      const int lk = i >> 6, e = i & 63;
      const float* pos = P.nsa_cmp_pos + (size_t)lk * 2048;
      const float* w = P.nsa_cmp_w + (size_t)lk * 2048 * 64;
      float a = 0.f;
#pragma unroll 8
      for (int k = lane; k < 2048; k += 64) a += pos[k] * w[(size_t)k * 64 + e];
      a = wave_sum(a);
      if (lane == 0) P.cmpbias[i] = a;
    }
  }
  for (size_t i = gtid; i < 2 * 2 * 64 * 64; i += gstride) {
    const int which = (int)(i / (2 * 64 * 64)), r = (int)(i % (2 * 64 * 64));
    const int g = r / (64 * 64), o = r % (64 * 64);
    u16* base = which ? P.VC : P.KC;
    base[(size_t)g * (S + 64) * 64 + (size_t)S * 64 + o] = 0;
  }
}

constexpr int GST = 144;
constexpr int G_BOFF = 128 * GST;
constexpr int G_RS_OFF = 71680;

DI float ssq8(const u32x4& v) {
  float s = 0.f;
  float a;
  a = bflo(v.x); s += a * a; a = bfhi(v.x); s += a * a;
  a = bflo(v.y); s += a * a; a = bfhi(v.y); s += a * a;
  a = bflo(v.z); s += a * a; a = bfhi(v.z); s += a * a;
  a = bflo(v.w); s += a * a; a = bfhi(v.w); s += a * a;
  return s;
}

template <bool SSQ>
DI void gemm_mainloop(const u16* __restrict__ A, int lda, const u16* __restrict__ Bt, int ldb, int K, char* sm, f32x16 (&acc)[2][2]) {
  const int tid = threadIdx.x, lane = tid & 63, wave = tid >> 6;
  const int wr = wave >> 1, wc = wave & 1;
  const int lrow = tid >> 3, lcol = (tid & 7) * 8;
  char* As = sm; char* Bs = sm + G_BOFF;
  u32x4 ra[4], rb[4];
  float ssq[4] = {0.f, 0.f, 0.f, 0.f};
#pragma unroll
  for (int i = 0; i < 4; ++i) {
    ra[i] = *(const u32x4*)(A + (size_t)(lrow + 32 * i) * lda + lcol);
    rb[i] = *(const u32x4*)(Bt + (size_t)(lrow + 32 * i) * ldb + lcol);
  }
  const int aoff = (wr * 64 + (lane & 31)) * GST + (lane >> 5) * 16;
  const int boff = (wc * 64 + (lane & 31)) * GST + (lane >> 5) * 16;
  for (int k0 = 0; k0 < K; k0 += 64) {
    __syncthreads();
#pragma unroll
    for (int i = 0; i < 4; ++i) {
      *(u32x4*)(As + (lrow + 32 * i) * GST + lcol * 2) = ra[i];
      *(u32x4*)(Bs + (lrow + 32 * i) * GST + lcol * 2) = rb[i];
      if (SSQ) ssq[i] += ssq8(ra[i]);
    }
    __syncthreads();
    if (k0 + 64 < K) {
#pragma unroll
      for (int i = 0; i < 4; ++i) {
        ra[i] = *(const u32x4*)(A + (size_t)(lrow + 32 * i) * lda + k0 + 64 + lcol);
        rb[i] = *(const u32x4*)(Bt + (size_t)(lrow + 32 * i) * ldb + k0 + 64 + lcol);
      }
    }
#pragma unroll
    for (int ks = 0; ks < 4; ++ks) {
      bf16x8 af[2], bfr[2];
#pragma unroll
      for (int i = 0; i < 2; ++i) af[i] = *(const bf16x8*)(As + aoff + i * 32 * GST + ks * 32);
#pragma unroll
      for (int j = 0; j < 2; ++j) bfr[j] = *(const bf16x8*)(Bs + boff + j * 32 * GST + ks * 32);
#pragma unroll
      for (int i = 0; i < 2; ++i)
#pragma unroll
        for (int j = 0; j < 2; ++j) acc[i][j] = MFMA32(af[i], bfr[j], acc[i][j]);
    }
  }
  __syncthreads();
  if (SSQ) {
    float* rs = (float*)(sm + G_RS_OFF);
#pragma unroll
    for (int i = 0; i < 4; ++i) {
      float s = ssq[i];
      s += __shfl_xor(s, 1); s += __shfl_xor(s, 2); s += __shfl_xor(s, 4);
      if ((tid & 7) == 0) rs[lrow + 32 * i] = rsqrtf(s * (1.f / (float)K) + 1e-6f);
    }
  }
}

DI void zero_acc(f32x16 (&acc)[2][2]) {
#pragma unroll
  for (int i = 0; i < 2; ++i)
#pragma unroll
    for (int j = 0; j < 2; ++j)
#pragma unroll
      for (int r = 0; r < 16; ++r) acc[i][j][r] = 0.f;
}

constexpr int EPS_LD = 132;
DI void acc_to_lds(const f32x16 (&acc)[2][2], float* tile) {
  const int lane = threadIdx.x & 63, wave = threadIdx.x >> 6;
  const int wr = wave >> 1, wc = wave & 1;
#pragma unroll
  for (int i = 0; i < 2; ++i)
#pragma unroll
    for (int j = 0; j < 2; ++j)
#pragma unroll
      for (int r = 0; r < 16; ++r)
        tile[(wr * 64 + i * 32 + crow(r, lane >> 5)) * EPS_LD + wc * 64 + j * 32 + (lane & 31)] = acc[i][j][r];
}

DI float log_sigmoid(float x) { return fminf(x, 0.f) - log1pf(expf(-fabsf(x))); }
DI float sigmoidf_(float x) { return 1.f / (1.f + expf(-x)); }

DI void store32_bf16(u16* dst, const float* o) {
  u32x4* d4 = (u32x4*)dst;
#pragma unroll
  for (int i = 0; i < 4; ++i)
    d4[i] = mk4(pack2(o[8 * i], o[8 * i + 1]), pack2(o[8 * i + 2], o[8 * i + 3]), pack2(o[8 * i + 4], o[8 * i + 5]), pack2(o[8 * i + 6], o[8 * i + 7]));
}

__device__ __forceinline__ void inproj_epilogue_half(const Params& P, int l, int mt, int nt, int half, const float* tile, const float* rs) {
  const int tid = threadIdx.x, lane = tid & 63, wave = tid >> 6;
  const int hl = wave >> 1, h32 = wave & 1;
  const int sg = 2 * nt + hl;
  const int rloc = half * 64 + lane;
  const int tok = mt * 128 + rloc;
  const float rstd = rs[rloc];
  if (sg >= 45) return;
  float v[64];
  {
    const f32x4* src = (const f32x4*)(tile + rloc * EPS_LD + hl * 64);
#pragma unroll
    for (int i = 0; i < 16; ++i) { f32x4 t = src[i]; v[4 * i] = t[0] * rstd; v[4 * i + 1] = t[1] * rstd; v[4 * i + 2] = t[2] * rstd; v[4 * i + 3] = t[3] * rstd; }
  }
  const u32 hmask = (u32)(-(int)h32);
#define VO(i) __uint_as_float((__float_as_uint(v[32 + (i)]) & hmask) | (__float_as_uint(v[(i)]) & ~hmask))
  if (sg == 44) {
    if (h32 == 0) {
      const int chunk = tok >> 6;
#pragma unroll
      for (int hd = 0; hd < 4; ++hd) {
        float x = log_sigmoid(v[hd] + P.fox_f_bias[l * 4 + hd]);
#pragma unroll
        for (int o = 1; o < 64; o <<= 1) { float t = __shfl_up(x, o); if (lane >= o) x += t; }
        P.cloc[(size_t)hd * S + tok] = x;
        if (lane == 63) P.ctot[chunk * 4 + hd] = x;
      }
    } else {
      float* g = P.gates + (size_t)tok * 24;
#pragma unroll
      for (int i = 0; i < 24; ++i) g[i] = sigmoidf_(v[4 + i]);
    }
    return;
  }
  float o[32];
  const bool is_vt = (sg >= 8 && sg < 12) || (sg == 26 || sg == 27) || (sg == 30 || sg == 31) || (sg >= 40);
  const bool is_raw = (sg >= 20 && sg < 24);
  const bool is_diff = (sg >= 32 && sg < 40);
  if (is_vt) {
    if (sg == 26 || sg == 27) {
      const int key = tok & 63, G = key >> 5, h4 = (key & 31) >> 3, j = key & 7;
      unsigned char* b8 = P.VS8t + (size_t)(sg - 26) * 64 * S + (size_t)(tok >> 6) * 4096 + G * 2048 + h4 * 128 + j;
#pragma unroll
      for (int i = 0; i < 32; i += 2) {
        const int wd = __builtin_amdgcn_cvt_pk_fp8_f32(VO(i), VO(i + 1), 0, false);
        const int d0 = h32 * 32 + i, d1 = d0 + 1;
        b8[(d0 >> 4) * 512 + (d0 & 15) * 8] = (unsigned char)(wd & 0xff);
        b8[(d1 >> 4) * 512 + (d1 & 15) * 8] = (unsigned char)((wd >> 8) & 0xff);
      }
      return;
    }
    u16* base;
    if (sg < 12) base = P.VFt + (size_t)(sg - 8) * 64 * S;
    else if (sg < 32) base = P.VWt + (size_t)(sg - 30) * 64 * S;
    else base = P.VDt + (size_t)(sg - 40) * 64 * S;
#pragma unroll
    for (int i = 0; i < 32; ++i) base[(size_t)(h32 * 32 + i) * S + tok] = f2bf(VO(i));
    return;
  }
  if (is_raw) {
    u16* base = (sg < 22) ? P.KC + (size_t)(sg - 20) * (S + 64) * 64 : P.VC + (size_t)(sg - 22) * (S + 64) * 64;
#pragma unroll
    for (int i = 0; i < 32; ++i) o[i] = VO(i);
    store32_bf16(base + (size_t)tok * 64 + h32 * 32, o);
    return;
  }
  if (is_diff) {
    const float* w = (sg < 36 ? P.diff_q_norm_w : P.diff_k_norm_w) + l * 32;
    float ss = 0.f;
#pragma unroll
    for (int i = 0; i < 32; ++i) ss += VO(i) * VO(i);
    const float rn = rsqrtf(ss * (1.f / 32.f) + 1e-6f);
    const float sc = (sg < 36) ? 0.17677669529663687f * LOG2E : 1.f;
    const float* rp = P.ropeD + (size_t)tok * 32;
#pragma unroll
    for (int i = 0; i < 16; ++i) {
      const float y1 = VO(i) * rn * w[i], y2 = VO(16 + i) * rn * w[16 + i];
      const float c = rp[i], s = rp[16 + i];
      o[i] = (y1 * c - y2 * s) * sc;
      o[16 + i] = (y2 * c + y1 * s) * sc;
    }
    u16* base = (sg < 36) ? P.QD + (size_t)(sg - 32) * S * 64 : P.KD + (size_t)(sg - 36) * S * 64;
    store32_bf16(base + (size_t)tok * 64 + h32 * 32, o);
    return;
  }
  const float* w;
  if (sg < 4) w = P.fox_q_norm_w + l * 64; else if (sg < 8) w = P.fox_k_norm_w + l * 64; else if (sg < 20) w = P.nsa_q_norm_w + l * 64; else w = P.nsa_k_norm_w + l * 64;
  float ss = 0.f;
#pragma unroll
  for (int i = 0; i < 64; ++i) ss += v[i] * v[i];
  const float rn = rsqrtf(ss * (1.f / 64.f) + 1e-6f);
  const float qs = 0.125f * LOG2E;
  if (sg < 8) {
    const float sc = (sg < 4) ? qs : 1.f;
#pragma unroll
    for (int i = 0; i < 32; ++i) o[i] = VO(i) * rn * w[h32 * 32 + i] * sc;
    u16* base = (sg < 4) ? P.QF + (size_t)sg * S * 64 : P.KF + (size_t)(sg - 4) * S * 64;
    store32_bf16(base + (size_t)tok * 64 + h32 * 32, o);
    return;
  }
  const float* rp = P.ropeN + (size_t)tok * 64;
  const float sc = (sg < 20) ? qs : 1.f;
  if (sg < 20) {
#pragma unroll
    for (int i = 0; i < 32; ++i) o[i] = VO(i) * rn * w[h32 * 32 + i] * sc;
    store32_bf16(P.QN + ((size_t)(sg - 12) * S + tok) * 64 + h32 * 32, o);
  }
#pragma unroll
  for (int i = 0; i < 32; ++i) {
    const float y1 = v[i] * rn * w[i], y2 = v[32 + i] * rn * w[32 + i];
    const float c = rp[i], s = rp[32 + i];
    o[i] = (h32 == 0 ? (y1 * c - y2 * s) : (y2 * c + y1 * s)) * sc;
  }
  if (sg == 24 || sg == 25) {
    const int key = tok & 63, G = key >> 5, r32 = key & 31, t = (r32 >> 2) & 1, i = ((r32 >> 3) << 2) | (r32 & 3);
    unsigned char* d8 = P.KS8 + (size_t)(sg - 24) * S * 64 + (size_t)(tok >> 6) * 4096 + ((G * 2 + t) * 2 + h32) * 512 + i * 8;
#pragma unroll
    for (int h4 = 0; h4 < 4; ++h4) {
      int w0 = 0, w1 = 0;
      w0 = __builtin_amdgcn_cvt_pk_fp8_f32(o[8 * h4], o[8 * h4 + 1], w0, false);
      w0 = __builtin_amdgcn_cvt_pk_fp8_f32(o[8 * h4 + 2], o[8 * h4 + 3], w0, true);
      w1 = __builtin_amdgcn_cvt_pk_fp8_f32(o[8 * h4 + 4], o[8 * h4 + 5], w1, false);
      w1 = __builtin_amdgcn_cvt_pk_fp8_f32(o[8 * h4 + 6], o[8 * h4 + 7], w1, true);
      *(u32x2*)(d8 + h4 * 128) = mk2((u32)w0, (u32)w1);
    }
    return;
  }
  u16* base;
  if (sg < 20) base = P.QR + (size_t)(sg - 12) * S * 64;
  else base = P.KW + (size_t)(sg - 28) * S * 64;
  store32_bf16(base + (size_t)tok * 64 + h32 * 32, o);
}

#undef VO
__device__ __forceinline__ void phase_inproj(const Params& P, int l, char* smem) {
  const u16* Wt = P.WinT + (size_t)l * NINP * D;
  float* tile = (float*)smem;
  const float* rs = (const float*)(smem + G_RS_OFF);
  for (int it = blockIdx.x; it < 128 * 23; it += gridDim.x) {
    const int mt = it / 23, nt = it % 23;
    f32x16 acc[2][2];
    zero_acc(acc);
    gemm_mainloop<true>(P.hb + (size_t)mt * 128 * D, D, Wt + (size_t)nt * 128 * D, D, D, smem, acc);
    acc_to_lds(acc, tile);
    __syncthreads();
#pragma unroll 1
    for (int half = 0; half < 2; ++half) inproj_epilogue_half(P, l, mt, nt, half, tile, rs);
  }
}

__device__ __forceinline__ void phase_compress(const Params& P, int l, char* smem) {
  float* tile = (float*)smem;
  for (int it = blockIdx.x; it < 32; it += gridDim.x) {
    const int kv = it >> 4, g = (it >> 3) & 1, mt = it & 7;
    const u16* A = (kv ? P.VC : P.KC) + (size_t)g * (S + 64) * 64 + (size_t)mt * 128 * 1024;
    const u16* Bt = P.CmpWT + (size_t)(l * 2 + kv) * 128 * 2048;
    const float* bias = P.cmpbias + (l * 2 + kv) * 64;
    f32x16 acc[2][2];
    zero_acc(acc);
    gemm_mainloop<false>(A, 1024, Bt, 2048, 2048, smem, acc);
    acc_to_lds(acc, tile);
    __syncthreads();
#pragma unroll 1
    for (int half = 0; half < 2; ++half) {
      {
        const int lane = threadIdx.x & 63, wave = threadIdx.x >> 6;
        const int idx = mt * 128 + half * 64 + lane;
        float v[64];
        const f32x4* src = (const f32x4*)(tile + (half * 64 + lane) * EPS_LD);
#pragma unroll
        for (int i = 0; i < 16; ++i) { f32x4 t = src[i]; v[4 * i] = t[0] + bias[4 * i]; v[4 * i + 1] = t[1] + bias[4 * i + 1]; v[4 * i + 2] = t[2] + bias[4 * i + 2]; v[4 * i + 3] = t[3] + bias[4 * i + 3]; }
        float vo[16];
#pragma unroll
        for (int i = 0; i < 4; ++i) { f32x4 t = src[wave * 4 + i]; const float* bb = bias + wave * 16 + 4 * i; vo[4 * i] = t[0] + bb[0]; vo[4 * i + 1] = t[1] + bb[1]; vo[4 * i + 2] = t[2] + bb[2]; vo[4 * i + 3] = t[3] + bb[3]; }
        if (kv == 0) {
          const float* w = P.nsa_k_norm_w + l * 64;
          float ss = 0.f;
#pragma unroll
          for (int i = 0; i < 64; ++i) ss += v[i] * v[i];
          const float rn = rsqrtf(ss * (1.f / 64.f) + 1e-6f);
          u32 o[8];
#pragma unroll
          for (int i = 0; i < 8; ++i) o[i] = pack2(vo[2 * i] * rn * w[wave * 16 + 2 * i], vo[2 * i + 1] * rn * w[wave * 16 + 2 * i + 1]);
          u32x4* dp = (u32x4*)(P.KCC + ((size_t)g * 1024 + idx) * 64 + wave * 16);
          dp[0] = mk4(o[0], o[1], o[2], o[3]);
          dp[1] = mk4(o[4], o[5], o[6], o[7]);
        } else {
#pragma unroll
          for (int i = 0; i < 16; ++i) P.VCCt[((size_t)g * 64 + wave * 16 + i) * 1024 + idx] = f2bf(vo[i]);
        }
      }
    }
  }
}

constexpr int AK_ST = 144;
constexpr int AV_ST = 136;
constexpr int AT_VOFF = 64 * AK_ST;
constexpr int AT_COFF = AT_VOFF + 64 * AV_ST;
constexpr int AT_STAGE = AT_COFF + 256;
constexpr int AT_MISC = 2 * AT_STAGE;

struct TileRegs { u32x4 k[2]; u32x4 v[2]; };

DI void tile_load(int t, TileRegs& r, const u16* __restrict__ K, const u16* __restrict__ Vt, size_t ldv, int key0, bool with_v) {
#pragma unroll
  for (int i = 0; i < 2; ++i) {
    const int c = t + 256 * i, row = c >> 3, part = c & 7;
    r.k[i] = *(const u32x4*)(K + (size_t)(key0 + row) * 64 + part * 8);
    if (with_v) r.v[i] = *(const u32x4*)(Vt + (size_t)row * ldv + key0 + part * 8);
  }
}
DI void tile_store(int t, const TileRegs& r, char* st, bool with_v) {
#pragma unroll
  for (int i = 0; i < 2; ++i) {
    const int c = t + 256 * i, row = c >> 3, part = c & 7;
    *(u32x4*)(st + row * AK_ST + part * 16) = r.k[i];
    if (with_v) {
      u32x2* d = (u32x2*)(st + AT_VOFF + row * AV_ST + part * 16);
      d[0] = mk2(r.v[i].x, r.v[i].y);
      d[1] = mk2(r.v[i].z, r.v[i].w);
    }
  }
}
DI bf16x8 pack_p(const f32x16& p, int sp) {
  u32x4 u = mk4(pack2(p[8 * sp], p[8 * sp + 1]), pack2(p[8 * sp + 2], p[8 * sp + 3]), pack2(p[8 * sp + 4], p[8 * sp + 5]), pack2(p[8 * sp + 6], p[8 * sp + 7]));
  return __builtin_bit_cast(bf16x8, u);
}
template <int NKS, bool ZINIT>
DI void qk_half(int tid, const char* st, int dofs_bytes, int kt, const bf16x8 (&qf)[NKS], f32x16& s) {
  const int lane = tid & 63;
  const char* base = st + (kt * 32 + (lane & 31)) * AK_ST + (lane >> 5) * 16 + dofs_bytes;
#pragma unroll
  for (int ks = 0; ks < NKS; ++ks) {
    const bf16x8 a = *(const bf16x8*)(base + ks * 32);
    if (ZINIT && ks == 0) { const f32x16 z = {0.f, 0.f, 0.f, 0.f, 0.f, 0.f, 0.f, 0.f, 0.f, 0.f, 0.f, 0.f, 0.f, 0.f, 0.f, 0.f}; s = MFMA32(a, qf[ks], z); }
    else s = MFMA32(a, qf[ks], s);
  }
}
DI void pv_half(int tid, const char* st, int kt, const f32x16& p, f32x16 (&o)[2]) {
  const int lane = tid & 63;
  const char* vb = st + AT_VOFF + (lane & 31) * AV_ST + (lane >> 5) * 8 + kt * 64;
#pragma unroll
  for (int sp = 0; sp < 2; ++sp) {
    const bf16x8 pb = pack_p(p, sp);
#pragma unroll
    for (int dt = 0; dt < 2; ++dt) {
      const char* a = vb + dt * 32 * AV_ST + sp * 32;
      const u32x2 lo = *(const u32x2*)a, hi = *(const u32x2*)(a + 16);
      const u32x4 u = mk4(lo.x, lo.y, hi.x, hi.y);
      o[dt] = MFMA32(__builtin_bit_cast(bf16x8, u), pb, o[dt]);
    }
  }
}
DI void load_q4(int tid, bf16x8 (&qf)[4], const u16* __restrict__ Q, int tok) {
  const int lane = tid & 63;
  const u16* b = Q + (size_t)tok * 64 + (lane >> 5) * 8;
#pragma unroll
  for (int ks = 0; ks < 4; ++ks) qf[ks] = *(const bf16x8*)(b + ks * 16);
}
DI float max_abs64(int tid, const float* w) {
  return wave_max(fabsf(w[tid & 63]));
}

struct AttnArgs {
  const u16* K; const u16* Vt; size_t ldv;
  int t0, t1;
  int q;
  int wq0;
  float M2;
  int dofs;
  int lim_hi, lim_lo, whi, wlo;
  int mask_hi, mask_lo;
  float cq; const float* cloc; const float* base;
};

template <int MODE, int NKS, bool MASK>
DI void attn_tile(int tid, const AttnArgs& a, const char* cur, int key0, int lim_hi, int lim_lo, const bf16x8 (&qf)[NKS], f32x16 (&o)[2], float& l) {
  const int h = (tid & 63) >> 5;
#pragma unroll
  for (int kt = 0; kt < 2; ++kt) {
    f32x16 s;
    if (MODE == 0) {
      const float* ckb = (const float*)(cur + AT_COFF);
#pragma unroll
      for (int rg = 0; rg < 4; ++rg) {
        const f32x4 c4 = *(const f32x4*)(ckb + 32 * kt + 8 * rg + 4 * h);
#pragma unroll
        for (int i = 0; i < 4; ++i) s[4 * rg + i] = a.cq - c4[i];
      }
      qk_half<NKS, false>(tid, cur, a.dofs, kt, qf, s);
    } else {
      qk_half<NKS, true>(tid, cur, a.dofs, kt, qf, s);
    }
#pragma unroll
    for (int i = 0; i < 16; ++i) {
      float p = __builtin_amdgcn_exp2f(s[i]);
      if (MASK) { const int key = key0 + 32 * kt + crow(i, h); if (key > lim_hi || key < lim_lo) p = 0.f; }
      s[i] = p; l += p;
    }
    pv_half(tid, cur, kt, s, o);
  }
}
template <int MODE, int NKS, bool PF2 = false>
DI void attn_loop(int tid, const AttnArgs& a, const bf16x8 (&qf)[NKS], f32x16 (&o)[2], float& l, char* smem) {
  TileRegs rA, rB; float cbA = 0.f, cbB = 0.f;
  if (a.t0 >= a.t1) return;
  tile_load(tid, rA, a.K, a.Vt, a.ldv, a.t0 * 64, true);
  if (MODE == 0 && tid < 64) cbA = a.cloc[a.t0 * 64 + tid];
  tile_store(tid, rA, smem, true);
  if (MODE == 0 && tid < 64) ((float*)(smem + AT_COFF))[tid] = (a.base[a.t0] + cbA) * LOG2E;
  __syncthreads();
  auto step = [&](int t, TileRegs& rs, float& cbs, TileRegs& rl, float& cbl, int dist) {
    char* cur = smem + ((t - a.t0) & 1) * AT_STAGE;
    char* nxt = smem + ((t - a.t0 + 1) & 1) * AT_STAGE;
    if (t + dist < a.t1) {
      tile_load(tid, rl, a.K, a.Vt, a.ldv, (t + dist) * 64, true);
      if (MODE == 0 && tid < 64) cbl = a.cloc[(t + dist) * 64 + tid];
    }
    const int key0 = t * 64;
    bool active, need_mask;
    if (MODE == 0 || MODE == 3) { active = key0 <= a.wq0 + 31; need_mask = key0 + 63 > a.wq0; }
    else if (MODE == 1) { const int nmax_w = (a.wq0 + 31 - 31) >> 4; active = (a.wq0 + 31 >= 31) && key0 <= nmax_w; need_mask = true; }
    else if (MODE == 2) { active = (key0 <= a.wq0 + 31) && (key0 + 63 >= a.wq0 - 511); need_mask = (key0 + 63 > a.wq0) || (key0 < a.wq0 + 31 - 511); }
    else { active = (key0 <= a.whi) && (key0 + 63 >= a.wlo); need_mask = (key0 + 63 > a.mask_hi) || (key0 < a.mask_lo); }
    if (active) {
      int lim_hi, lim_lo;
      if (MODE == 0 || MODE == 3) { lim_hi = a.q; lim_lo = 0; }
      else if (MODE == 1) { lim_hi = (a.q >= 31) ? ((a.q - 31) >> 4) : -1; lim_lo = 0; }
      else if (MODE == 2) { lim_hi = a.q; lim_lo = a.q - 511; }
      else { lim_hi = a.lim_hi; lim_lo = a.lim_lo; }
      if (__builtin_amdgcn_readfirstlane((int)need_mask)) attn_tile<MODE, NKS, true>(tid, a, cur, key0, lim_hi, lim_lo, qf, o, l);
      else attn_tile<MODE, NKS, false>(tid, a, cur, key0, lim_hi, lim_lo, qf, o, l);
    }
    if (t + 1 < a.t1) {
      tile_store(tid, rs, nxt, true);
      if (MODE == 0 && tid < 64) ((float*)(nxt + AT_COFF))[tid] = (a.base[t + 1] + cbs) * LOG2E;
    }
    __syncthreads();
  };
  if (!PF2) {
    for (int t = a.t0; t < a.t1; ++t) step(t, rA, cbA, rA, cbA, 1);
  } else {
    if (a.t0 + 1 < a.t1) { tile_load(tid, rA, a.K, a.Vt, a.ldv, (a.t0 + 1) * 64, true); if (MODE == 0 && tid < 64) cbA = a.cloc[(a.t0 + 1) * 64 + tid]; }
    for (int t = a.t0; t < a.t1; t += 2) {
      step(t, rA, cbA, rB, cbB, 2);
      if (t + 1 >= a.t1) break;
      step(t + 1, rB, cbB, rA, cbA, 2);
    }
  }
}

DI void zero_o(f32x16 (&o)[2]) {
#pragma unroll
  for (int d = 0; d < 2; ++d)
#pragma unroll
    for (int i = 0; i < 16; ++i) o[d][i] = 0.f;
}

DI void fox_chunk_bases(int tid, const Params& P, int hd, float* base, float* wtot) {
  const int lane = tid & 63, wave = tid >> 6;
  const float x = P.ctot[tid * 4 + hd];
  float inc = x;
#pragma unroll
  for (int o = 1; o < 64; o <<= 1) { float t = __shfl_up(inc, o); if (lane >= o) inc += t; }
  if (lane == 63) wtot[wave] = inc;
  __syncthreads();
  float off = 0.f;
  for (int w = 0; w < wave; ++w) off += wtot[w];
  base[tid] = inc - x + off;
  __syncthreads();
}

__device__ __forceinline__ void fox_item(const Params& P, int l, int hd, int qb, char* smem) {
  const int tid = opaque_tid(), lane = tid & 63, wave = tid >> 6, h = lane >> 5;
  float* base = (float*)(smem + AT_MISC);
  float* wtot = base + 256;
  fox_chunk_bases(tid, P, hd, base, wtot);
  const float M2 = 8.f * max_abs64(tid, P.fox_q_norm_w + l * 64) * max_abs64(tid, P.fox_k_norm_w + l * 64) * LOG2E * 1.01f + 0.1f;
  const int wq0 = qb * 128 + wave * 32, q = wq0 + (lane & 31);
  AttnArgs a;
  a.K = P.KF + (size_t)hd * S * 64; a.Vt = P.VFt + (size_t)hd * 64 * S; a.ldv = S;
  a.t1 = 2 * qb + 2; a.q = q; a.wq0 = wq0; a.M2 = M2;
  a.cloc = P.cloc + (size_t)hd * S; a.base = base;
  {
    const bool skip = (tid + 1 < 2 * qb) && ((base[2 * qb] - base[tid + 1]) * LOG2E < -160.f);
    a.t0 = __syncthreads_count(skip ? 1 : 0);
  }
  a.cq = (base[q >> 6] + a.cloc[q]) * LOG2E - M2;
  bf16x8 qf[4];
  load_q4(tid, qf, P.QF + (size_t)hd * S * 64, q);
  f32x16 o[2]; zero_o(o);
  float ls = 0.f;
  a.dofs = 0;
  attn_loop<0, 4, true>(tid, a, qf, o, ls, smem);
  ls += __shfl_xor(ls, 32);
  const float inv = (ABLATE & 1) ? 0.f : 1.f / ls;
  u16* dst = P.mix + (size_t)q * 1024 + hd * 64 + 4 * h;
#pragma unroll
  for (int dt = 0; dt < 2; ++dt)
#pragma unroll
    for (int rg = 0; rg < 4; ++rg)
      *(u32x2*)(dst + 32 * dt + 8 * rg) = mk2(pack2(o[dt][4 * rg] * inv, o[dt][4 * rg + 1] * inv), pack2(o[dt][4 * rg + 2] * inv, o[dt][4 * rg + 3] * inv));
}

__device__ __forceinline__ void diff_item(const Params& P, int l, int hd, int qb, char* smem) {
  const int tid = opaque_tid(), lane = tid & 63, wave = tid >> 6, h = lane >> 5;
  const float mq = wave_max(fabsf(P.diff_q_norm_w[l * 32 + (lane & 31)])), mk = wave_max(fabsf(P.diff_k_norm_w[l * 32 + (lane & 31)]));
  const float M2 = 5.656854249f * mq * mk * LOG2E * 1.01f + 0.1f;
  const float* lv = P.diff_lambda + l * 128;
  float d1 = (lane < 32) ? lv[lane] * lv[32 + lane] : 0.f, d2 = (lane < 32) ? lv[64 + lane] * lv[96 + lane] : 0.f;
  d1 = wave_sum(d1); d2 = wave_sum(d2);
  const float lam_init = 0.8f - 0.6f * expf(-0.3f * (float)l);
  const float lam = expf(d1) - expf(d2) + lam_init;
  const int wq0 = qb * 128 + wave * 32, q = wq0 + (lane & 31);
  AttnArgs a;
  a.K = P.KD + (size_t)hd * S * 64; a.Vt = P.VDt + (size_t)hd * 64 * S; a.ldv = S;
  a.t0 = 0; a.t1 = 2 * qb + 2; a.q = q; a.wq0 = wq0; a.M2 = M2; a.cq = 0.f; a.cloc = nullptr; a.base = nullptr;
  float* stash = P.dstash + (size_t)blockIdx.x * (128 * 64) + tid;
  f32x16 o[2];
#pragma unroll 1
  for (int c = 0; c < 2; ++c) {
    const int tid = opaque_tid(), lane = tid & 63, h = lane >> 5;
    bf16x8 qf[2];
    {
      const u16* b = P.QD + ((size_t)hd * S + q) * 64 + c * 32 + h * 8;
      qf[0] = *(const bf16x8*)b; qf[1] = *(const bf16x8*)(b + 16);
    }
    zero_o(o);
    float ls = 0.f;
    a.dofs = c * 64;
    attn_loop<3, 2>(tid, a, qf, o, ls, smem);
    ls += __shfl_xor(ls, 32);
    if (c == 0) {
      const float i0 = 1.f / ls;
#pragma unroll
      for (int dt = 0; dt < 2; ++dt)
#pragma unroll
        for (int i = 0; i < 16; ++i) stash[(dt * 16 + i) * 256] = o[dt][i] * i0;
    } else {
      const float i1 = lam / ls;
      float ss = 0.f;
#pragma unroll
      for (int dt = 0; dt < 2; ++dt)
#pragma unroll
        for (int i = 0; i < 16; ++i) { const float v = stash[(dt * 16 + i) * 256] - o[dt][i] * i1; o[dt][i] = v; ss += v * v; }
      ss += __shfl_xor(ss, 32);
      const float rn = rsqrtf(ss * (1.f / 64.f) + 1e-6f) * (1.f - lam_init);
      const float* sw = P.diff_subln_w + l * 64;
      u16* dst = P.mix + (size_t)q * 1024 + 768 + hd * 64 + 4 * h;
#pragma unroll
      for (int dt = 0; dt < 2; ++dt)
#pragma unroll
        for (int rg = 0; rg < 4; ++rg) {
          const int d0 = 32 * dt + 8 * rg + 4 * h;
          *(u32x2*)(dst + 32 * dt + 8 * rg) = mk2(pack2(o[dt][4 * rg] * rn * sw[d0], o[dt][4 * rg + 1] * rn * sw[d0 + 1]),
                                                 pack2(o[dt][4 * rg + 2] * rn * sw[d0 + 2], o[dt][4 * rg + 3] * rn * sw[d0 + 3]));
        }
    }
  }
}

struct SelFrags { u32x2 k[8]; u32x2 v[8]; };

DI void sel_load(int tid, SelFrags& f, const unsigned char* __restrict__ Kg, const unsigned char* __restrict__ Vtg, int b) {
  const int lane = tid & 63, i = lane & 15, h4 = lane >> 4;
  const int bu = __builtin_amdgcn_readfirstlane(b);
  const unsigned char* kb = Kg + (size_t)bu * 4096 + lane * 8;
  const unsigned char* vb = Vtg + (size_t)bu * 4096 + lane * 8;
  (void)i; (void)h4;
#pragma unroll
  for (int L = 0; L < 8; ++L) f.k[L] = *(const u32x2*)(kb + L * 512);
#pragma unroll
  for (int L = 0; L < 8; ++L) f.v[L] = *(const u32x2*)(vb + L * 512);
}
template <bool MASK>
DI void sel_compute_t(int tid, const SelFrags& f, const u32x2 (&qb)[2], int b, int qpos, float M2, f32x4 (&o)[4], f32x4& ol) {
  const int lane = tid & 63, h4 = lane >> 4;
  const float c0 = 8.f - M2;
  const u32x2 ones = mk2(0x38383838u, 0x38383838u);
#pragma unroll
  for (int G = 0; G < 2; ++G) {
    f32x4 s[2];
#pragma unroll
    for (int t = 0; t < 2; ++t) {
      s[t] = (f32x4){0.f, 0.f, 0.f, 0.f};
#pragma unroll
      for (int ks = 0; ks < 2; ++ks)
        s[t] = __builtin_amdgcn_mfma_f32_16x16x32_fp8_fp8(__builtin_bit_cast(long, f.k[G * 4 + t * 2 + ks]), __builtin_bit_cast(long, qb[ks]), s[t], 0, 0, 0);
    }
#pragma unroll
    for (int t = 0; t < 2; ++t)
#pragma unroll
      for (int r = 0; r < 4; ++r) {
        float p = __builtin_amdgcn_exp2f(s[t][r] * 0.0625f + c0);
        if (MASK) { const int key = b * 64 + 32 * G + 8 * h4 + 4 * t + r; if (key > qpos) p = 0.f; }
        s[t][r] = p;
      }
    int w0 = 0, w1 = 0;
    w0 = __builtin_amdgcn_cvt_pk_bf8_f32(s[0][0], s[0][1], w0, false);
    w0 = __builtin_amdgcn_cvt_pk_bf8_f32(s[0][2], s[0][3], w0, true);
    w1 = __builtin_amdgcn_cvt_pk_bf8_f32(s[1][0], s[1][1], w1, false);
    w1 = __builtin_amdgcn_cvt_pk_bf8_f32(s[1][2], s[1][3], w1, true);
    const u32x2 pb = mk2((u32)w0, (u32)w1);
#pragma unroll
    for (int dt = 0; dt < 4; ++dt)
      o[dt] = __builtin_amdgcn_mfma_f32_16x16x32_fp8_bf8(__builtin_bit_cast(long, f.v[G * 4 + dt]), __builtin_bit_cast(long, pb), o[dt], 0, 0, 0);
    ol = __builtin_amdgcn_mfma_f32_16x16x32_fp8_bf8(__builtin_bit_cast(long, ones), __builtin_bit_cast(long, pb), ol, 0, 0, 0);
  }
}
DI void sel_compute(int tid, const SelFrags& f, const u32x2 (&qb)[2], int b, int cur, int qpos, float M2, f32x4 (&o)[4], f32x4& ol) {
  if (__builtin_amdgcn_readfirstlane(b) == __builtin_amdgcn_readfirstlane(cur)) sel_compute_t<true>(tid, f, qb, b, qpos, M2, o, ol);
  else sel_compute_t<false>(tid, f, qb, b, qpos, M2, o, ol);
}

__device__ __forceinline__ void nsa_item(const Params& P, int l, int g, int qb, char* smem, int secmask = 7) {
  const int tid = opaque_tid(), lane = tid & 63, wave = tid >> 6, h = lane >> 5;
  const int q0 = qb * 128, wq0 = q0 + wave * 32, q = wq0 + (lane & 31), ql = wave * 32 + (lane & 31);
  const int item = g * 128 + qb;
  const float M2 = 8.f * max_abs64(tid, P.nsa_q_norm_w + l * 64) * max_abs64(tid, P.nsa_k_norm_w + l * 64) * LOG2E * 1.01f + 0.1f;
  unsigned char* sel = (unsigned char*)(smem + AT_MISC);
  unsigned char* nsel = sel + 2048;
  float* impA = P.impA + (size_t)item * 256 * 128;
  float* impB = P.impB + (size_t)item * 256 * 128;
  const u16* Kc = P.KCC + (size_t)g * 1024 * 64;
  const int ntc = ((q0 + 96) >> 10) + 1;
  const int nmaxq = (q >= 31) ? ((q - 31) >> 4) : -1;
  const int nmax_w = wq0 >> 4;

  {
    float lh[4] = {0.f, 0.f, 0.f, 0.f};
#pragma unroll 1
    for (int pass = 0; pass < 2; ++pass) {
      float inv[4];
      if (pass == 1) {
#pragma unroll
        for (int hh = 0; hh < 4; ++hh) { float t = lh[hh] + __shfl_xor(lh[hh], 32); inv[hh] = (t > 0.f) ? 1.f / t : 0.f; }
      }
      TileRegs r;
      tile_load(tid, r, Kc, nullptr, 0, 0, false);
      tile_store(tid, r, smem, false);
      __syncthreads();
      for (int t = 0; t < ntc; ++t) {
        char* cur = smem + (t & 1) * AT_STAGE;
        char* nxt = smem + ((t + 1) & 1) * AT_STAGE;
        const bool more = (t + 1 < ntc);
        if (more) tile_load(tid, r, Kc, nullptr, 0, (t + 1) * 64, false);
        const int key0 = t * 64;
        f32x16 ps[2];
#pragma unroll
        for (int kt = 0; kt < 2; ++kt)
#pragma unroll
          for (int i = 0; i < 16; ++i) ps[kt][i] = 0.f;
        if (key0 <= nmax_w) {
#pragma unroll
          for (int hh = 0; hh < 4; ++hh) {
            f32x16 s[2];
            bf16x8 qf[4];
            load_q4(tid, qf, P.QN + (size_t)(g * 4 + hh) * S * 64, q);
            qk_half<4, true>(tid, cur, 0, 0, qf, s[0]);
            qk_half<4, true>(tid, cur, 0, 1, qf, s[1]);
#pragma unroll
            for (int kt = 0; kt < 2; ++kt)
#pragma unroll
              for (int i = 0; i < 16; ++i) {
                float p = __builtin_amdgcn_exp2f(s[kt][i]);
                const int key = key0 + 32 * kt + crow(i, h);
                if (key > nmaxq) p = 0.f;
                if (pass == 0) lh[hh] += p; else ps[kt][i] += p * inv[hh];
              }
          }
        }
        if (pass == 1) {
#pragma unroll
          for (int kt = 0; kt < 2; ++kt)
#pragma unroll
            for (int rg = 0; rg < 4; ++rg) {
              const int j = 16 * t + 8 * kt + 2 * rg + h;
              impA[(size_t)j * 128 + ql] = ps[kt][4 * rg] + ps[kt][4 * rg + 1] + ps[kt][4 * rg + 2] + ps[kt][4 * rg + 3];
              impB[(size_t)j * 128 + ql] = ps[kt][4 * rg + 3];
            }
        }
        if (more) tile_store(tid, r, nxt, false);
        __syncthreads();
      }
    }
  }
  __threadfence_block();
  __syncthreads();
  {
    const int qt = tid >> 1, half = tid & 1;
    const int qp = q0 + qt, cur = qp >> 6;
    u32 lst[13];
#pragma unroll
    for (int i = 0; i < 13; ++i) lst[i] = 0u;
    for (int j0 = 1 + half; j0 <= cur - 2; j0 += 8) {
      float sc[4];
#pragma unroll
      for (int u = 0; u < 4; ++u) {
        const int j = j0 + 2 * u, jc = j <= cur - 2 ? j : 1;
        sc[u] = impA[(size_t)jc * 128 + qt] + impB[(size_t)(jc - 1) * 128 + qt];
      }
#pragma unroll
      for (int u = 0; u < 4; ++u) {
        const int j = j0 + 2 * u;
        u32 x = (j <= cur - 2) ? ((__float_as_uint(sc[u]) & 0xffffff00u) | (u32)j) : 0u;
#pragma unroll
        for (int i = 0; i < 13; ++i) { const u32 hi = max(lst[i], x); x = min(lst[i], x); lst[i] = hi; }
      }
    }
    u32 oth[13];
#pragma unroll
    for (int i = 0; i < 13; ++i) oth[i] = (u32)__shfl_xor((int)lst[i], 1);
#pragma unroll
    for (int k = 0; k < 13; ++k) {
      u32 x = oth[k];
#pragma unroll
      for (int i = 0; i < 13; ++i) { const u32 hi = max(lst[i], x); x = min(lst[i], x); lst[i] = hi; }
    }
    if (half == 0) {
      unsigned char* sp = sel + qt * 16;
      int n = 0;
      sp[n++] = 0;
      if (cur >= 1) sp[n++] = (unsigned char)cur;
      if (cur >= 2) sp[n++] = (unsigned char)(cur - 1);
      const int ncand = cur - 2 < 13 ? cur - 2 : 13;
#pragma unroll
      for (int i = 0; i < 13; ++i) if (i < ncand) sp[n++] = (unsigned char)(lst[i] & 0xffu);
      nsel[qt] = (unsigned char)n;
    }
  }
  __syncthreads();
  if (secmask & 2) {
    const unsigned char* Kg = P.KS8 + (size_t)g * S * 64; const unsigned char* Vtg = P.VS8t + (size_t)g * 64 * S;
    const int col = lane & 15, h4 = lane >> 4, hd = col & 3;
    const unsigned char* selw = sel + wave * 32 * 16;
    const unsigned char* nselw = nsel + wave * 32;
    u32x2* q8 = (u32x2*)(smem + wave * 8448);
    float* gl = (float*)(smem + 41472 + wave * 1600);
    u16* vis = (u16*)(smem + 41472 + wave * 1600 + 512);
    {
#pragma unroll 4
      for (int c = lane; c < 1024; c += 64) {
        const int qi = c >> 5, head = (c >> 3) & 3, ch = c & 7;
        const u32x4 qv = *(const u32x4*)(P.QR + ((size_t)(g * 4 + head) * S + wq0 + qi) * 64 + ch * 8);
        int w0 = 0, w1 = 0;
        w0 = __builtin_amdgcn_cvt_pk_fp8_f32(bflo(qv.x) * 16.f, bfhi(qv.x) * 16.f, w0, false);
        w0 = __builtin_amdgcn_cvt_pk_fp8_f32(bflo(qv.y) * 16.f, bfhi(qv.y) * 16.f, w0, true);
        w1 = __builtin_amdgcn_cvt_pk_fp8_f32(bflo(qv.z) * 16.f, bfhi(qv.z) * 16.f, w1, false);
        w1 = __builtin_amdgcn_cvt_pk_fp8_f32(bflo(qv.w) * 16.f, bfhi(qv.w) * 16.f, w1, true);
        q8[(qi * 8 + ch) * 4 + head] = mk2((u32)w0, (u32)w1);
      }
      if (lane < 32) q8[(32 * 8 + (lane >> 2)) * 4 + (lane & 3)] = mk2(0u, 0u);
      for (int c = lane; c < 128; c += 64) gl[c] = P.gates[(size_t)(wq0 + (c >> 2)) * 24 + (g * 4 + (c & 3)) * 3 + 1];
      int cnt = (lane < 32) ? (int)nselw[lane] : 0, pre = cnt;
#pragma unroll
      for (int o = 1; o < 32; o <<= 1) { const int t2 = __shfl_up(pre, o); if ((lane & 31) >= o) pre += t2; }
      const int V = __builtin_amdgcn_readlane(pre, 31);
      pre -= cnt;
      if (lane < 32) for (int i = 0; i < cnt; ++i) vis[pre + i] = (u16)(selw[lane * 16 + i] | (lane << 8) | (i + 1 == cnt ? 0x8000 : 0));
      if (lane < 5) vis[V + lane] = (u16)(32 << 8);
      __builtin_amdgcn_s_waitcnt(0xc07f);
      __builtin_amdgcn_wave_barrier();
      const int V3 = ((V + 2) / 3) * 3;
      SelFrags fr[3];
      sel_load(tid, fr[0], Kg, Vtg, vis[0] & 0xff);
      sel_load(tid, fr[1], Kg, Vtg, vis[1] & 0xff);
      f32x4 o[4];
#pragma unroll
      for (int dt = 0; dt < 4; ++dt) o[dt] = (f32x4){0.f, 0.f, 0.f, 0.f};
      f32x4 ol = (f32x4){0.f, 0.f, 0.f, 0.f};
#pragma unroll 1
      for (int v = 0; v < V3; v += 3) {
#pragma unroll
        for (int slot = 0; slot < 3; ++slot) {
          const int e = __builtin_amdgcn_readfirstlane((int)vis[v + slot]);
          const int e2 = __builtin_amdgcn_readfirstlane((int)vis[v + slot + 2]);
          sel_load(tid, fr[(slot + 2) % 3], Kg, Vtg, e2 & 0xff);
          const int qi = (e >> 8) & 63, bb = e & 0xff, qp = wq0 + qi;
          u32x2 qcur[2];
          qcur[0] = q8[(qi * 8 + h4) * 4 + hd]; qcur[1] = q8[(qi * 8 + 4 + h4) * 4 + hd];
          sel_compute(tid, fr[slot], qcur, bb, qp >> 6, qp, M2, o, ol);
          if (e & 0x8000) {
            const float lsum = ol[0];
            if (col < 4 && (!(secmask & 8) || lsum == 1.2345e33f)) {
              const float gs = (ABLATE & 4) ? 0.f : gl[qi * 4 + col] / lsum;
              u16* dst = P.mix + (size_t)qp * 1024 + 256 + (g * 4 + col) * 64 + 4 * h4;
#pragma unroll
              for (int dt = 0; dt < 4; ++dt)
                *(u32x2*)(dst + 16 * dt) = mk2(pack2(o[dt][0] * gs, o[dt][1] * gs), pack2(o[dt][2] * gs, o[dt][3] * gs));
            }
#pragma unroll
            for (int dt = 0; dt < 4; ++dt) o[dt] = (f32x4){0.f, 0.f, 0.f, 0.f};
            ol = (f32x4){0.f, 0.f, 0.f, 0.f};
          }
        }
      }
    }
  }
  __threadfence_block();
  __syncthreads();
#pragma unroll 1
  for (int hh = 0; hh < ((secmask & 4) ? 4 : 0); ++hh) {
    const int H = g * 4 + hh;
#pragma unroll 1
    for (int br = 0; br < 2; ++br) {
      AttnArgs a;
      a.q = q; a.wq0 = wq0; a.M2 = M2; a.cq = 0.f; a.cloc = nullptr; a.base = nullptr; a.dofs = 0;
      bf16x8 qf[4];
      f32x16 o[2]; zero_o(o);
      float ls = 0.f;
      if (br == 0) {
        load_q4(tid, qf, P.QN + (size_t)H * S * 64, q);
        a.K = Kc; a.Vt = P.VCCt + (size_t)g * 64 * 1024; a.ldv = 1024; a.t0 = 0; a.t1 = ntc;
        a.lim_hi = nmaxq; a.lim_lo = 0; a.whi = nmax_w; a.wlo = 0; a.mask_hi = (wq0 >= 31) ? ((wq0 - 31) >> 4) : -1; a.mask_lo = 0;
      } else {
        load_q4(tid, qf, P.QR + (size_t)H * S * 64, q);
        a.K = P.KW + (size_t)g * S * 64; a.Vt = P.VWt + (size_t)g * 64 * S; a.ldv = S;
        a.t0 = (q0 >> 6) - 8 < 0 ? 0 : (q0 >> 6) - 8; a.t1 = (q0 >> 6) + 2;
        a.lim_hi = q; a.lim_lo = q - 511; a.whi = wq0 + 31; a.wlo = wq0 - 511; a.mask_hi = wq0; a.mask_lo = wq0 + 31 - 511;
      }
      attn_loop<4, 4, true>(tid, a, qf, o, ls, smem);
      ls += __shfl_xor(ls, 32);
      float gt = (ls > 0.f) ? P.gates[(size_t)q * 24 + H * 3 + (br == 0 ? 0 : 2)] / ls : 0.f;
      if ((ABLATE & 2) && br == 0) gt = 0.f;
      if ((ABLATE & 8) && br == 1) gt = 0.f;
      u16* dst = P.mix + (size_t)q * 1024 + 256 + H * 64 + 4 * h;
      if (!(secmask & 8) || ls == 1.2345e33f)
#pragma unroll
      for (int dt = 0; dt < 2; ++dt)
#pragma unroll
        for (int rg = 0; rg < 4; ++rg) {
          u32x2* pp = (u32x2*)(dst + 32 * dt + 8 * rg);
          const u32x2 old = *pp;
          const float r0 = bflo(old.x) + gt * o[dt][4 * rg];
          const float r1 = bfhi(old.x) + gt * o[dt][4 * rg + 1];
          const float r2 = bflo(old.y) + gt * o[dt][4 * rg + 2];
          const float r3 = bfhi(old.y) + gt * o[dt][4 * rg + 3];
          *pp = mk2(pack2(r0, r1), pack2(r2, r3));
        }
    }
  }
}

DI unsigned xcc_id() { return (unsigned)__builtin_amdgcn_s_getreg((3 << 11) | 20) & 0xFu; }

__device__ __forceinline__ void phase_attention(const Params& P, int l, char* smem, unsigned* counter, int secmask = 7, bool nsa_only = false) {
  int* slot = (int*)(smem + AT_MISC + 4096);
  const int mygrp = (int)(xcc_id() & 1u);
#pragma unroll 1
  for (int pass = 0; pass < 2; ++pass) {
    const int g = pass == 0 ? mygrp : 1 - mygrp;
    for (;;) {
      __syncthreads();
      if (threadIdx.x == 0) *slot = (int)atomicAdd(counter + g, 1u);
      __syncthreads();
      const int it = *slot;
      if (it >= 128) break;
      nsa_item(P, l, g, 127 - it, smem, secmask);
    }
  }
  for (;;) {
    __syncthreads();
    if (threadIdx.x == 0) *slot = (int)atomicAdd(counter + 2, 1u);
    __syncthreads();
    const int it = *slot;
    if (it >= 1024 || nsa_only) break;
    const int qb = 127 - (it >> 3), k = it & 7;
    if (k < 4) diff_item(P, l, k, qb, smem); else fox_item(P, l, k - 4, qb, smem);
  }
}

__device__ __forceinline__ void phase_outproj(const Params& P, int l, char* smem, bool dry = false) {
  const u16* Wt = P.WoutT + (size_t)l * D * D;
  float* tile = (float*)smem;
  const int tid = threadIdx.x;
  for (int it = blockIdx.x; it < 128 * 8; it += gridDim.x) {
    const int mt = it >> 3, nt = it & 7;
    f32x16 acc[2][2];
    zero_acc(acc);
    gemm_mainloop<false>(P.mix + (size_t)mt * 128 * D, D, Wt + (size_t)nt * 128 * D, D, D, smem, acc);
    acc_to_lds(acc, tile);
    __syncthreads();
    const int c4 = (tid & 31) * 4, r0 = tid >> 5;
#pragma unroll 4
    for (int i = 0; i < 16; ++i) {
      const int row = r0 + 8 * i;
      const size_t idx = (size_t)(mt * 128 + row) * D + nt * 128 + c4;
      const f32x4 a4 = *(const f32x4*)(tile + row * EPS_LD + c4);
      f32x4 h4 = *(const f32x4*)(P.out + idx);
      h4 += a4;
      if (!dry || h4[0] == 1.2345e33f) {
        *(f32x4*)(P.out + idx) = h4;
        *(u32x2*)(P.hb2 + idx) = mk2(pack2(h4[0], h4[1]), pack2(h4[2], h4[3]));
      }
    }
  }
}

constexpr int QT_ST = 272;
DI u32 ord_key(float x, u32 idx) {
  u32 u = __float_as_uint(x);
  u = (u & 0x80000000u) ? ~u : (u | 0x80000000u);
  return (u & 0xffffff80u) | idx;
}
DI float ord_val(u32 k) {
  return (k & 0x80000000u) ? __uint_as_float(k & 0x7fffff80u) : __uint_as_float((~k) & 0xffffff80u);
}
DI void merge16(u32 (&lst)[16], int xm) {
  u32 c[16];
#pragma unroll
  for (int i = 0; i < 16; ++i) { const u32 o = (u32)__shfl_xor((int)lst[15 - i], xm); c[i] = max(lst[i], o); }
#pragma unroll
  for (int st = 8; st > 0; st >>= 1)
#pragma unroll
    for (int i = 0; i < 16; ++i)
      if ((i & st) == 0) { const u32 a = max(c[i], c[i + st]), b = min(c[i], c[i + st]); c[i] = a; c[i + st] = b; }
#pragma unroll
  for (int i = 0; i < 16; ++i) lst[i] = c[i];
}

__device__ __forceinline__ void phase_peerq(const Params& P, int l, char* smem) {
  const u16* Wt = P.WqT + (size_t)l * 2048 * D;
  const int tid = threadIdx.x, lane = tid & 63, wave = tid >> 6, wr = wave >> 1, wc = wave & 1, h = lane >> 5;
  const float* rs = (const float*)(smem + G_RS_OFF);
  float* tile = (float*)smem;
  for (int it = blockIdx.x; it < 128 * 16; it += gridDim.x) {
    const int mt = it >> 4, nt = it & 15;
    f32x16 acc[2][2];
    zero_acc(acc);
    gemm_mainloop<true>(P.hb2 + (size_t)mt * 128 * D, D, Wt + (size_t)nt * 128 * D, D, D, smem, acc);
    __syncthreads();
#pragma unroll
    for (int i = 0; i < 2; ++i)
#pragma unroll
      for (int j = 0; j < 2; ++j)
#pragma unroll
        for (int r = 0; r < 16; ++r) {
          const int row = wr * 64 + i * 32 + crow(r, h);
          *(u16*)(smem + row * QT_ST + (wc * 64 + j * 32 + (lane & 31)) * 2) = f2bf(acc[i][j][r] * rs[row]);
        }
    __syncthreads();
    zero_acc(acc);
    {
      const u16* Bk = P.SubK + ((size_t)(l * 16 + nt) * 128 + wc * 64 + (lane & 31)) * 128 + h * 8;
      const char* Aq = smem + (wr * 64 + (lane & 31)) * QT_ST + h * 16;
#pragma unroll
      for (int ks = 0; ks < 8; ++ks) {
        bf16x8 af[2], bfr[2];
#pragma unroll
        for (int i = 0; i < 2; ++i) af[i] = *(const bf16x8*)(Aq + i * 32 * QT_ST + ks * 32);
#pragma unroll
        for (int j = 0; j < 2; ++j) bfr[j] = *(const bf16x8*)(Bk + (size_t)j * 32 * 128 + ks * 16);
#pragma unroll
        for (int i = 0; i < 2; ++i)
#pragma unroll
          for (int j = 0; j < 2; ++j) acc[i][j] = MFMA32(af[i], bfr[j], acc[i][j]);
      }
    }
    __syncthreads();
    acc_to_lds(acc, tile);
    __syncthreads();
#pragma unroll 1
    for (int half = 0; half < 2; ++half) {
      {
        const int row = half * 64 + (tid >> 2), part = tid & 3;
        u32 lst[16];
#pragma unroll
        for (int i = 0; i < 16; ++i) lst[i] = 0u;
        const f32x4* src = (const f32x4*)(tile + row * EPS_LD + part * 32);
#pragma unroll
        for (int c4 = 0; c4 < 8; ++c4) {
          const f32x4 v = src[c4];
#pragma unroll
          for (int e = 0; e < 4; ++e) {
            u32 x = ord_key(v[e], (u32)(part * 32 + c4 * 4 + e));
#pragma unroll
            for (int i = 0; i < 16; ++i) { const u32 hi = max(lst[i], x); x = min(lst[i], x); lst[i] = hi; }
          }
        }
        merge16(lst, 1);
        merge16(lst, 2);
        if (part == 0) {
          u32x4* dp = (u32x4*)(P.topk + ((size_t)(mt * 128 + row) * 16 + nt) * 16);
          dp[0] = mk4(lst[0], lst[1], lst[2], lst[3]); dp[1] = mk4(lst[4], lst[5], lst[6], lst[7]);
          dp[2] = mk4(lst[8], lst[9], lst[10], lst[11]); dp[3] = mk4(lst[12], lst[13], lst[14], lst[15]);
        }
      }
    }
  }
}

__device__ const unsigned char kCandIJ[50] = {
  0x00,0x01,0x02,0x03,0x04,0x05,0x06,0x07,0x08,0x09,0x0a,0x0b,0x0c,0x0d,0x0e,0x0f,
  0x10,0x11,0x12,0x13,0x14,0x15,0x16,0x17,
  0x20,0x21,0x22,0x23,0x24,
  0x30,0x31,0x32,0x33,
  0x40,0x41,0x42,
  0x50,0x51, 0x60,0x61, 0x70,0x71,
  0x80,0x90,0xa0,0xb0,0xc0,0xd0,0xe0,0xf0};
DI float gelu_exact(float x) { return 0.5f * x * (1.f + erff(x * 0.7071067811865476f)); }

__device__ __forceinline__ void phase_peer(const Params& P, int l, char* smem, bool dry = false) {
  const int tid = threadIdx.x, lane = tid & 63, wave = tid >> 6;
  char* wsm = smem + wave * 8192;
  u32* keys = (u32*)wsm;
  float* cv = (float*)(wsm + 1024);
  int* exps = (int*)(wsm + 1024 + 1664);
  float* esc = (float*)(wsm + 3200);
  float* wts = (float*)(wsm + 3712);
  float* uinv = (float*)(wsm + 4224);
  float* vinv = (float*)(wsm + 4736);
  unsigned char* xrow8 = (unsigned char*)(wsm + 5248);
  const unsigned char* U8 = P.U8 + (size_t)l * S * D;
  const unsigned char* V8 = P.V8 + (size_t)l * S * D;
  const float* Uinv = P.Uinv + l * S; const float* Vinv = P.Vinv + l * S;
  for (int it = blockIdx.x; it < S / 4; it += gridDim.x) {
    const int tok = it * 4 + wave;
    *(u32x4*)(keys + lane * 4) = *(const u32x4*)(P.topk + (size_t)tok * 256 + lane * 4);
    const u32x4 xa = *(const u32x4*)(P.hb2 + (size_t)tok * D + lane * 16), xb = *(const u32x4*)(P.hb2 + (size_t)tok * D + lane * 16 + 8);
    float rstd = wave_sum(ssq8(xa) + ssq8(xb));
    rstd = rsqrtf(rstd * (1.f / 1024.f) + 1e-6f);
    float xinv;
    {
      float xv[16] = {bflo(xa.x), bfhi(xa.x), bflo(xa.y), bfhi(xa.y), bflo(xa.z), bfhi(xa.z), bflo(xa.w), bfhi(xa.w),
                      bflo(xb.x), bfhi(xb.x), bflo(xb.y), bfhi(xb.y), bflo(xb.z), bfhi(xb.z), bflo(xb.w), bfhi(xb.w)};
      float m = 0.f;
#pragma unroll
      for (int i = 0; i < 16; ++i) m = fmaxf(m, fabsf(xv[i]));
      m = wave_max(m);
      const float sx = (m > 0.f) ? 240.f / m : 0.f;
      xinv = m * (1.f / 240.f);
      u32 o4[4];
#pragma unroll
      for (int i = 0; i < 4; ++i) {
        int wd = 0;
        wd = __builtin_amdgcn_cvt_pk_fp8_f32(xv[4 * i] * sx, xv[4 * i + 1] * sx, wd, false);
        wd = __builtin_amdgcn_cvt_pk_fp8_f32(xv[4 * i + 2] * sx, xv[4 * i + 3] * sx, wd, true);
        o4[i] = (u32)wd;
      }
      *(u32x4*)(xrow8 + lane * 16) = mk4(o4[0], o4[1], o4[2], o4[3]);
    }
    __builtin_amdgcn_s_waitcnt(0xc07f);
    const int hd = lane >> 3, sub = lane & 7;
    float myv[7]; int mye[7];
#pragma unroll
    for (int m = 0; m < 7; ++m) {
      const int c = sub + 8 * m;
      myv[m] = -3.0e38f; mye[m] = 0;
      if (c < 50) {
        const int ij = kCandIJ[c], i = ij >> 4, j = ij & 15;
        const u32 k1 = keys[(hd * 2) * 16 + i], k2 = keys[(hd * 2 + 1) * 16 + j];
        myv[m] = ord_val(k1) + ord_val(k2);
        mye[m] = (int)((k1 & 127u) * 128u + (k2 & 127u));
        cv[hd * 52 + c] = myv[m];
      }
    }
    __builtin_amdgcn_s_waitcnt(0xc07f);
#pragma unroll
    for (int m = 0; m < 7; ++m) {
      const int c = sub + 8 * m;
      if (c < 50) {
        int rank = 0;
        for (int c2 = 0; c2 < 50; ++c2) { const float o = cv[hd * 52 + c2]; rank += (o > myv[m]) || (o == myv[m] && c2 < c); }
        if (rank < 16) {
          exps[hd * 16 + rank] = mye[m]; esc[hd * 16 + rank] = myv[m];
          uinv[hd * 16 + rank] = Uinv[mye[m]]; vinv[hd * 16 + rank] = Vinv[mye[m]];
        }
      }
    }
    __builtin_amdgcn_s_waitcnt(0xc07f);
    float g0, g1;
    {
      const float mx = esc[hd * 16];
      const float e0 = expf(esc[hd * 16 + 2 * sub] - mx), e1 = expf(esc[hd * 16 + 2 * sub + 1] - mx);
      float sm = e0 + e1;
      sm += __shfl_xor(sm, 1); sm += __shfl_xor(sm, 2); sm += __shfl_xor(sm, 4);
      g0 = e0 / sm; g1 = e1 / sm;
    }
    wts[hd * 16 + 2 * sub] = g0; wts[hd * 16 + 2 * sub + 1] = g1;
    __builtin_amdgcn_s_waitcnt(0xc07f);
    {
      const int i16 = lane & 15, h4 = lane >> 4;
      u32x4 a0[8], a1[8];
      auto uload = [&](u32x4 (&a)[8], int c) {
        const unsigned char* urow = U8 + (size_t)exps[(c >> 1) * 16 + i16] * D + 32 * h4 + (c & 1) * 512;
#pragma unroll
        for (int i = 0; i < 4; ++i) { a[2 * i] = *(const u32x4*)(urow + i * 128); a[2 * i + 1] = *(const u32x4*)(urow + i * 128 + 16); }
      };
      f32x4 acc = (f32x4){0.f, 0.f, 0.f, 0.f};
      auto umma = [&](const u32x4 (&a)[8], int c) {
#pragma unroll
        for (int i = 0; i < 8; ++i) {
          const u32x4 b = *(const u32x4*)(xrow8 + (c & 1) * 512 + (i >> 1) * 128 + 32 * h4 + (i & 1) * 16);
          acc = __builtin_amdgcn_mfma_f32_16x16x32_fp8_fp8(__builtin_bit_cast(long, mk2(a[i].x, a[i].y)), __builtin_bit_cast(long, mk2(b.x, b.y)), acc, 0, 0, 0);
          acc = __builtin_amdgcn_mfma_f32_16x16x32_fp8_fp8(__builtin_bit_cast(long, mk2(a[i].z, a[i].w)), __builtin_bit_cast(long, mk2(b.z, b.w)), acc, 0, 0, 0);
        }
        if (c & 1) {
          if (i16 == 0) {
            const int eg = c >> 1;
#pragma unroll
            for (int r = 0; r < 4; ++r) {
              const int k = eg * 16 + 4 * h4 + r;
              wts[k] = wts[k] * gelu_exact(rstd * acc[r] * uinv[k] * xinv) * vinv[k];
            }
          }
          acc = (f32x4){0.f, 0.f, 0.f, 0.f};
        }
      };
      uload(a0, 0);
#pragma unroll 1
      for (int c = 0; c < 16; c += 2) {
        uload(a1, c + 1);
        umma(a0, c);
        if (c + 2 < 16) uload(a0, c + 2);
        umma(a1, c + 1);
      }
    }
    __builtin_amdgcn_s_waitcnt(0xc07f);
    float o[16];
#pragma unroll
    for (int i = 0; i < 16; ++i) o[i] = 0.f;
    {
      u32x4 va[8], vb2[8];
      auto vload = [&](u32x4 (&x0)[8], int k) {
#pragma unroll
        for (int u = 0; u < 8; ++u) x0[u] = *(const u32x4*)(V8 + (size_t)exps[k + u] * D + lane * 16);
      };
      auto vacc = [&](const u32x4 (&x0)[8], int k) {
#pragma unroll
        for (int u = 0; u < 8; ++u) {
          const float w = wts[k + u];
#pragma unroll
          for (int c = 0; c < 4; ++c) {
            const f32x2 lo = __builtin_amdgcn_cvt_pk_f32_fp8((int)x0[u][c], false), hi = __builtin_amdgcn_cvt_pk_f32_fp8((int)x0[u][c], true);
            o[4 * c] += w * lo[0]; o[4 * c + 1] += w * lo[1]; o[4 * c + 2] += w * hi[0]; o[4 * c + 3] += w * hi[1];
          }
        }
      };
      vload(va, 0);
#pragma unroll 1
      for (int k = 0; k < 128; k += 16) {
        vload(vb2, k + 8);
        vacc(va, k);
        if (k + 16 < 128) vload(va, k + 16);
        vacc(vb2, k + 8);
      }
    }
    if (!dry || o[0] == 1.2345e33f) {
      f32x4* op = (f32x4*)(P.out + (size_t)tok * D + lane * 16);
      float r[16];
#pragma unroll
      for (int i = 0; i < 4; ++i) { f32x4 t = op[i]; t.x += o[4 * i]; t.y += o[4 * i + 1]; t.z += o[4 * i + 2]; t.w += o[4 * i + 3]; op[i] = t; r[4 * i] = t.x; r[4 * i + 1] = t.y; r[4 * i + 2] = t.z; r[4 * i + 3] = t.w; }
      u32x4* hp = (u32x4*)(P.hb2 + (size_t)tok * D + lane * 16);
      hp[0] = mk4(pack2(r[0], r[1]), pack2(r[2], r[3]), pack2(r[4], r[5]), pack2(r[6], r[7]));
      hp[1] = mk4(pack2(r[8], r[9]), pack2(r[10], r[11]), pack2(r[12], r[13]), pack2(r[14], r[15]));
    }
  }
}

__device__ __forceinline__ void phase_ple(const Params& P, int l, char* smem, bool dry = false) {
  const u16* Wg = P.WgT + (size_t)l * D * D;
  const u16* Wp = P.WpT + (size_t)l * D * 256;
  const u16* pb = P.pb + (size_t)l * S * 256;
  const int tid = threadIdx.x, lane = tid & 63, wave = tid >> 6, wr = wave >> 1, h = lane >> 5;
  const float* rs = (const float*)(smem + G_RS_OFF);
  float* tile = (float*)smem;
  for (int it = blockIdx.x; it < 128 * 8; it += gridDim.x) {
    const int mt = it >> 3, nt = it & 7;
    f32x16 acc[2][2];
    zero_acc(acc);
    gemm_mainloop<false>(pb + (size_t)mt * 128 * 256, 256, Wp + (size_t)nt * 128 * 256, 256, 256, smem, acc);
    u16* side = (u16*)(smem + 36864);
    const int wc = wave & 1;
#pragma unroll
    for (int i = 0; i < 2; ++i)
#pragma unroll
      for (int j = 0; j < 2; ++j)
#pragma unroll
        for (int r = 0; r < 16; ++r)
          side[(wr * 64 + i * 32 + crow(r, h)) * 136 + wc * 64 + j * 32 + (lane & 31)] = f2bf(acc[i][j][r]);
    zero_acc(acc);
    gemm_mainloop<true>(P.hb2 + (size_t)mt * 128 * D, D, Wg + (size_t)nt * 128 * D, D, D, smem, acc);
    __syncthreads();
#pragma unroll
    for (int i = 0; i < 2; ++i)
#pragma unroll
      for (int j = 0; j < 2; ++j)
#pragma unroll
        for (int r = 0; r < 16; ++r) {
          const int row = wr * 64 + i * 32 + crow(r, h);
          const float pv = bf2f(side[row * 136 + wc * 64 + j * 32 + (lane & 31)]);
          acc[i][j][r] = sigmoidf_(acc[i][j][r] * rs[row]) * pv;
        }
    __syncthreads();
    acc_to_lds(acc, tile);
    __syncthreads();
    const int c4 = (tid & 31) * 4, r0 = tid >> 5;
#pragma unroll 4
    for (int i = 0; i < 16; ++i) {
      const int row = r0 + 8 * i;
      const size_t idx = (size_t)(mt * 128 + row) * D + nt * 128 + c4;
      const f32x4 a4 = *(const f32x4*)(tile + row * EPS_LD + c4);
      f32x4 h4 = *(const f32x4*)(P.out + idx);
      h4 += a4;
      if (!dry || h4[0] == 1.2345e33f) {
        *(f32x4*)(P.out + idx) = h4;
        *(u32x2*)(P.hb + idx) = mk2(pack2(h4[0], h4[1]), pack2(h4[2], h4[3]));
      }
    }
  }
}

constexpr int N_PHASES = 15;
#define XB_TMO      128
#define XB_XCNT(j)  (256  + 64 * (j))
#define XB_XSUB(j)  (1280 + 64 * (j))
#define XB_XGEN(j)  (2304 + 64 * (j))
#define XB_TOP      3328
#define XB_TOPGEN   3392
#define XCD_BAR_WORDS 3456
#define XB_SPIN_CAP (1u << 24)
typedef __attribute__((address_space(3))) unsigned las_u32;
DI unsigned xb_ld(unsigned* p) { return __hip_atomic_load(p, __ATOMIC_RELAXED, __HIP_MEMORY_SCOPE_AGENT); }
DI unsigned xb_add(unsigned* p, unsigned v) { return __hip_atomic_fetch_add(p, v, __ATOMIC_RELAXED, __HIP_MEMORY_SCOPE_AGENT); }
#define XB_SPIN(cond, bar) do { unsigned _sp = 0; while (cond) { __builtin_amdgcn_s_sleep(1); \
    if ((++_sp & 255u) == 0u) { if (xb_ld(&(bar)[XB_TMO])) break; if (_sp > XB_SPIN_CAP) { (void)xb_add(&(bar)[XB_TMO], 1u); break; } } } } while (0)
struct XcdBarrier { unsigned* bar; unsigned x; volatile las_u32* st; };
DI XcdBarrier xcd_barrier_post(unsigned* bar, volatile las_u32* st) {
  XcdBarrier b; b.bar = bar; b.x = (unsigned)__builtin_amdgcn_s_getreg((3 << 11) | 20) & 0xFu; b.st = st;
  if (threadIdx.x == 0) (void)xb_add(&bar[XB_XCNT(b.x)], 1u);
  return b;
}
DI void xcd_barrier_complete(unsigned* bar, unsigned x, unsigned& nloc, unsigned& nx) {
  const unsigned G = gridDim.x * gridDim.y * gridDim.z;
  unsigned sum, cnt, mine, sp = 0u;
  for (;;) {
    sum = 0u; cnt = 0u; mine = 0u;
#pragma unroll
    for (unsigned j = 0; j < 16; ++j) { const unsigned c = xb_ld(&bar[XB_XCNT(j)]); sum += c; cnt += (c > 0u) ? 1u : 0u; mine = (j == x) ? c : mine; }
    if (sum == G) break;
    __builtin_amdgcn_s_sleep(1);
    if ((++sp & 255u) == 0u) { if (xb_ld(&bar[XB_TMO])) break; if (sp > XB_SPIN_CAP) { (void)xb_add(&bar[XB_TMO], 1u); break; } }
  }
  nloc = mine > 0u ? mine : 1u; nx = cnt > 0u ? cnt : 1u;
}
DI void xcd_barrier(unsigned* xbar, unsigned xx, volatile las_u32* xst_) {
  XcdBarrier b; b.bar = xbar; b.x = xx; b.st = xst_;
  asm volatile("s_waitcnt vmcnt(0)" ::: "memory");
  __syncthreads();
  if (threadIdx.x == 0) {
    unsigned* bar = b.bar;
    __builtin_amdgcn_s_waitcnt(0);
    unsigned nloc = b.st[0], nx = b.st[1];
    if (nloc == 0u) { xcd_barrier_complete(bar, b.x, nloc, nx); b.st[0] = nloc; b.st[1] = nx; }
    const unsigned old = xb_add(&bar[XB_XSUB(b.x)], 1u);
    const unsigned gen = old / nloc;
    if (old + 1u == (gen + 1u) * nloc) {
      __builtin_amdgcn_fence(__ATOMIC_RELEASE, "agent");
      asm volatile("s_waitcnt vmcnt(0)" ::: "memory");
      const unsigned og = xb_add(&bar[XB_TOP], 1u);
      const unsigned tg = og / nx;
      if (og + 1u == (tg + 1u) * nx) xb_add(&bar[XB_TOPGEN], 1u);
      else XB_SPIN(xb_ld(&bar[XB_TOPGEN]) == tg, bar);
      __builtin_amdgcn_fence(__ATOMIC_ACQUIRE, "agent");
      xb_add(&bar[XB_XGEN(b.x)], 1u);
      asm volatile("s_waitcnt vmcnt(0)" ::: "memory");
    } else {
      XB_SPIN(xb_ld(&bar[XB_XGEN(b.x)]) == gen, bar);
      __builtin_amdgcn_fence(__ATOMIC_ACQUIRE, "agent");
      asm volatile("s_waitcnt vmcnt(0)" ::: "memory");
    }
  }
  __syncthreads();
}
__global__ void __launch_bounds__(NT, 2) hymba_mega(Params P, unsigned* counters) {
  __shared__ __attribute__((aligned(16))) char smem[SMEM_BYTES];
  cg::grid_group grid = cg::this_grid();
  const int lo = P.phase_lo, hi = P.phase_hi;
#ifndef ONLY_PHASE
#define ONLY_PHASE -1
#endif
#define PH_ON(k) (ONLY_PHASE < 0 || ONLY_PHASE == (k))
  volatile las_u32* xst = (volatile las_u32*)(smem + SMEM_BYTES - 16);
  if (threadIdx.x < 4) xst[threadIdx.x] = 0u;
  __syncthreads();
  unsigned* const xbar = counters + 64;
  const unsigned xcc = xcd_barrier_post(xbar, xst).x;
#define RUN(ph, kind, call) if (lo <= (ph) && (ph) < hi) { const bool dry = false; const int rep = 0; (void)dry; (void)rep; if (PH_ON(kind)) { call; } if ((ph) + 1 < hi) { if ((ph) == 0) grid.sync(); else xcd_barrier(xbar, xcc, xst); } }
#define RUNREP(ph, kind, call) if (lo <= (ph) && (ph) < hi) { \
    const int nrep = ((ph) == P.rep_ph) ? P.rep_n : 1; \
    for (int rep = 0; rep < nrep; ++rep) { const bool dry = rep > 0; (void)dry; \
      if (PH_ON(kind)) { call; } \
      if ((ph) + 1 < hi || rep + 1 < nrep) { xcd_barrier(xbar, xcc, xst); } } }
#ifndef REPEAT
#define REPEAT -1
#define RSEC 7
#endif
  RUN(0, 7, phase_prep(P, smem))
  RUN(1, 0, phase_inproj(P, 0, smem))
  RUN(2, 1, phase_compress(P, 0, smem))
  RUNREP(3, 2, phase_attention(P, 0, smem, counters + 4 * rep, dry ? (P.rep_sec | 8) : 7, dry && P.rep_nsa_only))
  RUN(4, 3, phase_outproj(P, 0, smem, dry))
  RUN(5, 4, phase_peerq(P, 0, smem))
  RUN(6, 5, phase_peer(P, 0, smem, dry))
  RUN(7, 6, phase_ple(P, 0, smem, dry))
  RUN(8, 0, phase_inproj(P, 1, smem))
  RUN(9, 1, phase_compress(P, 1, smem))
  RUN(10, 2, phase_attention(P, 1, smem, counters + 16))
  RUN(11, 3, phase_outproj(P, 1, smem))
  RUN(12, 4, phase_peerq(P, 1, smem))
  RUN(13, 5, phase_peer(P, 1, smem))
  RUN(14, 6, phase_ple(P, 1, smem))
}

static size_t align_up(size_t x, size_t a) { return (x + a - 1) / a * a; }

extern "C" void kernel_launch(void* const* d_in, const int* in_sizes, int n_in, void* d_out, int out_size, void* d_ws, size_t ws_size, hipStream_t stream) {
  static int grid_blocks = 0;
  if (!grid_blocks) {
    int dev = 0, cus = 0, per_cu = 0;
    hipGetDevice(&dev);
    hipDeviceGetAttribute(&cus, hipDeviceAttributeMultiprocessorCount, dev);
    hipOccupancyMaxActiveBlocksPerMultiprocessor(&per_cu, hymba_mega, NT, 0);
    if (per_cu > 2) per_cu = 2;
    if (per_cu < 1) per_cu = 1;
    grid_blocks = cus * per_cu;
  }
  Params P;
  memset(&P, 0, sizeof(P));
  P.x = (const float*)d_in[0]; P.p = (const float*)d_in[1]; P.positions = (const int*)d_in[2];
  P.attn_norm_w = (const float*)d_in[3]; P.w_in = (const float*)d_in[4]; P.fox_f_bias = (const float*)d_in[5];
  P.fox_q_norm_w = (const float*)d_in[6]; P.fox_k_norm_w = (const float*)d_in[7];
  P.nsa_q_norm_w = (const float*)d_in[8]; P.nsa_k_norm_w = (const float*)d_in[9]; P.nsa_cmp_pos = (const float*)d_in[10]; P.nsa_cmp_w = (const float*)d_in[11];
  P.diff_q_norm_w = (const float*)d_in[12]; P.diff_k_norm_w = (const float*)d_in[13]; P.diff_lambda = (const float*)d_in[14]; P.diff_subln_w = (const float*)d_in[15];
  P.w_out = (const float*)d_in[16]; P.ffn_norm_w = (const float*)d_in[17]; P.peer_w_q = (const float*)d_in[18]; P.peer_sub_keys = (const float*)d_in[19];
  P.peer_u = (const float*)d_in[20]; P.peer_v = (const float*)d_in[21]; P.ple_norm_w = (const float*)d_in[22]; P.ple_w_gate = (const float*)d_in[23]; P.ple_w_proj = (const float*)d_in[24];
  P.out = (float*)d_out;
  char* w = (char*)d_ws; size_t off = 0;
  auto take = [&](size_t bytes) { char* p = w + off; off = align_up(off + bytes, 256); return p; };
  unsigned* counters = (unsigned*)take(256 + XCD_BAR_WORDS * 4);
  P.WinT = (u16*)take((size_t)2 * NINP * D * 2);
  P.WoutT = (u16*)take((size_t)2 * D * D * 2);
  P.WqT = (u16*)take((size_t)2 * 2048 * D * 2);
  P.WgT = (u16*)take((size_t)2 * D * D * 2);
  P.WpT = (u16*)take((size_t)2 * D * 256 * 2);
  P.SubK = (u16*)take((size_t)2 * 16 * 128 * 128 * 2);
  P.CmpWT = (u16*)take((size_t)2 * 2 * 128 * 2048 * 2);
  P.cmpbias = (float*)take(2 * 2 * 64 * 4);
  P.U8 = (unsigned char*)take((size_t)2 * S * D);
  P.V8 = (unsigned char*)take((size_t)2 * S * D);
  P.Uinv = (float*)take((size_t)2 * S * 4); P.Vinv = (float*)take((size_t)2 * S * 4);
  P.hb = (u16*)take((size_t)S * D * 2);
  P.hb2 = (u16*)take((size_t)S * D * 2);
  P.pb = (u16*)take((size_t)2 * S * 256 * 2);
  P.ropeN = (float*)take((size_t)S * 64 * 4);
  P.ropeD = (float*)take((size_t)S * 32 * 4);
  P.QF = (u16*)take((size_t)4 * S * 64 * 2); P.KF = (u16*)take((size_t)4 * S * 64 * 2); P.VFt = (u16*)take((size_t)4 * S * 64 * 2);
  P.cloc = (float*)take((size_t)4 * S * 4); P.ctot = (float*)take(256 * 4 * 4);
  P.QN = (u16*)take((size_t)8 * S * 64 * 2); P.QR = (u16*)take((size_t)8 * S * 64 * 2);
  P.KC = (u16*)take((size_t)2 * (S + 64) * 64 * 2); P.VC = (u16*)take((size_t)2 * (S + 64) * 64 * 2);
  P.KCC = (u16*)take((size_t)2 * 1024 * 64 * 2); P.VCCt = (u16*)take((size_t)2 * 64 * 1024 * 2);
  P.KS8 = (unsigned char*)take((size_t)2 * S * 64); P.VS8t = (unsigned char*)take((size_t)2 * S * 64);
  P.KW = (u16*)take((size_t)2 * S * 64 * 2); P.VWt = (u16*)take((size_t)2 * S * 64 * 2);
  P.gates = (float*)take((size_t)S * 24 * 4);
  P.QD = (u16*)take((size_t)4 * S * 64 * 2); P.KD = (u16*)take((size_t)4 * S * 64 * 2); P.VDt = (u16*)take((size_t)4 * S * 64 * 2);
  P.mix = (u16*)take((size_t)S * D * 2);
  P.dstash = (float*)take((size_t)grid_blocks * 128 * 64 * 4);
  P.impA = (float*)take((size_t)256 * 256 * 128 * 4); P.impB = (float*)take((size_t)256 * 256 * 128 * 4);
  P.topk = (u32*)take((size_t)S * 256 * 4);
  if (off > ws_size) { fprintf(stderr, "kernel_launch: workspace too small: need %zu, have %zu\n", off, ws_size); return; }
  hipMemsetAsync(counters, 0, 256 + XCD_BAR_WORDS * 4, stream);
#ifndef SINGLE_LAUNCH
#define SINGLE_LAUNCH 1
#endif
#ifndef REP_PH
#define REP_PH -1
#endif
#ifndef REP_N
#define REP_N 1
#endif
#ifndef REP_SEC
#define REP_SEC 7
#endif
#ifndef REP_NSA_ONLY
#define REP_NSA_ONLY 0
#endif
  P.rep_ph = REP_PH; P.rep_n = REP_N; P.rep_sec = REP_SEC; P.rep_nsa_only = REP_NSA_ONLY;
  if (SINGLE_LAUNCH) {
    P.phase_lo = 0; P.phase_hi = N_PHASES;
    void* args[] = {&P, &counters};
    hipError_t e = hipLaunchCooperativeKernel((void*)hymba_mega, dim3(grid_blocks), dim3(NT), args, 0, stream);
    if (e != hipSuccess) fprintf(stderr, "cooperative launch failed: %s (grid %d)\n", hipGetErrorString(e), grid_blocks);
  } else {
    for (int ph = 0; ph < N_PHASES; ++ph) {
      P.phase_lo = ph; P.phase_hi = ph + 1;
      void* args[] = {&P, &counters};
      hipError_t e = hipLaunchCooperativeKernel((void*)hymba_mega, dim3(grid_blocks), dim3(NT), args, 0, stream);
      if (e != hipSuccess) { fprintf(stderr, "cooperative launch failed: %s (grid %d, phase %d)\n", hipGetErrorString(e), grid_blocks, ph); break; }
    }
  }
}
```

```cpp
#include <hip/hip_runtime.h>
#include <hip/hip_cooperative_groups.h>
#include <cstdio>
#include <cstdint>
#include <cstring>
namespace cg = cooperative_groups;

typedef __attribute__((ext_vector_type(8))) short bf16x8;
typedef __attribute__((ext_vector_type(4))) short bf16x4;
typedef __attribute__((ext_vector_type(16))) float f32x16;
typedef __attribute__((ext_vector_type(4))) float f32x4;
typedef __attribute__((ext_vector_type(2))) float f32x2;
typedef __attribute__((ext_vector_type(2))) __bf16 bf2_t;
typedef unsigned short u16;
typedef unsigned int u32;
typedef __attribute__((ext_vector_type(4))) unsigned int u32x4;
typedef __attribute__((ext_vector_type(2))) unsigned int u32x2;

#define DI __device__ __forceinline__
#define MFMA32(a, b, c) __builtin_amdgcn_mfma_f32_32x32x16_bf16((a), (b), (c), 0, 0, 0)
#define MFMA16(a, b, c) __builtin_amdgcn_mfma_f32_16x16x32_bf16((a), (b), (c), 0, 0, 0)

constexpr int S = 16384;
constexpr int D = 1024;
constexpr int NT = 256;
constexpr int NIN = 2844;
constexpr int NINP = 2944;
constexpr int SMEM_BYTES = 72704;
constexpr float LOG2E = 1.4426950408889634f;
#ifndef ABLATE
#define ABLATE 0
#endif

struct Params {
  const float* x; const float* p; const int* positions;
  const float* attn_norm_w; const float* w_in; const float* fox_f_bias; const float* fox_q_norm_w; const float* fox_k_norm_w;
  const float* nsa_q_norm_w; const float* nsa_k_norm_w; const float* nsa_cmp_pos; const float* nsa_cmp_w;
  const float* diff_q_norm_w; const float* diff_k_norm_w; const float* diff_lambda; const float* diff_subln_w;
  const float* w_out; const float* ffn_norm_w; const float* peer_w_q; const float* peer_sub_keys; const float* peer_u; const float* peer_v;
  const float* ple_norm_w; const float* ple_w_gate; const float* ple_w_proj;
  float* out;
  u16* WinT;
  u16* WoutT;
  u16* WqT;
  u16* WgT;
  u16* WpT;
  u16* SubK;
  u16* CmpWT;
  float* cmpbias;
  unsigned char* U8;
  unsigned char* V8;
  float* Uinv; float* Vinv;
  u16* hb;
  u16* hb2;
  u16* pb;
  float* ropeN;
  float* ropeD;
  u16* QF; u16* KF; u16* VFt;
  float* cloc; float* ctot;
  u16* QN; u16* QR;
  u16* KC; u16* VC;
  u16* KCC; u16* VCCt;
  unsigned char* KS8; unsigned char* VS8t;
  u16* KW; u16* VWt;
  float* gates;
  u16* QD; u16* KD; u16* VDt;
  u16* mix;
  float* dstash;
  float* impA; float* impB;
  u32* topk;
  int phase_lo, phase_hi;
  int rep_ph, rep_n, rep_sec, rep_nsa_only;
};

DI u32x4 mk4(u32 a, u32 b, u32 c, u32 d) { return (u32x4){a, b, c, d}; }
DI u32x2 mk2(u32 a, u32 b) { return (u32x2){a, b}; }
DI u32 pack2(float a, float b) { f32x2 v = {a, b}; bf2_t r = __builtin_convertvector(v, bf2_t); return __builtin_bit_cast(u32, r); }
DI u16 f2bf(float a) { return (u16)(pack2(a, 0.f) & 0xffffu); }
DI float bf2f(u16 x) { return __uint_as_float(((u32)x) << 16); }
DI float bflo(u32 x) { return __uint_as_float(x << 16); }
DI float bfhi(u32 x) { return __uint_as_float(x & 0xffff0000u); }
DI int opaque_tid() { int t = threadIdx.x; asm volatile("" : "+v"(t)); return t; }
DI int crow(int reg, int h) { return (reg & 3) + 8 * (reg >> 2) + 4 * h; }
DI float wave_sum(float v) {
#pragma unroll
  for (int o = 32; o > 0; o >>= 1) v += __shfl_xor(v, o);
  return v;
}
DI float wave_max(float v) {
#pragma unroll
  for (int o = 32; o > 0; o >>= 1) v = fmaxf(v, __shfl_xor(v, o));
  return v;
}

DI int inproj_old_col(int j) {
  if (j < 768) return j;
  if (j < 2048) return j + 4;
  if (j < 2816) return j + 28;
  if (j < 2820) return j - 2048;
  if (j < 2844) return j - 768;
  return -1;
}
DI void transpose_tile(const float* __restrict__ src, int ldsrc, u16* __restrict__ dst, int K, const float* __restrict__ scale,
                       int n0, int k0, int mode, int nvalid, float* tile) {
  const int t = threadIdx.x;
  const int nn = t & 63, kq = t >> 6;
  int col = n0 + nn;
  if (mode == 1) col = inproj_old_col(col); else if (col >= nvalid) col = -1;
  float v[16];
#pragma unroll
  for (int i = 0; i < 16; ++i) v[i] = (col >= 0) ? src[(size_t)(k0 + kq + 4 * i) * ldsrc + col] : 0.f;
  if (scale) {
#pragma unroll
    for (int i = 0; i < 16; ++i) v[i] *= scale[k0 + kq + 4 * i];
  }
#pragma unroll
  for (int i = 0; i < 16; ++i) tile[(kq + 4 * i) * 65 + nn] = v[i];
  __syncthreads();
  const int n2 = t >> 2, kc = (t & 3) * 16;
  u32 o[8];
#pragma unroll
  for (int i = 0; i < 8; ++i) o[i] = pack2(tile[(kc + 2 * i) * 65 + n2], tile[(kc + 2 * i + 1) * 65 + n2]);
  u32x4* dp = (u32x4*)(dst + (size_t)(n0 + n2) * K + k0 + kc);
  dp[0] = mk4(o[0], o[1], o[2], o[3]);
  dp[1] = mk4(o[4], o[5], o[6], o[7]);
  __syncthreads();
}

DI void convert_rows(const float* __restrict__ src, u16* __restrict__ dst, size_t n8, float* __restrict__ copy) {
  const size_t stride = (size_t)gridDim.x * NT;
  for (size_t i0 = (size_t)blockIdx.x * NT + threadIdx.x; i0 < n8; i0 += 4 * stride) {
    f32x4 a[4], b[4];
#pragma unroll
    for (int u = 0; u < 4; ++u) {
      const size_t i = i0 + u * stride;
      if (i < n8) { a[u] = ((const f32x4*)src)[2 * i]; b[u] = ((const f32x4*)src)[2 * i + 1]; }
    }
#pragma unroll
    for (int u = 0; u < 4; ++u) {
      const size_t i = i0 + u * stride;
      if (i < n8) {
        if (copy) { ((f32x4*)copy)[2 * i] = a[u]; ((f32x4*)copy)[2 * i + 1] = b[u]; }
        ((u32x4*)dst)[i] = mk4(pack2(a[u][0], a[u][1]), pack2(a[u][2], a[u][3]), pack2(b[u][0], b[u][1]), pack2(b[u][2], b[u][3]));
      }
    }
  }
}

__device__ __forceinline__ void phase_prep(const Params& P, char* smem) {
  float* tile = (float*)smem;
  const int bid = blockIdx.x, nb = gridDim.x, t = threadIdx.x;
  for (int it0 = bid; it0 < 2 * 1952; it0 += nb) {
    const int l = it0 / 1952;
    int it = it0 % 1952;
    if (it < 736) { transpose_tile(P.w_in + (size_t)l * D * NIN, NIN, P.WinT + (size_t)l * NINP * D, D, P.attn_norm_w + l * D, (it >> 4) * 64, (it & 15) * 64, 1, 0, tile); continue; }
    it -= 736;
    if (it < 256) { transpose_tile(P.w_out + (size_t)l * D * D, D, P.WoutT + (size_t)l * D * D, D, nullptr, (it >> 4) * 64, (it & 15) * 64, 0, D, tile); continue; }
    it -= 256;
    if (it < 512) { transpose_tile(P.peer_w_q + (size_t)l * D * 2048, 2048, P.WqT + (size_t)l * 2048 * D, D, P.ffn_norm_w + l * D, (it >> 4) * 64, (it & 15) * 64, 0, 2048, tile); continue; }
    it -= 512;
    if (it < 256) { transpose_tile(P.ple_w_gate + (size_t)l * D * D, D, P.WgT + (size_t)l * D * D, D, P.ple_norm_w + l * D, (it >> 4) * 64, (it & 15) * 64, 0, D, tile); continue; }
    it -= 256;
    if (it < 64) { transpose_tile(P.ple_w_proj + (size_t)l * 256 * D, D, P.WpT + (size_t)l * D * 256, 256, nullptr, (it >> 2) * 64, (it & 3) * 64, 0, D, tile); continue; }
    it -= 64;
    { const int kv = it >> 6, i2 = it & 63;
      transpose_tile(P.nsa_cmp_w + (size_t)(l * 2 + kv) * 2048 * 64, 64, P.CmpWT + (size_t)(l * 2 + kv) * 128 * 2048, 2048, nullptr, (i2 >> 5) * 64, (i2 & 31) * 64, 0, 64, tile); }
  }
  convert_rows(P.peer_sub_keys, P.SubK, (size_t)2 * 16 * 128 * 128 / 8, nullptr);
  {
    const int lane = t & 63, gw = bid * 4 + (t >> 6), ngw = nb * 4;
    for (int r = gw; r < 4 * S; r += ngw) {
      const int tbl = r / (2 * S), l = (r / S) & 1, e = r % S;
      const float* src = (tbl ? P.peer_v : P.peer_u) + ((size_t)l * S + e) * D + lane * 16;
      float v[16];
#pragma unroll
      for (int i = 0; i < 4; ++i) { const f32x4 q4 = ((const f32x4*)src)[i]; v[4 * i] = q4[0]; v[4 * i + 1] = q4[1]; v[4 * i + 2] = q4[2]; v[4 * i + 3] = q4[3]; }
      if (tbl == 0) {
        const float* w = P.ffn_norm_w + l * D + lane * 16;
#pragma unroll
        for (int i = 0; i < 16; ++i) v[i] *= w[i];
      }
      float m = 0.f;
#pragma unroll
      for (int i = 0; i < 16; ++i) m = fmaxf(m, fabsf(v[i]));
      m = wave_max(m);
      if (tbl == 0) {
        const float sc = (m > 0.f) ? 240.f / m : 0.f;
        u32 o[4];
#pragma unroll
        for (int i = 0; i < 4; ++i) {
          int wd = 0;
          wd = __builtin_amdgcn_cvt_pk_fp8_f32(v[4 * i] * sc, v[4 * i + 1] * sc, wd, false);
          wd = __builtin_amdgcn_cvt_pk_fp8_f32(v[4 * i + 2] * sc, v[4 * i + 3] * sc, wd, true);
          o[i] = (u32)wd;
        }
        *(u32x4*)(P.U8 + ((size_t)l * S + e) * D + lane * 16) = mk4(o[0], o[1], o[2], o[3]);
        if (lane == 0) P.Uinv[l * S + e] = m * (1.f / 240.f);
      } else {
        const float sc = (m > 0.f) ? 6.f / m : 0.f;
        u32 o[2] = {0u, 0u};
#pragma unroll
        for (int i = 0; i < 8; ++i) {
          if ((i & 3) == 0) o[i >> 2] = __builtin_amdgcn_cvt_scalef32_pk_fp4_f32(o[i >> 2], v[2 * i] * sc, v[2 * i + 1] * sc, 1.0f, 0);
          else if ((i & 3) == 1) o[i >> 2] = __builtin_amdgcn_cvt_scalef32_pk_fp4_f32(o[i >> 2], v[2 * i] * sc, v[2 * i + 1] * sc, 1.0f, 1);
          else if ((i & 3) == 2) o[i >> 2] = __builtin_amdgcn_cvt_scalef32_pk_fp4_f32(o[i >> 2], v[2 * i] * sc, v[2 * i + 1] * sc, 1.0f, 2);
          else o[i >> 2] = __builtin_amdgcn_cvt_scalef32_pk_fp4_f32(o[i >> 2], v[2 * i] * sc, v[2 * i + 1] * sc, 1.0f, 3);
        }
        *(u32x2*)(P.V8 + ((size_t)l * S + e) * (D / 2) + lane * 8) = mk2(o[0], o[1]);
        if (lane == 0) P.Vinv[l * S + e] = m * (1.f / 6.f);
      }
    }
  }
  convert_rows(P.p, P.pb, (size_t)2 * S * 256 / 8, nullptr);
  convert_rows(P.x, P.hb, (size_t)S * D / 8, P.out);
  const size_t gtid = (size_t)bid * NT + t, gstride = (size_t)nb * NT;
  __syncthreads();
  if (t < 48) tile[t] = (t < 32) ? powf(10000.f, -(float)t / 32.f) : powf(10000.f, -(float)(t - 32) / 16.f);
  __syncthreads();
  for (size_t i = gtid; i < (size_t)S * 48; i += gstride) {
    const int tok = (int)(i / 48), r = (int)(i % 48);
    const float pos = (float)P.positions[tok];
    const float invf = tile[r];
    const float ang = pos * invf;
    const double rev = (double)ang * 0.15915494309189535;
    const float fr = (float)(rev - floor(rev));
    const float c = __builtin_amdgcn_cosf(fr), s = __builtin_amdgcn_sinf(fr);
    if (r < 32) { P.ropeN[(size_t)tok * 64 + r] = c; P.ropeN[(size_t)tok * 64 + 32 + r] = s; }
    else { P.ropeD[(size_t)tok * 32 + (r - 32)] = c; P.ropeD[(size_t)tok * 32 + 16 + (r - 32)] = s; }
  }
  {
    const int lane = t & 63, gw = bid * 4 + (t >> 6), ngw = nb * 4;
    for (int i = gw; i < 2 * 2 * 64; i += ngw) {
      const int lk = i >> 6, e = i & 63;
      const float* pos = P.nsa_cmp_pos + (size_t)lk * 2048;
      const float* w = P.nsa_cmp_w + (size_t)lk * 2048 * 64;
      float a = 0.f;
#pragma unroll 8
      for (int k = lane; k < 2048; k += 64) a += pos[k] * w[(size_t)k * 64 + e];
      a = wave_sum(a);
      if (lane == 0) P.cmpbias[i] = a;
    }
  }
  for (size_t i = gtid; i < 2 * 2 * 64 * 64; i += gstride) {
    const int which = (int)(i / (2 * 64 * 64)), r = (int)(i % (2 * 64 * 64));
    const int g = r / (64 * 64), o = r % (64 * 64);
    u16* base = which ? P.VC : P.KC;
    base[(size_t)g * (S + 64) * 64 + (size_t)S * 64 + o] = 0;
  }
}

constexpr int GST = 144;
constexpr int G_BOFF = 128 * GST;
constexpr int G_RS_OFF = 71680;

DI float ssq8(const u32x4& v) {
  float s = 0.f;
  float a;
  a = bflo(v.x); s += a * a; a = bfhi(v.x); s += a * a;
  a = bflo(v.y); s += a * a; a = bfhi(v.y); s += a * a;
  a = bflo(v.z); s += a * a; a = bfhi(v.z); s += a * a;
  a = bflo(v.w); s += a * a; a = bfhi(v.w); s += a * a;
  return s;
}

template <bool SSQ>
DI void gemm_mainloop(const u16* __restrict__ A, int lda, const u16* __restrict__ Bt, int ldb, int K, char* sm, f32x16 (&acc)[2][2]) {
  const int tid = threadIdx.x, lane = tid & 63, wave = tid >> 6;
  const int wr = wave >> 1, wc = wave & 1;
  const int lrow = tid >> 3, lcol = (tid & 7) * 8;
  char* As = sm; char* Bs = sm + G_BOFF;
  u32x4 ra[4], rb[4];
  float ssq[4] = {0.f, 0.f, 0.f, 0.f};
#pragma unroll
  for (int i = 0; i < 4; ++i) {
    ra[i] = *(const u32x4*)(A + (size_t)(lrow + 32 * i) * lda + lcol);
    rb[i] = *(const u32x4*)(Bt + (size_t)(lrow + 32 * i) * ldb + lcol);
  }
  const int aoff = (wr * 64 + (lane & 31)) * GST + (lane >> 5) * 16;
  const int boff = (wc * 64 + (lane & 31)) * GST + (lane >> 5) * 16;
  for (int k0 = 0; k0 < K; k0 += 64) {
    __syncthreads();
#pragma unroll
    for (int i = 0; i < 4; ++i) {
      *(u32x4*)(As + (lrow + 32 * i) * GST + lcol * 2) = ra[i];
      *(u32x4*)(Bs + (lrow + 32 * i) * GST + lcol * 2) = rb[i];
      if (SSQ) ssq[i] += ssq8(ra[i]);
    }
    __syncthreads();
    if (k0 + 64 < K) {
#pragma unroll
      for (int i = 0; i < 4; ++i) {
        ra[i] = *(const u32x4*)(A + (size_t)(lrow + 32 * i) * lda + k0 + 64 + lcol);
        rb[i] = *(const u32x4*)(Bt + (size_t)(lrow + 32 * i) * ldb + k0 + 64 + lcol);
      }
    }
#pragma unroll
    for (int ks = 0; ks < 4; ++ks) {
      bf16x8 af[2], bfr[2];
#pragma unroll
      for (int i = 0; i < 2; ++i) af[i] = *(const bf16x8*)(As + aoff + i * 32 * GST + ks * 32);
#pragma unroll
      for (int j = 0; j < 2; ++j) bfr[j] = *(const bf16x8*)(Bs + boff + j * 32 * GST + ks * 32);
#pragma unroll
      for (int i = 0; i < 2; ++i)
#pragma unroll
        for (int j = 0; j < 2; ++j) acc[i][j] = MFMA32(af[i], bfr[j], acc[i][j]);
    }
  }
  __syncthreads();
  if (SSQ) {
    float* rs = (float*)(sm + G_RS_OFF);
#pragma unroll
    for (int i = 0; i < 4; ++i) {
      float s = ssq[i];
      s += __shfl_xor(s, 1); s += __shfl_xor(s, 2); s += __shfl_xor(s, 4);
      if ((tid & 7) == 0) rs[lrow + 32 * i] = rsqrtf(s * (1.f / (float)K) + 1e-6f);
    }
  }
}

DI void zero_acc(f32x16 (&acc)[2][2]) {
#pragma unroll
  for (int i = 0; i < 2; ++i)
#pragma unroll
    for (int j = 0; j < 2; ++j)
#pragma unroll
      for (int r = 0; r < 16; ++r) acc[i][j][r] = 0.f;
}

constexpr int EPS_LD = 132;
DI void acc_to_lds(const f32x16 (&acc)[2][2], float* tile) {
  const int lane = threadIdx.x & 63, wave = threadIdx.x >> 6;
  const int wr = wave >> 1, wc = wave & 1;
#pragma unroll
  for (int i = 0; i < 2; ++i)
#pragma unroll
    for (int j = 0; j < 2; ++j)
#pragma unroll
      for (int r = 0; r < 16; ++r)
        tile[(wr * 64 + i * 32 + crow(r, lane >> 5)) * EPS_LD + wc * 64 + j * 32 + (lane & 31)] = acc[i][j][r];
}

DI float log_sigmoid(float x) { return fminf(x, 0.f) - log1pf(expf(-fabsf(x))); }
DI float sigmoidf_(float x) { return 1.f / (1.f + expf(-x)); }

DI void store32_bf16(u16* dst, const float* o) {
  u32x4* d4 = (u32x4*)dst;
#pragma unroll
  for (int i = 0; i < 4; ++i)
    d4[i] = mk4(pack2(o[8 * i], o[8 * i + 1]), pack2(o[8 * i + 2], o[8 * i + 3]), pack2(o[8 * i + 4], o[8 * i + 5]), pack2(o[8 * i + 6], o[8 * i + 7]));
}

__device__ __forceinline__ void inproj_epilogue_half(const Params& P, int l, int mt, int nt, int half, const float* tile, const float* rs) {
  const int tid = threadIdx.x, lane = tid & 63, wave = tid >> 6;
  const int hl = wave >> 1, h32 = wave & 1;
  const int sg = 2 * nt + hl;
  const int rloc = half * 64 + lane;
  const int tok = mt * 128 + rloc;
  const float rstd = rs[rloc];
  if (sg >= 45) return;
  float v[64];
  {
    const f32x4* src = (const f32x4*)(tile + rloc * EPS_LD + hl * 64);
#pragma unroll
    for (int i = 0; i < 16; ++i) { f32x4 t = src[i]; v[4 * i] = t[0] * rstd; v[4 * i + 1] = t[1] * rstd; v[4 * i + 2] = t[2] * rstd; v[4 * i + 3] = t[3] * rstd; }
  }
  const u32 hmask = (u32)(-(int)h32);
#define VO(i) __uint_as_float((__float_as_uint(v[32 + (i)]) & hmask) | (__float_as_uint(v[(i)]) & ~hmask))
  if (sg == 44) {
    if (h32 == 0) {
      const int chunk = tok >> 6;
#pragma unroll
      for (int hd = 0; hd < 4; ++hd) {
        float x = log_sigmoid(v[hd] + P.fox_f_bias[l * 4 + hd]);
#pragma unroll
        for (int o = 1; o < 64; o <<= 1) { float t = __shfl_up(x, o); if (lane >= o) x += t; }
        P.cloc[(size_t)hd * S + tok] = x;
        if (lane == 63) P.ctot[chunk * 4 + hd] = x;
      }
    } else {
      float* g = P.gates + (size_t)tok * 24;
#pragma unroll
      for (int i = 0; i < 24; ++i) g[i] = sigmoidf_(v[4 + i]);
    }
    return;
  }
  float o[32];
  const bool is_vt = (sg >= 8 && sg < 12) || (sg == 26 || sg == 27) || (sg == 30 || sg == 31) || (sg >= 40);
  const bool is_raw = (sg >= 20 && sg < 24);
  const bool is_diff = (sg >= 32 && sg < 40);
  if (is_vt) {
    if (sg == 26 || sg == 27) {
      const int key = tok & 63, G = key >> 5, h4 = (key & 31) >> 3, j = key & 7;
      unsigned char* b8 = P.VS8t + (size_t)(sg - 26) * 64 * S + (size_t)(tok >> 6) * 4096 + G * 2048 + h4 * 128 + j;
#pragma unroll
      for (int i = 0; i < 32; i += 2) {
        const int wd = __builtin_amdgcn_cvt_pk_fp8_f32(VO(i), VO(i + 1), 0, false);
        const int d0 = h32 * 32 + i, d1 = d0 + 1;
        b8[(d0 >> 4) * 512 + (d0 & 15) * 8] = (unsigned char)(wd & 0xff);
        b8[(d1 >> 4) * 512 + (d1 & 15) * 8] = (unsigned char)((wd >> 8) & 0xff);
      }
      return;
    }
    u16* base;
    if (sg < 12) base = P.VFt + (size_t)(sg - 8) * 64 * S;
    else if (sg < 32) base = P.VWt + (size_t)(sg - 30) * 64 * S;
    else base = P.VDt + (size_t)(sg - 40) * 64 * S;
#pragma unroll
    for (int i = 0; i < 32; ++i) base[(size_t)(h32 * 32 + i) * S + tok] = f2bf(VO(i));
    return;
  }
  if (is_raw) {
    u16* base = (sg < 22) ? P.KC + (size_t)(sg - 20) * (S + 64) * 64 : P.VC + (size_t)(sg - 22) * (S + 64) * 64;
#pragma unroll
    for (int i = 0; i < 32; ++i) o[i] = VO(i);
    store32_bf16(base + (size_t)tok * 64 + h32 * 32, o);
    return;
  }
  if (is_diff) {
    const float* w = (sg < 36 ? P.diff_q_norm_w : P.diff_k_norm_w) + l * 32;
    float ss = 0.f;
#pragma unroll
    for (int i = 0; i < 32; ++i) ss += VO(i) * VO(i);
    const float rn = rsqrtf(ss * (1.f / 32.f) + 1e-6f);
    const float sc = (sg < 36) ? 0.17677669529663687f * LOG2E : 1.f;
    const float* rp = P.ropeD + (size_t)tok * 32;
#pragma unroll
    for (int i = 0; i < 16; ++i) {
      const float y1 = VO(i) * rn * w[i], y2 = VO(16 + i) * rn * w[16 + i];
      const float c = rp[i], s = rp[16 + i];
      o[i] = (y1 * c - y2 * s) * sc;
      o[16 + i] = (y2 * c + y1 * s) * sc;
    }
    u16* base = (sg < 36) ? P.QD + (size_t)(sg - 32) * S * 64 : P.KD + (size_t)(sg - 36) * S * 64;
    store32_bf16(base + (size_t)tok * 64 + h32 * 32, o);
    return;
  }
  const float* w;
  if (sg < 4) w = P.fox_q_norm_w + l * 64; else if (sg < 8) w = P.fox_k_norm_w + l * 64; else if (sg < 20) w = P.nsa_q_norm_w + l * 64; else w = P.nsa_k_norm_w + l * 64;
  float ss = 0.f;
#pragma unroll
  for (int i = 0; i < 64; ++i) ss += v[i] * v[i];
  const float rn = rsqrtf(ss * (1.f / 64.f) + 1e-6f);
  const float qs = 0.125f * LOG2E;
  if (sg < 8) {
    const float sc = (sg < 4) ? qs : 1.f;
#pragma unroll
    for (int i = 0; i < 32; ++i) o[i] = VO(i) * rn * w[h32 * 32 + i] * sc;
    u16* base = (sg < 4) ? P.QF + (size_t)sg * S * 64 : P.KF + (size_t)(sg - 4) * S * 64;
    store32_bf16(base + (size_t)tok * 64 + h32 * 32, o);
    return;
  }
  const float* rp = P.ropeN + (size_t)tok * 64;
  const float sc = (sg < 20) ? qs : 1.f;
  if (sg < 20) {
#pragma unroll
    for (int i = 0; i < 32; ++i) o[i] = VO(i) * rn * w[h32 * 32 + i] * sc;
    store32_bf16(P.QN + ((size_t)(sg - 12) * S + tok) * 64 + h32 * 32, o);
  }
#pragma unroll
  for (int i = 0; i < 32; ++i) {
    const float y1 = v[i] * rn * w[i], y2 = v[32 + i] * rn * w[32 + i];
    const float c = rp[i], s = rp[32 + i];
    o[i] = (h32 == 0 ? (y1 * c - y2 * s) : (y2 * c + y1 * s)) * sc;
  }
  if (sg == 24 || sg == 25) {
    const int key = tok & 63, G = key >> 5, r32 = key & 31, t = (r32 >> 2) & 1, i = ((r32 >> 3) << 2) | (r32 & 3);
    unsigned char* d8 = P.KS8 + (size_t)(sg - 24) * S * 64 + (size_t)(tok >> 6) * 4096 + ((G * 2 + t) * 2 + h32) * 512 + i * 8;
#pragma unroll
    for (int h4 = 0; h4 < 4; ++h4) {
      int w0 = 0, w1 = 0;
      w0 = __builtin_amdgcn_cvt_pk_fp8_f32(o[8 * h4], o[8 * h4 + 1], w0, false);
      w0 = __builtin_amdgcn_cvt_pk_fp8_f32(o[8 * h4 + 2], o[8 * h4 + 3], w0, true);
      w1 = __builtin_amdgcn_cvt_pk_fp8_f32(o[8 * h4 + 4], o[8 * h4 + 5], w1, false);
      w1 = __builtin_amdgcn_cvt_pk_fp8_f32(o[8 * h4 + 6], o[8 * h4 + 7], w1, true);
      *(u32x2*)(d8 + h4 * 128) = mk2((u32)w0, (u32)w1);
    }
    return;
  }
  u16* base;
  if (sg < 20) base = P.QR + (size_t)(sg - 12) * S * 64;
  else base = P.KW + (size_t)(sg - 28) * S * 64;
  store32_bf16(base + (size_t)tok * 64 + h32 * 32, o);
}

#undef VO
__device__ __forceinline__ void phase_inproj(const Params& P, int l, char* smem) {
  const u16* Wt = P.WinT + (size_t)l * NINP * D;
  float* tile = (float*)smem;
  const float* rs = (const float*)(smem + G_RS_OFF);
  for (int it = blockIdx.x; it < 128 * 23; it += gridDim.x) {
    const int mt = it / 23, nt = it % 23;
    f32x16 acc[2][2];
    zero_acc(acc);
    gemm_mainloop<true>(P.hb + (size_t)mt * 128 * D, D, Wt + (size_t)nt * 128 * D, D, D, smem, acc);
    acc_to_lds(acc, tile);
    __syncthreads();
#pragma unroll 1
    for (int half = 0; half < 2; ++half) inproj_epilogue_half(P, l, mt, nt, half, tile, rs);
  }
}

__device__ __forceinline__ void phase_compress(const Params& P, int l, char* smem) {
  float* tile = (float*)smem;
  for (int it = blockIdx.x; it < 32; it += gridDim.x) {
    const int kv = it >> 4, g = (it >> 3) & 1, mt = it & 7;
    const u16* A = (kv ? P.VC : P.KC) + (size_t)g * (S + 64) * 64 + (size_t)mt * 128 * 1024;
    const u16* Bt = P.CmpWT + (size_t)(l * 2 + kv) * 128 * 2048;
    const float* bias = P.cmpbias + (l * 2 + kv) * 64;
    f32x16 acc[2][2];
    zero_acc(acc);
    gemm_mainloop<false>(A, 1024, Bt, 2048, 2048, smem, acc);
    acc_to_lds(acc, tile);
    __syncthreads();
#pragma unroll 1
    for (int half = 0; half < 2; ++half) {
      {
        const int lane = threadIdx.x & 63, wave = threadIdx.x >> 6;
        const int idx = mt * 128 + half * 64 + lane;
        float v[64];
        const f32x4* src = (const f32x4*)(tile + (half * 64 + lane) * EPS_LD);
#pragma unroll
        for (int i = 0; i < 16; ++i) { f32x4 t = src[i]; v[4 * i] = t[0] + bias[4 * i]; v[4 * i + 1] = t[1] + bias[4 * i + 1]; v[4 * i + 2] = t[2] + bias[4 * i + 2]; v[4 * i + 3] = t[3] + bias[4 * i + 3]; }
        float vo[16];
#pragma unroll
        for (int i = 0; i < 4; ++i) { f32x4 t = src[wave * 4 + i]; const float* bb = bias + wave * 16 + 4 * i; vo[4 * i] = t[0] + bb[0]; vo[4 * i + 1] = t[1] + bb[1]; vo[4 * i + 2] = t[2] + bb[2]; vo[4 * i + 3] = t[3] + bb[3]; }
        if (kv == 0) {
          const float* w = P.nsa_k_norm_w + l * 64;
          float ss = 0.f;
#pragma unroll
          for (int i = 0; i < 64; ++i) ss += v[i] * v[i];
          const float rn = rsqrtf(ss * (1.f / 64.f) + 1e-6f);
          u32 o[8];
#pragma unroll
          for (int i = 0; i < 8; ++i) o[i] = pack2(vo[2 * i] * rn * w[wave * 16 + 2 * i], vo[2 * i + 1] * rn * w[wave * 16 + 2 * i + 1]);
          u32x4* dp = (u32x4*)(P.KCC + ((size_t)g * 1024 + idx) * 64 + wave * 16);
          dp[0] = mk4(o[0], o[1], o[2], o[3]);
          dp[1] = mk4(o[4], o[5], o[6], o[7]);
        } else {
#pragma unroll
          for (int i = 0; i < 16; ++i) P.VCCt[((size_t)g * 64 + wave * 16 + i) * 1024 + idx] = f2bf(vo[i]);
        }
      }
    }
  }
}

constexpr int AK_ST = 144;
constexpr int AV_ST = 136;
constexpr int AT_VOFF = 64 * AK_ST;
constexpr int AT_COFF = AT_VOFF + 64 * AV_ST;
constexpr int AT_STAGE = AT_COFF + 256;
constexpr int AT_MISC = 2 * AT_STAGE;

struct TileRegs { u32x4 k[2]; u32x4 v[2]; };

DI void tile_load(int t, TileRegs& r, const u16* __restrict__ K, const u16* __restrict__ Vt, size_t ldv, int key0, bool with_v) {
#pragma unroll
  for (int i = 0; i < 2; ++i) {
    const int c = t + 256 * i, row = c >> 3, part = c & 7;
    r.k[i] = *(const u32x4*)(K + (size_t)(key0 + row) * 64 + part * 8);
    if (with_v) r.v[i] = *(const u32x4*)(Vt + (size_t)row * ldv + key0 + part * 8);
  }
}
DI void tile_store(int t, const TileRegs& r, char* st, bool with_v) {
#pragma unroll
  for (int i = 0; i < 2; ++i) {
    const int c = t + 256 * i, row = c >> 3, part = c & 7;
    *(u32x4*)(st + row * AK_ST + part * 16) = r.k[i];
    if (with_v) {
      u32x2* d = (u32x2*)(st + AT_VOFF + row * AV_ST + part * 16);
      d[0] = mk2(r.v[i].x, r.v[i].y);
      d[1] = mk2(r.v[i].z, r.v[i].w);
    }
  }
}
DI bf16x8 pack_p(const f32x16& p, int sp) {
  u32x4 u = mk4(pack2(p[8 * sp], p[8 * sp + 1]), pack2(p[8 * sp + 2], p[8 * sp + 3]), pack2(p[8 * sp + 4], p[8 * sp + 5]), pack2(p[8 * sp + 6], p[8 * sp + 7]));
  return __builtin_bit_cast(bf16x8, u);
}
template <int NKS, bool ZINIT>
DI void qk_half(int tid, const char* st, int dofs_bytes, int kt, const bf16x8 (&qf)[NKS], f32x16& s) {
  const int lane = tid & 63;
  const char* base = st + (kt * 32 + (lane & 31)) * AK_ST + (lane >> 5) * 16 + dofs_bytes;
#pragma unroll
  for (int ks = 0; ks < NKS; ++ks) {
    const bf16x8 a = *(const bf16x8*)(base + ks * 32);
    if (ZINIT && ks == 0) { const f32x16 z = {0.f, 0.f, 0.f, 0.f, 0.f, 0.f, 0.f, 0.f, 0.f, 0.f, 0.f, 0.f, 0.f, 0.f, 0.f, 0.f}; s = MFMA32(a, qf[ks], z); }
    else s = MFMA32(a, qf[ks], s);
  }
}
DI void pv_half(int tid, const char* st, int kt, const f32x16& p, f32x16 (&o)[2]) {
  const int lane = tid & 63;
  const char* vb = st + AT_VOFF + (lane & 31) * AV_ST + (lane >> 5) * 8 + kt * 64;
#pragma unroll
  for (int sp = 0; sp < 2; ++sp) {
    const bf16x8 pb = pack_p(p, sp);
#pragma unroll
    for (int dt = 0; dt < 2; ++dt) {
      const char* a = vb + dt * 32 * AV_ST + sp * 32;
      const u32x2 lo = *(const u32x2*)a, hi = *(const u32x2*)(a + 16);
      const u32x4 u = mk4(lo.x, lo.y, hi.x, hi.y);
      o[dt] = MFMA32(__builtin_bit_cast(bf16x8, u), pb, o[dt]);
    }
  }
}
DI void load_q4(int tid, bf16x8 (&qf)[4], const u16* __restrict__ Q, int tok) {
  const int lane = tid & 63;
  const u16* b = Q + (size_t)tok * 64 + (lane >> 5) * 8;
#pragma unroll
  for (int ks = 0; ks < 4; ++ks) qf[ks] = *(const bf16x8*)(b + ks * 16);
}
DI float max_abs64(int tid, const float* w) {
  return wave_max(fabsf(w[tid & 63]));
}

struct AttnArgs {
  const u16* K; const u16* Vt; size_t ldv;
  int t0, t1;
  int q;
  int wq0;
  float M2;
  int dofs;
  int lim_hi, lim_lo, whi, wlo;
  int mask_hi, mask_lo;
  float cq; const float* cloc; const float* base;
};

template <int MODE, int NKS, bool MASK>
DI void attn_tile(int tid, const AttnArgs& a, const char* cur, int key0, int lim_hi, int lim_lo, const bf16x8 (&qf)[NKS], f32x16 (&o)[2], float& l) {
  const int h = (tid & 63) >> 5;
#pragma unroll
  for (int kt = 0; kt < 2; ++kt) {
    f32x16 s;
    if (MODE == 0) {
      const float* ckb = (const float*)(cur + AT_COFF);
#pragma unroll
      for (int rg = 0; rg < 4; ++rg) {
        const f32x4 c4 = *(const f32x4*)(ckb + 32 * kt + 8 * rg + 4 * h);
#pragma unroll
        for (int i = 0; i < 4; ++i) s[4 * rg + i] = a.cq - c4[i];
      }
      qk_half<NKS, false>(tid, cur, a.dofs, kt, qf, s);
    } else {
      qk_half<NKS, true>(tid, cur, a.dofs, kt, qf, s);
    }
#pragma unroll
    for (int i = 0; i < 16; ++i) {
      float p = __builtin_amdgcn_exp2f(s[i]);
      if (MASK) { const int key = key0 + 32 * kt + crow(i, h); if (key > lim_hi || key < lim_lo) p = 0.f; }
      s[i] = p; l += p;
    }
    pv_half(tid, cur, kt, s, o);
  }
}
template <int MODE, int NKS, bool PF2 = false>
DI void attn_loop(int tid, const AttnArgs& a, const bf16x8 (&qf)[NKS], f32x16 (&o)[2], float& l, char* smem) {
  TileRegs rA, rB; float cbA = 0.f, cbB = 0.f;
  if (a.t0 >= a.t1) return;
  tile_load(tid, rA, a.K, a.Vt, a.ldv, a.t0 * 64, true);
  if (MODE == 0 && tid < 64) cbA = a.cloc[a.t0 * 64 + tid];
  tile_store(tid, rA, smem, true);
  if (MODE == 0 && tid < 64) ((float*)(smem + AT_COFF))[tid] = (a.base[a.t0] + cbA) * LOG2E;
  __syncthreads();
  auto step = [&](int t, TileRegs& rs, float& cbs, TileRegs& rl, float& cbl, int dist) {
    char* cur = smem + ((t - a.t0) & 1) * AT_STAGE;
    char* nxt = smem + ((t - a.t0 + 1) & 1) * AT_STAGE;
    if (t + dist < a.t1) {
      tile_load(tid, rl, a.K, a.Vt, a.ldv, (t + dist) * 64, true);
      if (MODE == 0 && tid < 64) cbl = a.cloc[(t + dist) * 64 + tid];
    }
    const int key0 = t * 64;
    bool active, need_mask;
    if (MODE == 0 || MODE == 3) { active = key0 <= a.wq0 + 31; need_mask = key0 + 63 > a.wq0; }
    else if (MODE == 1) { const int nmax_w = (a.wq0 + 31 - 31) >> 4; active = (a.wq0 + 31 >= 31) && key0 <= nmax_w; need_mask = true; }
    else if (MODE == 2) { active = (key0 <= a.wq0 + 31) && (key0 + 63 >= a.wq0 - 511); need_mask = (key0 + 63 > a.wq0) || (key0 < a.wq0 + 31 - 511); }
    else { active = (key0 <= a.whi) && (key0 + 63 >= a.wlo); need_mask = (key0 + 63 > a.mask_hi) || (key0 < a.mask_lo); }
    if (active) {
      int lim_hi, lim_lo;
      if (MODE == 0 || MODE == 3) { lim_hi = a.q; lim_lo = 0; }
      else if (MODE == 1) { lim_hi = (a.q >= 31) ? ((a.q - 31) >> 4) : -1; lim_lo = 0; }
      else if (MODE == 2) { lim_hi = a.q; lim_lo = a.q - 511; }
      else { lim_hi = a.lim_hi; lim_lo = a.lim_lo; }
      if (__builtin_amdgcn_readfirstlane((int)need_mask)) attn_tile<MODE, NKS, true>(tid, a, cur, key0, lim_hi, lim_lo, qf, o, l);
      else attn_tile<MODE, NKS, false>(tid, a, cur, key0, lim_hi, lim_lo, qf, o, l);
    }
    if (t + 1 < a.t1) {
      tile_store(tid, rs, nxt, true);
      if (MODE == 0 && tid < 64) ((float*)(nxt + AT_COFF))[tid] = (a.base[t + 1] + cbs) * LOG2E;
    }
    __syncthreads();
  };
  if (!PF2) {
    for (int t = a.t0; t < a.t1; ++t) step(t, rA, cbA, rA, cbA, 1);
  } else {
    if (a.t0 + 1 < a.t1) { tile_load(tid, rA, a.K, a.Vt, a.ldv, (a.t0 + 1) * 64, true); if (MODE == 0 && tid < 64) cbA = a.cloc[(a.t0 + 1) * 64 + tid]; }
    for (int t = a.t0; t < a.t1; t += 2) {
      step(t, rA, cbA, rB, cbB, 2);
      if (t + 1 >= a.t1) break;
      step(t + 1, rB, cbB, rA, cbA, 2);
    }
  }
}

DI void zero_o(f32x16 (&o)[2]) {
#pragma unroll
  for (int d = 0; d < 2; ++d)
#pragma unroll
    for (int i = 0; i < 16; ++i) o[d][i] = 0.f;
}

DI void fox_chunk_bases(int tid, const Params& P, int hd, float* base, float* wtot) {
  const int lane = tid & 63, wave = tid >> 6;
  const float x = P.ctot[tid * 4 + hd];
  float inc = x;
#pragma unroll
  for (int o = 1; o < 64; o <<= 1) { float t = __shfl_up(inc, o); if (lane >= o) inc += t; }
  if (lane == 63) wtot[wave] = inc;
  __syncthreads();
  float off = 0.f;
  for (int w = 0; w < wave; ++w) off += wtot[w];
  base[tid] = inc - x + off;
  __syncthreads();
}

__device__ __forceinline__ void fox_item(const Params& P, int l, int hd, int qb, char* smem) {
  const int tid = opaque_tid(), lane = tid & 63, wave = tid >> 6, h = lane >> 5;
  float* base = (float*)(smem + AT_MISC);
  float* wtot = base + 256;
  fox_chunk_bases(tid, P, hd, base, wtot);
  const float M2 = 8.f * max_abs64(tid, P.fox_q_norm_w + l * 64) * max_abs64(tid, P.fox_k_norm_w + l * 64) * LOG2E * 1.01f + 0.1f;
  const int wq0 = qb * 128 + wave * 32, q = wq0 + (lane & 31);
  AttnArgs a;
  a.K = P.KF + (size_t)hd * S * 64; a.Vt = P.VFt + (size_t)hd * 64 * S; a.ldv = S;
  a.t1 = 2 * qb + 2; a.q = q; a.wq0 = wq0; a.M2 = M2;
  a.cloc = P.cloc + (size_t)hd * S; a.base = base;
  {
    const bool skip = (tid + 1 < 2 * qb) && ((base[2 * qb] - base[tid + 1]) * LOG2E < -160.f);
    a.t0 = __syncthreads_count(skip ? 1 : 0);
  }
  a.cq = (base[q >> 6] + a.cloc[q]) * LOG2E - M2;
  bf16x8 qf[4];
  load_q4(tid, qf, P.QF + (size_t)hd * S * 64, q);
  f32x16 o[2]; zero_o(o);
  float ls = 0.f;
  a.dofs = 0;
  attn_loop<0, 4, true>(tid, a, qf, o, ls, smem);
  ls += __shfl_xor(ls, 32);
  const float inv = (ABLATE & 1) ? 0.f : 1.f / ls;
  u16* dst = P.mix + (size_t)q * 1024 + hd * 64 + 4 * h;
#pragma unroll
  for (int dt = 0; dt < 2; ++dt)
#pragma unroll
    for (int rg = 0; rg < 4; ++rg)
      *(u32x2*)(dst + 32 * dt + 8 * rg) = mk2(pack2(o[dt][4 * rg] * inv, o[dt][4 * rg + 1] * inv), pack2(o[dt][4 * rg + 2] * inv, o[dt][4 * rg + 3] * inv));
}

__device__ __forceinline__ void diff_item(const Params& P, int l, int hd, int qb, char* smem) {
  const int tid = opaque_tid(), lane = tid & 63, wave = tid >> 6, h = lane >> 5;
  const float mq = wave_max(fabsf(P.diff_q_norm_w[l * 32 + (lane & 31)])), mk = wave_max(fabsf(P.diff_k_norm_w[l * 32 + (lane & 31)]));
  const float M2 = 5.656854249f * mq * mk * LOG2E * 1.01f + 0.1f;
  const float* lv = P.diff_lambda + l * 128;
  float d1 = (lane < 32) ? lv[lane] * lv[32 + lane] : 0.f, d2 = (lane < 32) ? lv[64 + lane] * lv[96 + lane] : 0.f;
  d1 = wave_sum(d1); d2 = wave_sum(d2);
  const float lam_init = 0.8f - 0.6f * expf(-0.3f * (float)l);
  const float lam = expf(d1) - expf(d2) + lam_init;
  const int wq0 = qb * 128 + wave * 32, q = wq0 + (lane & 31);
  AttnArgs a;
  a.K = P.KD + (size_t)hd * S * 64; a.Vt = P.VDt + (size_t)hd * 64 * S; a.ldv = S;
  a.t0 = 0; a.t1 = 2 * qb + 2; a.q = q; a.wq0 = wq0; a.M2 = M2; a.cq = 0.f; a.cloc = nullptr; a.base = nullptr;
  float* stash = P.dstash + (size_t)blockIdx.x * (128 * 64) + tid;
  f32x16 o[2];
#pragma unroll 1
  for (int c = 0; c < 2; ++c) {
    const int tid = opaque_tid(), lane = tid & 63, h = lane >> 5;
    bf16x8 qf[2];
    {
      const u16* b = P.QD + ((size_t)hd * S + q) * 64 + c * 32 + h * 8;
      qf[0] = *(const bf16x8*)b; qf[1] = *(const bf16x8*)(b + 16);
    }
    zero_o(o);
    float ls = 0.f;
    a.dofs = c * 64;
    attn_loop<3, 2>(tid, a, qf, o, ls, smem);
    ls += __shfl_xor(ls, 32);
    if (c == 0) {
      const float i0 = 1.f / ls;
#pragma unroll
      for (int dt = 0; dt < 2; ++dt)
#pragma unroll
        for (int i = 0; i < 16; ++i) stash[(dt * 16 + i) * 256] = o[dt][i] * i0;
    } else {
      const float i1 = lam / ls;
      float ss = 0.f;
#pragma unroll
      for (int dt = 0; dt < 2; ++dt)
#pragma unroll
        for (int i = 0; i < 16; ++i) { const float v = stash[(dt * 16 + i) * 256] - o[dt][i] * i1; o[dt][i] = v; ss += v * v; }
      ss += __shfl_xor(ss, 32);
      const float rn = rsqrtf(ss * (1.f / 64.f) + 1e-6f) * (1.f - lam_init);
      const float* sw = P.diff_subln_w + l * 64;
      u16* dst = P.mix + (size_t)q * 1024 + 768 + hd * 64 + 4 * h;
#pragma unroll
      for (int dt = 0; dt < 2; ++dt)
#pragma unroll
        for (int rg = 0; rg < 4; ++rg) {
          const int d0 = 32 * dt + 8 * rg + 4 * h;
          *(u32x2*)(dst + 32 * dt + 8 * rg) = mk2(pack2(o[dt][4 * rg] * rn * sw[d0], o[dt][4 * rg + 1] * rn * sw[d0 + 1]),
                                                 pack2(o[dt][4 * rg + 2] * rn * sw[d0 + 2], o[dt][4 * rg + 3] * rn * sw[d0 + 3]));
        }
    }
  }
}

struct SelFrags { u32x2 k[8]; u32x2 v[8]; };

DI void sel_load(int tid, SelFrags& f, const unsigned char* __restrict__ Kg, const unsigned char* __restrict__ Vtg, int b) {
  const int lane = tid & 63, i = lane & 15, h4 = lane >> 4;
  const int bu = __builtin_amdgcn_readfirstlane(b);
  const unsigned char* kb = Kg + (size_t)bu * 4096 + lane * 8;
  const unsigned char* vb = Vtg + (size_t)bu * 4096 + lane * 8;
  (void)i; (void)h4;
#pragma unroll
  for (int L = 0; L < 8; ++L) f.k[L] = *(const u32x2*)(kb + L * 512);
#pragma unroll
  for (int L = 0; L < 8; ++L) f.v[L] = *(const u32x2*)(vb + L * 512);
}
template <bool MASK>
DI void sel_compute_t(int tid, const SelFrags& f, const u32x2 (&qb)[2], int b, int qpos, float M2, f32x4 (&o)[4], f32x4& ol) {
  const int lane = tid & 63, h4 = lane >> 4;
  const float c0 = 8.f - M2;
  const u32x2 ones = mk2(0x38383838u, 0x38383838u);
#pragma unroll
  for (int G = 0; G < 2; ++G) {
    f32x4 s[2];
#pragma unroll
    for (int t = 0; t < 2; ++t) {
      s[t] = (f32x4){0.f, 0.f, 0.f, 0.f};
#pragma unroll
      for (int ks = 0; ks < 2; ++ks)
        s[t] = __builtin_amdgcn_mfma_f32_16x16x32_fp8_fp8(__builtin_bit_cast(long, f.k[G * 4 + t * 2 + ks]), __builtin_bit_cast(long, qb[ks]), s[t], 0, 0, 0);
    }
#pragma unroll
    for (int t = 0; t < 2; ++t)
#pragma unroll
      for (int r = 0; r < 4; ++r) {
        float p = __builtin_amdgcn_exp2f(s[t][r] * 0.0625f + c0);
        if (MASK) { const int key = b * 64 + 32 * G + 8 * h4 + 4 * t + r; if (key > qpos) p = 0.f; }
        s[t][r] = p;
      }
    int w0 = 0, w1 = 0;
    w0 = __builtin_amdgcn_cvt_pk_bf8_f32(s[0][0], s[0][1], w0, false);
    w0 = __builtin_amdgcn_cvt_pk_bf8_f32(s[0][2], s[0][3], w0, true);
    w1 = __builtin_amdgcn_cvt_pk_bf8_f32(s[1][0], s[1][1], w1, false);
    w1 = __builtin_amdgcn_cvt_pk_bf8_f32(s[1][2], s[1][3], w1, true);
    const u32x2 pb = mk2((u32)w0, (u32)w1);
#pragma unroll
    for (int dt = 0; dt < 4; ++dt)
      o[dt] = __builtin_amdgcn_mfma_f32_16x16x32_fp8_bf8(__builtin_bit_cast(long, f.v[G * 4 + dt]), __builtin_bit_cast(long, pb), o[dt], 0, 0, 0);
    ol = __builtin_amdgcn_mfma_f32_16x16x32_fp8_bf8(__builtin_bit_cast(long, ones), __builtin_bit_cast(long, pb), ol, 0, 0, 0);
  }
}
DI void sel_compute(int tid, const SelFrags& f, const u32x2 (&qb)[2], int b, int cur, int qpos, float M2, f32x4 (&o)[4], f32x4& ol) {
  if (__builtin_amdgcn_readfirstlane(b) == __builtin_amdgcn_readfirstlane(cur)) sel_compute_t<true>(tid, f, qb, b, qpos, M2, o, ol);
  else sel_compute_t<false>(tid, f, qb, b, qpos, M2, o, ol);
}

__device__ __forceinline__ void nsa_item(const Params& P, int l, int g, int qb, char* smem, int secmask = 7) {
  const int tid = opaque_tid(), lane = tid & 63, wave = tid >> 6, h = lane >> 5;
  const int q0 = qb * 128, wq0 = q0 + wave * 32, q = wq0 + (lane & 31), ql = wave * 32 + (lane & 31);
  const int item = g * 128 + qb;
  const float M2 = 8.f * max_abs64(tid, P.nsa_q_norm_w + l * 64) * max_abs64(tid, P.nsa_k_norm_w + l * 64) * LOG2E * 1.01f + 0.1f;
  unsigned char* sel = (unsigned char*)(smem + AT_MISC);
  unsigned char* nsel = sel + 2048;
  float* impA = P.impA + (size_t)item * 256 * 128;
  float* impB = P.impB + (size_t)item * 256 * 128;
  const u16* Kc = P.KCC + (size_t)g * 1024 * 64;
  const int ntc = ((q0 + 96) >> 10) + 1;
  const int nmaxq = (q >= 31) ? ((q - 31) >> 4) : -1;
  const int nmax_w = wq0 >> 4;

  {
    float lh[4] = {0.f, 0.f, 0.f, 0.f};
#pragma unroll 1
    for (int pass = 0; pass < 2; ++pass) {
      float inv[4];
      if (pass == 1) {
#pragma unroll
        for (int hh = 0; hh < 4; ++hh) { float t = lh[hh] + __shfl_xor(lh[hh], 32); inv[hh] = (t > 0.f) ? 1.f / t : 0.f; }
      }
      TileRegs r;
      tile_load(tid, r, Kc, nullptr, 0, 0, false);
      tile_store(tid, r, smem, false);
      __syncthreads();
      for (int t = 0; t < ntc; ++t) {
        char* cur = smem + (t & 1) * AT_STAGE;
        char* nxt = smem + ((t + 1) & 1) * AT_STAGE;
        const bool more = (t + 1 < ntc);
        if (more) tile_load(tid, r, Kc, nullptr, 0, (t + 1) * 64, false);
        const int key0 = t * 64;
        f32x16 ps[2];
#pragma unroll
        for (int kt = 0; kt < 2; ++kt)
#pragma unroll
          for (int i = 0; i < 16; ++i) ps[kt][i] = 0.f;
        if (key0 <= nmax_w) {
#pragma unroll
          for (int hh = 0; hh < 4; ++hh) {
            f32x16 s[2];
            bf16x8 qf[4];
            load_q4(tid, qf, P.QN + (size_t)(g * 4 + hh) * S * 64, q);
            qk_half<4, true>(tid, cur, 0, 0, qf, s[0]);
            qk_half<4, true>(tid, cur, 0, 1, qf, s[1]);
#pragma unroll
            for (int kt = 0; kt < 2; ++kt)
#pragma unroll
              for (int i = 0; i < 16; ++i) {
                float p = __builtin_amdgcn_exp2f(s[kt][i]);
                const int key = key0 + 32 * kt + crow(i, h);
                if (key > nmaxq) p = 0.f;
                if (pass == 0) lh[hh] += p; else ps[kt][i] += p * inv[hh];
              }
          }
        }
        if (pass == 1) {
#pragma unroll
          for (int kt = 0; kt < 2; ++kt)
#pragma unroll
            for (int rg = 0; rg < 4; ++rg) {
              const int j = 16 * t + 8 * kt + 2 * rg + h;
              impA[(size_t)j * 128 + ql] = ps[kt][4 * rg] + ps[kt][4 * rg + 1] + ps[kt][4 * rg + 2] + ps[kt][4 * rg + 3];
              impB[(size_t)j * 128 + ql] = ps[kt][4 * rg + 3];
            }
        }
        if (more) tile_store(tid, r, nxt, false);
        __syncthreads();
      }
    }
  }
  __threadfence_block();
  __syncthreads();
  {
    const int qt = tid >> 1, half = tid & 1;
    const int qp = q0 + qt, cur = qp >> 6;
    u32 lst[13];
#pragma unroll
    for (int i = 0; i < 13; ++i) lst[i] = 0u;
    for (int j0 = 1 + half; j0 <= cur - 2; j0 += 8) {
      float sc[4];
#pragma unroll
      for (int u = 0; u < 4; ++u) {
        const int j = j0 + 2 * u, jc = j <= cur - 2 ? j : 1;
        sc[u] = impA[(size_t)jc * 128 + qt] + impB[(size_t)(jc - 1) * 128 + qt];
      }
#pragma unroll
      for (int u = 0; u < 4; ++u) {
        const int j = j0 + 2 * u;
        u32 x = (j <= cur - 2) ? ((__float_as_uint(sc[u]) & 0xffffff00u) | (u32)j) : 0u;
#pragma unroll
        for (int i = 0; i < 13; ++i) { const u32 hi = max(lst[i], x); x = min(lst[i], x); lst[i] = hi; }
      }
    }
    u32 oth[13];
#pragma unroll
    for (int i = 0; i < 13; ++i) oth[i] = (u32)__shfl_xor((int)lst[i], 1);
#pragma unroll
    for (int k = 0; k < 13; ++k) {
      u32 x = oth[k];
#pragma unroll
      for (int i = 0; i < 13; ++i) { const u32 hi = max(lst[i], x); x = min(lst[i], x); lst[i] = hi; }
    }
    if (half == 0) {
      unsigned char* sp = sel + qt * 16;
      int n = 0;
      sp[n++] = 0;
      if (cur >= 1) sp[n++] = (unsigned char)cur;
      if (cur >= 2) sp[n++] = (unsigned char)(cur - 1);
      const int ncand = cur - 2 < 13 ? cur - 2 : 13;
#pragma unroll
      for (int i = 0; i < 13; ++i) if (i < ncand) sp[n++] = (unsigned char)(lst[i] & 0xffu);
      nsel[qt] = (unsigned char)n;
    }
  }
  __syncthreads();
  if (secmask & 2) {
    const unsigned char* Kg = P.KS8 + (size_t)g * S * 64; const unsigned char* Vtg = P.VS8t + (size_t)g * 64 * S;
    const int col = lane & 15, h4 = lane >> 4, hd = col & 3;
    const unsigned char* selw = sel + wave * 32 * 16;
    const unsigned char* nselw = nsel + wave * 32;
    u32x2* q8 = (u32x2*)(smem + wave * 8448);
    float* gl = (float*)(smem + 41472 + wave * 1600);
    u16* vis = (u16*)(smem + 41472 + wave * 1600 + 512);
    {
#pragma unroll 4
      for (int c = lane; c < 1024; c += 64) {
        const int qi = c >> 5, head = (c >> 3) & 3, ch = c & 7;
        const u32x4 qv = *(const u32x4*)(P.QR + ((size_t)(g * 4 + head) * S + wq0 + qi) * 64 + ch * 8);
        int w0 = 0, w1 = 0;
        w0 = __builtin_amdgcn_cvt_pk_fp8_f32(bflo(qv.x) * 16.f, bfhi(qv.x) * 16.f, w0, false);
        w0 = __builtin_amdgcn_cvt_pk_fp8_f32(bflo(qv.y) * 16.f, bfhi(qv.y) * 16.f, w0, true);
        w1 = __builtin_amdgcn_cvt_pk_fp8_f32(bflo(qv.z) * 16.f, bfhi(qv.z) * 16.f, w1, false);
        w1 = __builtin_amdgcn_cvt_pk_fp8_f32(bflo(qv.w) * 16.f, bfhi(qv.w) * 16.f, w1, true);
        q8[(qi * 8 + ch) * 4 + head] = mk2((u32)w0, (u32)w1);
      }
      if (lane < 32) q8[(32 * 8 + (lane >> 2)) * 4 + (lane & 3)] = mk2(0u, 0u);
      for (int c = lane; c < 128; c += 64) gl[c] = P.gates[(size_t)(wq0 + (c >> 2)) * 24 + (g * 4 + (c & 3)) * 3 + 1];
      int cnt = (lane < 32) ? (int)nselw[lane] : 0, pre = cnt;
#pragma unroll
      for (int o = 1; o < 32; o <<= 1) { const int t2 = __shfl_up(pre, o); if ((lane & 31) >= o) pre += t2; }
      const int V = __builtin_amdgcn_readlane(pre, 31);
      pre -= cnt;
      if (lane < 32) for (int i = 0; i < cnt; ++i) vis[pre + i] = (u16)(selw[lane * 16 + i] | (lane << 8) | (i + 1 == cnt ? 0x8000 : 0));
      if (lane < 5) vis[V + lane] = (u16)(32 << 8);
      __builtin_amdgcn_s_waitcnt(0xc07f);
      __builtin_amdgcn_wave_barrier();
      const int V3 = ((V + 2) / 3) * 3;
      SelFrags fr[3];
      sel_load(tid, fr[0], Kg, Vtg, vis[0] & 0xff);
      sel_load(tid, fr[1], Kg, Vtg, vis[1] & 0xff);
      f32x4 o[4];
#pragma unroll
      for (int dt = 0; dt < 4; ++dt) o[dt] = (f32x4){0.f, 0.f, 0.f, 0.f};
      f32x4 ol = (f32x4){0.f, 0.f, 0.f, 0.f};
#pragma unroll 1
      for (int v = 0; v < V3; v += 3) {
#pragma unroll
        for (int slot = 0; slot < 3; ++slot) {
          const int e = __builtin_amdgcn_readfirstlane((int)vis[v + slot]);
          const int e2 = __builtin_amdgcn_readfirstlane((int)vis[v + slot + 2]);
          sel_load(tid, fr[(slot + 2) % 3], Kg, Vtg, e2 & 0xff);
          const int qi = (e >> 8) & 63, bb = e & 0xff, qp = wq0 + qi;
          u32x2 qcur[2];
          qcur[0] = q8[(qi * 8 + h4) * 4 + hd]; qcur[1] = q8[(qi * 8 + 4 + h4) * 4 + hd];
          sel_compute(tid, fr[slot], qcur, bb, qp >> 6, qp, M2, o, ol);
          if (e & 0x8000) {
            const float lsum = ol[0];
            if (col < 4 && (!(secmask & 8) || lsum == 1.2345e33f)) {
              const float gs = (ABLATE & 4) ? 0.f : gl[qi * 4 + col] / lsum;
              u16* dst = P.mix + (size_t)qp * 1024 + 256 + (g * 4 + col) * 64 + 4 * h4;
#pragma unroll
              for (int dt = 0; dt < 4; ++dt)
                *(u32x2*)(dst + 16 * dt) = mk2(pack2(o[dt][0] * gs, o[dt][1] * gs), pack2(o[dt][2] * gs, o[dt][3] * gs));
            }
#pragma unroll
            for (int dt = 0; dt < 4; ++dt) o[dt] = (f32x4){0.f, 0.f, 0.f, 0.f};
            ol = (f32x4){0.f, 0.f, 0.f, 0.f};
          }
        }
      }
    }
  }
  __threadfence_block();
  __syncthreads();
#pragma unroll 1
  for (int hh = 0; hh < ((secmask & 4) ? 4 : 0); ++hh) {
    const int H = g * 4 + hh;
#pragma unroll 1
    for (int br = 0; br < 2; ++br) {
      AttnArgs a;
      a.q = q; a.wq0 = wq0; a.M2 = M2; a.cq = 0.f; a.cloc = nullptr; a.base = nullptr; a.dofs = 0;
      bf16x8 qf[4];
      f32x16 o[2]; zero_o(o);
      float ls = 0.f;
      if (br == 0) {
        load_q4(tid, qf, P.QN + (size_t)H * S * 64, q);
        a.K = Kc; a.Vt = P.VCCt + (size_t)g * 64 * 1024; a.ldv = 1024; a.t0 = 0; a.t1 = ntc;
        a.lim_hi = nmaxq; a.lim_lo = 0; a.whi = nmax_w; a.wlo = 0; a.mask_hi = (wq0 >= 31) ? ((wq0 - 31) >> 4) : -1; a.mask_lo = 0;
      } else {
        load_q4(tid, qf, P.QR + (size_t)H * S * 64, q);
        a.K = P.KW + (size_t)g * S * 64; a.Vt = P.VWt + (size_t)g * 64 * S; a.ldv = S;
        a.t0 = (q0 >> 6) - 8 < 0 ? 0 : (q0 >> 6) - 8; a.t1 = (q0 >> 6) + 2;
        a.lim_hi = q; a.lim_lo = q - 511; a.whi = wq0 + 31; a.wlo = wq0 - 511; a.mask_hi = wq0; a.mask_lo = wq0 + 31 - 511;
      }
      attn_loop<4, 4, true>(tid, a, qf, o, ls, smem);
      ls += __shfl_xor(ls, 32);
      float gt = (ls > 0.f) ? P.gates[(size_t)q * 24 + H * 3 + (br == 0 ? 0 : 2)] / ls : 0.f;
      if ((ABLATE & 2) && br == 0) gt = 0.f;
      if ((ABLATE & 8) && br == 1) gt = 0.f;
      u16* dst = P.mix + (size_t)q * 1024 + 256 + H * 64 + 4 * h;
      if (!(secmask & 8) || ls == 1.2345e33f)
#pragma unroll
      for (int dt = 0; dt < 2; ++dt)
#pragma unroll
        for (int rg = 0; rg < 4; ++rg) {
          u32x2* pp = (u32x2*)(dst + 32 * dt + 8 * rg);
          const u32x2 old = *pp;
          const float r0 = bflo(old.x) + gt * o[dt][4 * rg];
          const float r1 = bfhi(old.x) + gt * o[dt][4 * rg + 1];
          const float r2 = bflo(old.y) + gt * o[dt][4 * rg + 2];
          const float r3 = bfhi(old.y) + gt * o[dt][4 * rg + 3];
          *pp = mk2(pack2(r0, r1), pack2(r2, r3));
        }
    }
  }
}

DI unsigned xcc_id() { return (unsigned)__builtin_amdgcn_s_getreg((3 << 11) | 20) & 0xFu; }

__device__ __forceinline__ void phase_attention(const Params& P, int l, char* smem, unsigned* counter, int secmask = 7, bool nsa_only = false) {
  int* slot = (int*)(smem + AT_MISC + 4096);
  const int mygrp = (int)(xcc_id() & 1u);
#pragma unroll 1
  for (int pass = 0; pass < 2; ++pass) {
    const int g = pass == 0 ? mygrp : 1 - mygrp;
    for (;;) {
      __syncthreads();
      if (threadIdx.x == 0) *slot = (int)atomicAdd(counter + g, 1u);
      __syncthreads();
      const int it = *slot;
      if (it >= 128) break;
      nsa_item(P, l, g, 127 - it, smem, secmask);
    }
  }
  for (;;) {
    __syncthreads();
    if (threadIdx.x == 0) *slot = (int)atomicAdd(counter + 2, 1u);
    __syncthreads();
    const int it = *slot;
    if (it >= 1024 || nsa_only) break;
    const int qb = 127 - (it >> 3), k = it & 7;
    if (k < 4) diff_item(P, l, k, qb, smem); else fox_item(P, l, k - 4, qb, smem);
  }
}

__device__ __forceinline__ void phase_outproj(const Params& P, int l, char* smem, bool dry = false) {
  const u16* Wt = P.WoutT + (size_t)l * D * D;
  float* tile = (float*)smem;
  const int tid = threadIdx.x;
  for (int it = blockIdx.x; it < 128 * 8; it += gridDim.x) {
    const int mt = it >> 3, nt = it & 7;
    f32x16 acc[2][2];
    zero_acc(acc);
    gemm_mainloop<false>(P.mix + (size_t)mt * 128 * D, D, Wt + (size_t)nt * 128 * D, D, D, smem, acc);
    acc_to_lds(acc, tile);
    __syncthreads();
    const int c4 = (tid & 31) * 4, r0 = tid >> 5;
#pragma unroll 4
    for (int i = 0; i < 16; ++i) {
      const int row = r0 + 8 * i;
      const size_t idx = (size_t)(mt * 128 + row) * D + nt * 128 + c4;
      const f32x4 a4 = *(const f32x4*)(tile + row * EPS_LD + c4);
      f32x4 h4 = *(const f32x4*)(P.out + idx);
      h4 += a4;
      if (!dry || h4[0] == 1.2345e33f) {
        *(f32x4*)(P.out + idx) = h4;
        *(u32x2*)(P.hb2 + idx) = mk2(pack2(h4[0], h4[1]), pack2(h4[2], h4[3]));
      }
    }
  }
}

constexpr int QT_ST = 272;
DI u32 ord_key(float x, u32 idx) {
  u32 u = __float_as_uint(x);
  u = (u & 0x80000000u) ? ~u : (u | 0x80000000u);
  return (u & 0xffffff80u) | idx;
}
DI float ord_val(u32 k) {
  return (k & 0x80000000u) ? __uint_as_float(k & 0x7fffff80u) : __uint_as_float((~k) & 0xffffff80u);
}
DI void merge16(u32 (&lst)[16], int xm) {
  u32 c[16];
#pragma unroll
  for (int i = 0; i < 16; ++i) { const u32 o = (u32)__shfl_xor((int)lst[15 - i], xm); c[i] = max(lst[i], o); }
#pragma unroll
  for (int st = 8; st > 0; st >>= 1)
#pragma unroll
    for (int i = 0; i < 16; ++i)
      if ((i & st) == 0) { const u32 a = max(c[i], c[i + st]), b = min(c[i], c[i + st]); c[i] = a; c[i + st] = b; }
#pragma unroll
  for (int i = 0; i < 16; ++i) lst[i] = c[i];
}

__device__ __forceinline__ void phase_peerq(const Params& P, int l, char* smem) {
  const u16* Wt = P.WqT + (size_t)l * 2048 * D;
  const int tid = threadIdx.x, lane = tid & 63, wave = tid >> 6, wr = wave >> 1, wc = wave & 1, h = lane >> 5;
  const float* rs = (const float*)(smem + G_RS_OFF);
  float* tile = (float*)smem;
  for (int it = blockIdx.x; it < 128 * 16; it += gridDim.x) {
    const int mt = it >> 4, nt = it & 15;
    f32x16 acc[2][2];
    zero_acc(acc);
    gemm_mainloop<true>(P.hb2 + (size_t)mt * 128 * D, D, Wt + (size_t)nt * 128 * D, D, D, smem, acc);
    __syncthreads();
#pragma unroll
    for (int i = 0; i < 2; ++i)
#pragma unroll
      for (int j = 0; j < 2; ++j)
#pragma unroll
        for (int r = 0; r < 16; ++r) {
          const int row = wr * 64 + i * 32 + crow(r, h);
          *(u16*)(smem + row * QT_ST + (wc * 64 + j * 32 + (lane & 31)) * 2) = f2bf(acc[i][j][r] * rs[row]);
        }
    __syncthreads();
    zero_acc(acc);
    {
      const u16* Bk = P.SubK + ((size_t)(l * 16 + nt) * 128 + wc * 64 + (lane & 31)) * 128 + h * 8;
      const char* Aq = smem + (wr * 64 + (lane & 31)) * QT_ST + h * 16;
#pragma unroll
      for (int ks = 0; ks < 8; ++ks) {
        bf16x8 af[2], bfr[2];
#pragma unroll
        for (int i = 0; i < 2; ++i) af[i] = *(const bf16x8*)(Aq + i * 32 * QT_ST + ks * 32);
#pragma unroll
        for (int j = 0; j < 2; ++j) bfr[j] = *(const bf16x8*)(Bk + (size_t)j * 32 * 128 + ks * 16);
#pragma unroll
        for (int i = 0; i < 2; ++i)
#pragma unroll
          for (int j = 0; j < 2; ++j) acc[i][j] = MFMA32(af[i], bfr[j], acc[i][j]);
      }
    }
    __syncthreads();
    acc_to_lds(acc, tile);
    __syncthreads();
#pragma unroll 1
    for (int half = 0; half < 2; ++half) {
      {
        const int row = half * 64 + (tid >> 2), part = tid & 3;
        u32 lst[16];
#pragma unroll
        for (int i = 0; i < 16; ++i) lst[i] = 0u;
        const f32x4* src = (const f32x4*)(tile + row * EPS_LD + part * 32);
#pragma unroll
        for (int c4 = 0; c4 < 8; ++c4) {
          const f32x4 v = src[c4];
#pragma unroll
          for (int e = 0; e < 4; ++e) {
            u32 x = ord_key(v[e], (u32)(part * 32 + c4 * 4 + e));
#pragma unroll
            for (int i = 0; i < 16; ++i) { const u32 hi = max(lst[i], x); x = min(lst[i], x); lst[i] = hi; }
          }
        }
        merge16(lst, 1);
        merge16(lst, 2);
        if (part == 0) {
          u32x4* dp = (u32x4*)(P.topk + ((size_t)(mt * 128 + row) * 16 + nt) * 16);
          dp[0] = mk4(lst[0], lst[1], lst[2], lst[3]); dp[1] = mk4(lst[4], lst[5], lst[6], lst[7]);
          dp[2] = mk4(lst[8], lst[9], lst[10], lst[11]); dp[3] = mk4(lst[12], lst[13], lst[14], lst[15]);
        }
      }
    }
  }
}

__device__ const unsigned char kCandIJ[50] = {
  0x00,0x01,0x02,0x03,0x04,0x05,0x06,0x07,0x08,0x09,0x0a,0x0b,0x0c,0x0d,0x0e,0x0f,
  0x10,0x11,0x12,0x13,0x14,0x15,0x16,0x17,
  0x20,0x21,0x22,0x23,0x24,
  0x30,0x31,0x32,0x33,
  0x40,0x41,0x42,
  0x50,0x51, 0x60,0x61, 0x70,0x71,
  0x80,0x90,0xa0,0xb0,0xc0,0xd0,0xe0,0xf0};
DI float gelu_exact(float x) { return 0.5f * x * (1.f + erff(x * 0.7071067811865476f)); }

__device__ __forceinline__ void phase_peer(const Params& P, int l, char* smem, bool dry = false) {
  const int tid = threadIdx.x, lane = tid & 63, wave = tid >> 6;
  char* wsm = smem + wave * 8192;
  u32* keys = (u32*)wsm;
  float* cv = (float*)(wsm + 1024);
  int* exps = (int*)(wsm + 1024 + 1664);
  float* esc = (float*)(wsm + 3200);
  float* wts = (float*)(wsm + 3712);
  float* uinv = (float*)(wsm + 4224);
  float* vinv = (float*)(wsm + 4736);
  unsigned char* xrow8 = (unsigned char*)(wsm + 5248);
  const unsigned char* U8 = P.U8 + (size_t)l * S * D;
  const unsigned char* V8 = P.V8 + (size_t)l * S * (D / 2);
  const float* Uinv = P.Uinv + l * S; const float* Vinv = P.Vinv + l * S;
  for (int it = blockIdx.x; it < S / 4; it += gridDim.x) {
    const int tok = it * 4 + wave;
    *(u32x4*)(keys + lane * 4) = *(const u32x4*)(P.topk + (size_t)tok * 256 + lane * 4);
    const u32x4 xa = *(const u32x4*)(P.hb2 + (size_t)tok * D + lane * 16), xb = *(const u32x4*)(P.hb2 + (size_t)tok * D + lane * 16 + 8);
    float rstd = wave_sum(ssq8(xa) + ssq8(xb));
    rstd = rsqrtf(rstd * (1.f / 1024.f) + 1e-6f);
    float xinv;
    {
      float xv[16] = {bflo(xa.x), bfhi(xa.x), bflo(xa.y), bfhi(xa.y), bflo(xa.z), bfhi(xa.z), bflo(xa.w), bfhi(xa.w),
                      bflo(xb.x), bfhi(xb.x), bflo(xb.y), bfhi(xb.y), bflo(xb.z), bfhi(xb.z), bflo(xb.w), bfhi(xb.w)};
      float m = 0.f;
#pragma unroll
      for (int i = 0; i < 16; ++i) m = fmaxf(m, fabsf(xv[i]));
      m = wave_max(m);
      const float sx = (m > 0.f) ? 240.f / m : 0.f;
      xinv = m * (1.f / 240.f);
      u32 o4[4];
#pragma unroll
      for (int i = 0; i < 4; ++i) {
        int wd = 0;
        wd = __builtin_amdgcn_cvt_pk_fp8_f32(xv[4 * i] * sx, xv[4 * i + 1] * sx, wd, false);
        wd = __builtin_amdgcn_cvt_pk_fp8_f32(xv[4 * i + 2] * sx, xv[4 * i + 3] * sx, wd, true);
        o4[i] = (u32)wd;
      }
      *(u32x4*)(xrow8 + lane * 16) = mk4(o4[0], o4[1], o4[2], o4[3]);
    }
    __builtin_amdgcn_s_waitcnt(0xc07f);
    const int hd = lane >> 3, sub = lane & 7;
    float myv[7]; int mye[7];
#pragma unroll
    for (int m = 0; m < 7; ++m) {
      const int c = sub + 8 * m;
      myv[m] = -3.0e38f; mye[m] = 0;
      if (c < 50) {
        const int ij = kCandIJ[c], i = ij >> 4, j = ij & 15;
        const u32 k1 = keys[(hd * 2) * 16 + i], k2 = keys[(hd * 2 + 1) * 16 + j];
        myv[m] = ord_val(k1) + ord_val(k2);
        mye[m] = (int)((k1 & 127u) * 128u + (k2 & 127u));
        cv[hd * 52 + c] = myv[m];
      }
    }
    __builtin_amdgcn_s_waitcnt(0xc07f);
#pragma unroll
    for (int m = 0; m < 7; ++m) {
      const int c = sub + 8 * m;
      if (c < 50) {
        int rank = 0;
        for (int c2 = 0; c2 < 50; ++c2) { const float o = cv[hd * 52 + c2]; rank += (o > myv[m]) || (o == myv[m] && c2 < c); }
        if (rank < 16) {
          exps[hd * 16 + rank] = mye[m]; esc[hd * 16 + rank] = myv[m];
          uinv[hd * 16 + rank] = Uinv[mye[m]]; vinv[hd * 16 + rank] = Vinv[mye[m]];
        }
      }
    }
    __builtin_amdgcn_s_waitcnt(0xc07f);
    float g0, g1;
    {
      const float mx = esc[hd * 16];
      const float e0 = expf(esc[hd * 16 + 2 * sub] - mx), e1 = expf(esc[hd * 16 + 2 * sub + 1] - mx);
      float sm = e0 + e1;
      sm += __shfl_xor(sm, 1); sm += __shfl_xor(sm, 2); sm += __shfl_xor(sm, 4);
      g0 = e0 / sm; g1 = e1 / sm;
    }
    wts[hd * 16 + 2 * sub] = g0; wts[hd * 16 + 2 * sub + 1] = g1;
    __builtin_amdgcn_s_waitcnt(0xc07f);
    {
      const int i16 = lane & 15, h4 = lane >> 4;
      u32x4 a0[8], a1[8];
      auto uload = [&](u32x4 (&a)[8], int c) {
        const unsigned char* urow = U8 + (size_t)exps[(c >> 1) * 16 + i16] * D + 32 * h4 + (c & 1) * 512;
#pragma unroll
        for (int i = 0; i < 4; ++i) { a[2 * i] = *(const u32x4*)(urow + i * 128); a[2 * i + 1] = *(const u32x4*)(urow + i * 128 + 16); }
      };
      f32x4 acc = (f32x4){0.f, 0.f, 0.f, 0.f};
      auto umma = [&](const u32x4 (&a)[8], int c) {
#pragma unroll
        for (int i = 0; i < 8; ++i) {
          const u32x4 b = *(const u32x4*)(xrow8 + (c & 1) * 512 + (i >> 1) * 128 + 32 * h4 + (i & 1) * 16);
          acc = __builtin_amdgcn_mfma_f32_16x16x32_fp8_fp8(__builtin_bit_cast(long, mk2(a[i].x, a[i].y)), __builtin_bit_cast(long, mk2(b.x, b.y)), acc, 0, 0, 0);
          acc = __builtin_amdgcn_mfma_f32_16x16x32_fp8_fp8(__builtin_bit_cast(long, mk2(a[i].z, a[i].w)), __builtin_bit_cast(long, mk2(b.z, b.w)), acc, 0, 0, 0);
        }
        if (c & 1) {
          if (i16 == 0) {
            const int eg = c >> 1;
#pragma unroll
            for (int r = 0; r < 4; ++r) {
              const int k = eg * 16 + 4 * h4 + r;
              wts[k] = wts[k] * gelu_exact(rstd * acc[r] * uinv[k] * xinv) * vinv[k];
            }
          }
          acc = (f32x4){0.f, 0.f, 0.f, 0.f};
        }
      };
      uload(a0, 0);
#pragma unroll 1
      for (int c = 0; c < 16; c += 2) {
        uload(a1, c + 1);
        umma(a0, c);
        if (c + 2 < 16) uload(a0, c + 2);
        umma(a1, c + 1);
      }
    }
    __builtin_amdgcn_s_waitcnt(0xc07f);
    float o[16];
#pragma unroll
    for (int i = 0; i < 16; ++i) o[i] = 0.f;
    {
      u32x2 va[8], vb2[8];
      auto vload = [&](u32x2 (&x0)[8], int k) {
#pragma unroll
        for (int u = 0; u < 8; ++u) x0[u] = *(const u32x2*)(V8 + (size_t)exps[k + u] * (D / 2) + lane * 8);
      };
      auto vacc = [&](const u32x2 (&x0)[8], int k) {
#pragma unroll
        for (int u = 0; u < 8; ++u) {
          const float w = wts[k + u];
#pragma unroll
          for (int c = 0; c < 2; ++c) {
            const f32x2 d0 = __builtin_amdgcn_cvt_scalef32_pk_f32_fp4(x0[u][c], 1.0f, 0), d1 = __builtin_amdgcn_cvt_scalef32_pk_f32_fp4(x0[u][c], 1.0f, 1);
            const f32x2 d2 = __builtin_amdgcn_cvt_scalef32_pk_f32_fp4(x0[u][c], 1.0f, 2), d3 = __builtin_amdgcn_cvt_scalef32_pk_f32_fp4(x0[u][c], 1.0f, 3);
            o[8 * c] += w * d0[0]; o[8 * c + 1] += w * d0[1]; o[8 * c + 2] += w * d1[0]; o[8 * c + 3] += w * d1[1];
            o[8 * c + 4] += w * d2[0]; o[8 * c + 5] += w * d2[1]; o[8 * c + 6] += w * d3[0]; o[8 * c + 7] += w * d3[1];
          }
        }
      };
      vload(va, 0);
#pragma unroll 1
      for (int k = 0; k < 128; k += 16) {
        vload(vb2, k + 8);
        vacc(va, k);
        if (k + 16 < 128) vload(va, k + 16);
        vacc(vb2, k + 8);
      }
    }
    if (!dry || o[0] == 1.2345e33f) {
      f32x4* op = (f32x4*)(P.out + (size_t)tok * D + lane * 16);
      float r[16];
#pragma unroll
      for (int i = 0; i < 4; ++i) { f32x4 t = op[i]; t.x += o[4 * i]; t.y += o[4 * i + 1]; t.z += o[4 * i + 2]; t.w += o[4 * i + 3]; op[i] = t; r[4 * i] = t.x; r[4 * i + 1] = t.y; r[4 * i + 2] = t.z; r[4 * i + 3] = t.w; }
      u32x4* hp = (u32x4*)(P.hb2 + (size_t)tok * D + lane * 16);
      hp[0] = mk4(pack2(r[0], r[1]), pack2(r[2], r[3]), pack2(r[4], r[5]), pack2(r[6], r[7]));
      hp[1] = mk4(pack2(r[8], r[9]), pack2(r[10], r[11]), pack2(r[12], r[13]), pack2(r[14], r[15]));
    }
  }
}

__device__ __forceinline__ void phase_ple(const Params& P, int l, char* smem, bool dry = false) {
  const u16* Wg = P.WgT + (size_t)l * D * D;
  const u16* Wp = P.WpT + (size_t)l * D * 256;
  const u16* pb = P.pb + (size_t)l * S * 256;
  const int tid = threadIdx.x, lane = tid & 63, wave = tid >> 6, wr = wave >> 1, h = lane >> 5;
  const float* rs = (const float*)(smem + G_RS_OFF);
  float* tile = (float*)smem;
  for (int it = blockIdx.x; it < 128 * 8; it += gridDim.x) {
    const int mt = it >> 3, nt = it & 7;
    f32x16 acc[2][2];
    zero_acc(acc);
    gemm_mainloop<false>(pb + (size_t)mt * 128 * 256, 256, Wp + (size_t)nt * 128 * 256, 256, 256, smem, acc);
    u16* side = (u16*)(smem + 36864);
    const int wc = wave & 1;
#pragma unroll
    for (int i = 0; i < 2; ++i)
#pragma unroll
      for (int j = 0; j < 2; ++j)
#pragma unroll
        for (int r = 0; r < 16; ++r)
          side[(wr * 64 + i * 32 + crow(r, h)) * 136 + wc * 64 + j * 32 + (lane & 31)] = f2bf(acc[i][j][r]);
    zero_acc(acc);
    gemm_mainloop<true>(P.hb2 + (size_t)mt * 128 * D, D, Wg + (size_t)nt * 128 * D, D, D, smem, acc);
    __syncthreads();
#pragma unroll
    for (int i = 0; i < 2; ++i)
#pragma unroll
      for (int j = 0; j < 2; ++j)
#pragma unroll
        for (int r = 0; r < 16; ++r) {
          const int row = wr * 64 + i * 32 + crow(r, h);
          const float pv = bf2f(side[row * 136 + wc * 64 + j * 32 + (lane & 31)]);
          acc[i][j][r] = sigmoidf_(acc[i][j][r] * rs[row]) * pv;
        }
    __syncthreads();
    acc_to_lds(acc, tile);
    __syncthreads();
    const int c4 = (tid & 31) * 4, r0 = tid >> 5;
#pragma unroll 4
    for (int i = 0; i < 16; ++i) {
      const int row = r0 + 8 * i;
      const size_t idx = (size_t)(mt * 128 + row) * D + nt * 128 + c4;
      const f32x4 a4 = *(const f32x4*)(tile + row * EPS_LD + c4);
      f32x4 h4 = *(const f32x4*)(P.out + idx);
      h4 += a4;
      if (!dry || h4[0] == 1.2345e33f) {
        *(f32x4*)(P.out + idx) = h4;
        *(u32x2*)(P.hb + idx) = mk2(pack2(h4[0], h4[1]), pack2(h4[2], h4[3]));
      }
    }
  }
}

constexpr int N_PHASES = 15;
#define XB_TMO      128
#define XB_XCNT(j)  (256  + 64 * (j))
#define XB_XSUB(j)  (1280 + 64 * (j))
#define XB_XGEN(j)  (2304 + 64 * (j))
#define XB_TOP      3328
#define XB_TOPGEN   3392
#define XCD_BAR_WORDS 3456
#define XB_SPIN_CAP (1u << 24)
typedef __attribute__((address_space(3))) unsigned las_u32;
DI unsigned xb_ld(unsigned* p) { return __hip_atomic_load(p, __ATOMIC_RELAXED, __HIP_MEMORY_SCOPE_AGENT); }
DI unsigned xb_add(unsigned* p, unsigned v) { return __hip_atomic_fetch_add(p, v, __ATOMIC_RELAXED, __HIP_MEMORY_SCOPE_AGENT); }
#define XB_SPIN(cond, bar) do { unsigned _sp = 0; while (cond) { __builtin_amdgcn_s_sleep(1); \
    if ((++_sp & 255u) == 0u) { if (xb_ld(&(bar)[XB_TMO])) break; if (_sp > XB_SPIN_CAP) { (void)xb_add(&(bar)[XB_TMO], 1u); break; } } } } while (0)
struct XcdBarrier { unsigned* bar; unsigned x; volatile las_u32* st; };
DI XcdBarrier xcd_barrier_post(unsigned* bar, volatile las_u32* st) {
  XcdBarrier b; b.bar = bar; b.x = (unsigned)__builtin_amdgcn_s_getreg((3 << 11) | 20) & 0xFu; b.st = st;
  if (threadIdx.x == 0) (void)xb_add(&bar[XB_XCNT(b.x)], 1u);
  return b;
}
DI void xcd_barrier_complete(unsigned* bar, unsigned x, unsigned& nloc, unsigned& nx) {
  const unsigned G = gridDim.x * gridDim.y * gridDim.z;
  unsigned sum, cnt, mine, sp = 0u;
  for (;;) {
    sum = 0u; cnt = 0u; mine = 0u;
#pragma unroll
    for (unsigned j = 0; j < 16; ++j) { const unsigned c = xb_ld(&bar[XB_XCNT(j)]); sum += c; cnt += (c > 0u) ? 1u : 0u; mine = (j == x) ? c : mine; }
    if (sum == G) break;
    __builtin_amdgcn_s_sleep(1);
    if ((++sp & 255u) == 0u) { if (xb_ld(&bar[XB_TMO])) break; if (sp > XB_SPIN_CAP) { (void)xb_add(&bar[XB_TMO], 1u); break; } }
  }
  nloc = mine > 0u ? mine : 1u; nx = cnt > 0u ? cnt : 1u;
}
DI void xcd_barrier(unsigned* xbar, unsigned xx, volatile las_u32* xst_) {
  XcdBarrier b; b.bar = xbar; b.x = xx; b.st = xst_;
  asm volatile("s_waitcnt vmcnt(0)" ::: "memory");
  __syncthreads();
  if (threadIdx.x == 0) {
    unsigned* bar = b.bar;
    __builtin_amdgcn_s_waitcnt(0);
    unsigned nloc = b.st[0], nx = b.st[1];
    if (nloc == 0u) { xcd_barrier_complete(bar, b.x, nloc, nx); b.st[0] = nloc; b.st[1] = nx; }
    const unsigned old = xb_add(&bar[XB_XSUB(b.x)], 1u);
    const unsigned gen = old / nloc;
    if (old + 1u == (gen + 1u) * nloc) {
      __builtin_amdgcn_fence(__ATOMIC_RELEASE, "agent");
      asm volatile("s_waitcnt vmcnt(0)" ::: "memory");
      const unsigned og = xb_add(&bar[XB_TOP], 1u);
      const unsigned tg = og / nx;
      if (og + 1u == (tg + 1u) * nx) xb_add(&bar[XB_TOPGEN], 1u);
      else XB_SPIN(xb_ld(&bar[XB_TOPGEN]) == tg, bar);
      __builtin_amdgcn_fence(__ATOMIC_ACQUIRE, "agent");
      xb_add(&bar[XB_XGEN(b.x)], 1u);
      asm volatile("s_waitcnt vmcnt(0)" ::: "memory");
    } else {
      XB_SPIN(xb_ld(&bar[XB_XGEN(b.x)]) == gen, bar);
      __builtin_amdgcn_fence(__ATOMIC_ACQUIRE, "agent");
      asm volatile("s_waitcnt vmcnt(0)" ::: "memory");
    }
  }
  __syncthreads();
}
__global__ void __launch_bounds__(NT, 2) hymba_mega(Params P, unsigned* counters) {
  __shared__ __attribute__((aligned(16))) char smem[SMEM_BYTES];
  cg::grid_group grid = cg::this_grid();
  const int lo = P.phase_lo, hi = P.phase_hi;
#ifndef ONLY_PHASE
#define ONLY_PHASE -1
#endif
#define PH_ON(k) (ONLY_PHASE < 0 || ONLY_PHASE == (k))
  volatile las_u32* xst = (volatile las_u32*)(smem + SMEM_BYTES - 16);
  if (threadIdx.x < 4) xst[threadIdx.x] = 0u;
  __syncthreads();
  unsigned* const xbar = counters + 64;
  const unsigned xcc = xcd_barrier_post(xbar, xst).x;
#define RUN(ph, kind, call) if (lo <= (ph) && (ph) < hi) { const bool dry = false; const int rep = 0; (void)dry; (void)rep; if (PH_ON(kind)) { call; } if ((ph) + 1 < hi) { if ((ph) == 0) grid.sync(); else xcd_barrier(xbar, xcc, xst); } }
#define RUNREP(ph, kind, call) if (lo <= (ph) && (ph) < hi) { \
    const int nrep = ((ph) == P.rep_ph) ? P.rep_n : 1; \
    for (int rep = 0; rep < nrep; ++rep) { const bool dry = rep > 0; (void)dry; \
      if (PH_ON(kind)) { call; } \
      if ((ph) + 1 < hi || rep + 1 < nrep) { xcd_barrier(xbar, xcc, xst); } } }
#ifndef REPEAT
#define REPEAT -1
#define RSEC 7
#endif
  RUN(0, 7, phase_prep(P, smem))
  RUN(1, 0, phase_inproj(P, 0, smem))
  RUN(2, 1, phase_compress(P, 0, smem))
  RUNREP(3, 2, phase_attention(P, 0, smem, counters + 4 * rep, dry ? (P.rep_sec | 8) : 7, dry && P.rep_nsa_only))
  RUN(4, 3, phase_outproj(P, 0, smem, dry))
  RUN(5, 4, phase_peerq(P, 0, smem))
  RUN(6, 5, phase_peer(P, 0, smem, dry))
  RUN(7, 6, phase_ple(P, 0, smem, dry))
  RUN(8, 0, phase_inproj(P, 1, smem))
  RUN(9, 1, phase_compress(P, 1, smem))
  RUN(10, 2, phase_attention(P, 1, smem, counters + 16))
  RUN(11, 3, phase_outproj(P, 1, smem))
  RUN(12, 4, phase_peerq(P, 1, smem))
  RUN(13, 5, phase_peer(P, 1, smem))
  RUN(14, 6, phase_ple(P, 1, smem))
}

static size_t align_up(size_t x, size_t a) { return (x + a - 1) / a * a; }

extern "C" void kernel_launch(void* const* d_in, const int* in_sizes, int n_in, void* d_out, int out_size, void* d_ws, size_t ws_size, hipStream_t stream) {
  static int grid_blocks = 0;
  if (!grid_blocks) {
    int dev = 0, cus = 0, per_cu = 0;
    hipGetDevice(&dev);
    hipDeviceGetAttribute(&cus, hipDeviceAttributeMultiprocessorCount, dev);
    hipOccupancyMaxActiveBlocksPerMultiprocessor(&per_cu, hymba_mega, NT, 0);
    if (per_cu > 2) per_cu = 2;
    if (per_cu < 1) per_cu = 1;
    grid_blocks = cus * per_cu;
  }
  Params P;
  memset(&P, 0, sizeof(P));
  P.x = (const float*)d_in[0]; P.p = (const float*)d_in[1]; P.positions = (const int*)d_in[2];
  P.attn_norm_w = (const float*)d_in[3]; P.w_in = (const float*)d_in[4]; P.fox_f_bias = (const float*)d_in[5];
  P.fox_q_norm_w = (const float*)d_in[6]; P.fox_k_norm_w = (const float*)d_in[7];
  P.nsa_q_norm_w = (const float*)d_in[8]; P.nsa_k_norm_w = (const float*)d_in[9]; P.nsa_cmp_pos = (const float*)d_in[10]; P.nsa_cmp_w = (const float*)d_in[11];
  P.diff_q_norm_w = (const float*)d_in[12]; P.diff_k_norm_w = (const float*)d_in[13]; P.diff_lambda = (const float*)d_in[14]; P.diff_subln_w = (const float*)d_in[15];
  P.w_out = (const float*)d_in[16]; P.ffn_norm_w = (const float*)d_in[17]; P.peer_w_q = (const float*)d_in[18]; P.peer_sub_keys = (const float*)d_in[19];
  P.peer_u = (const float*)d_in[20]; P.peer_v = (const float*)d_in[21]; P.ple_norm_w = (const float*)d_in[22]; P.ple_w_gate = (const float*)d_in[23]; P.ple_w_proj = (const float*)d_in[24];
  P.out = (float*)d_out;
  char* w = (char*)d_ws; size_t off = 0;
  auto take = [&](size_t bytes) { char* p = w + off; off = align_up(off + bytes, 256); return p; };
  unsigned* counters = (unsigned*)take(256 + XCD_BAR_WORDS * 4);
  P.WinT = (u16*)take((size_t)2 * NINP * D * 2);
  P.WoutT = (u16*)take((size_t)2 * D * D * 2);
  P.WqT = (u16*)take((size_t)2 * 2048 * D * 2);
  P.WgT = (u16*)take((size_t)2 * D * D * 2);
  P.WpT = (u16*)take((size_t)2 * D * 256 * 2);
  P.SubK = (u16*)take((size_t)2 * 16 * 128 * 128 * 2);
  P.CmpWT = (u16*)take((size_t)2 * 2 * 128 * 2048 * 2);
  P.cmpbias = (float*)take(2 * 2 * 64 * 4);
  P.U8 = (unsigned char*)take((size_t)2 * S * D);
  P.V8 = (unsigned char*)take((size_t)2 * S * D / 2);
  P.Uinv = (float*)take((size_t)2 * S * 4); P.Vinv = (float*)take((size_t)2 * S * 4);
  P.hb = (u16*)take((size_t)S * D * 2);
  P.hb2 = (u16*)take((size_t)S * D * 2);
  P.pb = (u16*)take((size_t)2 * S * 256 * 2);
  P.ropeN = (float*)take((size_t)S * 64 * 4);
  P.ropeD = (float*)take((size_t)S * 32 * 4);
  P.QF = (u16*)take((size_t)4 * S * 64 * 2); P.KF = (u16*)take((size_t)4 * S * 64 * 2); P.VFt = (u16*)take((size_t)4 * S * 64 * 2);
  P.cloc = (float*)take((size_t)4 * S * 4); P.ctot = (float*)take(256 * 4 * 4);
  P.QN = (u16*)take((size_t)8 * S * 64 * 2); P.QR = (u16*)take((size_t)8 * S * 64 * 2);
  P.KC = (u16*)take((size_t)2 * (S + 64) * 64 * 2); P.VC = (u16*)take((size_t)2 * (S + 64) * 64 * 2);
  P.KCC = (u16*)take((size_t)2 * 1024 * 64 * 2); P.VCCt = (u16*)take((size_t)2 * 64 * 1024 * 2);
  P.KS8 = (unsigned char*)take((size_t)2 * S * 64); P.VS8t = (unsigned char*)take((size_t)2 * S * 64);
  P.KW = (u16*)take((size_t)2 * S * 64 * 2); P.VWt = (u16*)take((size_t)2 * S * 64 * 2);
  P.gates = (float*)take((size_t)S * 24 * 4);
  P.QD = (u16*)take((size_t)4 * S * 64 * 2); P.KD = (u16*)take((size_t)4 * S * 64 * 2); P.VDt = (u16*)take((size_t)4 * S * 64 * 2);
  P.mix = (u16*)take((size_t)S * D * 2);
  P.dstash = (float*)take((size_t)grid_blocks * 128 * 64 * 4);
  P.impA = (float*)take((size_t)256 * 256 * 128 * 4); P.impB = (float*)take((size_t)256 * 256 * 128 * 4);
  P.topk = (u32*)take((size_t)S * 256 * 4);
  if (off > ws_size) { fprintf(stderr, "kernel_launch: workspace too small: need %zu, have %zu\n", off, ws_size); return; }
  hipMemsetAsync(counters, 0, 256 + XCD_BAR_WORDS * 4, stream);
#ifndef SINGLE_LAUNCH
#define SINGLE_LAUNCH 1
#endif
#ifndef REP_PH
#define REP_PH -1
#endif
#ifndef REP_N
#define REP_N 1
#endif
#ifndef REP_SEC
#define REP_SEC 7
#endif
#ifndef REP_NSA_ONLY
#define REP_NSA_ONLY 0
#endif
  P.rep_ph = REP_PH; P.rep_n = REP_N; P.rep_sec = REP_SEC; P.rep_nsa_only = REP_NSA_ONLY;
  if (SINGLE_LAUNCH) {
    P.phase_lo = 0; P.phase_hi = N_PHASES;
    void* args[] = {&P, &counters};
    hipError_t e = hipLaunchCooperativeKernel((void*)hymba_mega, dim3(grid_blocks), dim3(NT), args, 0, stream);
    if (e != hipSuccess) fprintf(stderr, "cooperative launch failed: %s (grid %d)\n", hipGetErrorString(e), grid_blocks);
  } else {
    for (int ph = 0; ph < N_PHASES; ++ph) {
      P.phase_lo = ph; P.phase_hi = ph + 1;
      void* args[] = {&P, &counters};
      hipError_t e = hipLaunchCooperativeKernel((void*)hymba_mega, dim3(grid_blocks), dim3(NT), args, 0, stream);
      if (e != hipSuccess) { fprintf(stderr, "cooperative launch failed: %s (grid %d, phase %d)\n", hipGetErrorString(e), grid_blocks, ph); break; }
    }
  }
}
```

```cpp
#include <hip/hip_runtime.h>
#include <hip/hip_cooperative_groups.h>
#include <cstdio>
#include <cstdint>
#include <cstring>
namespace cg = cooperative_groups;

typedef __attribute__((ext_vector_type(8))) short bf16x8;
typedef __attribute__((ext_vector_type(4))) short bf16x4;
typedef __attribute__((ext_vector_type(16))) float f32x16;
typedef __attribute__((ext_vector_type(4))) float f32x4;
typedef __attribute__((ext_vector_type(2))) float f32x2;
typedef __attribute__((ext_vector_type(2))) __bf16 bf2_t;
typedef unsigned short u16;
typedef unsigned int u32;
typedef __attribute__((ext_vector_type(4))) unsigned int u32x4;
typedef __attribute__((ext_vector_type(2))) unsigned int u32x2;

#define DI __device__ __forceinline__
#define MFMA32(a, b, c) __builtin_amdgcn_mfma_f32_32x32x16_bf16((a), (b), (c), 0, 0, 0)
#define MFMA16(a, b, c) __builtin_amdgcn_mfma_f32_16x16x32_bf16((a), (b), (c), 0, 0, 0)

constexpr int S = 16384;
constexpr int D = 1024;
constexpr int NT = 256;
constexpr int NIN = 2844;
constexpr int NINP = 2944;
constexpr int SMEM_BYTES = 72704;
constexpr float LOG2E = 1.4426950408889634f;
#ifndef ABLATE
#define ABLATE 0
#endif

typedef int i32x8 __attribute__((ext_vector_type(8)));
struct Params {
  const float* x; const float* p; const int* positions;
  const float* attn_norm_w; const float* w_in; const float* fox_f_bias; const float* fox_q_norm_w; const float* fox_k_norm_w;
  const float* nsa_q_norm_w; const float* nsa_k_norm_w; const float* nsa_cmp_pos; const float* nsa_cmp_w;
  const float* diff_q_norm_w; const float* diff_k_norm_w; const float* diff_lambda; const float* diff_subln_w;
  const float* w_out; const float* ffn_norm_w; const float* peer_w_q; const float* peer_sub_keys; const float* peer_u; const float* peer_v;
  const float* ple_norm_w; const float* ple_w_gate; const float* ple_w_proj;
  float* out;
  u16* WinT;
  u16* WoutT;
  u16* WqT;
  u16* WgT;
  u16* WpT;
  u16* SubK;
  u16* CmpWT;
  float* cmpbias;
  unsigned char* U8;
  unsigned char* V8;
  float* Uinv; float* Vinv;
  u16* hb;
  u16* hb2;
  u16* pb;
  float* ropeN;
  float* ropeD;
  u16* QF; u16* KF; u16* VFt;
  float* cloc; float* ctot;
  u16* QN; u16* QR;
  u16* KC; u16* VC;
  u16* KCC; u16* VCCt;
  unsigned char* KS8; unsigned char* VS8t;
  u16* KW; u16* VWt;
  float* gates;
  u16* QD; u16* KD; u16* VDt;
  u16* mix;
  float* dstash;
  float* impA; float* impB;
  u32* topk;
  int phase_lo, phase_hi;
  int rep_ph, rep_n, rep_sec, rep_nsa_only;
};

DI u32x4 mk4(u32 a, u32 b, u32 c, u32 d) { return (u32x4){a, b, c, d}; }
DI u32x2 mk2(u32 a, u32 b) { return (u32x2){a, b}; }
DI u32 pack2(float a, float b) { f32x2 v = {a, b}; bf2_t r = __builtin_convertvector(v, bf2_t); return __builtin_bit_cast(u32, r); }
DI u16 f2bf(float a) { return (u16)(pack2(a, 0.f) & 0xffffu); }
DI float bf2f(u16 x) { return __uint_as_float(((u32)x) << 16); }
DI float bflo(u32 x) { return __uint_as_float(x << 16); }
DI float bfhi(u32 x) { return __uint_as_float(x & 0xffff0000u); }
DI int opaque_tid() { int t = threadIdx.x; asm volatile("" : "+v"(t)); return t; }
DI int crow(int reg, int h) { return (reg & 3) + 8 * (reg >> 2) + 4 * h; }
DI float wave_sum(float v) {
#pragma unroll
  for (int o = 32; o > 0; o >>= 1) v += __shfl_xor(v, o);
  return v;
}
DI float wave_max(float v) {
#pragma unroll
  for (int o = 32; o > 0; o >>= 1) v = fmaxf(v, __shfl_xor(v, o));
  return v;
}

DI int inproj_old_col(int j) {
  if (j < 768) return j;
  if (j < 2048) return j + 4;
  if (j < 2816) return j + 28;
  if (j < 2820) return j - 2048;
  if (j < 2844) return j - 768;
  return -1;
}
DI void transpose_tile(const float* __restrict__ src, int ldsrc, u16* __restrict__ dst, int K, const float* __restrict__ scale,
                       int n0, int k0, int mode, int nvalid, float* tile) {
  const int t = threadIdx.x;
  const int nn = t & 63, kq = t >> 6;
  int col = n0 + nn;
  if (mode == 1) col = inproj_old_col(col); else if (col >= nvalid) col = -1;
  float v[16];
#pragma unroll
  for (int i = 0; i < 16; ++i) v[i] = (col >= 0) ? src[(size_t)(k0 + kq + 4 * i) * ldsrc + col] : 0.f;
  if (scale) {
#pragma unroll
    for (int i = 0; i < 16; ++i) v[i] *= scale[k0 + kq + 4 * i];
  }
#pragma unroll
  for (int i = 0; i < 16; ++i) tile[(kq + 4 * i) * 65 + nn] = v[i];
  __syncthreads();
  const int n2 = t >> 2, kc = (t & 3) * 16;
  u32 o[8];
#pragma unroll
  for (int i = 0; i < 8; ++i) o[i] = pack2(tile[(kc + 2 * i) * 65 + n2], tile[(kc + 2 * i + 1) * 65 + n2]);
  u32x4* dp = (u32x4*)(dst + (size_t)(n0 + n2) * K + k0 + kc);
  dp[0] = mk4(o[0], o[1], o[2], o[3]);
  dp[1] = mk4(o[4], o[5], o[6], o[7]);
  __syncthreads();
}

DI void convert_rows(const float* __restrict__ src, u16* __restrict__ dst, size_t n8, float* __restrict__ copy) {
  const size_t stride = (size_t)gridDim.x * NT;
  for (size_t i0 = (size_t)blockIdx.x * NT + threadIdx.x; i0 < n8; i0 += 4 * stride) {
    f32x4 a[4], b[4];
#pragma unroll
    for (int u = 0; u < 4; ++u) {
      const size_t i = i0 + u * stride;
      if (i < n8) { a[u] = ((const f32x4*)src)[2 * i]; b[u] = ((const f32x4*)src)[2 * i + 1]; }
    }
#pragma unroll
    for (int u = 0; u < 4; ++u) {
      const size_t i = i0 + u * stride;
      if (i < n8) {
        if (copy) { ((f32x4*)copy)[2 * i] = a[u]; ((f32x4*)copy)[2 * i + 1] = b[u]; }
        ((u32x4*)dst)[i] = mk4(pack2(a[u][0], a[u][1]), pack2(a[u][2], a[u][3]), pack2(b[u][0], b[u][1]), pack2(b[u][2], b[u][3]));
      }
    }
  }
}

__device__ __forceinline__ void phase_prep(const Params& P, char* smem) {
  float* tile = (float*)smem;
  const int bid = blockIdx.x, nb = gridDim.x, t = threadIdx.x;
  for (int it0 = bid; it0 < 2 * 1952; it0 += nb) {
    const int l = it0 / 1952;
    int it = it0 % 1952;
    if (it < 736) { transpose_tile(P.w_in + (size_t)l * D * NIN, NIN, P.WinT + (size_t)l * NINP * D, D, P.attn_norm_w + l * D, (it >> 4) * 64, (it & 15) * 64, 1, 0, tile); continue; }
    it -= 736;
    if (it < 256) { transpose_tile(P.w_out + (size_t)l * D * D, D, P.WoutT + (size_t)l * D * D, D, nullptr, (it >> 4) * 64, (it & 15) * 64, 0, D, tile); continue; }
    it -= 256;
    if (it < 512) { transpose_tile(P.peer_w_q + (size_t)l * D * 2048, 2048, P.WqT + (size_t)l * 2048 * D, D, P.ffn_norm_w + l * D, (it >> 4) * 64, (it & 15) * 64, 0, 2048, tile); continue; }
    it -= 512;
    if (it < 256) { transpose_tile(P.ple_w_gate + (size_t)l * D * D, D, P.WgT + (size_t)l * D * D, D, P.ple_norm_w + l * D, (it >> 4) * 64, (it & 15) * 64, 0, D, tile); continue; }
    it -= 256;
    if (it < 64) { transpose_tile(P.ple_w_proj + (size_t)l * 256 * D, D, P.WpT + (size_t)l * D * 256, 256, nullptr, (it >> 2) * 64, (it & 3) * 64, 0, D, tile); continue; }
    it -= 64;
    { const int kv = it >> 6, i2 = it & 63;
      transpose_tile(P.nsa_cmp_w + (size_t)(l * 2 + kv) * 2048 * 64, 64, P.CmpWT + (size_t)(l * 2 + kv) * 128 * 2048, 2048, nullptr, (i2 >> 5) * 64, (i2 & 31) * 64, 0, 64, tile); }
  }
  convert_rows(P.peer_sub_keys, P.SubK, (size_t)2 * 16 * 128 * 128 / 8, nullptr);
  {
    const int lane = t & 63, gw = bid * 4 + (t >> 6), ngw = nb * 4;
    for (int r = gw; r < 4 * S; r += ngw) {
      const int tbl = r / (2 * S), l = (r / S) & 1, e = r % S;
      const float* src = (tbl ? P.peer_v : P.peer_u) + ((size_t)l * S + e) * D + lane * 16;
      float v[16];
#pragma unroll
      for (int i = 0; i < 4; ++i) { const f32x4 q4 = ((const f32x4*)src)[i]; v[4 * i] = q4[0]; v[4 * i + 1] = q4[1]; v[4 * i + 2] = q4[2]; v[4 * i + 3] = q4[3]; }
      if (tbl == 0) {
        const float* w = P.ffn_norm_w + l * D + lane * 16;
#pragma unroll
        for (int i = 0; i < 16; ++i) v[i] *= w[i];
      }
      float m = 0.f;
#pragma unroll
      for (int i = 0; i < 16; ++i) m = fmaxf(m, fabsf(v[i]));
      m = wave_max(m);
      {
        const float sc = (m > 0.f) ? 6.f / m : 0.f;
        u32 o[2] = {0u, 0u};
#pragma unroll
        for (int i = 0; i < 8; ++i) {
          if ((i & 3) == 0) o[i >> 2] = __builtin_amdgcn_cvt_scalef32_pk_fp4_f32(o[i >> 2], v[2 * i] * sc, v[2 * i + 1] * sc, 1.0f, 0);
          else if ((i & 3) == 1) o[i >> 2] = __builtin_amdgcn_cvt_scalef32_pk_fp4_f32(o[i >> 2], v[2 * i] * sc, v[2 * i + 1] * sc, 1.0f, 1);
          else if ((i & 3) == 2) o[i >> 2] = __builtin_amdgcn_cvt_scalef32_pk_fp4_f32(o[i >> 2], v[2 * i] * sc, v[2 * i + 1] * sc, 1.0f, 2);
          else o[i >> 2] = __builtin_amdgcn_cvt_scalef32_pk_fp4_f32(o[i >> 2], v[2 * i] * sc, v[2 * i + 1] * sc, 1.0f, 3);
        }
        *(u32x2*)((tbl ? P.V8 : P.U8) + ((size_t)l * S + e) * (D / 2) + lane * 8) = mk2(o[0], o[1]);
        if (lane == 0) (tbl ? P.Vinv : P.Uinv)[l * S + e] = m * (1.f / 6.f);
      }
    }
  }
  convert_rows(P.p, P.pb, (size_t)2 * S * 256 / 8, nullptr);
  convert_rows(P.x, P.hb, (size_t)S * D / 8, P.out);
  const size_t gtid = (size_t)bid * NT + t, gstride = (size_t)nb * NT;
  __syncthreads();
  if (t < 48) tile[t] = (t < 32) ? powf(10000.f, -(float)t / 32.f) : powf(10000.f, -(float)(t - 32) / 16.f);
  __syncthreads();
  for (size_t i = gtid; i < (size_t)S * 48; i += gstride) {
    const int tok = (int)(i / 48), r = (int)(i % 48);
    const float pos = (float)P.positions[tok];
    const float invf = tile[r];
    const float ang = pos * invf;
    const double rev = (double)ang * 0.15915494309189535;
    const float fr = (float)(rev - floor(rev));
    const float c = __builtin_amdgcn_cosf(fr), s = __builtin_amdgcn_sinf(fr);
    if (r < 32) { P.ropeN[(size_t)tok * 64 + r] = c; P.ropeN[(size_t)tok * 64 + 32 + r] = s; }
    else { P.ropeD[(size_t)tok * 32 + (r - 32)] = c; P.ropeD[(size_t)tok * 32 + 16 + (r - 32)] = s; }
  }
  {
    const int lane = t & 63, gw = bid * 4 + (t >> 6), ngw = nb * 4;
    for (int i = gw; i < 2 * 2 * 64; i += ngw) {
      const int lk = i >> 6, e = i & 63;
      const float* pos = P.nsa_cmp_pos + (size_t)lk * 2048;
      const float* w = P.nsa_cmp_w + (size_t)lk * 2048 * 64;
      float a = 0.f;
#pragma unroll 8
      for (int k = lane; k < 2048; k += 64) a += pos[k] * w[(size_t)k * 64 + e];
      a = wave_sum(a);
      if (lane == 0) P.cmpbias[i] = a;
    }
  }
  for (size_t i = gtid; i < 2 * 2 * 64 * 64; i += gstride) {
    const int which = (int)(i / (2 * 64 * 64)), r = (int)(i % (2 * 64 * 64));
    const int g = r / (64 * 64), o = r % (64 * 64);
    u16* base = which ? P.VC : P.KC;
    base[(size_t)g * (S + 64) * 64 + (size_t)S * 64 + o] = 0;
  }
}

constexpr int GST = 144;
constexpr int G_BOFF = 128 * GST;
constexpr int G_RS_OFF = 71680;

DI float ssq8(const u32x4& v) {
  float s = 0.f;
  float a;
  a = bflo(v.x); s += a * a; a = bfhi(v.x); s += a * a;
  a = bflo(v.y); s += a * a; a = bfhi(v.y); s += a * a;
  a = bflo(v.z); s += a * a; a = bfhi(v.z); s += a * a;
  a = bflo(v.w); s += a * a; a = bfhi(v.w); s += a * a;
  return s;
}

template <bool SSQ>
DI void gemm_mainloop(const u16* __restrict__ A, int lda, const u16* __restrict__ Bt, int ldb, int K, char* sm, f32x16 (&acc)[2][2]) {
  const int tid = threadIdx.x, lane = tid & 63, wave = tid >> 6;
  const int wr = wave >> 1, wc = wave & 1;
  const int lrow = tid >> 3, lcol = (tid & 7) * 8;
  char* As = sm; char* Bs = sm + G_BOFF;
  u32x4 ra[4], rb[4];
  float ssq[4] = {0.f, 0.f, 0.f, 0.f};
#pragma unroll
  for (int i = 0; i < 4; ++i) {
    ra[i] = *(const u32x4*)(A + (size_t)(lrow + 32 * i) * lda + lcol);
    rb[i] = *(const u32x4*)(Bt + (size_t)(lrow + 32 * i) * ldb + lcol);
  }
  const int aoff = (wr * 64 + (lane & 31)) * GST + (lane >> 5) * 16;
  const int boff = (wc * 64 + (lane & 31)) * GST + (lane >> 5) * 16;
  for (int k0 = 0; k0 < K; k0 += 64) {
    __syncthreads();
#pragma unroll
    for (int i = 0; i < 4; ++i) {
      *(u32x4*)(As + (lrow + 32 * i) * GST + lcol * 2) = ra[i];
      *(u32x4*)(Bs + (lrow + 32 * i) * GST + lcol * 2) = rb[i];
      if (SSQ) ssq[i] += ssq8(ra[i]);
    }
    __syncthreads();
    if (k0 + 64 < K) {
#pragma unroll
      for (int i = 0; i < 4; ++i) {
        ra[i] = *(const u32x4*)(A + (size_t)(lrow + 32 * i) * lda + k0 + 64 + lcol);
        rb[i] = *(const u32x4*)(Bt + (size_t)(lrow + 32 * i) * ldb + k0 + 64 + lcol);
      }
    }
#pragma unroll
    for (int ks = 0; ks < 4; ++ks) {
      bf16x8 af[2], bfr[2];
#pragma unroll
      for (int i = 0; i < 2; ++i) af[i] = *(const bf16x8*)(As + aoff + i * 32 * GST + ks * 32);
#pragma unroll
      for (int j = 0; j < 2; ++j) bfr[j] = *(const bf16x8*)(Bs + boff + j * 32 * GST + ks * 32);
#pragma unroll
      for (int i = 0; i < 2; ++i)
#pragma unroll
        for (int j = 0; j < 2; ++j) acc[i][j] = MFMA32(af[i], bfr[j], acc[i][j]);
    }
  }
  __syncthreads();
  if (SSQ) {
    float* rs = (float*)(sm + G_RS_OFF);
#pragma unroll
    for (int i = 0; i < 4; ++i) {
      float s = ssq[i];
      s += __shfl_xor(s, 1); s += __shfl_xor(s, 2); s += __shfl_xor(s, 4);
      if ((tid & 7) == 0) rs[lrow + 32 * i] = rsqrtf(s * (1.f / (float)K) + 1e-6f);
    }
  }
}

DI void zero_acc(f32x16 (&acc)[2][2]) {
#pragma unroll
  for (int i = 0; i < 2; ++i)
#pragma unroll
    for (int j = 0; j < 2; ++j)
#pragma unroll
      for (int r = 0; r < 16; ++r) acc[i][j][r] = 0.f;
}

constexpr int EPS_LD = 132;
DI void acc_to_lds(const f32x16 (&acc)[2][2], float* tile) {
  const int lane = threadIdx.x & 63, wave = threadIdx.x >> 6;
  const int wr = wave >> 1, wc = wave & 1;
#pragma unroll
  for (int i = 0; i < 2; ++i)
#pragma unroll
    for (int j = 0; j < 2; ++j)
#pragma unroll
      for (int r = 0; r < 16; ++r)
        tile[(wr * 64 + i * 32 + crow(r, lane >> 5)) * EPS_LD + wc * 64 + j * 32 + (lane & 31)] = acc[i][j][r];
}

DI float log_sigmoid(float x) { return fminf(x, 0.f) - log1pf(expf(-fabsf(x))); }
DI float sigmoidf_(float x) { return 1.f / (1.f + expf(-x)); }

DI void store32_bf16(u16* dst, const float* o) {
  u32x4* d4 = (u32x4*)dst;
#pragma unroll
  for (int i = 0; i < 4; ++i)
    d4[i] = mk4(pack2(o[8 * i], o[8 * i + 1]), pack2(o[8 * i + 2], o[8 * i + 3]), pack2(o[8 * i + 4], o[8 * i + 5]), pack2(o[8 * i + 6], o[8 * i + 7]));
}

__device__ __forceinline__ void inproj_epilogue_half(const Params& P, int l, int mt, int nt, int half, const float* tile, const float* rs) {
  const int tid = threadIdx.x, lane = tid & 63, wave = tid >> 6;
  const int hl = wave >> 1, h32 = wave & 1;
  const int sg = 2 * nt + hl;
  const int rloc = half * 64 + lane;
  const int tok = mt * 128 + rloc;
  const float rstd = rs[rloc];
  if (sg >= 45) return;
  float v[64];
  {
    const f32x4* src = (const f32x4*)(tile + rloc * EPS_LD + hl * 64);
#pragma unroll
    for (int i = 0; i < 16; ++i) { f32x4 t = src[i]; v[4 * i] = t[0] * rstd; v[4 * i + 1] = t[1] * rstd; v[4 * i + 2] = t[2] * rstd; v[4 * i + 3] = t[3] * rstd; }
  }
  const u32 hmask = (u32)(-(int)h32);
#define VO(i) __uint_as_float((__float_as_uint(v[32 + (i)]) & hmask) | (__float_as_uint(v[(i)]) & ~hmask))
  if (sg == 44) {
    if (h32 == 0) {
      const int chunk = tok >> 6;
#pragma unroll
      for (int hd = 0; hd < 4; ++hd) {
        float x = log_sigmoid(v[hd] + P.fox_f_bias[l * 4 + hd]);
#pragma unroll
        for (int o = 1; o < 64; o <<= 1) { float t = __shfl_up(x, o); if (lane >= o) x += t; }
        P.cloc[(size_t)hd * S + tok] = x;
        if (lane == 63) P.ctot[chunk * 4 + hd] = x;
      }
    } else {
      float* g = P.gates + (size_t)tok * 24;
#pragma unroll
      for (int i = 0; i < 24; ++i) g[i] = sigmoidf_(v[4 + i]);
    }
    return;
  }
  float o[32];
  const bool is_vt = (sg >= 8 && sg < 12) || (sg == 26 || sg == 27) || (sg == 30 || sg == 31) || (sg >= 40);
  const bool is_raw = (sg >= 20 && sg < 24);
  const bool is_diff = (sg >= 32 && sg < 40);
  if (is_vt) {
    if (sg == 26 || sg == 27) {
      const int key = tok & 63, G = key >> 5, h4 = (key & 31) >> 3, j = key & 7;
      unsigned char* b8 = P.VS8t + (size_t)(sg - 26) * 64 * S + (size_t)(tok >> 6) * 4096 + G * 2048 + h4 * 128 + j;
#pragma unroll
      for (int i = 0; i < 32; i += 2) {
        const int wd = __builtin_amdgcn_cvt_pk_fp8_f32(VO(i), VO(i + 1), 0, false);
        const int d0 = h32 * 32 + i, d1 = d0 + 1;
        b8[(d0 >> 4) * 512 + (d0 & 15) * 8] = (unsigned char)(wd & 0xff);
        b8[(d1 >> 4) * 512 + (d1 & 15) * 8] = (unsigned char)((wd >> 8) & 0xff);
      }
      return;
    }
    u16* base;
    if (sg < 12) base = P.VFt + (size_t)(sg - 8) * 64 * S;
    else if (sg < 32) base = P.VWt + (size_t)(sg - 30) * 64 * S;
    else base = P.VDt + (size_t)(sg - 40) * 64 * S;
#pragma unroll
    for (int i = 0; i < 32; ++i) base[(size_t)(h32 * 32 + i) * S + tok] = f2bf(VO(i));
    return;
  }
  if (is_raw) {
    u16* base = (sg < 22) ? P.KC + (size_t)(sg - 20) * (S + 64) * 64 : P.VC + (size_t)(sg - 22) * (S + 64) * 64;
#pragma unroll
    for (int i = 0; i < 32; ++i) o[i] = VO(i);
    store32_bf16(base + (size_t)tok * 64 + h32 * 32, o);
    return;
  }
  if (is_diff) {
    const float* w = (sg < 36 ? P.diff_q_norm_w : P.diff_k_norm_w) + l * 32;
    float ss = 0.f;
#pragma unroll
    for (int i = 0; i < 32; ++i) ss += VO(i) * VO(i);
    const float rn = rsqrtf(ss * (1.f / 32.f) + 1e-6f);
    const float sc = (sg < 36) ? 0.17677669529663687f * LOG2E : 1.f;
    const float* rp = P.ropeD + (size_t)tok * 32;
#pragma unroll
    for (int i = 0; i < 16; ++i) {
      const float y1 = VO(i) * rn * w[i], y2 = VO(16 + i) * rn * w[16 + i];
      const float c = rp[i], s = rp[16 + i];
      o[i] = (y1 * c - y2 * s) * sc;
      o[16 + i] = (y2 * c + y1 * s) * sc;
    }
    u16* base = (sg < 36) ? P.QD + (size_t)(sg - 32) * S * 64 : P.KD + (size_t)(sg - 36) * S * 64;
    store32_bf16(base + (size_t)tok * 64 + h32 * 32, o);
    return;
  }
  const float* w;
  if (sg < 4) w = P.fox_q_norm_w + l * 64; else if (sg < 8) w = P.fox_k_norm_w + l * 64; else if (sg < 20) w = P.nsa_q_norm_w + l * 64; else w = P.nsa_k_norm_w + l * 64;
  float ss = 0.f;
#pragma unroll
  for (int i = 0; i < 64; ++i) ss += v[i] * v[i];
  const float rn = rsqrtf(ss * (1.f / 64.f) + 1e-6f);
  const float qs = 0.125f * LOG2E;
  if (sg < 8) {
    const float sc = (sg < 4) ? qs : 1.f;
#pragma unroll
    for (int i = 0; i < 32; ++i) o[i] = VO(i) * rn * w[h32 * 32 + i] * sc;
    u16* base = (sg < 4) ? P.QF + (size_t)sg * S * 64 : P.KF + (size_t)(sg - 4) * S * 64;
    store32_bf16(base + (size_t)tok * 64 + h32 * 32, o);
    return;
  }
  const float* rp = P.ropeN + (size_t)tok * 64;
  const float sc = (sg < 20) ? qs : 1.f;
  if (sg < 20) {
#pragma unroll
    for (int i = 0; i < 32; ++i) o[i] = VO(i) * rn * w[h32 * 32 + i] * sc;
    store32_bf16(P.QN + ((size_t)(sg - 12) * S + tok) * 64 + h32 * 32, o);
  }
#pragma unroll
  for (int i = 0; i < 32; ++i) {
    const float y1 = v[i] * rn * w[i], y2 = v[32 + i] * rn * w[32 + i];
    const float c = rp[i], s = rp[32 + i];
    o[i] = (h32 == 0 ? (y1 * c - y2 * s) : (y2 * c + y1 * s)) * sc;
  }
  if (sg == 24 || sg == 25) {
    const int key = tok & 63, G = key >> 5, r32 = key & 31, t = (r32 >> 2) & 1, i = ((r32 >> 3) << 2) | (r32 & 3);
    unsigned char* d8 = P.KS8 + (size_t)(sg - 24) * S * 64 + (size_t)(tok >> 6) * 4096 + ((G * 2 + t) * 2 + h32) * 512 + i * 8;
#pragma unroll
    for (int h4 = 0; h4 < 4; ++h4) {
      int w0 = 0, w1 = 0;
      w0 = __builtin_amdgcn_cvt_pk_fp8_f32(o[8 * h4], o[8 * h4 + 1], w0, false);
      w0 = __builtin_amdgcn_cvt_pk_fp8_f32(o[8 * h4 + 2], o[8 * h4 + 3], w0, true);
      w1 = __builtin_amdgcn_cvt_pk_fp8_f32(o[8 * h4 + 4], o[8 * h4 + 5], w1, false);
      w1 = __builtin_amdgcn_cvt_pk_fp8_f32(o[8 * h4 + 6], o[8 * h4 + 7], w1, true);
      *(u32x2*)(d8 + h4 * 128) = mk2((u32)w0, (u32)w1);
    }
    return;
  }
  u16* base;
  if (sg < 20) base = P.QR + (size_t)(sg - 12) * S * 64;
  else base = P.KW + (size_t)(sg - 28) * S * 64;
  store32_bf16(base + (size_t)tok * 64 + h32 * 32, o);
}

#undef VO
__device__ __forceinline__ void phase_inproj(const Params& P, int l, char* smem) {
  const u16* Wt = P.WinT + (size_t)l * NINP * D;
  float* tile = (float*)smem;
  const float* rs = (const float*)(smem + G_RS_OFF);
  for (int it = blockIdx.x; it < 128 * 23; it += gridDim.x) {
    const int mt = it / 23, nt = it % 23;
    f32x16 acc[2][2];
    zero_acc(acc);
    gemm_mainloop<true>(P.hb + (size_t)mt * 128 * D, D, Wt + (size_t)nt * 128 * D, D, D, smem, acc);
    acc_to_lds(acc, tile);
    __syncthreads();
#pragma unroll 1
    for (int half = 0; half < 2; ++half) inproj_epilogue_half(P, l, mt, nt, half, tile, rs);
  }
}

__device__ __forceinline__ void phase_compress(const Params& P, int l, char* smem) {
  float* tile = (float*)smem;
  for (int it = blockIdx.x; it < 32; it += gridDim.x) {
    const int kv = it >> 4, g = (it >> 3) & 1, mt = it & 7;
    const u16* A = (kv ? P.VC : P.KC) + (size_t)g * (S + 64) * 64 + (size_t)mt * 128 * 1024;
    const u16* Bt = P.CmpWT + (size_t)(l * 2 + kv) * 128 * 2048;
    const float* bias = P.cmpbias + (l * 2 + kv) * 64;
    f32x16 acc[2][2];
    zero_acc(acc);
    gemm_mainloop<false>(A, 1024, Bt, 2048, 2048, smem, acc);
    acc_to_lds(acc, tile);
    __syncthreads();
#pragma unroll 1
    for (int half = 0; half < 2; ++half) {
      {
        const int lane = threadIdx.x & 63, wave = threadIdx.x >> 6;
        const int idx = mt * 128 + half * 64 + lane;
        float v[64];
        const f32x4* src = (const f32x4*)(tile + (half * 64 + lane) * EPS_LD);
#pragma unroll
        for (int i = 0; i < 16; ++i) { f32x4 t = src[i]; v[4 * i] = t[0] + bias[4 * i]; v[4 * i + 1] = t[1] + bias[4 * i + 1]; v[4 * i + 2] = t[2] + bias[4 * i + 2]; v[4 * i + 3] = t[3] + bias[4 * i + 3]; }
        float vo[16];
#pragma unroll
        for (int i = 0; i < 4; ++i) { f32x4 t = src[wave * 4 + i]; const float* bb = bias + wave * 16 + 4 * i; vo[4 * i] = t[0] + bb[0]; vo[4 * i + 1] = t[1] + bb[1]; vo[4 * i + 2] = t[2] + bb[2]; vo[4 * i + 3] = t[3] + bb[3]; }
        if (kv == 0) {
          const float* w = P.nsa_k_norm_w + l * 64;
          float ss = 0.f;
#pragma unroll
          for (int i = 0; i < 64; ++i) ss += v[i] * v[i];
          const float rn = rsqrtf(ss * (1.f / 64.f) + 1e-6f);
          u32 o[8];
#pragma unroll
          for (int i = 0; i < 8; ++i) o[i] = pack2(vo[2 * i] * rn * w[wave * 16 + 2 * i], vo[2 * i + 1] * rn * w[wave * 16 + 2 * i + 1]);
          u32x4* dp = (u32x4*)(P.KCC + ((size_t)g * 1024 + idx) * 64 + wave * 16);
          dp[0] = mk4(o[0], o[1], o[2], o[3]);
          dp[1] = mk4(o[4], o[5], o[6], o[7]);
        } else {
#pragma unroll
          for (int i = 0; i < 16; ++i) P.VCCt[((size_t)g * 64 + wave * 16 + i) * 1024 + idx] = f2bf(vo[i]);
        }
      }
    }
  }
}

constexpr int AK_ST = 144;
constexpr int AV_ST = 136;
constexpr int AT_VOFF = 64 * AK_ST;
constexpr int AT_COFF = AT_VOFF + 64 * AV_ST;
constexpr int AT_STAGE = AT_COFF + 256;
constexpr int AT_MISC = 2 * AT_STAGE;

struct TileRegs { u32x4 k[2]; u32x4 v[2]; };

DI void tile_load(int t, TileRegs& r, const u16* __restrict__ K, const u16* __restrict__ Vt, size_t ldv, int key0, bool with_v) {
#pragma unroll
  for (int i = 0; i < 2; ++i) {
    const int c = t + 256 * i, row = c >> 3, part = c & 7;
    r.k[i] = *(const u32x4*)(K + (size_t)(key0 + row) * 64 + part * 8);
    if (with_v) r.v[i] = *(const u32x4*)(Vt + (size_t)row * ldv + key0 + part * 8);
  }
}
DI void tile_store(int t, const TileRegs& r, char* st, bool with_v) {
#pragma unroll
  for (int i = 0; i < 2; ++i) {
    const int c = t + 256 * i, row = c >> 3, part = c & 7;
    *(u32x4*)(st + row * AK_ST + part * 16) = r.k[i];
    if (with_v) {
      u32x2* d = (u32x2*)(st + AT_VOFF + row * AV_ST + part * 16);
      d[0] = mk2(r.v[i].x, r.v[i].y);
      d[1] = mk2(r.v[i].z, r.v[i].w);
    }
  }
}
DI bf16x8 pack_p(const f32x16& p, int sp) {
  u32x4 u = mk4(pack2(p[8 * sp], p[8 * sp + 1]), pack2(p[8 * sp + 2], p[8 * sp + 3]), pack2(p[8 * sp + 4], p[8 * sp + 5]), pack2(p[8 * sp + 6], p[8 * sp + 7]));
  return __builtin_bit_cast(bf16x8, u);
}
template <int NKS, bool ZINIT>
DI void qk_half(int tid, const char* st, int dofs_bytes, int kt, const bf16x8 (&qf)[NKS], f32x16& s) {
  const int lane = tid & 63;
  const char* base = st + (kt * 32 + (lane & 31)) * AK_ST + (lane >> 5) * 16 + dofs_bytes;
#pragma unroll
  for (int ks = 0; ks < NKS; ++ks) {
    const bf16x8 a = *(const bf16x8*)(base + ks * 32);
    if (ZINIT && ks == 0) { const f32x16 z = {0.f, 0.f, 0.f, 0.f, 0.f, 0.f, 0.f, 0.f, 0.f, 0.f, 0.f, 0.f, 0.f, 0.f, 0.f, 0.f}; s = MFMA32(a, qf[ks], z); }
    else s = MFMA32(a, qf[ks], s);
  }
}
DI void pv_half(int tid, const char* st, int kt, const f32x16& p, f32x16 (&o)[2]) {
  const int lane = tid & 63;
  const char* vb = st + AT_VOFF + (lane & 31) * AV_ST + (lane >> 5) * 8 + kt * 64;
#pragma unroll
  for (int sp = 0; sp < 2; ++sp) {
    const bf16x8 pb = pack_p(p, sp);
#pragma unroll
    for (int dt = 0; dt < 2; ++dt) {
      const char* a = vb + dt * 32 * AV_ST + sp * 32;
      const u32x2 lo = *(const u32x2*)a, hi = *(const u32x2*)(a + 16);
      const u32x4 u = mk4(lo.x, lo.y, hi.x, hi.y);
      o[dt] = MFMA32(__builtin_bit_cast(bf16x8, u), pb, o[dt]);
    }
  }
}
DI void load_q4(int tid, bf16x8 (&qf)[4], const u16* __restrict__ Q, int tok) {
  const int lane = tid & 63;
  const u16* b = Q + (size_t)tok * 64 + (lane >> 5) * 8;
#pragma unroll
  for (int ks = 0; ks < 4; ++ks) qf[ks] = *(const bf16x8*)(b + ks * 16);
}
DI float max_abs64(int tid, const float* w) {
  return wave_max(fabsf(w[tid & 63]));
}

struct AttnArgs {
  const u16* K; const u16* Vt; size_t ldv;
  int t0, t1;
  int q;
  int wq0;
  float M2;
  int dofs;
  int lim_hi, lim_lo, whi, wlo;
  int mask_hi, mask_lo;
  float cq; const float* cloc; const float* base;
};

template <int MODE, int NKS, bool MASK>
DI void attn_tile(int tid, const AttnArgs& a, const char* cur, int key0, int lim_hi, int lim_lo, const bf16x8 (&qf)[NKS], f32x16 (&o)[2], float& l) {
  const int h = (tid & 63) >> 5;
#pragma unroll
  for (int kt = 0; kt < 2; ++kt) {
    f32x16 s;
    if (MODE == 0) {
      const float* ckb = (const float*)(cur + AT_COFF);
#pragma unroll
      for (int rg = 0; rg < 4; ++rg) {
        const f32x4 c4 = *(const f32x4*)(ckb + 32 * kt + 8 * rg + 4 * h);
#pragma unroll
        for (int i = 0; i < 4; ++i) s[4 * rg + i] = a.cq - c4[i];
      }
      qk_half<NKS, false>(tid, cur, a.dofs, kt, qf, s);
    } else {
      qk_half<NKS, true>(tid, cur, a.dofs, kt, qf, s);
    }
#pragma unroll
    for (int i = 0; i < 16; ++i) {
      float p = __builtin_amdgcn_exp2f(s[i]);
      if (MASK) { const int key = key0 + 32 * kt + crow(i, h); if (key > lim_hi || key < lim_lo) p = 0.f; }
      s[i] = p; l += p;
    }
    pv_half(tid, cur, kt, s, o);
  }
}
template <int MODE, int NKS, bool PF2 = false>
DI void attn_loop(int tid, const AttnArgs& a, const bf16x8 (&qf)[NKS], f32x16 (&o)[2], float& l, char* smem) {
  TileRegs rA, rB; float cbA = 0.f, cbB = 0.f;
  if (a.t0 >= a.t1) return;
  tile_load(tid, rA, a.K, a.Vt, a.ldv, a.t0 * 64, true);
  if (MODE == 0 && tid < 64) cbA = a.cloc[a.t0 * 64 + tid];
  tile_store(tid, rA, smem, true);
  if (MODE == 0 && tid < 64) ((float*)(smem + AT_COFF))[tid] = (a.base[a.t0] + cbA) * LOG2E;
  __syncthreads();
  auto step = [&](int t, TileRegs& rs, float& cbs, TileRegs& rl, float& cbl, int dist) {
    char* cur = smem + ((t - a.t0) & 1) * AT_STAGE;
    char* nxt = smem + ((t - a.t0 + 1) & 1) * AT_STAGE;
    if (t + dist < a.t1) {
      tile_load(tid, rl, a.K, a.Vt, a.ldv, (t + dist) * 64, true);
      if (MODE == 0 && tid < 64) cbl = a.cloc[(t + dist) * 64 + tid];
    }
    const int key0 = t * 64;
    bool active, need_mask;
    if (MODE == 0 || MODE == 3) { active = key0 <= a.wq0 + 31; need_mask = key0 + 63 > a.wq0; }
    else if (MODE == 1) { const int nmax_w = (a.wq0 + 31 - 31) >> 4; active = (a.wq0 + 31 >= 31) && key0 <= nmax_w; need_mask = true; }
    else if (MODE == 2) { active = (key0 <= a.wq0 + 31) && (key0 + 63 >= a.wq0 - 511); need_mask = (key0 + 63 > a.wq0) || (key0 < a.wq0 + 31 - 511); }
    else { active = (key0 <= a.whi) && (key0 + 63 >= a.wlo); need_mask = (key0 + 63 > a.mask_hi) || (key0 < a.mask_lo); }
    if (active) {
      int lim_hi, lim_lo;
      if (MODE == 0 || MODE == 3) { lim_hi = a.q; lim_lo = 0; }
      else if (MODE == 1) { lim_hi = (a.q >= 31) ? ((a.q - 31) >> 4) : -1; lim_lo = 0; }
      else if (MODE == 2) { lim_hi = a.q; lim_lo = a.q - 511; }
      else { lim_hi = a.lim_hi; lim_lo = a.lim_lo; }
      if (__builtin_amdgcn_readfirstlane((int)need_mask)) attn_tile<MODE, NKS, true>(tid, a, cur, key0, lim_hi, lim_lo, qf, o, l);
      else attn_tile<MODE, NKS, false>(tid, a, cur, key0, lim_hi, lim_lo, qf, o, l);
    }
    if (t + 1 < a.t1) {
      tile_store(tid, rs, nxt, true);
      if (MODE == 0 && tid < 64) ((float*)(nxt + AT_COFF))[tid] = (a.base[t + 1] + cbs) * LOG2E;
    }
    __syncthreads();
  };
  if (!PF2) {
    for (int t = a.t0; t < a.t1; ++t) step(t, rA, cbA, rA, cbA, 1);
  } else {
    if (a.t0 + 1 < a.t1) { tile_load(tid, rA, a.K, a.Vt, a.ldv, (a.t0 + 1) * 64, true); if (MODE == 0 && tid < 64) cbA = a.cloc[(a.t0 + 1) * 64 + tid]; }
    for (int t = a.t0; t < a.t1; t += 2) {
      step(t, rA, cbA, rB, cbB, 2);
      if (t + 1 >= a.t1) break;
      step(t + 1, rB, cbB, rA, cbA, 2);
    }
  }
}

DI void zero_o(f32x16 (&o)[2]) {
#pragma unroll
  for (int d = 0; d < 2; ++d)
#pragma unroll
    for (int i = 0; i < 16; ++i) o[d][i] = 0.f;
}

DI void fox_chunk_bases(int tid, const Params& P, int hd, float* base, float* wtot) {
  const int lane = tid & 63, wave = tid >> 6;
  const float x = P.ctot[tid * 4 + hd];
  float inc = x;
#pragma unroll
  for (int o = 1; o < 64; o <<= 1) { float t = __shfl_up(inc, o); if (lane >= o) inc += t; }
  if (lane == 63) wtot[wave] = inc;
  __syncthreads();
  float off = 0.f;
  for (int w = 0; w < wave; ++w) off += wtot[w];
  base[tid] = inc - x + off;
  __syncthreads();
}

__device__ __forceinline__ void fox_item(const Params& P, int l, int hd, int qb, char* smem) {
  const int tid = opaque_tid(), lane = tid & 63, wave = tid >> 6, h = lane >> 5;
  float* base = (float*)(smem + AT_MISC);
  float* wtot = base + 256;
  fox_chunk_bases(tid, P, hd, base, wtot);
  const float M2 = 8.f * max_abs64(tid, P.fox_q_norm_w + l * 64) * max_abs64(tid, P.fox_k_norm_w + l * 64) * LOG2E * 1.01f + 0.1f;
  const int wq0 = qb * 128 + wave * 32, q = wq0 + (lane & 31);
  AttnArgs a;
  a.K = P.KF + (size_t)hd * S * 64; a.Vt = P.VFt + (size_t)hd * 64 * S; a.ldv = S;
  a.t1 = 2 * qb + 2; a.q = q; a.wq0 = wq0; a.M2 = M2;
  a.cloc = P.cloc + (size_t)hd * S; a.base = base;
  {
    const bool skip = (tid + 1 < 2 * qb) && ((base[2 * qb] - base[tid + 1]) * LOG2E < -160.f);
    a.t0 = __syncthreads_count(skip ? 1 : 0);
  }
  a.cq = (base[q >> 6] + a.cloc[q]) * LOG2E - M2;
  bf16x8 qf[4];
  load_q4(tid, qf, P.QF + (size_t)hd * S * 64, q);
  f32x16 o[2]; zero_o(o);
  float ls = 0.f;
  a.dofs = 0;
  attn_loop<0, 4, true>(tid, a, qf, o, ls, smem);
  ls += __shfl_xor(ls, 32);
  const float inv = (ABLATE & 1) ? 0.f : 1.f / ls;
  u16* dst = P.mix + (size_t)q * 1024 + hd * 64 + 4 * h;
#pragma unroll
  for (int dt = 0; dt < 2; ++dt)
#pragma unroll
    for (int rg = 0; rg < 4; ++rg)
      *(u32x2*)(dst + 32 * dt + 8 * rg) = mk2(pack2(o[dt][4 * rg] * inv, o[dt][4 * rg + 1] * inv), pack2(o[dt][4 * rg + 2] * inv, o[dt][4 * rg + 3] * inv));
}

__device__ __forceinline__ void diff_item(const Params& P, int l, int hd, int qb, char* smem) {
  const int tid = opaque_tid(), lane = tid & 63, wave = tid >> 6, h = lane >> 5;
  const float mq = wave_max(fabsf(P.diff_q_norm_w[l * 32 + (lane & 31)])), mk = wave_max(fabsf(P.diff_k_norm_w[l * 32 + (lane & 31)]));
  const float M2 = 5.656854249f * mq * mk * LOG2E * 1.01f + 0.1f;
  const float* lv = P.diff_lambda + l * 128;
  float d1 = (lane < 32) ? lv[lane] * lv[32 + lane] : 0.f, d2 = (lane < 32) ? lv[64 + lane] * lv[96 + lane] : 0.f;
  d1 = wave_sum(d1); d2 = wave_sum(d2);
  const float lam_init = 0.8f - 0.6f * expf(-0.3f * (float)l);
  const float lam = expf(d1) - expf(d2) + lam_init;
  const int wq0 = qb * 128 + wave * 32, q = wq0 + (lane & 31);
  AttnArgs a;
  a.K = P.KD + (size_t)hd * S * 64; a.Vt = P.VDt + (size_t)hd * 64 * S; a.ldv = S;
  a.t0 = 0; a.t1 = 2 * qb + 2; a.q = q; a.wq0 = wq0; a.M2 = M2; a.cq = 0.f; a.cloc = nullptr; a.base = nullptr;
  float* stash = P.dstash + (size_t)blockIdx.x * (128 * 64) + tid;
  f32x16 o[2];
#pragma unroll 1
  for (int c = 0; c < 2; ++c) {
    const int tid = opaque_tid(), lane = tid & 63, h = lane >> 5;
    bf16x8 qf[2];
    {
      const u16* b = P.QD + ((size_t)hd * S + q) * 64 + c * 32 + h * 8;
      qf[0] = *(const bf16x8*)b; qf[1] = *(const bf16x8*)(b + 16);
    }
    zero_o(o);
    float ls = 0.f;
    a.dofs = c * 64;
    attn_loop<3, 2>(tid, a, qf, o, ls, smem);
    ls += __shfl_xor(ls, 32);
    if (c == 0) {
      const float i0 = 1.f / ls;
#pragma unroll
      for (int dt = 0; dt < 2; ++dt)
#pragma unroll
        for (int i = 0; i < 16; ++i) stash[(dt * 16 + i) * 256] = o[dt][i] * i0;
    } else {
      const float i1 = lam / ls;
      float ss = 0.f;
#pragma unroll
      for (int dt = 0; dt < 2; ++dt)
#pragma unroll
        for (int i = 0; i < 16; ++i) { const float v = stash[(dt * 16 + i) * 256] - o[dt][i] * i1; o[dt][i] = v; ss += v * v; }
      ss += __shfl_xor(ss, 32);
      const float rn = rsqrtf(ss * (1.f / 64.f) + 1e-6f) * (1.f - lam_init);
      const float* sw = P.diff_subln_w + l * 64;
      u16* dst = P.mix + (size_t)q * 1024 + 768 + hd * 64 + 4 * h;
#pragma unroll
      for (int dt = 0; dt < 2; ++dt)
#pragma unroll
        for (int rg = 0; rg < 4; ++rg) {
          const int d0 = 32 * dt + 8 * rg + 4 * h;
          *(u32x2*)(dst + 32 * dt + 8 * rg) = mk2(pack2(o[dt][4 * rg] * rn * sw[d0], o[dt][4 * rg + 1] * rn * sw[d0 + 1]),
                                                 pack2(o[dt][4 * rg + 2] * rn * sw[d0 + 2], o[dt][4 * rg + 3] * rn * sw[d0 + 3]));
        }
    }
  }
}

struct SelFrags { u32x2 k[8]; u32x2 v[8]; };

DI void sel_load(int tid, SelFrags& f, const unsigned char* __restrict__ Kg, const unsigned char* __restrict__ Vtg, int b) {
  const int lane = tid & 63, i = lane & 15, h4 = lane >> 4;
  const int bu = __builtin_amdgcn_readfirstlane(b);
  const unsigned char* kb = Kg + (size_t)bu * 4096 + lane * 8;
  const unsigned char* vb = Vtg + (size_t)bu * 4096 + lane * 8;
  (void)i; (void)h4;
#pragma unroll
  for (int L = 0; L < 8; ++L) f.k[L] = *(const u32x2*)(kb + L * 512);
#pragma unroll
  for (int L = 0; L < 8; ++L) f.v[L] = *(const u32x2*)(vb + L * 512);
}
template <bool MASK>
DI void sel_compute_t(int tid, const SelFrags& f, const u32x2 (&qb)[2], int b, int qpos, float M2, f32x4 (&o)[4], f32x4& ol) {
  const int lane = tid & 63, h4 = lane >> 4;
  const float c0 = 8.f - M2;
  const u32x2 ones = mk2(0x38383838u, 0x38383838u);
#pragma unroll
  for (int G = 0; G < 2; ++G) {
    f32x4 s[2];
#pragma unroll
    for (int t = 0; t < 2; ++t) {
      s[t] = (f32x4){0.f, 0.f, 0.f, 0.f};
#pragma unroll
      for (int ks = 0; ks < 2; ++ks)
        s[t] = __builtin_amdgcn_mfma_f32_16x16x32_fp8_fp8(__builtin_bit_cast(long, f.k[G * 4 + t * 2 + ks]), __builtin_bit_cast(long, qb[ks]), s[t], 0, 0, 0);
    }
#pragma unroll
    for (int t = 0; t < 2; ++t)
#pragma unroll
      for (int r = 0; r < 4; ++r) {
        float p = __builtin_amdgcn_exp2f(s[t][r] * 0.0625f + c0);
        if (MASK) { const int key = b * 64 + 32 * G + 8 * h4 + 4 * t + r; if (key > qpos) p = 0.f; }
        s[t][r] = p;
      }
    int w0 = 0, w1 = 0;
    w0 = __builtin_amdgcn_cvt_pk_bf8_f32(s[0][0], s[0][1], w0, false);
    w0 = __builtin_amdgcn_cvt_pk_bf8_f32(s[0][2], s[0][3], w0, true);
    w1 = __builtin_amdgcn_cvt_pk_bf8_f32(s[1][0], s[1][1], w1, false);
    w1 = __builtin_amdgcn_cvt_pk_bf8_f32(s[1][2], s[1][3], w1, true);
    const u32x2 pb = mk2((u32)w0, (u32)w1);
#pragma unroll
    for (int dt = 0; dt < 4; ++dt)
      o[dt] = __builtin_amdgcn_mfma_f32_16x16x32_fp8_bf8(__builtin_bit_cast(long, f.v[G * 4 + dt]), __builtin_bit_cast(long, pb), o[dt], 0, 0, 0);
    ol = __builtin_amdgcn_mfma_f32_16x16x32_fp8_bf8(__builtin_bit_cast(long, ones), __builtin_bit_cast(long, pb), ol, 0, 0, 0);
  }
}
DI void sel_compute(int tid, const SelFrags& f, const u32x2 (&qb)[2], int b, int cur, int qpos, float M2, f32x4 (&o)[4], f32x4& ol) {
  if (__builtin_amdgcn_readfirstlane(b) == __builtin_amdgcn_readfirstlane(cur)) sel_compute_t<true>(tid, f, qb, b, qpos, M2, o, ol);
  else sel_compute_t<false>(tid, f, qb, b, qpos, M2, o, ol);
}

__device__ __forceinline__ void nsa_item(const Params& P, int l, int g, int qb, char* smem, int secmask = 7) {
  const int tid = opaque_tid(), lane = tid & 63, wave = tid >> 6, h = lane >> 5;
  const int q0 = qb * 128, wq0 = q0 + wave * 32, q = wq0 + (lane & 31), ql = wave * 32 + (lane & 31);
  const int item = g * 128 + qb;
  const float M2 = 8.f * max_abs64(tid, P.nsa_q_norm_w + l * 64) * max_abs64(tid, P.nsa_k_norm_w + l * 64) * LOG2E * 1.01f + 0.1f;
  unsigned char* sel = (unsigned char*)(smem + AT_MISC);
  unsigned char* nsel = sel + 2048;
  float* impA = P.impA + (size_t)item * 256 * 128;
  float* impB = P.impB + (size_t)item * 256 * 128;
  const u16* Kc = P.KCC + (size_t)g * 1024 * 64;
  const int ntc = ((q0 + 96) >> 10) + 1;
  const int nmaxq = (q >= 31) ? ((q - 31) >> 4) : -1;
  const int nmax_w = wq0 >> 4;

  {
    float lh[4] = {0.f, 0.f, 0.f, 0.f};
#pragma unroll 1
    for (int pass = 0; pass < 2; ++pass) {
      float inv[4];
      if (pass == 1) {
#pragma unroll
        for (int hh = 0; hh < 4; ++hh) { float t = lh[hh] + __shfl_xor(lh[hh], 32); inv[hh] = (t > 0.f) ? 1.f / t : 0.f; }
      }
      TileRegs r;
      tile_load(tid, r, Kc, nullptr, 0, 0, false);
      tile_store(tid, r, smem, false);
      __syncthreads();
      for (int t = 0; t < ntc; ++t) {
        char* cur = smem + (t & 1) * AT_STAGE;
        char* nxt = smem + ((t + 1) & 1) * AT_STAGE;
        const bool more = (t + 1 < ntc);
        if (more) tile_load(tid, r, Kc, nullptr, 0, (t + 1) * 64, false);
        const int key0 = t * 64;
        f32x16 ps[2];
#pragma unroll
        for (int kt = 0; kt < 2; ++kt)
#pragma unroll
          for (int i = 0; i < 16; ++i) ps[kt][i] = 0.f;
        if (key0 <= nmax_w) {
#pragma unroll
          for (int hh = 0; hh < 4; ++hh) {
            f32x16 s[2];
            bf16x8 qf[4];
            load_q4(tid, qf, P.QN + (size_t)(g * 4 + hh) * S * 64, q);
            qk_half<4, true>(tid, cur, 0, 0, qf, s[0]);
            qk_half<4, true>(tid, cur, 0, 1, qf, s[1]);
#pragma unroll
            for (int kt = 0; kt < 2; ++kt)
#pragma unroll
              for (int i = 0; i < 16; ++i) {
                float p = __builtin_amdgcn_exp2f(s[kt][i]);
                const int key = key0 + 32 * kt + crow(i, h);
                if (key > nmaxq) p = 0.f;
                if (pass == 0) lh[hh] += p; else ps[kt][i] += p * inv[hh];
              }
          }
        }
        if (pass == 1) {
#pragma unroll
          for (int kt = 0; kt < 2; ++kt)
#pragma unroll
            for (int rg = 0; rg < 4; ++rg) {
              const int j = 16 * t + 8 * kt + 2 * rg + h;
              impA[(size_t)j * 128 + ql] = ps[kt][4 * rg] + ps[kt][4 * rg + 1] + ps[kt][4 * rg + 2] + ps[kt][4 * rg + 3];
              impB[(size_t)j * 128 + ql] = ps[kt][4 * rg + 3];
            }
        }
        if (more) tile_store(tid, r, nxt, false);
        __syncthreads();
      }
    }
  }
  __threadfence_block();
  __syncthreads();
  {
    const int qt = tid >> 1, half = tid & 1;
    const int qp = q0 + qt, cur = qp >> 6;
    u32 lst[13];
#pragma unroll
    for (int i = 0; i < 13; ++i) lst[i] = 0u;
    for (int j0 = 1 + half; j0 <= cur - 2; j0 += 8) {
      float sc[4];
#pragma unroll
      for (int u = 0; u < 4; ++u) {
        const int j = j0 + 2 * u, jc = j <= cur - 2 ? j : 1;
        sc[u] = impA[(size_t)jc * 128 + qt] + impB[(size_t)(jc - 1) * 128 + qt];
      }
#pragma unroll
      for (int u = 0; u < 4; ++u) {
        const int j = j0 + 2 * u;
        u32 x = (j <= cur - 2) ? ((__float_as_uint(sc[u]) & 0xffffff00u) | (u32)j) : 0u;
#pragma unroll
        for (int i = 0; i < 13; ++i) { const u32 hi = max(lst[i], x); x = min(lst[i], x); lst[i] = hi; }
      }
    }
    u32 oth[13];
#pragma unroll
    for (int i = 0; i < 13; ++i) oth[i] = (u32)__shfl_xor((int)lst[i], 1);
#pragma unroll
    for (int k = 0; k < 13; ++k) {
      u32 x = oth[k];
#pragma unroll
      for (int i = 0; i < 13; ++i) { const u32 hi = max(lst[i], x); x = min(lst[i], x); lst[i] = hi; }
    }
    if (half == 0) {
      unsigned char* sp = sel + qt * 16;
      int n = 0;
      sp[n++] = 0;
      if (cur >= 1) sp[n++] = (unsigned char)cur;
      if (cur >= 2) sp[n++] = (unsigned char)(cur - 1);
      const int ncand = cur - 2 < 13 ? cur - 2 : 13;
#pragma unroll
      for (int i = 0; i < 13; ++i) if (i < ncand) sp[n++] = (unsigned char)(lst[i] & 0xffu);
      nsel[qt] = (unsigned char)n;
    }
  }
  __syncthreads();
  if (secmask & 2) {
    const unsigned char* Kg = P.KS8 + (size_t)g * S * 64; const unsigned char* Vtg = P.VS8t + (size_t)g * 64 * S;
    const int col = lane & 15, h4 = lane >> 4, hd = col & 3;
    const unsigned char* selw = sel + wave * 32 * 16;
    const unsigned char* nselw = nsel + wave * 32;
    u32x2* q8 = (u32x2*)(smem + wave * 8448);
    float* gl = (float*)(smem + 41472 + wave * 1600);
    u16* vis = (u16*)(smem + 41472 + wave * 1600 + 512);
    {
#pragma unroll 4
      for (int c = lane; c < 1024; c += 64) {
        const int qi = c >> 5, head = (c >> 3) & 3, ch = c & 7;
        const u32x4 qv = *(const u32x4*)(P.QR + ((size_t)(g * 4 + head) * S + wq0 + qi) * 64 + ch * 8);
        int w0 = 0, w1 = 0;
        w0 = __builtin_amdgcn_cvt_pk_fp8_f32(bflo(qv.x) * 16.f, bfhi(qv.x) * 16.f, w0, false);
        w0 = __builtin_amdgcn_cvt_pk_fp8_f32(bflo(qv.y) * 16.f, bfhi(qv.y) * 16.f, w0, true);
        w1 = __builtin_amdgcn_cvt_pk_fp8_f32(bflo(qv.z) * 16.f, bfhi(qv.z) * 16.f, w1, false);
        w1 = __builtin_amdgcn_cvt_pk_fp8_f32(bflo(qv.w) * 16.f, bfhi(qv.w) * 16.f, w1, true);
        q8[(qi * 8 + ch) * 4 + head] = mk2((u32)w0, (u32)w1);
      }
      if (lane < 32) q8[(32 * 8 + (lane >> 2)) * 4 + (lane & 3)] = mk2(0u, 0u);
      for (int c = lane; c < 128; c += 64) gl[c] = P.gates[(size_t)(wq0 + (c >> 2)) * 24 + (g * 4 + (c & 3)) * 3 + 1];
      int cnt = (lane < 32) ? (int)nselw[lane] : 0, pre = cnt;
#pragma unroll
      for (int o = 1; o < 32; o <<= 1) { const int t2 = __shfl_up(pre, o); if ((lane & 31) >= o) pre += t2; }
      const int V = __builtin_amdgcn_readlane(pre, 31);
      pre -= cnt;
      if (lane < 32) for (int i = 0; i < cnt; ++i) vis[pre + i] = (u16)(selw[lane * 16 + i] | (lane << 8) | (i + 1 == cnt ? 0x8000 : 0));
      if (lane < 5) vis[V + lane] = (u16)(32 << 8);
      __builtin_amdgcn_s_waitcnt(0xc07f);
      __builtin_amdgcn_wave_barrier();
      const int V3 = ((V + 2) / 3) * 3;
      SelFrags fr[3];
      sel_load(tid, fr[0], Kg, Vtg, vis[0] & 0xff);
      sel_load(tid, fr[1], Kg, Vtg, vis[1] & 0xff);
      f32x4 o[4];
#pragma unroll
      for (int dt = 0; dt < 4; ++dt) o[dt] = (f32x4){0.f, 0.f, 0.f, 0.f};
      f32x4 ol = (f32x4){0.f, 0.f, 0.f, 0.f};
#pragma unroll 1
      for (int v = 0; v < V3; v += 3) {
#pragma unroll
        for (int slot = 0; slot < 3; ++slot) {
          const int e = __builtin_amdgcn_readfirstlane((int)vis[v + slot]);
          const int e2 = __builtin_amdgcn_readfirstlane((int)vis[v + slot + 2]);
          sel_load(tid, fr[(slot + 2) % 3], Kg, Vtg, e2 & 0xff);
          const int qi = (e >> 8) & 63, bb = e & 0xff, qp = wq0 + qi;
          u32x2 qcur[2];
          qcur[0] = q8[(qi * 8 + h4) * 4 + hd]; qcur[1] = q8[(qi * 8 + 4 + h4) * 4 + hd];
          sel_compute(tid, fr[slot], qcur, bb, qp >> 6, qp, M2, o, ol);
          if (e & 0x8000) {
            const float lsum = ol[0];
            if (col < 4 && (!(secmask & 8) || lsum == 1.2345e33f)) {
              const float gs = (ABLATE & 4) ? 0.f : gl[qi * 4 + col] / lsum;
              u16* dst = P.mix + (size_t)qp * 1024 + 256 + (g * 4 + col) * 64 + 4 * h4;
#pragma unroll
              for (int dt = 0; dt < 4; ++dt)
                *(u32x2*)(dst + 16 * dt) = mk2(pack2(o[dt][0] * gs, o[dt][1] * gs), pack2(o[dt][2] * gs, o[dt][3] * gs));
            }
#pragma unroll
            for (int dt = 0; dt < 4; ++dt) o[dt] = (f32x4){0.f, 0.f, 0.f, 0.f};
            ol = (f32x4){0.f, 0.f, 0.f, 0.f};
          }
        }
      }
    }
  }
  __threadfence_block();
  __syncthreads();
#pragma unroll 1
  for (int hh = 0; hh < ((secmask & 4) ? 4 : 0); ++hh) {
    const int H = g * 4 + hh;
#pragma unroll 1
    for (int br = 0; br < 2; ++br) {
      AttnArgs a;
      a.q = q; a.wq0 = wq0; a.M2 = M2; a.cq = 0.f; a.cloc = nullptr; a.base = nullptr; a.dofs = 0;
      bf16x8 qf[4];
      f32x16 o[2]; zero_o(o);
      float ls = 0.f;
      if (br == 0) {
        load_q4(tid, qf, P.QN + (size_t)H * S * 64, q);
        a.K = Kc; a.Vt = P.VCCt + (size_t)g * 64 * 1024; a.ldv = 1024; a.t0 = 0; a.t1 = ntc;
        a.lim_hi = nmaxq; a.lim_lo = 0; a.whi = nmax_w; a.wlo = 0; a.mask_hi = (wq0 >= 31) ? ((wq0 - 31) >> 4) : -1; a.mask_lo = 0;
      } else {
        load_q4(tid, qf, P.QR + (size_t)H * S * 64, q);
        a.K = P.KW + (size_t)g * S * 64; a.Vt = P.VWt + (size_t)g * 64 * S; a.ldv = S;
        a.t0 = (q0 >> 6) - 8 < 0 ? 0 : (q0 >> 6) - 8; a.t1 = (q0 >> 6) + 2;
        a.lim_hi = q; a.lim_lo = q - 511; a.whi = wq0 + 31; a.wlo = wq0 - 511; a.mask_hi = wq0; a.mask_lo = wq0 + 31 - 511;
      }
      attn_loop<4, 4, true>(tid, a, qf, o, ls, smem);
      ls += __shfl_xor(ls, 32);
      float gt = (ls > 0.f) ? P.gates[(size_t)q * 24 + H * 3 + (br == 0 ? 0 : 2)] / ls : 0.f;
      if ((ABLATE & 2) && br == 0) gt = 0.f;
      if ((ABLATE & 8) && br == 1) gt = 0.f;
      u16* dst = P.mix + (size_t)q * 1024 + 256 + H * 64 + 4 * h;
      if (!(secmask & 8) || ls == 1.2345e33f)
#pragma unroll
      for (int dt = 0; dt < 2; ++dt)
#pragma unroll
        for (int rg = 0; rg < 4; ++rg) {
          u32x2* pp = (u32x2*)(dst + 32 * dt + 8 * rg);
          const u32x2 old = *pp;
          const float r0 = bflo(old.x) + gt * o[dt][4 * rg];
          const float r1 = bfhi(old.x) + gt * o[dt][4 * rg + 1];
          const float r2 = bflo(old.y) + gt * o[dt][4 * rg + 2];
          const float r3 = bfhi(old.y) + gt * o[dt][4 * rg + 3];
          *pp = mk2(pack2(r0, r1), pack2(r2, r3));
        }
    }
  }
}

DI unsigned xcc_id() { return (unsigned)__builtin_amdgcn_s_getreg((3 << 11) | 20) & 0xFu; }

__device__ __forceinline__ void phase_attention(const Params& P, int l, char* smem, unsigned* counter, int secmask = 7, bool nsa_only = false) {
  int* slot = (int*)(smem + AT_MISC + 4096);
  const int mygrp = (int)(xcc_id() & 1u);
#pragma unroll 1
  for (int pass = 0; pass < 2; ++pass) {
    const int g = pass == 0 ? mygrp : 1 - mygrp;
    for (;;) {
      __syncthreads();
      if (threadIdx.x == 0) *slot = (int)atomicAdd(counter + g, 1u);
      __syncthreads();
      const int it = *slot;
      if (it >= 128) break;
      nsa_item(P, l, g, 127 - it, smem, secmask);
    }
  }
  for (;;) {
    __syncthreads();
    if (threadIdx.x == 0) *slot = (int)atomicAdd(counter + 2, 1u);
    __syncthreads();
    const int it = *slot;
    if (it >= 1024 || nsa_only) break;
    const int qb = 127 - (it >> 3), k = it & 7;
    if (k < 4) diff_item(P, l, k, qb, smem); else fox_item(P, l, k - 4, qb, smem);
  }
}

__device__ __forceinline__ void phase_outproj(const Params& P, int l, char* smem, bool dry = false) {
  const u16* Wt = P.WoutT + (size_t)l * D * D;
  float* tile = (float*)smem;
  const int tid = threadIdx.x;
  for (int it = blockIdx.x; it < 128 * 8; it += gridDim.x) {
    const int mt = it >> 3, nt = it & 7;
    f32x16 acc[2][2];
    zero_acc(acc);
    gemm_mainloop<false>(P.mix + (size_t)mt * 128 * D, D, Wt + (size_t)nt * 128 * D, D, D, smem, acc);
    acc_to_lds(acc, tile);
    __syncthreads();
    const int c4 = (tid & 31) * 4, r0 = tid >> 5;
#pragma unroll 4
    for (int i = 0; i < 16; ++i) {
      const int row = r0 + 8 * i;
      const size_t idx = (size_t)(mt * 128 + row) * D + nt * 128 + c4;
      const f32x4 a4 = *(const f32x4*)(tile + row * EPS_LD + c4);
      f32x4 h4 = *(const f32x4*)(P.out + idx);
      h4 += a4;
      if (!dry || h4[0] == 1.2345e33f) {
        *(f32x4*)(P.out + idx) = h4;
        *(u32x2*)(P.hb2 + idx) = mk2(pack2(h4[0], h4[1]), pack2(h4[2], h4[3]));
      }
    }
  }
}

constexpr int QT_ST = 272;
DI u32 ord_key(float x, u32 idx) {
  u32 u = __float_as_uint(x);
  u = (u & 0x80000000u) ? ~u : (u | 0x80000000u);
  return (u & 0xffffff80u) | idx;
}
DI float ord_val(u32 k) {
  return (k & 0x80000000u) ? __uint_as_float(k & 0x7fffff80u) : __uint_as_float((~k) & 0xffffff80u);
}
DI void merge16(u32 (&lst)[16], int xm) {
  u32 c[16];
#pragma unroll
  for (int i = 0; i < 16; ++i) { const u32 o = (u32)__shfl_xor((int)lst[15 - i], xm); c[i] = max(lst[i], o); }
#pragma unroll
  for (int st = 8; st > 0; st >>= 1)
#pragma unroll
    for (int i = 0; i < 16; ++i)
      if ((i & st) == 0) { const u32 a = max(c[i], c[i + st]), b = min(c[i], c[i + st]); c[i] = a; c[i + st] = b; }
#pragma unroll
  for (int i = 0; i < 16; ++i) lst[i] = c[i];
}

__device__ __forceinline__ void phase_peerq(const Params& P, int l, char* smem) {
  const u16* Wt = P.WqT + (size_t)l * 2048 * D;
  const int tid = threadIdx.x, lane = tid & 63, wave = tid >> 6, wr = wave >> 1, wc = wave & 1, h = lane >> 5;
  const float* rs = (const float*)(smem + G_RS_OFF);
  float* tile = (float*)smem;
  for (int it = blockIdx.x; it < 128 * 16; it += gridDim.x) {
    const int mt = it >> 4, nt = it & 15;
    f32x16 acc[2][2];
    zero_acc(acc);
    gemm_mainloop<true>(P.hb2 + (size_t)mt * 128 * D, D, Wt + (size_t)nt * 128 * D, D, D, smem, acc);
    __syncthreads();
#pragma unroll
    for (int i = 0; i < 2; ++i)
#pragma unroll
      for (int j = 0; j < 2; ++j)
#pragma unroll
        for (int r = 0; r < 16; ++r) {
          const int row = wr * 64 + i * 32 + crow(r, h);
          *(u16*)(smem + row * QT_ST + (wc * 64 + j * 32 + (lane & 31)) * 2) = f2bf(acc[i][j][r] * rs[row]);
        }
    __syncthreads();
    zero_acc(acc);
    {
      const u16* Bk = P.SubK + ((size_t)(l * 16 + nt) * 128 + wc * 64 + (lane & 31)) * 128 + h * 8;
      const char* Aq = smem + (wr * 64 + (lane & 31)) * QT_ST + h * 16;
#pragma unroll
      for (int ks = 0; ks < 8; ++ks) {
        bf16x8 af[2], bfr[2];
#pragma unroll
        for (int i = 0; i < 2; ++i) af[i] = *(const bf16x8*)(Aq + i * 32 * QT_ST + ks * 32);
#pragma unroll
        for (int j = 0; j < 2; ++j) bfr[j] = *(const bf16x8*)(Bk + (size_t)j * 32 * 128 + ks * 16);
#pragma unroll
        for (int i = 0; i < 2; ++i)
#pragma unroll
          for (int j = 0; j < 2; ++j) acc[i][j] = MFMA32(af[i], bfr[j], acc[i][j]);
      }
    }
    __syncthreads();
    acc_to_lds(acc, tile);
    __syncthreads();
#pragma unroll 1
    for (int half = 0; half < 2; ++half) {
      {
        const int row = half * 64 + (tid >> 2), part = tid & 3;
        u32 lst[16];
#pragma unroll
        for (int i = 0; i < 16; ++i) lst[i] = 0u;
        const f32x4* src = (const f32x4*)(tile + row * EPS_LD + part * 32);
#pragma unroll
        for (int c4 = 0; c4 < 8; ++c4) {
          const f32x4 v = src[c4];
#pragma unroll
          for (int e = 0; e < 4; ++e) {
            u32 x = ord_key(v[e], (u32)(part * 32 + c4 * 4 + e));
#pragma unroll
            for (int i = 0; i < 16; ++i) { const u32 hi = max(lst[i], x); x = min(lst[i], x); lst[i] = hi; }
          }
        }
        merge16(lst, 1);
        merge16(lst, 2);
        if (part == 0) {
          u32x4* dp = (u32x4*)(P.topk + ((size_t)(mt * 128 + row) * 16 + nt) * 16);
          dp[0] = mk4(lst[0], lst[1], lst[2], lst[3]); dp[1] = mk4(lst[4], lst[5], lst[6], lst[7]);
          dp[2] = mk4(lst[8], lst[9], lst[10], lst[11]); dp[3] = mk4(lst[12], lst[13], lst[14], lst[15]);
        }
      }
    }
  }
}

__device__ const unsigned char kCandIJ[50] = {
  0x00,0x01,0x02,0x03,0x04,0x05,0x06,0x07,0x08,0x09,0x0a,0x0b,0x0c,0x0d,0x0e,0x0f,
  0x10,0x11,0x12,0x13,0x14,0x15,0x16,0x17,
  0x20,0x21,0x22,0x23,0x24,
  0x30,0x31,0x32,0x33,
  0x40,0x41,0x42,
  0x50,0x51, 0x60,0x61, 0x70,0x71,
  0x80,0x90,0xa0,0xb0,0xc0,0xd0,0xe0,0xf0};
DI float gelu_exact(float x) { return 0.5f * x * (1.f + erff(x * 0.7071067811865476f)); }

__device__ __forceinline__ void phase_peer(const Params& P, int l, char* smem, bool dry = false) {
  const int tid = threadIdx.x, lane = tid & 63, wave = tid >> 6;
  char* wsm = smem + wave * 8192;
  u32* keys = (u32*)wsm;
  float* cv = (float*)(wsm + 1024);
  int* exps = (int*)(wsm + 1024 + 1664);
  float* esc = (float*)(wsm + 3200);
  float* wts = (float*)(wsm + 3712);
  float* uinv = (float*)(wsm + 4224);
  float* vinv = (float*)(wsm + 4736);
  unsigned char* xrow8 = (unsigned char*)(wsm + 5248);
  const unsigned char* U8 = P.U8 + (size_t)l * S * (D / 2);
  const unsigned char* V8 = P.V8 + (size_t)l * S * (D / 2);
  const float* Uinv = P.Uinv + l * S; const float* Vinv = P.Vinv + l * S;
  for (int it = blockIdx.x; it < S / 4; it += gridDim.x) {
    const int tok = it * 4 + wave;
    *(u32x4*)(keys + lane * 4) = *(const u32x4*)(P.topk + (size_t)tok * 256 + lane * 4);
    const u32x4 xa = *(const u32x4*)(P.hb2 + (size_t)tok * D + lane * 16), xb = *(const u32x4*)(P.hb2 + (size_t)tok * D + lane * 16 + 8);
    float rstd = wave_sum(ssq8(xa) + ssq8(xb));
    rstd = rsqrtf(rstd * (1.f / 1024.f) + 1e-6f);
    float xinv;
    {
      float xv[16] = {bflo(xa.x), bfhi(xa.x), bflo(xa.y), bfhi(xa.y), bflo(xa.z), bfhi(xa.z), bflo(xa.w), bfhi(xa.w),
                      bflo(xb.x), bfhi(xb.x), bflo(xb.y), bfhi(xb.y), bflo(xb.z), bfhi(xb.z), bflo(xb.w), bfhi(xb.w)};
      float m = 0.f;
#pragma unroll
      for (int i = 0; i < 16; ++i) m = fmaxf(m, fabsf(xv[i]));
      m = wave_max(m);
      const float sx = (m > 0.f) ? 240.f / m : 0.f;
      xinv = m * (1.f / 240.f);
      u32 o4[4];
#pragma unroll
      for (int i = 0; i < 4; ++i) {
        int wd = 0;
        wd = __builtin_amdgcn_cvt_pk_fp8_f32(xv[4 * i] * sx, xv[4 * i + 1] * sx, wd, false);
        wd = __builtin_amdgcn_cvt_pk_fp8_f32(xv[4 * i + 2] * sx, xv[4 * i + 3] * sx, wd, true);
        o4[i] = (u32)wd;
      }
      *(u32x4*)(xrow8 + lane * 16) = mk4(o4[0], o4[1], o4[2], o4[3]);
    }
    __builtin_amdgcn_s_waitcnt(0xc07f);
    const int hd = lane >> 3, sub = lane & 7;
    float myv[7]; int mye[7];
#pragma unroll
    for (int m = 0; m < 7; ++m) {
      const int c = sub + 8 * m;
      myv[m] = -3.0e38f; mye[m] = 0;
      if (c < 50) {
        const int ij = kCandIJ[c], i = ij >> 4, j = ij & 15;
        const u32 k1 = keys[(hd * 2) * 16 + i], k2 = keys[(hd * 2 + 1) * 16 + j];
        myv[m] = ord_val(k1) + ord_val(k2);
        mye[m] = (int)((k1 & 127u) * 128u + (k2 & 127u));
        cv[hd * 52 + c] = myv[m];
      }
    }
    __builtin_amdgcn_s_waitcnt(0xc07f);
#pragma unroll
    for (int m = 0; m < 7; ++m) {
      const int c = sub + 8 * m;
      if (c < 50) {
        int rank = 0;
        for (int c2 = 0; c2 < 50; ++c2) { const float o = cv[hd * 52 + c2]; rank += (o > myv[m]) || (o == myv[m] && c2 < c); }
        if (rank < 16) {
          exps[hd * 16 + rank] = mye[m]; esc[hd * 16 + rank] = myv[m];
          uinv[hd * 16 + rank] = Uinv[mye[m]]; vinv[hd * 16 + rank] = Vinv[mye[m]];
        }
      }
    }
    __builtin_amdgcn_s_waitcnt(0xc07f);
    float g0, g1;
    {
      const float mx = esc[hd * 16];
      const float e0 = expf(esc[hd * 16 + 2 * sub] - mx), e1 = expf(esc[hd * 16 + 2 * sub + 1] - mx);
      float sm = e0 + e1;
      sm += __shfl_xor(sm, 1); sm += __shfl_xor(sm, 2); sm += __shfl_xor(sm, 4);
      g0 = e0 / sm; g1 = e1 / sm;
    }
    wts[hd * 16 + 2 * sub] = g0; wts[hd * 16 + 2 * sub + 1] = g1;
    __builtin_amdgcn_s_waitcnt(0xc07f);
    {
      const int i16 = lane & 15, h4 = lane >> 4;
      u32x4 a0[8], a1[8];
      auto uload = [&](u32x4 (&a)[8], int g) {
        const unsigned char* urow = U8 + (size_t)exps[g * 16 + i16] * (D / 2) + 16 * h4;
#pragma unroll
        for (int i = 0; i < 8; ++i) a[i] = *(const u32x4*)(urow + i * 64);
      };
      auto umma = [&](const u32x4 (&a)[8], int g) {
        f32x4 acc = (f32x4){0.f, 0.f, 0.f, 0.f};
#pragma unroll
        for (int i = 0; i < 8; ++i) {
          const u32x4 b0 = *(const u32x4*)(xrow8 + i * 128 + 16 * h4), b1 = *(const u32x4*)(xrow8 + i * 128 + 64 + 16 * h4);
          const i32x8 A = {(int)a[i].x, (int)a[i].y, (int)a[i].z, (int)a[i].w, 0, 0, 0, 0};
          const i32x8 B = {(int)b0.x, (int)b0.y, (int)b0.z, (int)b0.w, (int)b1.x, (int)b1.y, (int)b1.z, (int)b1.w};
          acc = __builtin_amdgcn_mfma_scale_f32_16x16x128_f8f6f4(A, B, acc, 4, 0, 0, 0x7f7f7f7f, 0, 0x7f7f7f7f);
        }
        if (i16 == 0) {
#pragma unroll
          for (int r = 0; r < 4; ++r) {
            const int k = g * 16 + 4 * h4 + r;
            wts[k] = wts[k] * gelu_exact(rstd * acc[r] * uinv[k] * xinv) * vinv[k];
          }
        }
      };
      uload(a0, 0);
#pragma unroll 1
      for (int g = 0; g < 8; g += 2) {
        uload(a1, g + 1);
        umma(a0, g);
        if (g + 2 < 8) uload(a0, g + 2);
        umma(a1, g + 1);
      }
    }
    __builtin_amdgcn_s_waitcnt(0xc07f);
    float o[16];
#pragma unroll
    for (int i = 0; i < 16; ++i) o[i] = 0.f;
    {
      u32x2 va[8], vb2[8];
      auto vload = [&](u32x2 (&x0)[8], int k) {
#pragma unroll
        for (int u = 0; u < 8; ++u) x0[u] = *(const u32x2*)(V8 + (size_t)exps[k + u] * (D / 2) + lane * 8);
      };
      auto vacc = [&](const u32x2 (&x0)[8], int k) {
#pragma unroll
        for (int u = 0; u < 8; ++u) {
          const float w = wts[k + u];
#pragma unroll
          for (int c = 0; c < 2; ++c) {
            const f32x2 d0 = __builtin_amdgcn_cvt_scalef32_pk_f32_fp4(x0[u][c], 1.0f, 0), d1 = __builtin_amdgcn_cvt_scalef32_pk_f32_fp4(x0[u][c], 1.0f, 1);
            const f32x2 d2 = __builtin_amdgcn_cvt_scalef32_pk_f32_fp4(x0[u][c], 1.0f, 2), d3 = __builtin_amdgcn_cvt_scalef32_pk_f32_fp4(x0[u][c], 1.0f, 3);
            o[8 * c] += w * d0[0]; o[8 * c + 1] += w * d0[1]; o[8 * c + 2] += w * d1[0]; o[8 * c + 3] += w * d1[1];
            o[8 * c + 4] += w * d2[0]; o[8 * c + 5] += w * d2[1]; o[8 * c + 6] += w * d3[0]; o[8 * c + 7] += w * d3[1];
          }
        }
      };
      vload(va, 0);
#pragma unroll 1
      for (int k = 0; k < 128; k += 16) {
        vload(vb2, k + 8);
        vacc(va, k);
        if (k + 16 < 128) vload(va, k + 16);
        vacc(vb2, k + 8);
      }
    }
    if (!dry || o[0] == 1.2345e33f) {
      f32x4* op = (f32x4*)(P.out + (size_t)tok * D + lane * 16);
      float r[16];
#pragma unroll
      for (int i = 0; i < 4; ++i) { f32x4 t = op[i]; t.x += o[4 * i]; t.y += o[4 * i + 1]; t.z += o[4 * i + 2]; t.w += o[4 * i + 3]; op[i] = t; r[4 * i] = t.x; r[4 * i + 1] = t.y; r[4 * i + 2] = t.z; r[4 * i + 3] = t.w; }
      u32x4* hp = (u32x4*)(P.hb2 + (size_t)tok * D + lane * 16);
      hp[0] = mk4(pack2(r[0], r[1]), pack2(r[2], r[3]), pack2(r[4], r[5]), pack2(r[6], r[7]));
      hp[1] = mk4(pack2(r[8], r[9]), pack2(r[10], r[11]), pack2(r[12], r[13]), pack2(r[14], r[15]));
    }
  }
}

__device__ __forceinline__ void phase_ple(const Params& P, int l, char* smem, bool dry = false) {
  const u16* Wg = P.WgT + (size_t)l * D * D;
  const u16* Wp = P.WpT + (size_t)l * D * 256;
  const u16* pb = P.pb + (size_t)l * S * 256;
  const int tid = threadIdx.x, lane = tid & 63, wave = tid >> 6, wr = wave >> 1, h = lane >> 5;
  const float* rs = (const float*)(smem + G_RS_OFF);
  float* tile = (float*)smem;
  for (int it = blockIdx.x; it < 128 * 8; it += gridDim.x) {
    const int mt = it >> 3, nt = it & 7;
    f32x16 acc[2][2];
    zero_acc(acc);
    gemm_mainloop<false>(pb + (size_t)mt * 128 * 256, 256, Wp + (size_t)nt * 128 * 256, 256, 256, smem, acc);
    u16* side = (u16*)(smem + 36864);
    const int wc = wave & 1;
#pragma unroll
    for (int i = 0; i < 2; ++i)
#pragma unroll
      for (int j = 0; j < 2; ++j)
#pragma unroll
        for (int r = 0; r < 16; ++r)
          side[(wr * 64 + i * 32 + crow(r, h)) * 136 + wc * 64 + j * 32 + (lane & 31)] = f2bf(acc[i][j][r]);
    zero_acc(acc);
    gemm_mainloop<true>(P.hb2 + (size_t)mt * 128 * D, D, Wg + (size_t)nt * 128 * D, D, D, smem, acc);
    __syncthreads();
#pragma unroll
    for (int i = 0; i < 2; ++i)
#pragma unroll
      for (int j = 0; j < 2; ++j)
#pragma unroll
        for (int r = 0; r < 16; ++r) {
          const int row = wr * 64 + i * 32 + crow(r, h);
          const float pv = bf2f(side[row * 136 + wc * 64 + j * 32 + (lane & 31)]);
          acc[i][j][r] = sigmoidf_(acc[i][j][r] * rs[row]) * pv;
        }
    __syncthreads();
    acc_to_lds(acc, tile);
    __syncthreads();
    const int c4 = (tid & 31) * 4, r0 = tid >> 5;
#pragma unroll 4
    for (int i = 0; i < 16; ++i) {
      const int row = r0 + 8 * i;
      const size_t idx = (size_t)(mt * 128 + row) * D + nt * 128 + c4;
      const f32x4 a4 = *(const f32x4*)(tile + row * EPS_LD + c4);
      f32x4 h4 = *(const f32x4*)(P.out + idx);
      h4 += a4;
      if (!dry || h4[0] == 1.2345e33f) {
        *(f32x4*)(P.out + idx) = h4;
        *(u32x2*)(P.hb + idx) = mk2(pack2(h4[0], h4[1]), pack2(h4[2], h4[3]));
      }
    }
  }
}

constexpr int N_PHASES = 15;
#define XB_TMO      128
#define XB_XCNT(j)  (256  + 64 * (j))
#define XB_XSUB(j)  (1280 + 64 * (j))
#define XB_XGEN(j)  (2304 + 64 * (j))
#define XB_TOP      3328
#define XB_TOPGEN   3392
#define XCD_BAR_WORDS 3456
#define XB_SPIN_CAP (1u << 24)
typedef __attribute__((address_space(3))) unsigned las_u32;
DI unsigned xb_ld(unsigned* p) { return __hip_atomic_load(p, __ATOMIC_RELAXED, __HIP_MEMORY_SCOPE_AGENT); }
DI unsigned xb_add(unsigned* p, unsigned v) { return __hip_atomic_fetch_add(p, v, __ATOMIC_RELAXED, __HIP_MEMORY_SCOPE_AGENT); }
#define XB_SPIN(cond, bar) do { unsigned _sp = 0; while (cond) { __builtin_amdgcn_s_sleep(1); \
    if ((++_sp & 255u) == 0u) { if (xb_ld(&(bar)[XB_TMO])) break; if (_sp > XB_SPIN_CAP) { (void)xb_add(&(bar)[XB_TMO], 1u); break; } } } } while (0)
struct XcdBarrier { unsigned* bar; unsigned x; volatile las_u32* st; };
DI XcdBarrier xcd_barrier_post(unsigned* bar, volatile las_u32* st) {
  XcdBarrier b; b.bar = bar; b.x = (unsigned)__builtin_amdgcn_s_getreg((3 << 11) | 20) & 0xFu; b.st = st;
  if (threadIdx.x == 0) (void)xb_add(&bar[XB_XCNT(b.x)], 1u);
  return b;
}
DI void xcd_barrier_complete(unsigned* bar, unsigned x, unsigned& nloc, unsigned& nx) {
  const unsigned G = gridDim.x * gridDim.y * gridDim.z;
  unsigned sum, cnt, mine, sp = 0u;
  for (;;) {
    sum = 0u; cnt = 0u; mine = 0u;
#pragma unroll
    for (unsigned j = 0; j < 16; ++j) { const unsigned c = xb_ld(&bar[XB_XCNT(j)]); sum += c; cnt += (c > 0u) ? 1u : 0u; mine = (j == x) ? c : mine; }
    if (sum == G) break;
    __builtin_amdgcn_s_sleep(1);
    if ((++sp & 255u) == 0u) { if (xb_ld(&bar[XB_TMO])) break; if (sp > XB_SPIN_CAP) { (void)xb_add(&bar[XB_TMO], 1u); break; } }
  }
  nloc = mine > 0u ? mine : 1u; nx = cnt > 0u ? cnt : 1u;
}
DI void xcd_barrier(unsigned* xbar, unsigned xx, volatile las_u32* xst_) {
  XcdBarrier b; b.bar = xbar; b.x = xx; b.st = xst_;
  asm volatile("s_waitcnt vmcnt(0)" ::: "memory");
  __syncthreads();
  if (threadIdx.x == 0) {
    unsigned* bar = b.bar;
    __builtin_amdgcn_s_waitcnt(0);
    unsigned nloc = b.st[0], nx = b.st[1];
    if (nloc == 0u) { xcd_barrier_complete(bar, b.x, nloc, nx); b.st[0] = nloc; b.st[1] = nx; }
    const unsigned old = xb_add(&bar[XB_XSUB(b.x)], 1u);
    const unsigned gen = old / nloc;
    if (old + 1u == (gen + 1u) * nloc) {
      __builtin_amdgcn_fence(__ATOMIC_RELEASE, "agent");
      asm volatile("s_waitcnt vmcnt(0)" ::: "memory");
      const unsigned og = xb_add(&bar[XB_TOP], 1u);
      const unsigned tg = og / nx;
      if (og + 1u == (tg + 1u) * nx) xb_add(&bar[XB_TOPGEN], 1u);
      else XB_SPIN(xb_ld(&bar[XB_TOPGEN]) == tg, bar);
      __builtin_amdgcn_fence(__ATOMIC_ACQUIRE, "agent");
      xb_add(&bar[XB_XGEN(b.x)], 1u);
      asm volatile("s_waitcnt vmcnt(0)" ::: "memory");
    } else {
      XB_SPIN(xb_ld(&bar[XB_XGEN(b.x)]) == gen, bar);
      __builtin_amdgcn_fence(__ATOMIC_ACQUIRE, "agent");
      asm volatile("s_waitcnt vmcnt(0)" ::: "memory");
    }
  }
  __syncthreads();
}
__global__ void __launch_bounds__(NT, 2) hymba_mega(Params P, unsigned* counters) {
  __shared__ __attribute__((aligned(16))) char smem[SMEM_BYTES];
  cg::grid_group grid = cg::this_grid();
  const int lo = P.phase_lo, hi = P.phase_hi;
#ifndef ONLY_PHASE
#define ONLY_PHASE -1
#endif
#define PH_ON(k) (ONLY_PHASE < 0 || ONLY_PHASE == (k))
  volatile las_u32* xst = (volatile las_u32*)(smem + SMEM_BYTES - 16);
  if (threadIdx.x < 4) xst[threadIdx.x] = 0u;
  __syncthreads();
  unsigned* const xbar = counters + 64;
  const unsigned xcc = xcd_barrier_post(xbar, xst).x;
#define RUN(ph, kind, call) if (lo <= (ph) && (ph) < hi) { const bool dry = false; const int rep = 0; (void)dry; (void)rep; if (PH_ON(kind)) { call; } if ((ph) + 1 < hi) { if ((ph) == 0) grid.sync(); else xcd_barrier(xbar, xcc, xst); } }
#define RUNREP(ph, kind, call) if (lo <= (ph) && (ph) < hi) { \
    const int nrep = ((ph) == P.rep_ph) ? P.rep_n : 1; \
    for (int rep = 0; rep < nrep; ++rep) { const bool dry = rep > 0; (void)dry; \
      if (PH_ON(kind)) { call; } \
      if ((ph) + 1 < hi || rep + 1 < nrep) { xcd_barrier(xbar, xcc, xst); } } }
#ifndef REPEAT
#define REPEAT -1
#define RSEC 7
#endif
  RUN(0, 7, phase_prep(P, smem))
  RUN(1, 0, phase_inproj(P, 0, smem))
  RUN(2, 1, phase_compress(P, 0, smem))
  RUNREP(3, 2, phase_attention(P, 0, smem, counters + 4 * rep, dry ? (P.rep_sec | 8) : 7, dry && P.rep_nsa_only))
  RUN(4, 3, phase_outproj(P, 0, smem, dry))
  RUN(5, 4, phase_peerq(P, 0, smem))
  RUN(6, 5, phase_peer(P, 0, smem, dry))
  RUN(7, 6, phase_ple(P, 0, smem, dry))
  RUN(8, 0, phase_inproj(P, 1, smem))
  RUN(9, 1, phase_compress(P, 1, smem))
  RUN(10, 2, phase_attention(P, 1, smem, counters + 16))
  RUN(11, 3, phase_outproj(P, 1, smem))
  RUN(12, 4, phase_peerq(P, 1, smem))
  RUN(13, 5, phase_peer(P, 1, smem))
  RUN(14, 6, phase_ple(P, 1, smem))
}

static size_t align_up(size_t x, size_t a) { return (x + a - 1) / a * a; }

extern "C" void kernel_launch(void* const* d_in, const int* in_sizes, int n_in, void* d_out, int out_size, void* d_ws, size_t ws_size, hipStream_t stream) {
  static int grid_blocks = 0;
  if (!grid_blocks) {
    int dev = 0, cus = 0, per_cu = 0;
    hipGetDevice(&dev);
    hipDeviceGetAttribute(&cus, hipDeviceAttributeMultiprocessorCount, dev);
    hipOccupancyMaxActiveBlocksPerMultiprocessor(&per_cu, hymba_mega, NT, 0);
    if (per_cu > 2) per_cu = 2;
    if (per_cu < 1) per_cu = 1;
    grid_blocks = cus * per_cu;
  }
  Params P;
  memset(&P, 0, sizeof(P));
  P.x = (const float*)d_in[0]; P.p = (const float*)d_in[1]; P.positions = (const int*)d_in[2];
  P.attn_norm_w = (const float*)d_in[3]; P.w_in = (const float*)d_in[4]; P.fox_f_bias = (const float*)d_in[5];
  P.fox_q_norm_w = (const float*)d_in[6]; P.fox_k_norm_w = (const float*)d_in[7];
  P.nsa_q_norm_w = (const float*)d_in[8]; P.nsa_k_norm_w = (const float*)d_in[9]; P.nsa_cmp_pos = (const float*)d_in[10]; P.nsa_cmp_w = (const float*)d_in[11];
  P.diff_q_norm_w = (const float*)d_in[12]; P.diff_k_norm_w = (const float*)d_in[13]; P.diff_lambda = (const float*)d_in[14]; P.diff_subln_w = (const float*)d_in[15];
  P.w_out = (const float*)d_in[16]; P.ffn_norm_w = (const float*)d_in[17]; P.peer_w_q = (const float*)d_in[18]; P.peer_sub_keys = (const float*)d_in[19];
  P.peer_u = (const float*)d_in[20]; P.peer_v = (const float*)d_in[21]; P.ple_norm_w = (const float*)d_in[22]; P.ple_w_gate = (const float*)d_in[23]; P.ple_w_proj = (const float*)d_in[24];
  P.out = (float*)d_out;
  char* w = (char*)d_ws; size_t off = 0;
  auto take = [&](size_t bytes) { char* p = w + off; off = align_up(off + bytes, 256); return p; };
  unsigned* counters = (unsigned*)take(256 + XCD_BAR_WORDS * 4);
  P.WinT = (u16*)take((size_t)2 * NINP * D * 2);
  P.WoutT = (u16*)take((size_t)2 * D * D * 2);
  P.WqT = (u16*)take((size_t)2 * 2048 * D * 2);
  P.WgT = (u16*)take((size_t)2 * D * D * 2);
  P.WpT = (u16*)take((size_t)2 * D * 256 * 2);
  P.SubK = (u16*)take((size_t)2 * 16 * 128 * 128 * 2);
  P.CmpWT = (u16*)take((size_t)2 * 2 * 128 * 2048 * 2);
  P.cmpbias = (float*)take(2 * 2 * 64 * 4);
  P.U8 = (unsigned char*)take((size_t)2 * S * D / 2);
  P.V8 = (unsigned char*)take((size_t)2 * S * D / 2);
  P.Uinv = (float*)take((size_t)2 * S * 4); P.Vinv = (float*)take((size_t)2 * S * 4);
  P.hb = (u16*)take((size_t)S * D * 2);
  P.hb2 = (u16*)take((size_t)S * D * 2);
  P.pb = (u16*)take((size_t)2 * S * 256 * 2);
  P.ropeN = (float*)take((size_t)S * 64 * 4);
  P.ropeD = (float*)take((size_t)S * 32 * 4);
  P.QF = (u16*)take((size_t)4 * S * 64 * 2); P.KF = (u16*)take((size_t)4 * S * 64 * 2); P.VFt = (u16*)take((size_t)4 * S * 64 * 2);
  P.cloc = (float*)take((size_t)4 * S * 4); P.ctot = (float*)take(256 * 4 * 4);
  P.QN = (u16*)take((size_t)8 * S * 64 * 2); P.QR = (u16*)take((size_t)8 * S * 64 * 2);
  P.KC = (u16*)take((size_t)2 * (S + 64) * 64 * 2); P.VC = (u16*)take((size_t)2 * (S + 64) * 64 * 2);
  P.KCC = (u16*)take((size_t)2 * 1024 * 64 * 2); P.VCCt = (u16*)take((size_t)2 * 64 * 1024 * 2);
  P.KS8 = (unsigned char*)take((size_t)2 * S * 64); P.VS8t = (unsigned char*)take((size_t)2 * S * 64);
  P.KW = (u16*)take((size_t)2 * S * 64 * 2); P.VWt = (u16*)take((size_t)2 * S * 64 * 2);
  P.gates = (float*)take((size_t)S * 24 * 4);
  P.QD = (u16*)take((size_t)4 * S * 64 * 2); P.KD = (u16*)take((size_t)4 * S * 64 * 2); P.VDt = (u16*)take((size_t)4 * S * 64 * 2);
  P.mix = (u16*)take((size_t)S * D * 2);
  P.dstash = (float*)take((size_t)grid_blocks * 128 * 64 * 4);
  P.impA = (float*)take((size_t)256 * 256 * 128 * 4); P.impB = (float*)take((size_t)256 * 256 * 128 * 4);
  P.topk = (u32*)take((size_t)S * 256 * 4);
  if (off > ws_size) { fprintf(stderr, "kernel_launch: workspace too small: need %zu, have %zu\n", off, ws_size); return; }
  hipMemsetAsync(counters, 0, 256 + XCD_BAR_WORDS * 4, stream);
#ifndef SINGLE_LAUNCH
#define SINGLE_LAUNCH 1
#endif
#ifndef REP_PH
#define REP_PH -1
#endif
#ifndef REP_N
#define REP_N 1
#endif
#ifndef REP_SEC
#define REP_SEC 7
#endif
#ifndef REP_NSA_ONLY
#define REP_NSA_ONLY 0
#endif
  P.rep_ph = REP_PH; P.rep_n = REP_N; P.rep_sec = REP_SEC; P.rep_nsa_only = REP_NSA_ONLY;
  if (SINGLE_LAUNCH) {
    P.phase_lo = 0; P.phase_hi = N_PHASES;
    void* args[] = {&P, &counters};
    hipError_t e = hipLaunchCooperativeKernel((void*)hymba_mega, dim3(grid_blocks), dim3(NT), args, 0, stream);
    if (e != hipSuccess) fprintf(stderr, "cooperative launch failed: %s (grid %d)\n", hipGetErrorString(e), grid_blocks);
  } else {
    for (int ph = 0; ph < N_PHASES; ++ph) {
      P.phase_lo = ph; P.phase_hi = ph + 1;
      void* args[] = {&P, &counters};
      hipError_t e = hipLaunchCooperativeKernel((void*)hymba_mega, dim3(grid_blocks), dim3(NT), args, 0, stream);
      if (e != hipSuccess) { fprintf(stderr, "cooperative launch failed: %s (grid %d, phase %d)\n", hipGetErrorString(e), grid_blocks, ph); break; }
    }
  }
}
```

```cpp
#include <hip/hip_runtime.h>
#include <hip/hip_cooperative_groups.h>
#include <cstdio>
#include <cstdint>
#include <cstring>
namespace cg = cooperative_groups;

typedef __attribute__((ext_vector_type(8))) short bf16x8;
typedef __attribute__((ext_vector_type(4))) short bf16x4;
typedef __attribute__((ext_vector_type(16))) float f32x16;
typedef __attribute__((ext_vector_type(4))) float f32x4;
typedef __attribute__((ext_vector_type(2))) float f32x2;
typedef __attribute__((ext_vector_type(2))) __bf16 bf2_t;
typedef unsigned short u16;
typedef unsigned int u32;
typedef __attribute__((ext_vector_type(4))) unsigned int u32x4;
typedef __attribute__((ext_vector_type(2))) unsigned int u32x2;

#define DI __device__ __forceinline__
#define MFMA32(a, b, c) __builtin_amdgcn_mfma_f32_32x32x16_bf16((a), (b), (c), 0, 0, 0)
#define MFMA16(a, b, c) __builtin_amdgcn_mfma_f32_16x16x32_bf16((a), (b), (c), 0, 0, 0)

constexpr int S = 16384;
constexpr int D = 1024;
constexpr int NT = 256;
constexpr int NIN = 2844;
constexpr int NINP = 2944;
constexpr int SMEM_BYTES = 72704;
constexpr float LOG2E = 1.4426950408889634f;
#ifndef ABLATE
#define ABLATE 0
#endif

typedef int i32x8 __attribute__((ext_vector_type(8)));
struct Params {
  const float* x; const float* p; const int* positions;
  const float* attn_norm_w; const float* w_in; const float* fox_f_bias; const float* fox_q_norm_w; const float* fox_k_norm_w;
  const float* nsa_q_norm_w; const float* nsa_k_norm_w; const float* nsa_cmp_pos; const float* nsa_cmp_w;
  const float* diff_q_norm_w; const float* diff_k_norm_w; const float* diff_lambda; const float* diff_subln_w;
  const float* w_out; const float* ffn_norm_w; const float* peer_w_q; const float* peer_sub_keys; const float* peer_u; const float* peer_v;
  const float* ple_norm_w; const float* ple_w_gate; const float* ple_w_proj;
  float* out;
  u16* WinT;
  u16* WoutT;
  u16* WqT;
  u16* WgT;
  u16* WpT;
  u16* SubK;
  u16* CmpWT;
  float* cmpbias;
  unsigned char* U8;
  unsigned char* V8;
  float* Uinv; float* Vinv;
  u16* hb;
  u16* hb2;
  u16* pb;
  float* ropeN;
  float* ropeD;
  u16* QF; u16* KF; u16* VFt;
  float* cloc; float* ctot;
  u16* QN; u16* QR;
  u16* KC; u16* VC;
  u16* KCC; u16* VCCt;
  unsigned char* KS8; unsigned char* VS8t;
  u16* KW; u16* VWt;
  float* gates;
  u16* QD; u16* KD; u16* VDt;
  u16* mix;
  float* dstash;
  float* impA; float* impB;
  u32* topk;
  int phase_lo, phase_hi;
  int rep_ph, rep_n, rep_sec, rep_nsa_only;
};

DI u32x4 mk4(u32 a, u32 b, u32 c, u32 d) { return (u32x4){a, b, c, d}; }
DI u32x2 mk2(u32 a, u32 b) { return (u32x2){a, b}; }
DI u32 pack2(float a, float b) { f32x2 v = {a, b}; bf2_t r = __builtin_convertvector(v, bf2_t); return __builtin_bit_cast(u32, r); }
DI u16 f2bf(float a) { return (u16)(pack2(a, 0.f) & 0xffffu); }
DI float bf2f(u16 x) { return __uint_as_float(((u32)x) << 16); }
DI float bflo(u32 x) { return __uint_as_float(x << 16); }
DI float bfhi(u32 x) { return __uint_as_float(x & 0xffff0000u); }
DI int opaque_tid() { int t = threadIdx.x; asm volatile("" : "+v"(t)); return t; }
DI int crow(int reg, int h) { return (reg & 3) + 8 * (reg >> 2) + 4 * h; }
DI float wave_sum(float v) {
#pragma unroll
  for (int o = 32; o > 0; o >>= 1) v += __shfl_xor(v, o);
  return v;
}
DI float wave_max(float v) {
#pragma unroll
  for (int o = 32; o > 0; o >>= 1) v = fmaxf(v, __shfl_xor(v, o));
  return v;
}

DI int inproj_old_col(int j) {
  if (j < 768) return j;
  if (j < 2048) return j + 4;
  if (j < 2816) return j + 28;
  if (j < 2820) return j - 2048;
  if (j < 2844) return j - 768;
  return -1;
}
DI void transpose_tile(const float* __restrict__ src, int ldsrc, u16* __restrict__ dst, int K, const float* __restrict__ scale,
                       int n0, int k0, int mode, int nvalid, float* tile) {
  const int t = threadIdx.x;
  const int nn = t & 63, kq = t >> 6;
  int col = n0 + nn;
  if (mode == 1) col = inproj_old_col(col); else if (col >= nvalid) col = -1;
  float v[16];
#pragma unroll
  for (int i = 0; i < 16; ++i) v[i] = (col >= 0) ? src[(size_t)(k0 + kq + 4 * i) * ldsrc + col] : 0.f;
  if (scale) {
#pragma unroll
    for (int i = 0; i < 16; ++i) v[i] *= scale[k0 + kq + 4 * i];
  }
#pragma unroll
  for (int i = 0; i < 16; ++i) tile[(kq + 4 * i) * 65 + nn] = v[i];
  __syncthreads();
  const int n2 = t >> 2, kc = (t & 3) * 16;
  u32 o[8];
#pragma unroll
  for (int i = 0; i < 8; ++i) o[i] = pack2(tile[(kc + 2 * i) * 65 + n2], tile[(kc + 2 * i + 1) * 65 + n2]);
  u32x4* dp = (u32x4*)(dst + (size_t)(n0 + n2) * K + k0 + kc);
  dp[0] = mk4(o[0], o[1], o[2], o[3]);
  dp[1] = mk4(o[4], o[5], o[6], o[7]);
  __syncthreads();
}

DI void convert_rows(const float* __restrict__ src, u16* __restrict__ dst, size_t n8, float* __restrict__ copy) {
  const size_t stride = (size_t)gridDim.x * NT;
  for (size_t i0 = (size_t)blockIdx.x * NT + threadIdx.x; i0 < n8; i0 += 4 * stride) {
    f32x4 a[4], b[4];
#pragma unroll
    for (int u = 0; u < 4; ++u) {
      const size_t i = i0 + u * stride;
      if (i < n8) { a[u] = ((const f32x4*)src)[2 * i]; b[u] = ((const f32x4*)src)[2 * i + 1]; }
    }
#pragma unroll
    for (int u = 0; u < 4; ++u) {
      const size_t i = i0 + u * stride;
      if (i < n8) {
        if (copy) { ((f32x4*)copy)[2 * i] = a[u]; ((f32x4*)copy)[2 * i + 1] = b[u]; }
        ((u32x4*)dst)[i] = mk4(pack2(a[u][0], a[u][1]), pack2(a[u][2], a[u][3]), pack2(b[u][0], b[u][1]), pack2(b[u][2], b[u][3]));
      }
    }
  }
}

__device__ __forceinline__ void phase_prep(const Params& P, char* smem) {
  float* tile = (float*)smem;
  const int bid = blockIdx.x, nb = gridDim.x, t = threadIdx.x;
  for (int it0 = bid; it0 < 2 * 1952; it0 += nb) {
    const int l = it0 / 1952;
    int it = it0 % 1952;
    if (it < 736) { transpose_tile(P.w_in + (size_t)l * D * NIN, NIN, P.WinT + (size_t)l * NINP * D, D, P.attn_norm_w + l * D, (it >> 4) * 64, (it & 15) * 64, 1, 0, tile); continue; }
    it -= 736;
    if (it < 256) { transpose_tile(P.w_out + (size_t)l * D * D, D, P.WoutT + (size_t)l * D * D, D, nullptr, (it >> 4) * 64, (it & 15) * 64, 0, D, tile); continue; }
    it -= 256;
    if (it < 512) { transpose_tile(P.peer_w_q + (size_t)l * D * 2048, 2048, P.WqT + (size_t)l * 2048 * D, D, P.ffn_norm_w + l * D, (it >> 4) * 64, (it & 15) * 64, 0, 2048, tile); continue; }
    it -= 512;
    if (it < 256) { transpose_tile(P.ple_w_gate + (size_t)l * D * D, D, P.WgT + (size_t)l * D * D, D, P.ple_norm_w + l * D, (it >> 4) * 64, (it & 15) * 64, 0, D, tile); continue; }
    it -= 256;
    if (it < 64) { transpose_tile(P.ple_w_proj + (size_t)l * 256 * D, D, P.WpT + (size_t)l * D * 256, 256, nullptr, (it >> 2) * 64, (it & 3) * 64, 0, D, tile); continue; }
    it -= 64;
    { const int kv = it >> 6, i2 = it & 63;
      transpose_tile(P.nsa_cmp_w + (size_t)(l * 2 + kv) * 2048 * 64, 64, P.CmpWT + (size_t)(l * 2 + kv) * 128 * 2048, 2048, nullptr, (i2 >> 5) * 64, (i2 & 31) * 64, 0, 64, tile); }
  }
  convert_rows(P.peer_sub_keys, P.SubK, (size_t)2 * 16 * 128 * 128 / 8, nullptr);
  {
    const int lane = t & 63, gw = bid * 4 + (t >> 6), ngw = nb * 4;
    for (int r = gw; r < 4 * S; r += ngw) {
      const int tbl = r / (2 * S), l = (r / S) & 1, e = r % S;
      const float* src = (tbl ? P.peer_v : P.peer_u) + ((size_t)l * S + e) * D + lane * 16;
      float v[16];
#pragma unroll
      for (int i = 0; i < 4; ++i) { const f32x4 q4 = ((const f32x4*)src)[i]; v[4 * i] = q4[0]; v[4 * i + 1] = q4[1]; v[4 * i + 2] = q4[2]; v[4 * i + 3] = q4[3]; }
      if (tbl == 0) {
        const float* w = P.ffn_norm_w + l * D + lane * 16;
#pragma unroll
        for (int i = 0; i < 16; ++i) v[i] *= w[i];
      }
      float m = 0.f;
#pragma unroll
      for (int i = 0; i < 16; ++i) m = fmaxf(m, fabsf(v[i]));
      m = wave_max(m);
      {
        const float sc = (m > 0.f) ? 6.f / m : 0.f;
        u32 o[2] = {0u, 0u};
#pragma unroll
        for (int i = 0; i < 8; ++i) {
          if ((i & 3) == 0) o[i >> 2] = __builtin_amdgcn_cvt_scalef32_pk_fp4_f32(o[i >> 2], v[2 * i] * sc, v[2 * i + 1] * sc, 1.0f, 0);
          else if ((i & 3) == 1) o[i >> 2] = __builtin_amdgcn_cvt_scalef32_pk_fp4_f32(o[i >> 2], v[2 * i] * sc, v[2 * i + 1] * sc, 1.0f, 1);
          else if ((i & 3) == 2) o[i >> 2] = __builtin_amdgcn_cvt_scalef32_pk_fp4_f32(o[i >> 2], v[2 * i] * sc, v[2 * i + 1] * sc, 1.0f, 2);
          else o[i >> 2] = __builtin_amdgcn_cvt_scalef32_pk_fp4_f32(o[i >> 2], v[2 * i] * sc, v[2 * i + 1] * sc, 1.0f, 3);
        }
        *(u32x2*)((tbl ? P.V8 : P.U8) + ((size_t)l * S + e) * (D / 2) + lane * 8) = mk2(o[0], o[1]);
        if (lane == 0) (tbl ? P.Vinv : P.Uinv)[l * S + e] = m * (1.f / 6.f);
      }
    }
  }
  convert_rows(P.p, P.pb, (size_t)2 * S * 256 / 8, nullptr);
  convert_rows(P.x, P.hb, (size_t)S * D / 8, P.out);
  const size_t gtid = (size_t)bid * NT + t, gstride = (size_t)nb * NT;
  __syncthreads();
  if (t < 48) tile[t] = (t < 32) ? powf(10000.f, -(float)t / 32.f) : powf(10000.f, -(float)(t - 32) / 16.f);
  __syncthreads();
  for (size_t i = gtid; i < (size_t)S * 48; i += gstride) {
    const int tok = (int)(i / 48), r = (int)(i % 48);
    const float pos = (float)P.positions[tok];
    const float invf = tile[r];
    const float ang = pos * invf;
    const double rev = (double)ang * 0.15915494309189535;
    const float fr = (float)(rev - floor(rev));
    const float c = __builtin_amdgcn_cosf(fr), s = __builtin_amdgcn_sinf(fr);
    if (r < 32) { P.ropeN[(size_t)tok * 64 + r] = c; P.ropeN[(size_t)tok * 64 + 32 + r] = s; }
    else { P.ropeD[(size_t)tok * 32 + (r - 32)] = c; P.ropeD[(size_t)tok * 32 + 16 + (r - 32)] = s; }
  }
  {
    const int lane = t & 63, gw = bid * 4 + (t >> 6), ngw = nb * 4;
    for (int i = gw; i < 2 * 2 * 64; i += ngw) {
      const int lk = i >> 6, e = i & 63;
      const float* pos = P.nsa_cmp_pos + (size_t)lk * 2048;
      const float* w = P.nsa_cmp_w + (size_t)lk * 2048 * 64;
      float a = 0.f;
#pragma unroll 8
      for (int k = lane; k < 2048; k += 64) a += pos[k] * w[(size_t)k * 64 + e];
      a = wave_sum(a);
      if (lane == 0) P.cmpbias[i] = a;
    }
  }
  for (size_t i = gtid; i < 2 * 2 * 64 * 64; i += gstride) {
    const int which = (int)(i / (2 * 64 * 64)), r = (int)(i % (2 * 64 * 64));
    const int g = r / (64 * 64), o = r % (64 * 64);
    u16* base = which ? P.VC : P.KC;
    base[(size_t)g * (S + 64) * 64 + (size_t)S * 64 + o] = 0;
  }
}

constexpr int GST = 144;
constexpr int G_BOFF = 128 * GST;
constexpr int G_RS_OFF = 71680;

DI float ssq8(const u32x4& v) {
  float s = 0.f;
  float a;
  a = bflo(v.x); s += a * a; a = bfhi(v.x); s += a * a;
  a = bflo(v.y); s += a * a; a = bfhi(v.y); s += a * a;
  a = bflo(v.z); s += a * a; a = bfhi(v.z); s += a * a;
  a = bflo(v.w); s += a * a; a = bfhi(v.w); s += a * a;
  return s;
}

template <bool SSQ>
DI void gemm_mainloop(const u16* __restrict__ A, int lda, const u16* __restrict__ Bt, int ldb, int K, char* sm, f32x16 (&acc)[2][2]) {
  const int tid = threadIdx.x, lane = tid & 63, wave = tid >> 6;
  const int wr = wave >> 1, wc = wave & 1;
  const int lrow = tid >> 3, lcol = (tid & 7) * 8;
  char* As = sm; char* Bs = sm + G_BOFF;
  u32x4 ra[4], rb[4];
  float ssq[4] = {0.f, 0.f, 0.f, 0.f};
#pragma unroll
  for (int i = 0; i < 4; ++i) {
    ra[i] = *(const u32x4*)(A + (size_t)(lrow + 32 * i) * lda + lcol);
    rb[i] = *(const u32x4*)(Bt + (size_t)(lrow + 32 * i) * ldb + lcol);
  }
  const int aoff = (wr * 64 + (lane & 31)) * GST + (lane >> 5) * 16;
  const int boff = (wc * 64 + (lane & 31)) * GST + (lane >> 5) * 16;
  for (int k0 = 0; k0 < K; k0 += 64) {
    __syncthreads();
#pragma unroll
    for (int i = 0; i < 4; ++i) {
      *(u32x4*)(As + (lrow + 32 * i) * GST + lcol * 2) = ra[i];
      *(u32x4*)(Bs + (lrow + 32 * i) * GST + lcol * 2) = rb[i];
      if (SSQ) ssq[i] += ssq8(ra[i]);
    }
    __syncthreads();
    if (k0 + 64 < K) {
#pragma unroll
      for (int i = 0; i < 4; ++i) {
        ra[i] = *(const u32x4*)(A + (size_t)(lrow + 32 * i) * lda + k0 + 64 + lcol);
        rb[i] = *(const u32x4*)(Bt + (size_t)(lrow + 32 * i) * ldb + k0 + 64 + lcol);
      }
    }
#pragma unroll
    for (int ks = 0; ks < 4; ++ks) {
      bf16x8 af[2], bfr[2];
#pragma unroll
      for (int i = 0; i < 2; ++i) af[i] = *(const bf16x8*)(As + aoff + i * 32 * GST + ks * 32);
#pragma unroll
      for (int j = 0; j < 2; ++j) bfr[j] = *(const bf16x8*)(Bs + boff + j * 32 * GST + ks * 32);
#pragma unroll
      for (int i = 0; i < 2; ++i)
#pragma unroll
        for (int j = 0; j < 2; ++j) acc[i][j] = MFMA32(af[i], bfr[j], acc[i][j]);
    }
  }
  __syncthreads();
  if (SSQ) {
    float* rs = (float*)(sm + G_RS_OFF);
#pragma unroll
    for (int i = 0; i < 4; ++i) {
      float s = ssq[i];
      s += __shfl_xor(s, 1); s += __shfl_xor(s, 2); s += __shfl_xor(s, 4);
      if ((tid & 7) == 0) rs[lrow + 32 * i] = rsqrtf(s * (1.f / (float)K) + 1e-6f);
    }
  }
}

DI void zero_acc(f32x16 (&acc)[2][2]) {
#pragma unroll
  for (int i = 0; i < 2; ++i)
#pragma unroll
    for (int j = 0; j < 2; ++j)
#pragma unroll
      for (int r = 0; r < 16; ++r) acc[i][j][r] = 0.f;
}

constexpr int EPS_LD = 132;
DI void acc_to_lds(const f32x16 (&acc)[2][2], float* tile) {
  const int lane = threadIdx.x & 63, wave = threadIdx.x >> 6;
  const int wr = wave >> 1, wc = wave & 1;
#pragma unroll
  for (int i = 0; i < 2; ++i)
#pragma unroll
    for (int j = 0; j < 2; ++j)
#pragma unroll
      for (int r = 0; r < 16; ++r)
        tile[(wr * 64 + i * 32 + crow(r, lane >> 5)) * EPS_LD + wc * 64 + j * 32 + (lane & 31)] = acc[i][j][r];
}

DI float log_sigmoid(float x) { return fminf(x, 0.f) - log1pf(expf(-fabsf(x))); }
DI float sigmoidf_(float x) { return 1.f / (1.f + expf(-x)); }

DI void store32_bf16(u16* dst, const float* o) {
  u32x4* d4 = (u32x4*)dst;
#pragma unroll
  for (int i = 0; i < 4; ++i)
    d4[i] = mk4(pack2(o[8 * i], o[8 * i + 1]), pack2(o[8 * i + 2], o[8 * i + 3]), pack2(o[8 * i + 4], o[8 * i + 5]), pack2(o[8 * i + 6], o[8 * i + 7]));
}

__device__ __forceinline__ void inproj_epilogue_half(const Params& P, int l, int mt, int nt, int half, const float* tile, const float* rs) {
  const int tid = threadIdx.x, lane = tid & 63, wave = tid >> 6;
  const int hl = wave >> 1, h32 = wave & 1;
  const int sg = 2 * nt + hl;
  const int rloc = half * 64 + lane;
  const int tok = mt * 128 + rloc;
  const float rstd = rs[rloc];
  if (sg >= 45) return;
  float v[64];
  {
    const f32x4* src = (const f32x4*)(tile + rloc * EPS_LD + hl * 64);
#pragma unroll
    for (int i = 0; i < 16; ++i) { f32x4 t = src[i]; v[4 * i] = t[0] * rstd; v[4 * i + 1] = t[1] * rstd; v[4 * i + 2] = t[2] * rstd; v[4 * i + 3] = t[3] * rstd; }
  }
  const u32 hmask = (u32)(-(int)h32);
#define VO(i) __uint_as_float((__float_as_uint(v[32 + (i)]) & hmask) | (__float_as_uint(v[(i)]) & ~hmask))
  if (sg == 44) {
    if (h32 == 0) {
      const int chunk = tok >> 6;
#pragma unroll
      for (int hd = 0; hd < 4; ++hd) {
        float x = log_sigmoid(v[hd] + P.fox_f_bias[l * 4 + hd]);
#pragma unroll
        for (int o = 1; o < 64; o <<= 1) { float t = __shfl_up(x, o); if (lane >= o) x += t; }
        P.cloc[(size_t)hd * S + tok] = x;
        if (lane == 63) P.ctot[chunk * 4 + hd] = x;
      }
    } else {
      float* g = P.gates + (size_t)tok * 24;
#pragma unroll
      for (int i = 0; i < 24; ++i) g[i] = sigmoidf_(v[4 + i]);
    }
    return;
  }
  float o[32];
  const bool is_vt = (sg >= 8 && sg < 12) || (sg == 26 || sg == 27) || (sg == 30 || sg == 31) || (sg >= 40);
  const bool is_raw = (sg >= 20 && sg < 24);
  const bool is_diff = (sg >= 32 && sg < 40);
  if (is_vt) {
    if (sg == 26 || sg == 27) {
      const int key = tok & 63, G = key >> 5, h4 = (key & 31) >> 3, j = key & 7;
      unsigned char* b8 = P.VS8t + (size_t)(sg - 26) * 64 * S + (size_t)(tok >> 6) * 4096 + G * 2048 + h4 * 128 + j;
#pragma unroll
      for (int i = 0; i < 32; i += 2) {
        const int wd = __builtin_amdgcn_cvt_pk_fp8_f32(VO(i), VO(i + 1), 0, false);
        const int d0 = h32 * 32 + i, d1 = d0 + 1;
        b8[(d0 >> 4) * 512 + (d0 & 15) * 8] = (unsigned char)(wd & 0xff);
        b8[(d1 >> 4) * 512 + (d1 & 15) * 8] = (unsigned char)((wd >> 8) & 0xff);
      }
      return;
    }
    u16* base;
    if (sg < 12) base = P.VFt + (size_t)(sg - 8) * 64 * S;
    else if (sg < 32) base = P.VWt + (size_t)(sg - 30) * 64 * S;
    else base = P.VDt + (size_t)(sg - 40) * 64 * S;
#pragma unroll
    for (int i = 0; i < 32; ++i) base[(size_t)(h32 * 32 + i) * S + tok] = f2bf(VO(i));
    return;
  }
  if (is_raw) {
    u16* base = (sg < 22) ? P.KC + (size_t)(sg - 20) * (S + 64) * 64 : P.VC + (size_t)(sg - 22) * (S + 64) * 64;
#pragma unroll
    for (int i = 0; i < 32; ++i) o[i] = VO(i);
    store32_bf16(base + (size_t)tok * 64 + h32 * 32, o);
    return;
  }
  if (is_diff) {
    const float* w = (sg < 36 ? P.diff_q_norm_w : P.diff_k_norm_w) + l * 32;
    float ss = 0.f;
#pragma unroll
    for (int i = 0; i < 32; ++i) ss += VO(i) * VO(i);
    const float rn = rsqrtf(ss * (1.f / 32.f) + 1e-6f);
    const float sc = (sg < 36) ? 0.17677669529663687f * LOG2E : 1.f;
    const float* rp = P.ropeD + (size_t)tok * 32;
#pragma unroll
    for (int i = 0; i < 16; ++i) {
      const float y1 = VO(i) * rn * w[i], y2 = VO(16 + i) * rn * w[16 + i];
      const float c = rp[i], s = rp[16 + i];
      o[i] = (y1 * c - y2 * s) * sc;
      o[16 + i] = (y2 * c + y1 * s) * sc;
    }
    u16* base = (sg < 36) ? P.QD + (size_t)(sg - 32) * S * 64 : P.KD + (size_t)(sg - 36) * S * 64;
    store32_bf16(base + (size_t)tok * 64 + h32 * 32, o);
    return;
  }
  const float* w;
  if (sg < 4) w = P.fox_q_norm_w + l * 64; else if (sg < 8) w = P.fox_k_norm_w + l * 64; else if (sg < 20) w = P.nsa_q_norm_w + l * 64; else w = P.nsa_k_norm_w + l * 64;
  float ss = 0.f;
#pragma unroll
  for (int i = 0; i < 64; ++i) ss += v[i] * v[i];
  const float rn = rsqrtf(ss * (1.f / 64.f) + 1e-6f);
  const float qs = 0.125f * LOG2E;
  if (sg < 8) {
    const float sc = (sg < 4) ? qs : 1.f;
#pragma unroll
    for (int i = 0; i < 32; ++i) o[i] = VO(i) * rn * w[h32 * 32 + i] * sc;
    u16* base = (sg < 4) ? P.QF + (size_t)sg * S * 64 : P.KF + (size_t)(sg - 4) * S * 64;
    store32_bf16(base + (size_t)tok * 64 + h32 * 32, o);
    return;
  }
  const float* rp = P.ropeN + (size_t)tok * 64;
  const float sc = (sg < 20) ? qs : 1.f;
  if (sg < 20) {
#pragma unroll
    for (int i = 0; i < 32; ++i) o[i] = VO(i) * rn * w[h32 * 32 + i] * sc;
    store32_bf16(P.QN + ((size_t)(sg - 12) * S + tok) * 64 + h32 * 32, o);
  }
#pragma unroll
  for (int i = 0; i < 32; ++i) {
    const float y1 = v[i] * rn * w[i], y2 = v[32 + i] * rn * w[32 + i];
    const float c = rp[i], s = rp[32 + i];
    o[i] = (h32 == 0 ? (y1 * c - y2 * s) : (y2 * c + y1 * s)) * sc;
  }
  if (sg == 24 || sg == 25) {
    const int key = tok & 63, G = key >> 5, r32 = key & 31, t = (r32 >> 2) & 1, i = ((r32 >> 3) << 2) | (r32 & 3);
    unsigned char* d8 = P.KS8 + (size_t)(sg - 24) * S * 64 + (size_t)(tok >> 6) * 4096 + ((G * 2 + t) * 2 + h32) * 512 + i * 8;
#pragma unroll
    for (int h4 = 0; h4 < 4; ++h4) {
      int w0 = 0, w1 = 0;
      w0 = __builtin_amdgcn_cvt_pk_fp8_f32(o[8 * h4], o[8 * h4 + 1], w0, false);
      w0 = __builtin_amdgcn_cvt_pk_fp8_f32(o[8 * h4 + 2], o[8 * h4 + 3], w0, true);
      w1 = __builtin_amdgcn_cvt_pk_fp8_f32(o[8 * h4 + 4], o[8 * h4 + 5], w1, false);
      w1 = __builtin_amdgcn_cvt_pk_fp8_f32(o[8 * h4 + 6], o[8 * h4 + 7], w1, true);
      *(u32x2*)(d8 + h4 * 128) = mk2((u32)w0, (u32)w1);
    }
    return;
  }
  u16* base;
  if (sg < 20) base = P.QR + (size_t)(sg - 12) * S * 64;
  else base = P.KW + (size_t)(sg - 28) * S * 64;
  store32_bf16(base + (size_t)tok * 64 + h32 * 32, o);
}

#undef VO
__device__ __forceinline__ void phase_inproj(const Params& P, int l, char* smem) {
  const u16* Wt = P.WinT + (size_t)l * NINP * D;
  float* tile = (float*)smem;
  const float* rs = (const float*)(smem + G_RS_OFF);
  for (int it = blockIdx.x; it < 128 * 23; it += gridDim.x) {
    const int mt = it / 23, nt = it % 23;
    f32x16 acc[2][2];
    zero_acc(acc);
    gemm_mainloop<true>(P.hb + (size_t)mt * 128 * D, D, Wt + (size_t)nt * 128 * D, D, D, smem, acc);
    acc_to_lds(acc, tile);
    __syncthreads();
#pragma unroll 1
    for (int half = 0; half < 2; ++half) inproj_epilogue_half(P, l, mt, nt, half, tile, rs);
  }
}

__device__ __forceinline__ void phase_compress(const Params& P, int l, char* smem) {
  float* tile = (float*)smem;
  for (int it = blockIdx.x; it < 32; it += gridDim.x) {
    const int kv = it >> 4, g = (it >> 3) & 1, mt = it & 7;
    const u16* A = (kv ? P.VC : P.KC) + (size_t)g * (S + 64) * 64 + (size_t)mt * 128 * 1024;
    const u16* Bt = P.CmpWT + (size_t)(l * 2 + kv) * 128 * 2048;
    const float* bias = P.cmpbias + (l * 2 + kv) * 64;
    f32x16 acc[2][2];
    zero_acc(acc);
    gemm_mainloop<false>(A, 1024, Bt, 2048, 2048, smem, acc);
    acc_to_lds(acc, tile);
    __syncthreads();
#pragma unroll 1
    for (int half = 0; half < 2; ++half) {
      {
        const int lane = threadIdx.x & 63, wave = threadIdx.x >> 6;
        const int idx = mt * 128 + half * 64 + lane;
        float v[64];
        const f32x4* src = (const f32x4*)(tile + (half * 64 + lane) * EPS_LD);
#pragma unroll
        for (int i = 0; i < 16; ++i) { f32x4 t = src[i]; v[4 * i] = t[0] + bias[4 * i]; v[4 * i + 1] = t[1] + bias[4 * i + 1]; v[4 * i + 2] = t[2] + bias[4 * i + 2]; v[4 * i + 3] = t[3] + bias[4 * i + 3]; }
        float vo[16];
#pragma unroll
        for (int i = 0; i < 4; ++i) { f32x4 t = src[wave * 4 + i]; const float* bb = bias + wave * 16 + 4 * i; vo[4 * i] = t[0] + bb[0]; vo[4 * i + 1] = t[1] + bb[1]; vo[4 * i + 2] = t[2] + bb[2]; vo[4 * i + 3] = t[3] + bb[3]; }
        if (kv == 0) {
          const float* w = P.nsa_k_norm_w + l * 64;
          float ss = 0.f;
#pragma unroll
          for (int i = 0; i < 64; ++i) ss += v[i] * v[i];
          const float rn = rsqrtf(ss * (1.f / 64.f) + 1e-6f);
          u32 o[8];
#pragma unroll
          for (int i = 0; i < 8; ++i) o[i] = pack2(vo[2 * i] * rn * w[wave * 16 + 2 * i], vo[2 * i + 1] * rn * w[wave * 16 + 2 * i + 1]);
          u32x4* dp = (u32x4*)(P.KCC + ((size_t)g * 1024 + idx) * 64 + wave * 16);
          dp[0] = mk4(o[0], o[1], o[2], o[3]);
          dp[1] = mk4(o[4], o[5], o[6], o[7]);
        } else {
#pragma unroll
          for (int i = 0; i < 16; ++i) P.VCCt[((size_t)g * 64 + wave * 16 + i) * 1024 + idx] = f2bf(vo[i]);
        }
      }
    }
  }
}

constexpr int AK_ST = 144;
constexpr int AV_ST = 136;
constexpr int AT_VOFF = 64 * AK_ST;
constexpr int AT_COFF = AT_VOFF + 64 * AV_ST;
constexpr int AT_STAGE = AT_COFF + 256;
constexpr int AT_MISC = 2 * AT_STAGE;

struct TileRegs { u32x4 k[2]; u32x4 v[2]; };

DI void tile_load(int t, TileRegs& r, const u16* __restrict__ K, const u16* __restrict__ Vt, size_t ldv, int key0, bool with_v) {
#pragma unroll
  for (int i = 0; i < 2; ++i) {
    const int c = t + 256 * i, row = c >> 3, part = c & 7;
    r.k[i] = *(const u32x4*)(K + (size_t)(key0 + row) * 64 + part * 8);
    if (with_v) r.v[i] = *(const u32x4*)(Vt + (size_t)row * ldv + key0 + part * 8);
  }
}
DI void tile_store(int t, const TileRegs& r, char* st, bool with_v) {
#pragma unroll
  for (int i = 0; i < 2; ++i) {
    const int c = t + 256 * i, row = c >> 3, part = c & 7;
    *(u32x4*)(st + row * AK_ST + part * 16) = r.k[i];
    if (with_v) {
      u32x2* d = (u32x2*)(st + AT_VOFF + row * AV_ST + part * 16);
      d[0] = mk2(r.v[i].x, r.v[i].y);
      d[1] = mk2(r.v[i].z, r.v[i].w);
    }
  }
}
DI bf16x8 pack_p(const f32x16& p, int sp) {
  u32x4 u = mk4(pack2(p[8 * sp], p[8 * sp + 1]), pack2(p[8 * sp + 2], p[8 * sp + 3]), pack2(p[8 * sp + 4], p[8 * sp + 5]), pack2(p[8 * sp + 6], p[8 * sp + 7]));
  return __builtin_bit_cast(bf16x8, u);
}
template <int NKS, bool ZINIT>
DI void qk_half(int tid, const char* st, int dofs_bytes, int kt, const bf16x8 (&qf)[NKS], f32x16& s) {
  const int lane = tid & 63;
  const char* base = st + (kt * 32 + (lane & 31)) * AK_ST + (lane >> 5) * 16 + dofs_bytes;
#pragma unroll
  for (int ks = 0; ks < NKS; ++ks) {
    const bf16x8 a = *(const bf16x8*)(base + ks * 32);
    if (ZINIT && ks == 0) { const f32x16 z = {0.f, 0.f, 0.f, 0.f, 0.f, 0.f, 0.f, 0.f, 0.f, 0.f, 0.f, 0.f, 0.f, 0.f, 0.f, 0.f}; s = MFMA32(a, qf[ks], z); }
    else s = MFMA32(a, qf[ks], s);
  }
}
DI void pv_half(int tid, const char* st, int kt, const f32x16& p, f32x16 (&o)[2]) {
  const int lane = tid & 63;
  const char* vb = st + AT_VOFF + (lane & 31) * AV_ST + (lane >> 5) * 8 + kt * 64;
#pragma unroll
  for (int sp = 0; sp < 2; ++sp) {
    const bf16x8 pb = pack_p(p, sp);
#pragma unroll
    for (int dt = 0; dt < 2; ++dt) {
      const char* a = vb + dt * 32 * AV_ST + sp * 32;
      const u32x2 lo = *(const u32x2*)a, hi = *(const u32x2*)(a + 16);
      const u32x4 u = mk4(lo.x, lo.y, hi.x, hi.y);
      o[dt] = MFMA32(__builtin_bit_cast(bf16x8, u), pb, o[dt]);
    }
  }
}
DI void load_q4(int tid, bf16x8 (&qf)[4], const u16* __restrict__ Q, int tok) {
  const int lane = tid & 63;
  const u16* b = Q + (size_t)tok * 64 + (lane >> 5) * 8;
#pragma unroll
  for (int ks = 0; ks < 4; ++ks) qf[ks] = *(const bf16x8*)(b + ks * 16);
}
DI float max_abs64(int tid, const float* w) {
  return wave_max(fabsf(w[tid & 63]));
}

struct AttnArgs {
  const u16* K; const u16* Vt; size_t ldv;
  int t0, t1;
  int q;
  int wq0;
  float M2;
  int dofs;
  int lim_hi, lim_lo, whi, wlo;
  int mask_hi, mask_lo;
  float cq; const float* cloc; const float* base;
};

template <int MODE, int NKS, bool MASK>
DI void attn_tile(int tid, const AttnArgs& a, const char* cur, int key0, int lim_hi, int lim_lo, const bf16x8 (&qf)[NKS], f32x16 (&o)[2], float& l) {
  const int h = (tid & 63) >> 5;
#pragma unroll
  for (int kt = 0; kt < 2; ++kt) {
    f32x16 s;
    if (MODE == 0) {
      const float* ckb = (const float*)(cur + AT_COFF);
#pragma unroll
      for (int rg = 0; rg < 4; ++rg) {
        const f32x4 c4 = *(const f32x4*)(ckb + 32 * kt + 8 * rg + 4 * h);
#pragma unroll
        for (int i = 0; i < 4; ++i) s[4 * rg + i] = a.cq - c4[i];
      }
      qk_half<NKS, false>(tid, cur, a.dofs, kt, qf, s);
    } else {
      qk_half<NKS, true>(tid, cur, a.dofs, kt, qf, s);
    }
#pragma unroll
    for (int i = 0; i < 16; ++i) {
      float p = __builtin_amdgcn_exp2f(s[i]);
      if (MASK) { const int key = key0 + 32 * kt + crow(i, h); if (key > lim_hi || key < lim_lo) p = 0.f; }
      s[i] = p; l += p;
    }
    pv_half(tid, cur, kt, s, o);
  }
}
template <int MODE, int NKS, bool PF2 = false>
DI void attn_loop(int tid, const AttnArgs& a, const bf16x8 (&qf)[NKS], f32x16 (&o)[2], float& l, char* smem) {
  TileRegs rA, rB; float cbA = 0.f, cbB = 0.f;
  if (a.t0 >= a.t1) return;
  tile_load(tid, rA, a.K, a.Vt, a.ldv, a.t0 * 64, true);
  if (MODE == 0 && tid < 64) cbA = a.cloc[a.t0 * 64 + tid];
  tile_store(tid, rA, smem, true);
  if (MODE == 0 && tid < 64) ((float*)(smem + AT_COFF))[tid] = (a.base[a.t0] + cbA) * LOG2E;
  __syncthreads();
  auto step = [&](int t, TileRegs& rs, float& cbs, TileRegs& rl, float& cbl, int dist) {
    char* cur = smem + ((t - a.t0) & 1) * AT_STAGE;
    char* nxt = smem + ((t - a.t0 + 1) & 1) * AT_STAGE;
    if (t + dist < a.t1) {
      tile_load(tid, rl, a.K, a.Vt, a.ldv, (t + dist) * 64, true);
      if (MODE == 0 && tid < 64) cbl = a.cloc[(t + dist) * 64 + tid];
    }
    const int key0 = t * 64;
    bool active, need_mask;
    if (MODE == 0 || MODE == 3) { active = key0 <= a.wq0 + 31; need_mask = key0 + 63 > a.wq0; }
    else if (MODE == 1) { const int nmax_w = (a.wq0 + 31 - 31) >> 4; active = (a.wq0 + 31 >= 31) && key0 <= nmax_w; need_mask = true; }
    else if (MODE == 2) { active = (key0 <= a.wq0 + 31) && (key0 + 63 >= a.wq0 - 511); need_mask = (key0 + 63 > a.wq0) || (key0 < a.wq0 + 31 - 511); }
    else { active = (key0 <= a.whi) && (key0 + 63 >= a.wlo); need_mask = (key0 + 63 > a.mask_hi) || (key0 < a.mask_lo); }
    if (active) {
      int lim_hi, lim_lo;
      if (MODE == 0 || MODE == 3) { lim_hi = a.q; lim_lo = 0; }
      else if (MODE == 1) { lim_hi = (a.q >= 31) ? ((a.q - 31) >> 4) : -1; lim_lo = 0; }
      else if (MODE == 2) { lim_hi = a.q; lim_lo = a.q - 511; }
      else { lim_hi = a.lim_hi; lim_lo = a.lim_lo; }
      if (__builtin_amdgcn_readfirstlane((int)need_mask)) attn_tile<MODE, NKS, true>(tid, a, cur, key0, lim_hi, lim_lo, qf, o, l);
      else attn_tile<MODE, NKS, false>(tid, a, cur, key0, lim_hi, lim_lo, qf, o, l);
    }
    if (t + 1 < a.t1) {
      tile_store(tid, rs, nxt, true);
      if (MODE == 0 && tid < 64) ((float*)(nxt + AT_COFF))[tid] = (a.base[t + 1] + cbs) * LOG2E;
    }
    __syncthreads();
  };
  if (!PF2) {
    for (int t = a.t0; t < a.t1; ++t) step(t, rA, cbA, rA, cbA, 1);
  } else {
    if (a.t0 + 1 < a.t1) { tile_load(tid, rA, a.K, a.Vt, a.ldv, (a.t0 + 1) * 64, true); if (MODE == 0 && tid < 64) cbA = a.cloc[(a.t0 + 1) * 64 + tid]; }
    for (int t = a.t0; t < a.t1; t += 2) {
      step(t, rA, cbA, rB, cbB, 2);
      if (t + 1 >= a.t1) break;
      step(t + 1, rB, cbB, rA, cbA, 2);
    }
  }
}

DI void zero_o(f32x16 (&o)[2]) {
#pragma unroll
  for (int d = 0; d < 2; ++d)
#pragma unroll
    for (int i = 0; i < 16; ++i) o[d][i] = 0.f;
}

DI void fox_chunk_bases(int tid, const Params& P, int hd, float* base, float* wtot) {
  const int lane = tid & 63, wave = tid >> 6;
  const float x = P.ctot[tid * 4 + hd];
  float inc = x;
#pragma unroll
  for (int o = 1; o < 64; o <<= 1) { float t = __shfl_up(inc, o); if (lane >= o) inc += t; }
  if (lane == 63) wtot[wave] = inc;
  __syncthreads();
  float off = 0.f;
  for (int w = 0; w < wave; ++w) off += wtot[w];
  base[tid] = inc - x + off;
  __syncthreads();
}

__device__ __forceinline__ void fox_item(const Params& P, int l, int hd, int qb, char* smem) {
  const int tid = opaque_tid(), lane = tid & 63, wave = tid >> 6, h = lane >> 5;
  float* base = (float*)(smem + AT_MISC);
  float* wtot = base + 256;
  fox_chunk_bases(tid, P, hd, base, wtot);
  const float M2 = 8.f * max_abs64(tid, P.fox_q_norm_w + l * 64) * max_abs64(tid, P.fox_k_norm_w + l * 64) * LOG2E * 1.01f + 0.1f;
  const int wq0 = qb * 128 + wave * 32, q = wq0 + (lane & 31);
  AttnArgs a;
  a.K = P.KF + (size_t)hd * S * 64; a.Vt = P.VFt + (size_t)hd * 64 * S; a.ldv = S;
  a.t1 = 2 * qb + 2; a.q = q; a.wq0 = wq0; a.M2 = M2;
  a.cloc = P.cloc + (size_t)hd * S; a.base = base;
  {
    const bool skip = (tid + 1 < 2 * qb) && ((base[2 * qb] - base[tid + 1]) * LOG2E < -160.f);
    a.t0 = __syncthreads_count(skip ? 1 : 0);
  }
  a.cq = (base[q >> 6] + a.cloc[q]) * LOG2E - M2;
  bf16x8 qf[4];
  load_q4(tid, qf, P.QF + (size_t)hd * S * 64, q);
  f32x16 o[2]; zero_o(o);
  float ls = 0.f;
  a.dofs = 0;
  attn_loop<0, 4, true>(tid, a, qf, o, ls, smem);
  ls += __shfl_xor(ls, 32);
  const float inv = (ABLATE & 1) ? 0.f : 1.f / ls;
  u16* dst = P.mix + (size_t)q * 1024 + hd * 64 + 4 * h;
#pragma unroll
  for (int dt = 0; dt < 2; ++dt)
#pragma unroll
    for (int rg = 0; rg < 4; ++rg)
      *(u32x2*)(dst + 32 * dt + 8 * rg) = mk2(pack2(o[dt][4 * rg] * inv, o[dt][4 * rg + 1] * inv), pack2(o[dt][4 * rg + 2] * inv, o[dt][4 * rg + 3] * inv));
}

__device__ __forceinline__ void diff_item(const Params& P, int l, int hd, int qb, char* smem) {
  const int tid = opaque_tid(), lane = tid & 63, wave = tid >> 6, h = lane >> 5;
  const float mq = wave_max(fabsf(P.diff_q_norm_w[l * 32 + (lane & 31)])), mk = wave_max(fabsf(P.diff_k_norm_w[l * 32 + (lane & 31)]));
  const float M2 = 5.656854249f * mq * mk * LOG2E * 1.01f + 0.1f;
  const float* lv = P.diff_lambda + l * 128;
  float d1 = (lane < 32) ? lv[lane] * lv[32 + lane] : 0.f, d2 = (lane < 32) ? lv[64 + lane] * lv[96 + lane] : 0.f;
  d1 = wave_sum(d1); d2 = wave_sum(d2);
  const float lam_init = 0.8f - 0.6f * expf(-0.3f * (float)l);
  const float lam = expf(d1) - expf(d2) + lam_init;
  const int wq0 = qb * 128 + wave * 32, q = wq0 + (lane & 31);
  AttnArgs a;
  a.K = P.KD + (size_t)hd * S * 64; a.Vt = P.VDt + (size_t)hd * 64 * S; a.ldv = S;
  a.t0 = 0; a.t1 = 2 * qb + 2; a.q = q; a.wq0 = wq0; a.M2 = M2; a.cq = 0.f; a.cloc = nullptr; a.base = nullptr;
  float* stash = P.dstash + (size_t)blockIdx.x * (128 * 64) + tid;
  f32x16 o[2];
#pragma unroll 1
  for (int c = 0; c < 2; ++c) {
    const int tid = opaque_tid(), lane = tid & 63, h = lane >> 5;
    bf16x8 qf[2];
    {
      const u16* b = P.QD + ((size_t)hd * S + q) * 64 + c * 32 + h * 8;
      qf[0] = *(const bf16x8*)b; qf[1] = *(const bf16x8*)(b + 16);
    }
    zero_o(o);
    float ls = 0.f;
    a.dofs = c * 64;
    attn_loop<3, 2>(tid, a, qf, o, ls, smem);
    ls += __shfl_xor(ls, 32);
    if (c == 0) {
      const float i0 = 1.f / ls;
#pragma unroll
      for (int dt = 0; dt < 2; ++dt)
#pragma unroll
        for (int i = 0; i < 16; ++i) stash[(dt * 16 + i) * 256] = o[dt][i] * i0;
    } else {
      const float i1 = lam / ls;
      float ss = 0.f;
#pragma unroll
      for (int dt = 0; dt < 2; ++dt)
#pragma unroll
        for (int i = 0; i < 16; ++i) { const float v = stash[(dt * 16 + i) * 256] - o[dt][i] * i1; o[dt][i] = v; ss += v * v; }
      ss += __shfl_xor(ss, 32);
      const float rn = rsqrtf(ss * (1.f / 64.f) + 1e-6f) * (1.f - lam_init);
      const float* sw = P.diff_subln_w + l * 64;
      u16* dst = P.mix + (size_t)q * 1024 + 768 + hd * 64 + 4 * h;
#pragma unroll
      for (int dt = 0; dt < 2; ++dt)
#pragma unroll
        for (int rg = 0; rg < 4; ++rg) {
          const int d0 = 32 * dt + 8 * rg + 4 * h;
          *(u32x2*)(dst + 32 * dt + 8 * rg) = mk2(pack2(o[dt][4 * rg] * rn * sw[d0], o[dt][4 * rg + 1] * rn * sw[d0 + 1]),
                                                 pack2(o[dt][4 * rg + 2] * rn * sw[d0 + 2], o[dt][4 * rg + 3] * rn * sw[d0 + 3]));
        }
    }
  }
}

struct SelFrags { u32x2 k[8]; u32x2 v[8]; };

DI void sel_load(int tid, SelFrags& f, const unsigned char* __restrict__ Kg, const unsigned char* __restrict__ Vtg, int b) {
  const int lane = tid & 63, i = lane & 15, h4 = lane >> 4;
  const int bu = __builtin_amdgcn_readfirstlane(b);
  const unsigned char* kb = Kg + (size_t)bu * 4096 + lane * 8;
  const unsigned char* vb = Vtg + (size_t)bu * 4096 + lane * 8;
  (void)i; (void)h4;
#pragma unroll
  for (int L = 0; L < 8; ++L) f.k[L] = *(const u32x2*)(kb + L * 512);
#pragma unroll
  for (int L = 0; L < 8; ++L) f.v[L] = *(const u32x2*)(vb + L * 512);
}
template <bool MASK>
DI void sel_compute_t(int tid, const SelFrags& f, const u32x2 (&qb)[2], int b, int qpos, float M2, f32x4 (&o)[4], f32x4& ol) {
  const int lane = tid & 63, h4 = lane >> 4;
  const float c0 = 8.f - M2;
  const u32x2 ones = mk2(0x38383838u, 0x38383838u);
#pragma unroll
  for (int G = 0; G < 2; ++G) {
    f32x4 s[2];
#pragma unroll
    for (int t = 0; t < 2; ++t) {
      s[t] = (f32x4){0.f, 0.f, 0.f, 0.f};
#pragma unroll
      for (int ks = 0; ks < 2; ++ks)
        s[t] = __builtin_amdgcn_mfma_f32_16x16x32_fp8_fp8(__builtin_bit_cast(long, f.k[G * 4 + t * 2 + ks]), __builtin_bit_cast(long, qb[ks]), s[t], 0, 0, 0);
    }
#pragma unroll
    for (int t = 0; t < 2; ++t)
#pragma unroll
      for (int r = 0; r < 4; ++r) {
        float p = __builtin_amdgcn_exp2f(s[t][r] * 0.0625f + c0);
        if (MASK) { const int key = b * 64 + 32 * G + 8 * h4 + 4 * t + r; if (key > qpos) p = 0.f; }
        s[t][r] = p;
      }
    int w0 = 0, w1 = 0;
    w0 = __builtin_amdgcn_cvt_pk_bf8_f32(s[0][0], s[0][1], w0, false);
    w0 = __builtin_amdgcn_cvt_pk_bf8_f32(s[0][2], s[0][3], w0, true);
    w1 = __builtin_amdgcn_cvt_pk_bf8_f32(s[1][0], s[1][1], w1, false);
    w1 = __builtin_amdgcn_cvt_pk_bf8_f32(s[1][2], s[1][3], w1, true);
    const u32x2 pb = mk2((u32)w0, (u32)w1);
#pragma unroll
    for (int dt = 0; dt < 4; ++dt)
      o[dt] = __builtin_amdgcn_mfma_f32_16x16x32_fp8_bf8(__builtin_bit_cast(long, f.v[G * 4 + dt]), __builtin_bit_cast(long, pb), o[dt], 0, 0, 0);
    ol = __builtin_amdgcn_mfma_f32_16x16x32_fp8_bf8(__builtin_bit_cast(long, ones), __builtin_bit_cast(long, pb), ol, 0, 0, 0);
  }
}
DI void sel_compute(int tid, const SelFrags& f, const u32x2 (&qb)[2], int b, int cur, int qpos, float M2, f32x4 (&o)[4], f32x4& ol) {
  if (__builtin_amdgcn_readfirstlane(b) == __builtin_amdgcn_readfirstlane(cur)) sel_compute_t<true>(tid, f, qb, b, qpos, M2, o, ol);
  else sel_compute_t<false>(tid, f, qb, b, qpos, M2, o, ol);
}

__device__ __forceinline__ void nsa_item(const Params& P, int l, int g, int qb, char* smem, int secmask = 7) {
  const int tid = opaque_tid(), lane = tid & 63, wave = tid >> 6, h = lane >> 5;
  const int q0 = qb * 128, wq0 = q0 + wave * 32, q = wq0 + (lane & 31), ql = wave * 32 + (lane & 31);
  const int item = g * 128 + qb;
  const float M2 = 8.f * max_abs64(tid, P.nsa_q_norm_w + l * 64) * max_abs64(tid, P.nsa_k_norm_w + l * 64) * LOG2E * 1.01f + 0.1f;
  unsigned char* sel = (unsigned char*)(smem + AT_MISC);
  unsigned char* nsel = sel + 2048;
  float* impA = P.impA + (size_t)item * 256 * 128;
  float* impB = P.impB + (size_t)item * 256 * 128;
  const u16* Kc = P.KCC + (size_t)g * 1024 * 64;
  const int ntc = ((q0 + 96) >> 10) + 1;
  const int nmaxq = (q >= 31) ? ((q - 31) >> 4) : -1;
  const int nmax_w = wq0 >> 4;

  {
    float lh[4] = {0.f, 0.f, 0.f, 0.f};
#pragma unroll 1
    for (int pass = 0; pass < 2; ++pass) {
      float inv[4];
      if (pass == 1) {
#pragma unroll
        for (int hh = 0; hh < 4; ++hh) { float t = lh[hh] + __shfl_xor(lh[hh], 32); inv[hh] = (t > 0.f) ? 1.f / t : 0.f; }
      }
      TileRegs r;
      tile_load(tid, r, Kc, nullptr, 0, 0, false);
      tile_store(tid, r, smem, false);
      __syncthreads();
      for (int t = 0; t < ntc; ++t) {
        char* cur = smem + (t & 1) * AT_STAGE;
        char* nxt = smem + ((t + 1) & 1) * AT_STAGE;
        const bool more = (t + 1 < ntc);
        if (more) tile_load(tid, r, Kc, nullptr, 0, (t + 1) * 64, false);
        const int key0 = t * 64;
        f32x16 ps[2];
#pragma unroll
        for (int kt = 0; kt < 2; ++kt)
#pragma unroll
          for (int i = 0; i < 16; ++i) ps[kt][i] = 0.f;
        if (key0 <= nmax_w) {
#pragma unroll
          for (int hh = 0; hh < 4; ++hh) {
            f32x16 s[2];
            bf16x8 qf[4];
            load_q4(tid, qf, P.QN + (size_t)(g * 4 + hh) * S * 64, q);
            qk_half<4, true>(tid, cur, 0, 0, qf, s[0]);
            qk_half<4, true>(tid, cur, 0, 1, qf, s[1]);
#pragma unroll
            for (int kt = 0; kt < 2; ++kt)
#pragma unroll
              for (int i = 0; i < 16; ++i) {
                float p = __builtin_amdgcn_exp2f(s[kt][i]);
                const int key = key0 + 32 * kt + crow(i, h);
                if (key > nmaxq) p = 0.f;
                if (pass == 0) lh[hh] += p; else ps[kt][i] += p * inv[hh];
              }
          }
        }
        if (pass == 1) {
#pragma unroll
          for (int kt = 0; kt < 2; ++kt)
#pragma unroll
            for (int rg = 0; rg < 4; ++rg) {
              const int j = 16 * t + 8 * kt + 2 * rg + h;
              impA[(size_t)j * 128 + ql] = ps[kt][4 * rg] + ps[kt][4 * rg + 1] + ps[kt][4 * rg + 2] + ps[kt][4 * rg + 3];
              impB[(size_t)j * 128 + ql] = ps[kt][4 * rg + 3];
            }
        }
        if (more) tile_store(tid, r, nxt, false);
        __syncthreads();
      }
    }
  }
  __threadfence_block();
  __syncthreads();
  {
    const int qt = tid >> 1, half = tid & 1;
    const int qp = q0 + qt, cur = qp >> 6;
    u32 lst[13];
#pragma unroll
    for (int i = 0; i < 13; ++i) lst[i] = 0u;
    for (int j0 = 1 + half; j0 <= cur - 2; j0 += 8) {
      float sc[4];
#pragma unroll
      for (int u = 0; u < 4; ++u) {
        const int j = j0 + 2 * u, jc = j <= cur - 2 ? j : 1;
        sc[u] = impA[(size_t)jc * 128 + qt] + impB[(size_t)(jc - 1) * 128 + qt];
      }
#pragma unroll
      for (int u = 0; u < 4; ++u) {
        const int j = j0 + 2 * u;
        u32 x = (j <= cur - 2) ? ((__float_as_uint(sc[u]) & 0xffffff00u) | (u32)j) : 0u;
#pragma unroll
        for (int i = 0; i < 13; ++i) { const u32 hi = max(lst[i], x); x = min(lst[i], x); lst[i] = hi; }
      }
    }
    u32 oth[13];
#pragma unroll
    for (int i = 0; i < 13; ++i) oth[i] = (u32)__shfl_xor((int)lst[i], 1);
#pragma unroll
    for (int k = 0; k < 13; ++k) {
      u32 x = oth[k];
#pragma unroll
      for (int i = 0; i < 13; ++i) { const u32 hi = max(lst[i], x); x = min(lst[i], x); lst[i] = hi; }
    }
    if (half == 0) {
      unsigned char* sp = sel + qt * 16;
      int n = 0;
      sp[n++] = 0;
      if (cur >= 1) sp[n++] = (unsigned char)cur;
      if (cur >= 2) sp[n++] = (unsigned char)(cur - 1);
      const int ncand = cur - 2 < 13 ? cur - 2 : 13;
#pragma unroll
      for (int i = 0; i < 13; ++i) if (i < ncand) sp[n++] = (unsigned char)(lst[i] & 0xffu);
      nsel[qt] = (unsigned char)n;
    }
  }
  __syncthreads();
  if (secmask & 2) {
    const unsigned char* Kg = P.KS8 + (size_t)g * S * 64; const unsigned char* Vtg = P.VS8t + (size_t)g * 64 * S;
    const int col = lane & 15, h4 = lane >> 4, hd = col & 3;
    const unsigned char* selw = sel + wave * 32 * 16;
    const unsigned char* nselw = nsel + wave * 32;
    u32x2* q8 = (u32x2*)(smem + wave * 8448);
    float* gl = (float*)(smem + 41472 + wave * 1600);
    u16* vis = (u16*)(smem + 41472 + wave * 1600 + 512);
    {
#pragma unroll 4
      for (int c = lane; c < 1024; c += 64) {
        const int qi = c >> 5, head = (c >> 3) & 3, ch = c & 7;
        const u32x4 qv = *(const u32x4*)(P.QR + ((size_t)(g * 4 + head) * S + wq0 + qi) * 64 + ch * 8);
        int w0 = 0, w1 = 0;
        w0 = __builtin_amdgcn_cvt_pk_fp8_f32(bflo(qv.x) * 16.f, bfhi(qv.x) * 16.f, w0, false);
        w0 = __builtin_amdgcn_cvt_pk_fp8_f32(bflo(qv.y) * 16.f, bfhi(qv.y) * 16.f, w0, true);
        w1 = __builtin_amdgcn_cvt_pk_fp8_f32(bflo(qv.z) * 16.f, bfhi(qv.z) * 16.f, w1, false);
        w1 = __builtin_amdgcn_cvt_pk_fp8_f32(bflo(qv.w) * 16.f, bfhi(qv.w) * 16.f, w1, true);
        q8[(qi * 8 + ch) * 4 + head] = mk2((u32)w0, (u32)w1);
      }
      if (lane < 32) q8[(32 * 8 + (lane >> 2)) * 4 + (lane & 3)] = mk2(0u, 0u);
      for (int c = lane; c < 128; c += 64) gl[c] = P.gates[(size_t)(wq0 + (c >> 2)) * 24 + (g * 4 + (c & 3)) * 3 + 1];
      int cnt = (lane < 32) ? (int)nselw[lane] : 0, pre = cnt;
#pragma unroll
      for (int o = 1; o < 32; o <<= 1) { const int t2 = __shfl_up(pre, o); if ((lane & 31) >= o) pre += t2; }
      const int V = __builtin_amdgcn_readlane(pre, 31);
      pre -= cnt;
      if (lane < 32) for (int i = 0; i < cnt; ++i) vis[pre + i] = (u16)(selw[lane * 16 + i] | (lane << 8) | (i + 1 == cnt ? 0x8000 : 0));
      if (lane < 5) vis[V + lane] = (u16)(32 << 8);
      __builtin_amdgcn_s_waitcnt(0xc07f);
      __builtin_amdgcn_wave_barrier();
      const int V3 = ((V + 2) / 3) * 3;
      SelFrags fr[3];
      sel_load(tid, fr[0], Kg, Vtg, vis[0] & 0xff);
      sel_load(tid, fr[1], Kg, Vtg, vis[1] & 0xff);
      f32x4 o[4];
#pragma unroll
      for (int dt = 0; dt < 4; ++dt) o[dt] = (f32x4){0.f, 0.f, 0.f, 0.f};
      f32x4 ol = (f32x4){0.f, 0.f, 0.f, 0.f};
#pragma unroll 1
      for (int v = 0; v < V3; v += 3) {
#pragma unroll
        for (int slot = 0; slot < 3; ++slot) {
          const int e = __builtin_amdgcn_readfirstlane((int)vis[v + slot]);
          const int e2 = __builtin_amdgcn_readfirstlane((int)vis[v + slot + 2]);
          sel_load(tid, fr[(slot + 2) % 3], Kg, Vtg, e2 & 0xff);
          const int qi = (e >> 8) & 63, bb = e & 0xff, qp = wq0 + qi;
          u32x2 qcur[2];
          qcur[0] = q8[(qi * 8 + h4) * 4 + hd]; qcur[1] = q8[(qi * 8 + 4 + h4) * 4 + hd];
          sel_compute(tid, fr[slot], qcur, bb, qp >> 6, qp, M2, o, ol);
          if (e & 0x8000) {
            const float lsum = ol[0];
            if (col < 4 && (!(secmask & 8) || lsum == 1.2345e33f)) {
              const float gs = (ABLATE & 4) ? 0.f : gl[qi * 4 + col] / lsum;
              u16* dst = P.mix + (size_t)qp * 1024 + 256 + (g * 4 + col) * 64 + 4 * h4;
#pragma unroll
              for (int dt = 0; dt < 4; ++dt)
                *(u32x2*)(dst + 16 * dt) = mk2(pack2(o[dt][0] * gs, o[dt][1] * gs), pack2(o[dt][2] * gs, o[dt][3] * gs));
            }
#pragma unroll
            for (int dt = 0; dt < 4; ++dt) o[dt] = (f32x4){0.f, 0.f, 0.f, 0.f};
            ol = (f32x4){0.f, 0.f, 0.f, 0.f};
          }
        }
      }
    }
  }
  __threadfence_block();
  __syncthreads();
#pragma unroll 1
  for (int hh = 0; hh < ((secmask & 4) ? 4 : 0); ++hh) {
    const int H = g * 4 + hh;
#pragma unroll 1
    for (int br = 0; br < 2; ++br) {
      AttnArgs a;
      a.q = q; a.wq0 = wq0; a.M2 = M2; a.cq = 0.f; a.cloc = nullptr; a.base = nullptr; a.dofs = 0;
      bf16x8 qf[4];
      f32x16 o[2]; zero_o(o);
      float ls = 0.f;
      if (br == 0) {
        load_q4(tid, qf, P.QN + (size_t)H * S * 64, q);
        a.K = Kc; a.Vt = P.VCCt + (size_t)g * 64 * 1024; a.ldv = 1024; a.t0 = 0; a.t1 = ntc;
        a.lim_hi = nmaxq; a.lim_lo = 0; a.whi = nmax_w; a.wlo = 0; a.mask_hi = (wq0 >= 31) ? ((wq0 - 31) >> 4) : -1; a.mask_lo = 0;
      } else {
        load_q4(tid, qf, P.QR + (size_t)H * S * 64, q);
        a.K = P.KW + (size_t)g * S * 64; a.Vt = P.VWt + (size_t)g * 64 * S; a.ldv = S;
        a.t0 = (q0 >> 6) - 8 < 0 ? 0 : (q0 >> 6) - 8; a.t1 = (q0 >> 6) + 2;
        a.lim_hi = q; a.lim_lo = q - 511; a.whi = wq0 + 31; a.wlo = wq0 - 511; a.mask_hi = wq0; a.mask_lo = wq0 + 31 - 511;
      }
      attn_loop<4, 4, true>(tid, a, qf, o, ls, smem);
      ls += __shfl_xor(ls, 32);
      float gt = (ls > 0.f) ? P.gates[(size_t)q * 24 + H * 3 + (br == 0 ? 0 : 2)] / ls : 0.f;
      if ((ABLATE & 2) && br == 0) gt = 0.f;
      if ((ABLATE & 8) && br == 1) gt = 0.f;
      u16* dst = P.mix + (size_t)q * 1024 + 256 + H * 64 + 4 * h;
      if (!(secmask & 8) || ls == 1.2345e33f)
#pragma unroll
      for (int dt = 0; dt < 2; ++dt)
#pragma unroll
        for (int rg = 0; rg < 4; ++rg) {
          u32x2* pp = (u32x2*)(dst + 32 * dt + 8 * rg);
          const u32x2 old = *pp;
          const float r0 = bflo(old.x) + gt * o[dt][4 * rg];
          const float r1 = bfhi(old.x) + gt * o[dt][4 * rg + 1];
          const float r2 = bflo(old.y) + gt * o[dt][4 * rg + 2];
          const float r3 = bfhi(old.y) + gt * o[dt][4 * rg + 3];
          *pp = mk2(pack2(r0, r1), pack2(r2, r3));
        }
    }
  }
}

DI unsigned xcc_id() { return (unsigned)__builtin_amdgcn_s_getreg((3 << 11) | 20) & 0xFu; }

__device__ __forceinline__ void phase_attention(const Params& P, int l, char* smem, unsigned* counter, int secmask = 7, bool nsa_only = false) {
  int* slot = (int*)(smem + AT_MISC + 4096);
  const int mygrp = (int)(xcc_id() & 1u);
#pragma unroll 1
  for (int pass = 0; pass < 2; ++pass) {
    const int g = pass == 0 ? mygrp : 1 - mygrp;
    for (;;) {
      __syncthreads();
      if (threadIdx.x == 0) *slot = (int)atomicAdd(counter + g, 1u);
      __syncthreads();
      const int it = *slot;
      if (it >= 128) break;
      nsa_item(P, l, g, 127 - it, smem, secmask);
    }
  }
  for (;;) {
    __syncthreads();
    if (threadIdx.x == 0) *slot = (int)atomicAdd(counter + 2, 1u);
    __syncthreads();
    const int it = *slot;
    if (it >= 1024 || nsa_only) break;
    const int qb = 127 - (it >> 3), k = it & 7;
    if (k < 4) diff_item(P, l, k, qb, smem); else fox_item(P, l, k - 4, qb, smem);
  }
}

__device__ __forceinline__ void phase_outproj(const Params& P, int l, char* smem, bool dry = false) {
  const u16* Wt = P.WoutT + (size_t)l * D * D;
  float* tile = (float*)smem;
  const int tid = threadIdx.x;
  for (int it = blockIdx.x; it < 128 * 8; it += gridDim.x) {
    const int mt = it >> 3, nt = it & 7;
    f32x16 acc[2][2];
    zero_acc(acc);
    gemm_mainloop<false>(P.mix + (size_t)mt * 128 * D, D, Wt + (size_t)nt * 128 * D, D, D, smem, acc);
    acc_to_lds(acc, tile);
    __syncthreads();
    const int c4 = (tid & 31) * 4, r0 = tid >> 5;
#pragma unroll 4
    for (int i = 0; i < 16; ++i) {
      const int row = r0 + 8 * i;
      const size_t idx = (size_t)(mt * 128 + row) * D + nt * 128 + c4;
      const f32x4 a4 = *(const f32x4*)(tile + row * EPS_LD + c4);
      f32x4 h4 = *(const f32x4*)(P.out + idx);
      h4 += a4;
      if (!dry || h4[0] == 1.2345e33f) {
        *(f32x4*)(P.out + idx) = h4;
        *(u32x2*)(P.hb2 + idx) = mk2(pack2(h4[0], h4[1]), pack2(h4[2], h4[3]));
      }
    }
  }
}

constexpr int QT_ST = 272;
DI u32 ord_key(float x, u32 idx) {
  u32 u = __float_as_uint(x);
  u = (u & 0x80000000u) ? ~u : (u | 0x80000000u);
  return (u & 0xffffff80u) | idx;
}
DI float ord_val(u32 k) {
  return (k & 0x80000000u) ? __uint_as_float(k & 0x7fffff80u) : __uint_as_float((~k) & 0xffffff80u);
}
DI void merge16(u32 (&lst)[16], int xm) {
  u32 c[16];
#pragma unroll
  for (int i = 0; i < 16; ++i) { const u32 o = (u32)__shfl_xor((int)lst[15 - i], xm); c[i] = max(lst[i], o); }
#pragma unroll
  for (int st = 8; st > 0; st >>= 1)
#pragma unroll
    for (int i = 0; i < 16; ++i)
      if ((i & st) == 0) { const u32 a = max(c[i], c[i + st]), b = min(c[i], c[i + st]); c[i] = a; c[i + st] = b; }
#pragma unroll
  for (int i = 0; i < 16; ++i) lst[i] = c[i];
}

__device__ __forceinline__ void phase_peerq(const Params& P, int l, char* smem) {
  const u16* Wt = P.WqT + (size_t)l * 2048 * D;
  const int tid = threadIdx.x, lane = tid & 63, wave = tid >> 6, wr = wave >> 1, wc = wave & 1, h = lane >> 5;
  const float* rs = (const float*)(smem + G_RS_OFF);
  float* tile = (float*)smem;
  for (int it = blockIdx.x; it < 128 * 16; it += gridDim.x) {
    const int mt = it >> 4, nt = it & 15;
    f32x16 acc[2][2];
    zero_acc(acc);
    gemm_mainloop<true>(P.hb2 + (size_t)mt * 128 * D, D, Wt + (size_t)nt * 128 * D, D, D, smem, acc);
    __syncthreads();
#pragma unroll
    for (int i = 0; i < 2; ++i)
#pragma unroll
      for (int j = 0; j < 2; ++j)
#pragma unroll
        for (int r = 0; r < 16; ++r) {
          const int row = wr * 64 + i * 32 + crow(r, h);
          *(u16*)(smem + row * QT_ST + (wc * 64 + j * 32 + (lane & 31)) * 2) = f2bf(acc[i][j][r] * rs[row]);
        }
    __syncthreads();
    zero_acc(acc);
    {
      const u16* Bk = P.SubK + ((size_t)(l * 16 + nt) * 128 + wc * 64 + (lane & 31)) * 128 + h * 8;
      const char* Aq = smem + (wr * 64 + (lane & 31)) * QT_ST + h * 16;
#pragma unroll
      for (int ks = 0; ks < 8; ++ks) {
        bf16x8 af[2], bfr[2];
#pragma unroll
        for (int i = 0; i < 2; ++i) af[i] = *(const bf16x8*)(Aq + i * 32 * QT_ST + ks * 32);
#pragma unroll
        for (int j = 0; j < 2; ++j) bfr[j] = *(const bf16x8*)(Bk + (size_t)j * 32 * 128 + ks * 16);
#pragma unroll
        for (int i = 0; i < 2; ++i)
#pragma unroll
          for (int j = 0; j < 2; ++j) acc[i][j] = MFMA32(af[i], bfr[j], acc[i][j]);
      }
    }
    __syncthreads();
    acc_to_lds(acc, tile);
    __syncthreads();
#pragma unroll 1
    for (int half = 0; half < 2; ++half) {
      {
        const int row = half * 64 + (tid >> 2), part = tid & 3;
        u32 lst[16];
#pragma unroll
        for (int i = 0; i < 16; ++i) lst[i] = 0u;
        const f32x4* src = (const f32x4*)(tile + row * EPS_LD + part * 32);
#pragma unroll
        for (int c4 = 0; c4 < 8; ++c4) {
          const f32x4 v = src[c4];
#pragma unroll
          for (int e = 0; e < 4; ++e) {
            u32 x = ord_key(v[e], (u32)(part * 32 + c4 * 4 + e));
#pragma unroll
            for (int i = 0; i < 16; ++i) { const u32 hi = max(lst[i], x); x = min(lst[i], x); lst[i] = hi; }
          }
        }
        merge16(lst, 1);
        merge16(lst, 2);
        if (part == 0) {
          u32x4* dp = (u32x4*)(P.topk + ((size_t)(mt * 128 + row) * 16 + nt) * 16);
          dp[0] = mk4(lst[0], lst[1], lst[2], lst[3]); dp[1] = mk4(lst[4], lst[5], lst[6], lst[7]);
          dp[2] = mk4(lst[8], lst[9], lst[10], lst[11]); dp[3] = mk4(lst[12], lst[13], lst[14], lst[15]);
        }
      }
    }
  }
}

__device__ const unsigned char kCandIJ[50] = {
  0x00,0x01,0x02,0x03,0x04,0x05,0x06,0x07,0x08,0x09,0x0a,0x0b,0x0c,0x0d,0x0e,0x0f,
  0x10,0x11,0x12,0x13,0x14,0x15,0x16,0x17,
  0x20,0x21,0x22,0x23,0x24,
  0x30,0x31,0x32,0x33,
  0x40,0x41,0x42,
  0x50,0x51, 0x60,0x61, 0x70,0x71,
  0x80,0x90,0xa0,0xb0,0xc0,0xd0,0xe0,0xf0};
DI float gelu_exact(float x) { return 0.5f * x * (1.f + erff(x * 0.7071067811865476f)); }

__device__ __forceinline__ void phase_peer(const Params& P, int l, char* smem, bool dry = false) {
  const int tid = threadIdx.x, lane = tid & 63, wave = tid >> 6;
  char* wsm = smem + wave * 8192;
  u32* keys = (u32*)wsm;
  u32* cvk = (u32*)(wsm + 1024);
  int* exps = (int*)(wsm + 1024 + 1664);
  float* esc = (float*)(wsm + 3200);
  float* wts = (float*)(wsm + 3712);
  float* hraw = (float*)(wsm + 4224);
  unsigned char* xrow8 = (unsigned char*)(wsm + 5248);
  const unsigned char* U8 = P.U8 + (size_t)l * S * (D / 2);
  const unsigned char* V8 = P.V8 + (size_t)l * S * (D / 2);
  const float* Uinv = P.Uinv + l * S; const float* Vinv = P.Vinv + l * S;
  if (lane < 16) cvk[(lane >> 1) * 52 + 50 + (lane & 1)] = 0u;
  int it = blockIdx.x;
  u32x4 kq = mk4(0u, 0u, 0u, 0u), xa = kq, xb = kq;
  if (it < S / 4) {
    const int tok = it * 4 + wave;
    kq = *(const u32x4*)(P.topk + (size_t)tok * 256 + lane * 4);
    xa = *(const u32x4*)(P.hb2 + (size_t)tok * D + lane * 16); xb = *(const u32x4*)(P.hb2 + (size_t)tok * D + lane * 16 + 8);
  }
  for (; it < S / 4; it += gridDim.x) {
    const int tok = it * 4 + wave;
    *(u32x4*)(keys + lane * 4) = kq;
    float rstd = wave_sum(ssq8(xa) + ssq8(xb));
    rstd = rsqrtf(rstd * (1.f / 1024.f) + 1e-6f);
    float xinv;
    {
      float xv[16] = {bflo(xa.x), bfhi(xa.x), bflo(xa.y), bfhi(xa.y), bflo(xa.z), bfhi(xa.z), bflo(xa.w), bfhi(xa.w),
                      bflo(xb.x), bfhi(xb.x), bflo(xb.y), bfhi(xb.y), bflo(xb.z), bfhi(xb.z), bflo(xb.w), bfhi(xb.w)};
      float m = 0.f;
#pragma unroll
      for (int i = 0; i < 16; ++i) m = fmaxf(m, fabsf(xv[i]));
      m = wave_max(m);
      const float sx = (m > 0.f) ? 240.f / m : 0.f;
      xinv = m * (1.f / 240.f);
      u32 o4[4];
#pragma unroll
      for (int i = 0; i < 4; ++i) {
        int wd = 0;
        wd = __builtin_amdgcn_cvt_pk_fp8_f32(xv[4 * i] * sx, xv[4 * i + 1] * sx, wd, false);
        wd = __builtin_amdgcn_cvt_pk_fp8_f32(xv[4 * i + 2] * sx, xv[4 * i + 3] * sx, wd, true);
        o4[i] = (u32)wd;
      }
      *(u32x4*)(xrow8 + lane * 16) = mk4(o4[0], o4[1], o4[2], o4[3]);
    }
    {
      const int nit = it + gridDim.x;
      if (nit < S / 4) {
        const int ntok = nit * 4 + wave;
        kq = *(const u32x4*)(P.topk + (size_t)ntok * 256 + lane * 4);
        xa = *(const u32x4*)(P.hb2 + (size_t)ntok * D + lane * 16); xb = *(const u32x4*)(P.hb2 + (size_t)ntok * D + lane * 16 + 8);
      }
    }
    __builtin_amdgcn_s_waitcnt(0xc07f);
    const int hd = lane >> 3, sub = lane & 7;
    float myv[7]; int mye[7]; u32 mk[7];
#pragma unroll
    for (int m = 0; m < 7; ++m) {
      const int c = sub + 8 * m;
      myv[m] = -3.0e38f; mye[m] = 0; mk[m] = 0u;
      if (m < 6 || c < 50) {
        const int ij = kCandIJ[c], i = ij >> 4, j = ij & 15;
        const u32 k1 = keys[(hd * 2) * 16 + i], k2 = keys[(hd * 2 + 1) * 16 + j];
        myv[m] = ord_val(k1) + ord_val(k2);
        mye[m] = (int)((k1 & 127u) * 128u + (k2 & 127u));
        u32 sk = __float_as_uint(myv[m]);
        sk = (sk & 0x80000000u) ? ~sk : (sk | 0x80000000u);
        mk[m] = (sk & 0xffffffc0u) | (u32)(63 - c);
        cvk[hd * 52 + c] = mk[m];
      }
    }
    __builtin_amdgcn_s_waitcnt(0xc07f);
    {
      int rk[7];
#pragma unroll
      for (int m = 0; m < 7; ++m) rk[m] = 0;
#pragma unroll
      for (int j = 0; j < 13; ++j) {
        const u32x4 o = *(const u32x4*)(cvk + hd * 52 + 4 * j);
#pragma unroll
        for (int m = 0; m < 7; ++m) rk[m] += (int)(o.x > mk[m]) + (int)(o.y > mk[m]) + (int)(o.z > mk[m]) + (int)(o.w > mk[m]);
      }
#pragma unroll
      for (int m = 0; m < 7; ++m) {
        const int c = sub + 8 * m;
        if ((m < 6 || c < 50) && rk[m] < 16) { exps[hd * 16 + rk[m]] = mye[m]; esc[hd * 16 + rk[m]] = myv[m]; }
      }
    }
    __builtin_amdgcn_s_waitcnt(0xc07f);
    const int ex0 = exps[lane], ex1 = exps[lane + 64];
    const float ui0 = Uinv[ex0], ui1 = Uinv[ex1], vi0 = Vinv[ex0], vi1 = Vinv[ex1];
    float g0, g1;
    {
      const float mx = esc[hd * 16];
      const float e0 = expf(esc[hd * 16 + 2 * sub] - mx), e1 = expf(esc[hd * 16 + 2 * sub + 1] - mx);
      float sm = e0 + e1;
      sm += __shfl_xor(sm, 1); sm += __shfl_xor(sm, 2); sm += __shfl_xor(sm, 4);
      g0 = e0 / sm; g1 = e1 / sm;
    }
    wts[hd * 16 + 2 * sub] = g0; wts[hd * 16 + 2 * sub + 1] = g1;
    {
      const int i16 = lane & 15, h4 = lane >> 4;
      u32x4 a0[8], a1[8];
      auto uload = [&](u32x4 (&a)[8], int g) {
        const unsigned char* urow = U8 + (u32)(exps[g * 16 + i16] * (D / 2) + 16 * h4);
#pragma unroll
        for (int i = 0; i < 8; ++i) a[i] = *(const u32x4*)(urow + i * 64);
      };
      auto umma = [&](const u32x4 (&a)[8], int g) {
        f32x4 acc = (f32x4){0.f, 0.f, 0.f, 0.f};
#pragma unroll
        for (int i = 0; i < 8; ++i) {
          const u32x4 b0 = *(const u32x4*)(xrow8 + i * 128 + 16 * h4), b1 = *(const u32x4*)(xrow8 + i * 128 + 64 + 16 * h4);
          const i32x8 A = {(int)a[i].x, (int)a[i].y, (int)a[i].z, (int)a[i].w, 0, 0, 0, 0};
          const i32x8 B = {(int)b0.x, (int)b0.y, (int)b0.z, (int)b0.w, (int)b1.x, (int)b1.y, (int)b1.z, (int)b1.w};
          acc = __builtin_amdgcn_mfma_scale_f32_16x16x128_f8f6f4(A, B, acc, 4, 0, 0, 0x7f7f7f7f, 0, 0x7f7f7f7f);
        }
        if (i16 == 0) *(f32x4*)(hraw + g * 16 + 4 * h4) = acc;
      };
      uload(a0, 0);
#pragma unroll 1
      for (int g = 0; g < 8; g += 2) {
        uload(a1, g + 1);
        umma(a0, g);
        if (g + 2 < 8) uload(a0, g + 2);
        umma(a1, g + 1);
      }
    }
    __builtin_amdgcn_s_waitcnt(0xc07f);
    {
      const float h0 = hraw[lane], h1 = hraw[lane + 64];
      const float w0 = wts[lane], w1 = wts[lane + 64];
      wts[lane] = w0 * gelu_exact(rstd * h0 * ui0 * xinv) * vi0;
      wts[lane + 64] = w1 * gelu_exact(rstd * h1 * ui1 * xinv) * vi1;
    }
    __builtin_amdgcn_s_waitcnt(0xc07f);
    float o[16];
#pragma unroll
    for (int i = 0; i < 16; ++i) o[i] = 0.f;
    {
      u32x2 va[8], vb2[8];
      auto vload = [&](u32x2 (&x0)[8], int k) {
#pragma unroll
        for (int u = 0; u < 8; ++u) x0[u] = *(const u32x2*)(V8 + (u32)(exps[k + u] * (D / 2) + lane * 8));
      };
      auto vacc = [&](const u32x2 (&x0)[8], int k) {
#pragma unroll
        for (int u = 0; u < 8; ++u) {
          const float w = wts[k + u];
#pragma unroll
          for (int c = 0; c < 2; ++c) {
            const f32x2 d0 = __builtin_amdgcn_cvt_scalef32_pk_f32_fp4(x0[u][c], 1.0f, 0), d1 = __builtin_amdgcn_cvt_scalef32_pk_f32_fp4(x0[u][c], 1.0f, 1);
            const f32x2 d2 = __builtin_amdgcn_cvt_scalef32_pk_f32_fp4(x0[u][c], 1.0f, 2), d3 = __builtin_amdgcn_cvt_scalef32_pk_f32_fp4(x0[u][c], 1.0f, 3);
            o[8 * c] += w * d0[0]; o[8 * c + 1] += w * d0[1]; o[8 * c + 2] += w * d1[0]; o[8 * c + 3] += w * d1[1];
            o[8 * c + 4] += w * d2[0]; o[8 * c + 5] += w * d2[1]; o[8 * c + 6] += w * d3[0]; o[8 * c + 7] += w * d3[1];
          }
        }
      };
      vload(va, 0);
#pragma unroll 1
      for (int k = 0; k < 128; k += 16) {
        vload(vb2, k + 8);
        vacc(va, k);
        if (k + 16 < 128) vload(va, k + 16);
        vacc(vb2, k + 8);
      }
    }
    if (!dry || o[0] == 1.2345e33f) {
      f32x4* op = (f32x4*)(P.out + (size_t)tok * D + lane * 16);
      float r[16];
#pragma unroll
      for (int i = 0; i < 4; ++i) { f32x4 t = op[i]; t.x += o[4 * i]; t.y += o[4 * i + 1]; t.z += o[4 * i + 2]; t.w += o[4 * i + 3]; op[i] = t; r[4 * i] = t.x; r[4 * i + 1] = t.y; r[4 * i + 2] = t.z; r[4 * i + 3] = t.w; }
      u32x4* hp = (u32x4*)(P.hb2 + (size_t)tok * D + lane * 16);
      hp[0] = mk4(pack2(r[0], r[1]), pack2(r[2], r[3]), pack2(r[4], r[5]), pack2(r[6], r[7]));
      hp[1] = mk4(pack2(r[8], r[9]), pack2(r[10], r[11]), pack2(r[12], r[13]), pack2(r[14], r[15]));
    }
  }
}

__device__ __forceinline__ void phase_ple(const Params& P, int l, char* smem, bool dry = false) {
  const u16* Wg = P.WgT + (size_t)l * D * D;
  const u16* Wp = P.WpT + (size_t)l * D * 256;
  const u16* pb = P.pb + (size_t)l * S * 256;
  const int tid = threadIdx.x, lane = tid & 63, wave = tid >> 6, wr = wave >> 1, h = lane >> 5;
  const float* rs = (const float*)(smem + G_RS_OFF);
  float* tile = (float*)smem;
  for (int it = blockIdx.x; it < 128 * 8; it += gridDim.x) {
    const int mt = it >> 3, nt = it & 7;
    f32x16 acc[2][2];
    zero_acc(acc);
    gemm_mainloop<false>(pb + (size_t)mt * 128 * 256, 256, Wp + (size_t)nt * 128 * 256, 256, 256, smem, acc);
    u16* side = (u16*)(smem + 36864);
    const int wc = wave & 1;
#pragma unroll
    for (int i = 0; i < 2; ++i)
#pragma unroll
      for (int j = 0; j < 2; ++j)
#pragma unroll
        for (int r = 0; r < 16; ++r)
          side[(wr * 64 + i * 32 + crow(r, h)) * 136 + wc * 64 + j * 32 + (lane & 31)] = f2bf(acc[i][j][r]);
    zero_acc(acc);
    gemm_mainloop<true>(P.hb2 + (size_t)mt * 128 * D, D, Wg + (size_t)nt * 128 * D, D, D, smem, acc);
    __syncthreads();
#pragma unroll
    for (int i = 0; i < 2; ++i)
#pragma unroll
      for (int j = 0; j < 2; ++j)
#pragma unroll
        for (int r = 0; r < 16; ++r) {
          const int row = wr * 64 + i * 32 + crow(r, h);
          const float pv = bf2f(side[row * 136 + wc * 64 + j * 32 + (lane & 31)]);
          acc[i][j][r] = sigmoidf_(acc[i][j][r] * rs[row]) * pv;
        }
    __syncthreads();
    acc_to_lds(acc, tile);
    __syncthreads();
    const int c4 = (tid & 31) * 4, r0 = tid >> 5;
#pragma unroll 4
    for (int i = 0; i < 16; ++i) {
      const int row = r0 + 8 * i;
      const size_t idx = (size_t)(mt * 128 + row) * D + nt * 128 + c4;
      const f32x4 a4 = *(const f32x4*)(tile + row * EPS_LD + c4);
      f32x4 h4 = *(const f32x4*)(P.out + idx);
      h4 += a4;
      if (!dry || h4[0] == 1.2345e33f) {
        *(f32x4*)(P.out + idx) = h4;
        *(u32x2*)(P.hb + idx) = mk2(pack2(h4[0], h4[1]), pack2(h4[2], h4[3]));
      }
    }
  }
}

constexpr int N_PHASES = 15;
#define XB_TMO      128
#define XB_XCNT(j)  (256  + 64 * (j))
#define XB_XSUB(j)  (1280 + 64 * (j))
#define XB_XGEN(j)  (2304 + 64 * (j))
#define XB_TOP      3328
#define XB_TOPGEN   3392
#define XCD_BAR_WORDS 3456
#define XB_SPIN_CAP (1u << 24)
typedef __attribute__((address_space(3))) unsigned las_u32;
DI unsigned xb_ld(unsigned* p) { return __hip_atomic_load(p, __ATOMIC_RELAXED, __HIP_MEMORY_SCOPE_AGENT); }
DI unsigned xb_add(unsigned* p, unsigned v) { return __hip_atomic_fetch_add(p, v, __ATOMIC_RELAXED, __HIP_MEMORY_SCOPE_AGENT); }
#define XB_SPIN(cond, bar) do { unsigned _sp = 0; while (cond) { __builtin_amdgcn_s_sleep(1); \
    if ((++_sp & 255u) == 0u) { if (xb_ld(&(bar)[XB_TMO])) break; if (_sp > XB_SPIN_CAP) { (void)xb_add(&(bar)[XB_TMO], 1u); break; } } } } while (0)
struct XcdBarrier { unsigned* bar; unsigned x; volatile las_u32* st; };
DI XcdBarrier xcd_barrier_post(unsigned* bar, volatile las_u32* st) {
  XcdBarrier b; b.bar = bar; b.x = (unsigned)__builtin_amdgcn_s_getreg((3 << 11) | 20) & 0xFu; b.st = st;
  if (threadIdx.x == 0) (void)xb_add(&bar[XB_XCNT(b.x)], 1u);
  return b;
}
DI void xcd_barrier_complete(unsigned* bar, unsigned x, unsigned& nloc, unsigned& nx) {
  const unsigned G = gridDim.x * gridDim.y * gridDim.z;
  unsigned sum, cnt, mine, sp = 0u;
  for (;;) {
    sum = 0u; cnt = 0u; mine = 0u;
#pragma unroll
    for (unsigned j = 0; j < 16; ++j) { const unsigned c = xb_ld(&bar[XB_XCNT(j)]); sum += c; cnt += (c > 0u) ? 1u : 0u; mine = (j == x) ? c : mine; }
    if (sum == G) break;
    __builtin_amdgcn_s_sleep(1);
    if ((++sp & 255u) == 0u) { if (xb_ld(&bar[XB_TMO])) break; if (sp > XB_SPIN_CAP) { (void)xb_add(&bar[XB_TMO], 1u); break; } }
  }
  nloc = mine > 0u ? mine : 1u; nx = cnt > 0u ? cnt : 1u;
}
DI void xcd_barrier(unsigned* xbar, unsigned xx, volatile las_u32* xst_) {
  XcdBarrier b; b.bar = xbar; b.x = xx; b.st = xst_;
  asm volatile("s_waitcnt vmcnt(0)" ::: "memory");
  __syncthreads();
  if (threadIdx.x == 0) {
    unsigned* bar = b.bar;
    __builtin_amdgcn_s_waitcnt(0);
    unsigned nloc = b.st[0], nx = b.st[1];
    if (nloc == 0u) { xcd_barrier_complete(bar, b.x, nloc, nx); b.st[0] = nloc; b.st[1] = nx; }
    const unsigned old = xb_add(&bar[XB_XSUB(b.x)], 1u);
    const unsigned gen = old / nloc;
    if (old + 1u == (gen + 1u) * nloc) {
      __builtin_amdgcn_fence(__ATOMIC_RELEASE, "agent");
      asm volatile("s_waitcnt vmcnt(0)" ::: "memory");
      const unsigned og = xb_add(&bar[XB_TOP], 1u);
      const unsigned tg = og / nx;
      if (og + 1u == (tg + 1u) * nx) xb_add(&bar[XB_TOPGEN], 1u);
      else XB_SPIN(xb_ld(&bar[XB_TOPGEN]) == tg, bar);
      __builtin_amdgcn_fence(__ATOMIC_ACQUIRE, "agent");
      xb_add(&bar[XB_XGEN(b.x)], 1u);
      asm volatile("s_waitcnt vmcnt(0)" ::: "memory");
    } else {
      XB_SPIN(xb_ld(&bar[XB_XGEN(b.x)]) == gen, bar);
      __builtin_amdgcn_fence(__ATOMIC_ACQUIRE, "agent");
      asm volatile("s_waitcnt vmcnt(0)" ::: "memory");
    }
  }
  __syncthreads();
}
__global__ void __launch_bounds__(NT, 2) hymba_mega(Params P, unsigned* counters) {
  __shared__ __attribute__((aligned(16))) char smem[SMEM_BYTES];
  cg::grid_group grid = cg::this_grid();
  const int lo = P.phase_lo, hi = P.phase_hi;
#ifndef ONLY_PHASE
#define ONLY_PHASE -1
#endif
#define PH_ON(k) (ONLY_PHASE < 0 || ONLY_PHASE == (k))
  volatile las_u32* xst = (volatile las_u32*)(smem + SMEM_BYTES - 16);
  if (threadIdx.x < 4) xst[threadIdx.x] = 0u;
  __syncthreads();
  unsigned* const xbar = counters + 64;
  const unsigned xcc = xcd_barrier_post(xbar, xst).x;
#define RUN(ph, kind, call) if (lo <= (ph) && (ph) < hi) { const bool dry = false; const int rep = 0; (void)dry; (void)rep; if (PH_ON(kind)) { call; } if ((ph) + 1 < hi) { if ((ph) == 0) grid.sync(); else xcd_barrier(xbar, xcc, xst); } }
#define RUNREP(ph, kind, call) if (lo <= (ph) && (ph) < hi) { \
    const int nrep = ((ph) == P.rep_ph) ? P.rep_n : 1; \
    for (int rep = 0; rep < nrep; ++rep) { const bool dry = rep > 0; (void)dry; \
      if (PH_ON(kind)) { call; } \
      if ((ph) + 1 < hi || rep + 1 < nrep) { xcd_barrier(xbar, xcc, xst); } } }
#ifndef REPEAT
#define REPEAT -1
#define RSEC 7
#endif
  RUN(0, 7, phase_prep(P, smem))
  RUN(1, 0, phase_inproj(P, 0, smem))
  RUN(2, 1, phase_compress(P, 0, smem))
  RUNREP(3, 2, phase_attention(P, 0, smem, counters + 4 * rep, dry ? (P.rep_sec | 8) : 7, dry && P.rep_nsa_only))
  RUN(4, 3, phase_outproj(P, 0, smem, dry))
  RUN(5, 4, phase_peerq(P, 0, smem))
  RUN(6, 5, phase_peer(P, 0, smem, dry))
  RUN(7, 6, phase_ple(P, 0, smem, dry))
  RUN(8, 0, phase_inproj(P, 1, smem))
  RUN(9, 1, phase_compress(P, 1, smem))
  RUN(10, 2, phase_attention(P, 1, smem, counters + 16))
  RUN(11, 3, phase_outproj(P, 1, smem))
  RUN(12, 4, phase_peerq(P, 1, smem))
  RUN(13, 5, phase_peer(P, 1, smem))
  RUN(14, 6, phase_ple(P, 1, smem))
}

static size_t align_up(size_t x, size_t a) { return (x + a - 1) / a * a; }

extern "C" void kernel_launch(void* const* d_in, const int* in_sizes, int n_in, void* d_out, int out_size, void* d_ws, size_t ws_size, hipStream_t stream) {
  static int grid_blocks = 0;
  if (!grid_blocks) {
    int dev = 0, cus = 0, per_cu = 0;
    hipGetDevice(&dev);
    hipDeviceGetAttribute(&cus, hipDeviceAttributeMultiprocessorCount, dev);
    hipOccupancyMaxActiveBlocksPerMultiprocessor(&per_cu, hymba_mega, NT, 0);
    if (per_cu > 2) per_cu = 2;
    if (per_cu < 1) per_cu = 1;
    grid_blocks = cus * per_cu;
  }
  Params P;
  memset(&P, 0, sizeof(P));
  P.x = (const float*)d_in[0]; P.p = (const float*)d_in[1]; P.positions = (const int*)d_in[2];
  P.attn_norm_w = (const float*)d_in[3]; P.w_in = (const float*)d_in[4]; P.fox_f_bias = (const float*)d_in[5];
  P.fox_q_norm_w = (const float*)d_in[6]; P.fox_k_norm_w = (const float*)d_in[7];
  P.nsa_q_norm_w = (const float*)d_in[8]; P.nsa_k_norm_w = (const float*)d_in[9]; P.nsa_cmp_pos = (const float*)d_in[10]; P.nsa_cmp_w = (const float*)d_in[11];
  P.diff_q_norm_w = (const float*)d_in[12]; P.diff_k_norm_w = (const float*)d_in[13]; P.diff_lambda = (const float*)d_in[14]; P.diff_subln_w = (const float*)d_in[15];
  P.w_out = (const float*)d_in[16]; P.ffn_norm_w = (const float*)d_in[17]; P.peer_w_q = (const float*)d_in[18]; P.peer_sub_keys = (const float*)d_in[19];
  P.peer_u = (const float*)d_in[20]; P.peer_v = (const float*)d_in[21]; P.ple_norm_w = (const float*)d_in[22]; P.ple_w_gate = (const float*)d_in[23]; P.ple_w_proj = (const float*)d_in[24];
  P.out = (float*)d_out;
  char* w = (char*)d_ws; size_t off = 0;
  auto take = [&](size_t bytes) { char* p = w + off; off = align_up(off + bytes, 256); return p; };
  unsigned* counters = (unsigned*)take(256 + XCD_BAR_WORDS * 4);
  P.WinT = (u16*)take((size_t)2 * NINP * D * 2);
  P.WoutT = (u16*)take((size_t)2 * D * D * 2);
  P.WqT = (u16*)take((size_t)2 * 2048 * D * 2);
  P.WgT = (u16*)take((size_t)2 * D * D * 2);
  P.WpT = (u16*)take((size_t)2 * D * 256 * 2);
  P.SubK = (u16*)take((size_t)2 * 16 * 128 * 128 * 2);
  P.CmpWT = (u16*)take((size_t)2 * 2 * 128 * 2048 * 2);
  P.cmpbias = (float*)take(2 * 2 * 64 * 4);
  P.U8 = (unsigned char*)take((size_t)2 * S * D / 2);
  P.V8 = (unsigned char*)take((size_t)2 * S * D / 2);
  P.Uinv = (float*)take((size_t)2 * S * 4); P.Vinv = (float*)take((size_t)2 * S * 4);
  P.hb = (u16*)take((size_t)S * D * 2);
  P.hb2 = (u16*)take((size_t)S * D * 2);
  P.pb = (u16*)take((size_t)2 * S * 256 * 2);
  P.ropeN = (float*)take((size_t)S * 64 * 4);
  P.ropeD = (float*)take((size_t)S * 32 * 4);
  P.QF = (u16*)take((size_t)4 * S * 64 * 2); P.KF = (u16*)take((size_t)4 * S * 64 * 2); P.VFt = (u16*)take((size_t)4 * S * 64 * 2);
  P.cloc = (float*)take((size_t)4 * S * 4); P.ctot = (float*)take(256 * 4 * 4);
  P.QN = (u16*)take((size_t)8 * S * 64 * 2); P.QR = (u16*)take((size_t)8 * S * 64 * 2);
  P.KC = (u16*)take((size_t)2 * (S + 64) * 64 * 2); P.VC = (u16*)take((size_t)2 * (S + 64) * 64 * 2);
  P.KCC = (u16*)take((size_t)2 * 1024 * 64 * 2); P.VCCt = (u16*)take((size_t)2 * 64 * 1024 * 2);
  P.KS8 = (unsigned char*)take((size_t)2 * S * 64); P.VS8t = (unsigned char*)take((size_t)2 * S * 64);
  P.KW = (u16*)take((size_t)2 * S * 64 * 2); P.VWt = (u16*)take((size_t)2 * S * 64 * 2);
  P.gates = (float*)take((size_t)S * 24 * 4);
  P.QD = (u16*)take((size_t)4 * S * 64 * 2); P.KD = (u16*)take((size_t)4 * S * 64 * 2); P.VDt = (u16*)take((size_t)4 * S * 64 * 2);
  P.mix = (u16*)take((size_t)S * D * 2);
  P.dstash = (float*)take((size_t)grid_blocks * 128 * 64 * 4);
  P.impA = (float*)take((size_t)256 * 256 * 128 * 4); P.impB = (float*)take((size_t)256 * 256 * 128 * 4);
  P.topk = (u32*)take((size_t)S * 256 * 4);
  if (off > ws_size) { fprintf(stderr, "kernel_launch: workspace too small: need %zu, have %zu\n", off, ws_size); return; }
  hipMemsetAsync(counters, 0, 256 + XCD_BAR_WORDS * 4, stream);
#ifndef SINGLE_LAUNCH
#define SINGLE_LAUNCH 1
#endif
#ifndef REP_PH
#define REP_PH -1
#endif
#ifndef REP_N
#define REP_N 1
#endif
#ifndef REP_SEC
#define REP_SEC 7
#endif
#ifndef REP_NSA_ONLY
#define REP_NSA_ONLY 0
#endif
  P.rep_ph = REP_PH; P.rep_n = REP_N; P.rep_sec = REP_SEC; P.rep_nsa_only = REP_NSA_ONLY;
  if (SINGLE_LAUNCH) {
    P.phase_lo = 0; P.phase_hi = N_PHASES;
    void* args[] = {&P, &counters};
    hipError_t e = hipLaunchCooperativeKernel((void*)hymba_mega, dim3(grid_blocks), dim3(NT), args, 0, stream);
    if (e != hipSuccess) fprintf(stderr, "cooperative launch failed: %s (grid %d)\n", hipGetErrorString(e), grid_blocks);
  } else {
    for (int ph = 0; ph < N_PHASES; ++ph) {
      P.phase_lo = ph; P.phase_hi = ph + 1;
      void* args[] = {&P, &counters};
      hipError_t e = hipLaunchCooperativeKernel((void*)hymba_mega, dim3(grid_blocks), dim3(NT), args, 0, stream);
      if (e != hipSuccess) { fprintf(stderr, "cooperative launch failed: %s (grid %d, phase %d)\n", hipGetErrorString(e), grid_blocks, ph); break; }
    }
  }
}
```

```cpp
#include <hip/hip_runtime.h>
#include <hip/hip_cooperative_groups.h>
#include <cstdio>
#include <cstdint>
#include <cstring>
namespace cg = cooperative_groups;

typedef __attribute__((ext_vector_type(8))) short bf16x8;
typedef __attribute__((ext_vector_type(4))) short bf16x4;
typedef __attribute__((ext_vector_type(16))) float f32x16;
typedef __attribute__((ext_vector_type(4))) float f32x4;
typedef __attribute__((ext_vector_type(2))) float f32x2;
typedef __attribute__((ext_vector_type(2))) __bf16 bf2_t;
typedef unsigned short u16;
typedef unsigned int u32;
typedef __attribute__((ext_vector_type(4))) unsigned int u32x4;
typedef __attribute__((ext_vector_type(2))) unsigned int u32x2;

#define DI __device__ __forceinline__
#define MFMA32(a, b, c) __builtin_amdgcn_mfma_f32_32x32x16_bf16((a), (b), (c), 0, 0, 0)
#define MFMA16(a, b, c) __builtin_amdgcn_mfma_f32_16x16x32_bf16((a), (b), (c), 0, 0, 0)

constexpr int S = 16384;
constexpr int D = 1024;
constexpr int NT = 256;
constexpr int NIN = 2844;
constexpr int NINP = 2944;
constexpr int SMEM_BYTES = 72704;
constexpr float LOG2E = 1.4426950408889634f;
#ifndef ABLATE
#define ABLATE 0
#endif

typedef int i32x8 __attribute__((ext_vector_type(8)));
struct Params {
  const float* x; const float* p; const int* positions;
  const float* attn_norm_w; const float* w_in; const float* fox_f_bias; const float* fox_q_norm_w; const float* fox_k_norm_w;
  const float* nsa_q_norm_w; const float* nsa_k_norm_w; const float* nsa_cmp_pos; const float* nsa_cmp_w;
  const float* diff_q_norm_w; const float* diff_k_norm_w; const float* diff_lambda; const float* diff_subln_w;
  const float* w_out; const float* ffn_norm_w; const float* peer_w_q; const float* peer_sub_keys; const float* peer_u; const float* peer_v;
  const float* ple_norm_w; const float* ple_w_gate; const float* ple_w_proj;
  float* out;
  u16* WinT;
  u16* WoutT;
  u16* WqT;
  u16* WgT;
  u16* WpT;
  u16* SubK;
  u16* CmpWT;
  float* cmpbias;
  unsigned char* U8;
  unsigned char* V8;
  float* Uinv; float* Vinv;
  u16* hb;
  u16* hb2;
  u16* pb;
  float* ropeN;
  float* ropeD;
  u16* QF; u16* KF; u16* VFt;
  float* cloc; float* ctot;
  u16* QN; u16* QR;
  u16* KC; u16* VC;
  u16* KCC; u16* VCCt;
  unsigned char* KS8; unsigned char* VS8t;
  u16* KW; u16* VWt;
  float* gates;
  u16* QD; u16* KD; u16* VDt;
  u16* mix;
  float* dstash;
  float* impA; float* impB;
  u32* topk;
  int phase_lo, phase_hi;
  int rep_ph, rep_n, rep_sec, rep_nsa_only;
};

DI u32x4 mk4(u32 a, u32 b, u32 c, u32 d) { return (u32x4){a, b, c, d}; }
DI u32x2 mk2(u32 a, u32 b) { return (u32x2){a, b}; }
DI u32 pack2(float a, float b) { f32x2 v = {a, b}; bf2_t r = __builtin_convertvector(v, bf2_t); return __builtin_bit_cast(u32, r); }
DI u16 f2bf(float a) { return (u16)(pack2(a, 0.f) & 0xffffu); }
DI float bf2f(u16 x) { return __uint_as_float(((u32)x) << 16); }
DI float bflo(u32 x) { return __uint_as_float(x << 16); }
DI float bfhi(u32 x) { return __uint_as_float(x & 0xffff0000u); }
DI int opaque_tid() { int t = threadIdx.x; asm volatile("" : "+v"(t)); return t; }
DI int crow(int reg, int h) { return (reg & 3) + 8 * (reg >> 2) + 4 * h; }
DI float wave_sum(float v) {
#pragma unroll
  for (int o = 32; o > 0; o >>= 1) v += __shfl_xor(v, o);
  return v;
}
DI float wave_max(float v) {
#pragma unroll
  for (int o = 32; o > 0; o >>= 1) v = fmaxf(v, __shfl_xor(v, o));
  return v;
}

DI int inproj_old_col(int j) {
  if (j < 768) return j;
  if (j < 2048) return j + 4;
  if (j < 2816) return j + 28;
  if (j < 2820) return j - 2048;
  if (j < 2844) return j - 768;
  return -1;
}
DI void transpose_tile(const float* __restrict__ src, int ldsrc, u16* __restrict__ dst, int K, const float* __restrict__ scale,
                       int n0, int k0, int mode, int nvalid, float* tile) {
  const int t = threadIdx.x;
  const int nn = t & 63, kq = t >> 6;
  int col = n0 + nn;
  if (mode == 1) col = inproj_old_col(col); else if (col >= nvalid) col = -1;
  float v[16];
#pragma unroll
  for (int i = 0; i < 16; ++i) v[i] = (col >= 0) ? src[(size_t)(k0 + kq + 4 * i) * ldsrc + col] : 0.f;
  if (scale) {
#pragma unroll
    for (int i = 0; i < 16; ++i) v[i] *= scale[k0 + kq + 4 * i];
  }
#pragma unroll
  for (int i = 0; i < 16; ++i) tile[(kq + 4 * i) * 65 + nn] = v[i];
  __syncthreads();
  const int n2 = t >> 2, kc = (t & 3) * 16;
  u32 o[8];
#pragma unroll
  for (int i = 0; i < 8; ++i) o[i] = pack2(tile[(kc + 2 * i) * 65 + n2], tile[(kc + 2 * i + 1) * 65 + n2]);
  u32x4* dp = (u32x4*)(dst + (size_t)(n0 + n2) * K + k0 + kc);
  dp[0] = mk4(o[0], o[1], o[2], o[3]);
  dp[1] = mk4(o[4], o[5], o[6], o[7]);
  __syncthreads();
}

DI void convert_rows(const float* __restrict__ src, u16* __restrict__ dst, size_t n8, float* __restrict__ copy) {
  const size_t stride = (size_t)gridDim.x * NT;
  for (size_t i0 = (size_t)blockIdx.x * NT + threadIdx.x; i0 < n8; i0 += 4 * stride) {
    f32x4 a[4], b[4];
#pragma unroll
    for (int u = 0; u < 4; ++u) {
      const size_t i = i0 + u * stride;
      if (i < n8) { a[u] = ((const f32x4*)src)[2 * i]; b[u] = ((const f32x4*)src)[2 * i + 1]; }
    }
#pragma unroll
    for (int u = 0; u < 4; ++u) {
      const size_t i = i0 + u * stride;
      if (i < n8) {
        if (copy) { ((f32x4*)copy)[2 * i] = a[u]; ((f32x4*)copy)[2 * i + 1] = b[u]; }
        ((u32x4*)dst)[i] = mk4(pack2(a[u][0], a[u][1]), pack2(a[u][2], a[u][3]), pack2(b[u][0], b[u][1]), pack2(b[u][2], b[u][3]));
      }
    }
  }
}

__device__ __forceinline__ void phase_prep(const Params& P, char* smem) {
  float* tile = (float*)smem;
  const int bid = blockIdx.x, nb = gridDim.x, t = threadIdx.x;
  for (int it0 = bid; it0 < 2 * 1952; it0 += nb) {
    const int l = it0 / 1952;
    int it = it0 % 1952;
    if (it < 736) { transpose_tile(P.w_in + (size_t)l * D * NIN, NIN, P.WinT + (size_t)l * NINP * D, D, P.attn_norm_w + l * D, (it >> 4) * 64, (it & 15) * 64, 1, 0, tile); continue; }
    it -= 736;
    if (it < 256) { transpose_tile(P.w_out + (size_t)l * D * D, D, P.WoutT + (size_t)l * D * D, D, nullptr, (it >> 4) * 64, (it & 15) * 64, 0, D, tile); continue; }
    it -= 256;
    if (it < 512) { transpose_tile(P.peer_w_q + (size_t)l * D * 2048, 2048, P.WqT + (size_t)l * 2048 * D, D, P.ffn_norm_w + l * D, (it >> 4) * 64, (it & 15) * 64, 0, 2048, tile); continue; }
    it -= 512;
    if (it < 256) { transpose_tile(P.ple_w_gate + (size_t)l * D * D, D, P.WgT + (size_t)l * D * D, D, P.ple_norm_w + l * D, (it >> 4) * 64, (it & 15) * 64, 0, D, tile); continue; }
    it -= 256;
    if (it < 64) { transpose_tile(P.ple_w_proj + (size_t)l * 256 * D, D, P.WpT + (size_t)l * D * 256, 256, nullptr, (it >> 2) * 64, (it & 3) * 64, 0, D, tile); continue; }
    it -= 64;
    { const int kv = it >> 6, i2 = it & 63;
      transpose_tile(P.nsa_cmp_w + (size_t)(l * 2 + kv) * 2048 * 64, 64, P.CmpWT + (size_t)(l * 2 + kv) * 128 * 2048, 2048, nullptr, (i2 >> 5) * 64, (i2 & 31) * 64, 0, 64, tile); }
  }
  convert_rows(P.peer_sub_keys, P.SubK, (size_t)2 * 16 * 128 * 128 / 8, nullptr);
  {
    const int lane = t & 63, gw = bid * 4 + (t >> 6), ngw = nb * 4;
    for (int r = gw; r < 4 * S; r += ngw) {
      const int tbl = r / (2 * S), l = (r / S) & 1, e = r % S;
      const float* src = (tbl ? P.peer_v : P.peer_u) + ((size_t)l * S + e) * D + lane * 16;
      float v[16];
#pragma unroll
      for (int i = 0; i < 4; ++i) { const f32x4 q4 = ((const f32x4*)src)[i]; v[4 * i] = q4[0]; v[4 * i + 1] = q4[1]; v[4 * i + 2] = q4[2]; v[4 * i + 3] = q4[3]; }
      if (tbl == 0) {
        const float* w = P.ffn_norm_w + l * D + lane * 16;
#pragma unroll
        for (int i = 0; i < 16; ++i) v[i] *= w[i];
      }
      float m = 0.f;
#pragma unroll
      for (int i = 0; i < 16; ++i) m = fmaxf(m, fabsf(v[i]));
      m = wave_max(m);
      {
        const float sc = (m > 0.f) ? 6.f / m : 0.f;
        u32 o[2] = {0u, 0u};
#pragma unroll
        for (int i = 0; i < 8; ++i) {
          if ((i & 3) == 0) o[i >> 2] = __builtin_amdgcn_cvt_scalef32_pk_fp4_f32(o[i >> 2], v[2 * i] * sc, v[2 * i + 1] * sc, 1.0f, 0);
          else if ((i & 3) == 1) o[i >> 2] = __builtin_amdgcn_cvt_scalef32_pk_fp4_f32(o[i >> 2], v[2 * i] * sc, v[2 * i + 1] * sc, 1.0f, 1);
          else if ((i & 3) == 2) o[i >> 2] = __builtin_amdgcn_cvt_scalef32_pk_fp4_f32(o[i >> 2], v[2 * i] * sc, v[2 * i + 1] * sc, 1.0f, 2);
          else o[i >> 2] = __builtin_amdgcn_cvt_scalef32_pk_fp4_f32(o[i >> 2], v[2 * i] * sc, v[2 * i + 1] * sc, 1.0f, 3);
        }
        *(u32x2*)((tbl ? P.V8 : P.U8) + ((size_t)l * S + e) * (D / 2) + lane * 8) = mk2(o[0], o[1]);
        if (lane == 0) (tbl ? P.Vinv : P.Uinv)[l * S + e] = m * (1.f / 6.f);
      }
    }
  }
  convert_rows(P.p, P.pb, (size_t)2 * S * 256 / 8, nullptr);
  convert_rows(P.x, P.hb, (size_t)S * D / 8, P.out);
  const size_t gtid = (size_t)bid * NT + t, gstride = (size_t)nb * NT;
  __syncthreads();
  if (t < 48) tile[t] = (t < 32) ? powf(10000.f, -(float)t / 32.f) : powf(10000.f, -(float)(t - 32) / 16.f);
  __syncthreads();
  for (size_t i = gtid; i < (size_t)S * 48; i += gstride) {
    const int tok = (int)(i / 48), r = (int)(i % 48);
    const float pos = (float)P.positions[tok];
    const float invf = tile[r];
    const float ang = pos * invf;
    const double rev = (double)ang * 0.15915494309189535;
    const float fr = (float)(rev - floor(rev));
    const float c = __builtin_amdgcn_cosf(fr), s = __builtin_amdgcn_sinf(fr);
    if (r < 32) { P.ropeN[(size_t)tok * 64 + r] = c; P.ropeN[(size_t)tok * 64 + 32 + r] = s; }
    else { P.ropeD[(size_t)tok * 32 + (r - 32)] = c; P.ropeD[(size_t)tok * 32 + 16 + (r - 32)] = s; }
  }
  {
    const int lane = t & 63, gw = bid * 4 + (t >> 6), ngw = nb * 4;
    for (int i = gw; i < 2 * 2 * 64; i += ngw) {
      const int lk = i >> 6, e = i & 63;
      const float* pos = P.nsa_cmp_pos + (size_t)lk * 2048;
      const float* w = P.nsa_cmp_w + (size_t)lk * 2048 * 64;
      float a = 0.f;
#pragma unroll 8
      for (int k = lane; k < 2048; k += 64) a += pos[k] * w[(size_t)k * 64 + e];
      a = wave_sum(a);
      if (lane == 0) P.cmpbias[i] = a;
    }
  }
  for (size_t i = gtid; i < 2 * 2 * 64 * 64; i += gstride) {
    const int which = (int)(i / (2 * 64 * 64)), r = (int)(i % (2 * 64 * 64));
    const int g = r / (64 * 64), o = r % (64 * 64);
    u16* base = which ? P.VC : P.KC;
    base[(size_t)g * (S + 64) * 64 + (size_t)S * 64 + o] = 0;
  }
}

constexpr int GST = 144;
constexpr int G_BOFF = 128 * GST;
constexpr int G_RS_OFF = 71680;

DI float ssq8(const u32x4& v) {
  float s = 0.f;
  float a;
  a = bflo(v.x); s += a * a; a = bfhi(v.x); s += a * a;
  a = bflo(v.y); s += a * a; a = bfhi(v.y); s += a * a;
  a = bflo(v.z); s += a * a; a = bfhi(v.z); s += a * a;
  a = bflo(v.w); s += a * a; a = bfhi(v.w); s += a * a;
  return s;
}

template <bool SSQ>
DI void gemm_mainloop(const u16* __restrict__ A, int lda, const u16* __restrict__ Bt, int ldb, int K, char* sm, f32x16 (&acc)[2][2]) {
  const int tid = threadIdx.x, lane = tid & 63, wave = tid >> 6;
  const int wr = wave >> 1, wc = wave & 1;
  const int lrow = tid >> 3, lcol = (tid & 7) * 8;
  char* As = sm; char* Bs = sm + G_BOFF;
  u32x4 ra[4], rb[4];
  float ssq[4] = {0.f, 0.f, 0.f, 0.f};
#pragma unroll
  for (int i = 0; i < 4; ++i) {
    ra[i] = *(const u32x4*)(A + (size_t)(lrow + 32 * i) * lda + lcol);
    rb[i] = *(const u32x4*)(Bt + (size_t)(lrow + 32 * i) * ldb + lcol);
  }
  const int aoff = (wr * 64 + (lane & 31)) * GST + (lane >> 5) * 16;
  const int boff = (wc * 64 + (lane & 31)) * GST + (lane >> 5) * 16;
  for (int k0 = 0; k0 < K; k0 += 64) {
    __syncthreads();
#pragma unroll
    for (int i = 0; i < 4; ++i) {
      *(u32x4*)(As + (lrow + 32 * i) * GST + lcol * 2) = ra[i];
      *(u32x4*)(Bs + (lrow + 32 * i) * GST + lcol * 2) = rb[i];
      if (SSQ) ssq[i] += ssq8(ra[i]);
    }
    __syncthreads();
    if (k0 + 64 < K) {
#pragma unroll
      for (int i = 0; i < 4; ++i) {
        ra[i] = *(const u32x4*)(A + (size_t)(lrow + 32 * i) * lda + k0 + 64 + lcol);
        rb[i] = *(const u32x4*)(Bt + (size_t)(lrow + 32 * i) * ldb + k0 + 64 + lcol);
      }
    }
#pragma unroll
    for (int ks = 0; ks < 4; ++ks) {
      bf16x8 af[2], bfr[2];
#pragma unroll
      for (int i = 0; i < 2; ++i) af[i] = *(const bf16x8*)(As + aoff + i * 32 * GST + ks * 32);
#pragma unroll
      for (int j = 0; j < 2; ++j) bfr[j] = *(const bf16x8*)(Bs + boff + j * 32 * GST + ks * 32);
#pragma unroll
      for (int i = 0; i < 2; ++i)
#pragma unroll
        for (int j = 0; j < 2; ++j) acc[i][j] = MFMA32(af[i], bfr[j], acc[i][j]);
    }
  }
  __syncthreads();
  if (SSQ) {
    float* rs = (float*)(sm + G_RS_OFF);
#pragma unroll
    for (int i = 0; i < 4; ++i) {
      float s = ssq[i];
      s += __shfl_xor(s, 1); s += __shfl_xor(s, 2); s += __shfl_xor(s, 4);
      if ((tid & 7) == 0) rs[lrow + 32 * i] = rsqrtf(s * (1.f / (float)K) + 1e-6f);
    }
  }
}

DI void zero_acc(f32x16 (&acc)[2][2]) {
#pragma unroll
  for (int i = 0; i < 2; ++i)
#pragma unroll
    for (int j = 0; j < 2; ++j)
#pragma unroll
      for (int r = 0; r < 16; ++r) acc[i][j][r] = 0.f;
}

constexpr int EPS_LD = 132;
DI void acc_to_lds(const f32x16 (&acc)[2][2], float* tile) {
  const int lane = threadIdx.x & 63, wave = threadIdx.x >> 6;
  const int wr = wave >> 1, wc = wave & 1;
#pragma unroll
  for (int i = 0; i < 2; ++i)
#pragma unroll
    for (int j = 0; j < 2; ++j)
#pragma unroll
      for (int r = 0; r < 16; ++r)
        tile[(wr * 64 + i * 32 + crow(r, lane >> 5)) * EPS_LD + wc * 64 + j * 32 + (lane & 31)] = acc[i][j][r];
}

DI float log_sigmoid(float x) { return fminf(x, 0.f) - log1pf(expf(-fabsf(x))); }
DI float sigmoidf_(float x) { return 1.f / (1.f + expf(-x)); }

DI void store32_bf16(u16* dst, const float* o) {
  u32x4* d4 = (u32x4*)dst;
#pragma unroll
  for (int i = 0; i < 4; ++i)
    d4[i] = mk4(pack2(o[8 * i], o[8 * i + 1]), pack2(o[8 * i + 2], o[8 * i + 3]), pack2(o[8 * i + 4], o[8 * i + 5]), pack2(o[8 * i + 6], o[8 * i + 7]));
}

__device__ __forceinline__ void inproj_epilogue_half(const Params& P, int l, int mt, int nt, int half, const float* tile, const float* rs) {
  const int tid = threadIdx.x, lane = tid & 63, wave = tid >> 6;
  const int hl = wave >> 1, h32 = wave & 1;
  const int sg = 2 * nt + hl;
  const int rloc = half * 64 + lane;
  const int tok = mt * 128 + rloc;
  const float rstd = rs[rloc];
  if (sg >= 45) return;
  float v[64];
  {
    const f32x4* src = (const f32x4*)(tile + rloc * EPS_LD + hl * 64);
#pragma unroll
    for (int i = 0; i < 16; ++i) { f32x4 t = src[i]; v[4 * i] = t[0] * rstd; v[4 * i + 1] = t[1] * rstd; v[4 * i + 2] = t[2] * rstd; v[4 * i + 3] = t[3] * rstd; }
  }
  const u32 hmask = (u32)(-(int)h32);
#define VO(i) __uint_as_float((__float_as_uint(v[32 + (i)]) & hmask) | (__float_as_uint(v[(i)]) & ~hmask))
  if (sg == 44) {
    if (h32 == 0) {
      const int chunk = tok >> 6;
#pragma unroll
      for (int hd = 0; hd < 4; ++hd) {
        float x = log_sigmoid(v[hd] + P.fox_f_bias[l * 4 + hd]);
#pragma unroll
        for (int o = 1; o < 64; o <<= 1) { float t = __shfl_up(x, o); if (lane >= o) x += t; }
        P.cloc[(size_t)hd * S + tok] = x;
        if (lane == 63) P.ctot[chunk * 4 + hd] = x;
      }
    } else {
      float* g = P.gates + (size_t)tok * 24;
#pragma unroll
      for (int i = 0; i < 24; ++i) g[i] = sigmoidf_(v[4 + i]);
    }
    return;
  }
  float o[32];
  const bool is_vt = (sg >= 8 && sg < 12) || (sg == 26 || sg == 27) || (sg == 30 || sg == 31) || (sg >= 40);
  const bool is_raw = (sg >= 20 && sg < 24);
  const bool is_diff = (sg >= 32 && sg < 40);
  if (is_vt) {
    if (sg == 26 || sg == 27) {
      const int key = tok & 63, G = key >> 5, h4 = (key & 31) >> 3, j = key & 7;
      unsigned char* b8 = P.VS8t + (size_t)(sg - 26) * 64 * S + (size_t)(tok >> 6) * 4096 + G * 2048 + h4 * 128 + j;
#pragma unroll
      for (int i = 0; i < 32; i += 2) {
        const int wd = __builtin_amdgcn_cvt_pk_fp8_f32(VO(i), VO(i + 1), 0, false);
        const int d0 = h32 * 32 + i, d1 = d0 + 1;
        b8[(d0 >> 4) * 512 + (d0 & 15) * 8] = (unsigned char)(wd & 0xff);
        b8[(d1 >> 4) * 512 + (d1 & 15) * 8] = (unsigned char)((wd >> 8) & 0xff);
      }
      return;
    }
    u16* base;
    if (sg < 12) base = P.VFt + (size_t)(sg - 8) * 64 * S;
    else if (sg < 32) base = P.VWt + (size_t)(sg - 30) * 64 * S;
    else base = P.VDt + (size_t)(sg - 40) * 64 * S;
#pragma unroll
    for (int i = 0; i < 32; ++i) base[(size_t)(h32 * 32 + i) * S + tok] = f2bf(VO(i));
    return;
  }
  if (is_raw) {
    u16* base = (sg < 22) ? P.KC + (size_t)(sg - 20) * (S + 64) * 64 : P.VC + (size_t)(sg - 22) * (S + 64) * 64;
#pragma unroll
    for (int i = 0; i < 32; ++i) o[i] = VO(i);
    store32_bf16(base + (size_t)tok * 64 + h32 * 32, o);
    return;
  }
  if (is_diff) {
    const float* w = (sg < 36 ? P.diff_q_norm_w : P.diff_k_norm_w) + l * 32;
    float ss = 0.f;
#pragma unroll
    for (int i = 0; i < 32; ++i) ss += VO(i) * VO(i);
    const float rn = rsqrtf(ss * (1.f / 32.f) + 1e-6f);
    const float sc = (sg < 36) ? 0.17677669529663687f * LOG2E : 1.f;
    const float* rp = P.ropeD + (size_t)tok * 32;
#pragma unroll
    for (int i = 0; i < 16; ++i) {
      const float y1 = VO(i) * rn * w[i], y2 = VO(16 + i) * rn * w[16 + i];
      const float c = rp[i], s = rp[16 + i];
      o[i] = (y1 * c - y2 * s) * sc;
      o[16 + i] = (y2 * c + y1 * s) * sc;
    }
    u16* base = (sg < 36) ? P.QD + (size_t)(sg - 32) * S * 64 : P.KD + (size_t)(sg - 36) * S * 64;
    store32_bf16(base + (size_t)tok * 64 + h32 * 32, o);
    return;
  }
  const float* w;
  if (sg < 4) w = P.fox_q_norm_w + l * 64; else if (sg < 8) w = P.fox_k_norm_w + l * 64; else if (sg < 20) w = P.nsa_q_norm_w + l * 64; else w = P.nsa_k_norm_w + l * 64;
  float ss = 0.f;
#pragma unroll
  for (int i = 0; i < 64; ++i) ss += v[i] * v[i];
  const float rn = rsqrtf(ss * (1.f / 64.f) + 1e-6f);
  const float qs = 0.125f * LOG2E;
  if (sg < 8) {
    const float sc = (sg < 4) ? qs : 1.f;
#pragma unroll
    for (int i = 0; i < 32; ++i) o[i] = VO(i) * rn * w[h32 * 32 + i] * sc;
    u16* base = (sg < 4) ? P.QF + (size_t)sg * S * 64 : P.KF + (size_t)(sg - 4) * S * 64;
    store32_bf16(base + (size_t)tok * 64 + h32 * 32, o);
    return;
  }
  const float* rp = P.ropeN + (size_t)tok * 64;
  const float sc = (sg < 20) ? qs : 1.f;
  if (sg < 20) {
#pragma unroll
    for (int i = 0; i < 32; ++i) o[i] = VO(i) * rn * w[h32 * 32 + i] * sc;
    store32_bf16(P.QN + ((size_t)(sg - 12) * S + tok) * 64 + h32 * 32, o);
  }
#pragma unroll
  for (int i = 0; i < 32; ++i) {
    const float y1 = v[i] * rn * w[i], y2 = v[32 + i] * rn * w[32 + i];
    const float c = rp[i], s = rp[32 + i];
    o[i] = (h32 == 0 ? (y1 * c - y2 * s) : (y2 * c + y1 * s)) * sc;
  }
  if (sg == 24 || sg == 25) {
    const int key = tok & 63, G = key >> 5, r32 = key & 31, t = (r32 >> 2) & 1, i = ((r32 >> 3) << 2) | (r32 & 3);
    unsigned char* d8 = P.KS8 + (size_t)(sg - 24) * S * 64 + (size_t)(tok >> 6) * 4096 + ((G * 2 + t) * 2 + h32) * 512 + i * 8;
#pragma unroll
    for (int h4 = 0; h4 < 4; ++h4) {
      int w0 = 0, w1 = 0;
      w0 = __builtin_amdgcn_cvt_pk_fp8_f32(o[8 * h4], o[8 * h4 + 1], w0, false);
      w0 = __builtin_amdgcn_cvt_pk_fp8_f32(o[8 * h4 + 2], o[8 * h4 + 3], w0, true);
      w1 = __builtin_amdgcn_cvt_pk_fp8_f32(o[8 * h4 + 4], o[8 * h4 + 5], w1, false);
      w1 = __builtin_amdgcn_cvt_pk_fp8_f32(o[8 * h4 + 6], o[8 * h4 + 7], w1, true);
      *(u32x2*)(d8 + h4 * 128) = mk2((u32)w0, (u32)w1);
    }
    return;
  }
  u16* base;
  if (sg < 20) base = P.QR + (size_t)(sg - 12) * S * 64;
  else base = P.KW + (size_t)(sg - 28) * S * 64;
  store32_bf16(base + (size_t)tok * 64 + h32 * 32, o);
}

#undef VO
__device__ __forceinline__ void phase_inproj(const Params& P, int l, char* smem) {
  const u16* Wt = P.WinT + (size_t)l * NINP * D;
  float* tile = (float*)smem;
  const float* rs = (const float*)(smem + G_RS_OFF);
  for (int it = blockIdx.x; it < 128 * 23; it += gridDim.x) {
    const int mt = it / 23, nt = it % 23;
    f32x16 acc[2][2];
    zero_acc(acc);
    gemm_mainloop<true>(P.hb + (size_t)mt * 128 * D, D, Wt + (size_t)nt * 128 * D, D, D, smem, acc);
    acc_to_lds(acc, tile);
    __syncthreads();
#pragma unroll 1
    for (int half = 0; half < 2; ++half) inproj_epilogue_half(P, l, mt, nt, half, tile, rs);
  }
}

__device__ __forceinline__ void phase_compress(const Params& P, int l, char* smem) {
  float* tile = (float*)smem;
  for (int it = blockIdx.x; it < 32; it += gridDim.x) {
    const int kv = it >> 4, g = (it >> 3) & 1, mt = it & 7;
    const u16* A = (kv ? P.VC : P.KC) + (size_t)g * (S + 64) * 64 + (size_t)mt * 128 * 1024;
    const u16* Bt = P.CmpWT + (size_t)(l * 2 + kv) * 128 * 2048;
    const float* bias = P.cmpbias + (l * 2 + kv) * 64;
    f32x16 acc[2][2];
    zero_acc(acc);
    gemm_mainloop<false>(A, 1024, Bt, 2048, 2048, smem, acc);
    acc_to_lds(acc, tile);
    __syncthreads();
#pragma unroll 1
    for (int half = 0; half < 2; ++half) {
      {
        const int lane = threadIdx.x & 63, wave = threadIdx.x >> 6;
        const int idx = mt * 128 + half * 64 + lane;
        float v[64];
        const f32x4* src = (const f32x4*)(tile + (half * 64 + lane) * EPS_LD);
#pragma unroll
        for (int i = 0; i < 16; ++i) { f32x4 t = src[i]; v[4 * i] = t[0] + bias[4 * i]; v[4 * i + 1] = t[1] + bias[4 * i + 1]; v[4 * i + 2] = t[2] + bias[4 * i + 2]; v[4 * i + 3] = t[3] + bias[4 * i + 3]; }
        float vo[16];
#pragma unroll
        for (int i = 0; i < 4; ++i) { f32x4 t = src[wave * 4 + i]; const float* bb = bias + wave * 16 + 4 * i; vo[4 * i] = t[0] + bb[0]; vo[4 * i + 1] = t[1] + bb[1]; vo[4 * i + 2] = t[2] + bb[2]; vo[4 * i + 3] = t[3] + bb[3]; }
        if (kv == 0) {
          const float* w = P.nsa_k_norm_w + l * 64;
          float ss = 0.f;
#pragma unroll
          for (int i = 0; i < 64; ++i) ss += v[i] * v[i];
          const float rn = rsqrtf(ss * (1.f / 64.f) + 1e-6f);
          u32 o[8];
#pragma unroll
          for (int i = 0; i < 8; ++i) o[i] = pack2(vo[2 * i] * rn * w[wave * 16 + 2 * i], vo[2 * i + 1] * rn * w[wave * 16 + 2 * i + 1]);
          u32x4* dp = (u32x4*)(P.KCC + ((size_t)g * 1024 + idx) * 64 + wave * 16);
          dp[0] = mk4(o[0], o[1], o[2], o[3]);
          dp[1] = mk4(o[4], o[5], o[6], o[7]);
        } else {
#pragma unroll
          for (int i = 0; i < 16; ++i) P.VCCt[((size_t)g * 64 + wave * 16 + i) * 1024 + idx] = f2bf(vo[i]);
        }
      }
    }
  }
}

constexpr int AK_ST = 144;
constexpr int AV_ST = 136;
constexpr int AT_VOFF = 64 * AK_ST;
constexpr int AT_COFF = AT_VOFF + 64 * AV_ST;
constexpr int AT_STAGE = AT_COFF + 256;
constexpr int AT_MISC = 2 * AT_STAGE;

struct TileRegs { u32x4 k[2]; u32x4 v[2]; };

DI void tile_load(int t, TileRegs& r, const u16* __restrict__ K, const u16* __restrict__ Vt, size_t ldv, int key0, bool with_v) {
#pragma unroll
  for (int i = 0; i < 2; ++i) {
    const int c = t + 256 * i, row = c >> 3, part = c & 7;
    r.k[i] = *(const u32x4*)(K + (size_t)(key0 + row) * 64 + part * 8);
    if (with_v) r.v[i] = *(const u32x4*)(Vt + (size_t)row * ldv + key0 + part * 8);
  }
}
DI void tile_store(int t, const TileRegs& r, char* st, bool with_v) {
#pragma unroll
  for (int i = 0; i < 2; ++i) {
    const int c = t + 256 * i, row = c >> 3, part = c & 7;
    *(u32x4*)(st + row * AK_ST + part * 16) = r.k[i];
    if (with_v) {
      u32x2* d = (u32x2*)(st + AT_VOFF + row * AV_ST + part * 16);
      d[0] = mk2(r.v[i].x, r.v[i].y);
      d[1] = mk2(r.v[i].z, r.v[i].w);
    }
  }
}
DI bf16x8 pack_p(const f32x16& p, int sp) {
  u32x4 u = mk4(pack2(p[8 * sp], p[8 * sp + 1]), pack2(p[8 * sp + 2], p[8 * sp + 3]), pack2(p[8 * sp + 4], p[8 * sp + 5]), pack2(p[8 * sp + 6], p[8 * sp + 7]));
  return __builtin_bit_cast(bf16x8, u);
}
template <int NKS, bool ZINIT>
DI void qk_half(int tid, const char* st, int dofs_bytes, int kt, const bf16x8 (&qf)[NKS], f32x16& s) {
  const int lane = tid & 63;
  const char* base = st + (kt * 32 + (lane & 31)) * AK_ST + (lane >> 5) * 16 + dofs_bytes;
#pragma unroll
  for (int ks = 0; ks < NKS; ++ks) {
    const bf16x8 a = *(const bf16x8*)(base + ks * 32);
    if (ZINIT && ks == 0) { const f32x16 z = {0.f, 0.f, 0.f, 0.f, 0.f, 0.f, 0.f, 0.f, 0.f, 0.f, 0.f, 0.f, 0.f, 0.f, 0.f, 0.f}; s = MFMA32(a, qf[ks], z); }
    else s = MFMA32(a, qf[ks], s);
  }
}
DI void pv_half(int tid, const char* st, int kt, const f32x16& p, f32x16 (&o)[2]) {
  const int lane = tid & 63;
  const char* vb = st + AT_VOFF + (lane & 31) * AV_ST + (lane >> 5) * 8 + kt * 64;
#pragma unroll
  for (int sp = 0; sp < 2; ++sp) {
    const bf16x8 pb = pack_p(p, sp);
#pragma unroll
    for (int dt = 0; dt < 2; ++dt) {
      const char* a = vb + dt * 32 * AV_ST + sp * 32;
      const u32x2 lo = *(const u32x2*)a, hi = *(const u32x2*)(a + 16);
      const u32x4 u = mk4(lo.x, lo.y, hi.x, hi.y);
      o[dt] = MFMA32(__builtin_bit_cast(bf16x8, u), pb, o[dt]);
    }
  }
}
DI void load_q4(int tid, bf16x8 (&qf)[4], const u16* __restrict__ Q, int tok) {
  const int lane = tid & 63;
  const u16* b = Q + (size_t)tok * 64 + (lane >> 5) * 8;
#pragma unroll
  for (int ks = 0; ks < 4; ++ks) qf[ks] = *(const bf16x8*)(b + ks * 16);
}
DI float max_abs64(int tid, const float* w) {
  return wave_max(fabsf(w[tid & 63]));
}

struct AttnArgs {
  const u16* K; const u16* Vt; size_t ldv;
  int t0, t1;
  int q;
  int wq0;
  float M2;
  int dofs;
  int lim_hi, lim_lo, whi, wlo;
  int mask_hi, mask_lo;
  float cq; const float* cloc; const float* base;
};

template <int MODE, int NKS>
DI void attn_tile(int tid, const AttnArgs& a, const char* cur, int key0, int lim_hi, int lim_lo, bool mask_u, const bf16x8 (&qf)[NKS], f32x16 (&o)[2], float& l) {
  const int h = (tid & 63) >> 5;
#pragma unroll
  for (int kt = 0; kt < 2; ++kt) {
    f32x16 s;
    if (MODE == 0) {
      const float* ckb = (const float*)(cur + AT_COFF);
#pragma unroll
      for (int rg = 0; rg < 4; ++rg) {
        const f32x4 c4 = *(const f32x4*)(ckb + 32 * kt + 8 * rg + 4 * h);
#pragma unroll
        for (int i = 0; i < 4; ++i) s[4 * rg + i] = a.cq - c4[i];
      }
      qk_half<NKS, false>(tid, cur, a.dofs, kt, qf, s);
    } else {
      qk_half<NKS, true>(tid, cur, a.dofs, kt, qf, s);
    }
#pragma unroll
    for (int i = 0; i < 16; ++i) s[i] = __builtin_amdgcn_exp2f(s[i]);
    if (mask_u) {
#pragma unroll
      for (int i = 0; i < 16; ++i) { const int key = key0 + 32 * kt + crow(i, h); if (key > lim_hi || key < lim_lo) s[i] = 0.f; }
    }
#pragma unroll
    for (int i = 0; i < 16; ++i) l += s[i];
    pv_half(tid, cur, kt, s, o);
  }
}
template <int MODE, int NKS, bool PF2 = false>
DI void attn_loop(int tid, const AttnArgs& a, const bf16x8 (&qf)[NKS], f32x16 (&o)[2], float& l, char* smem) {
  TileRegs rA, rB; float cbA = 0.f, cbB = 0.f;
  if (a.t0 >= a.t1) return;
  tile_load(tid, rA, a.K, a.Vt, a.ldv, a.t0 * 64, true);
  if (MODE == 0 && tid < 64) cbA = a.cloc[a.t0 * 64 + tid];
  tile_store(tid, rA, smem, true);
  if (MODE == 0 && tid < 64) ((float*)(smem + AT_COFF))[tid] = (a.base[a.t0] + cbA) * LOG2E;
  __syncthreads();
  auto step = [&](int t, TileRegs& rs, float& cbs, TileRegs& rl, float& cbl, int dist) {
    char* cur = smem + ((t - a.t0) & 1) * AT_STAGE;
    char* nxt = smem + ((t - a.t0 + 1) & 1) * AT_STAGE;
    if (t + dist < a.t1) {
      tile_load(tid, rl, a.K, a.Vt, a.ldv, (t + dist) * 64, true);
      if (MODE == 0 && tid < 64) cbl = a.cloc[(t + dist) * 64 + tid];
    }
    const int key0 = t * 64;
    bool active, need_mask;
    if (MODE == 0 || MODE == 3) { active = key0 <= a.wq0 + 31; need_mask = key0 + 63 > a.wq0; }
    else if (MODE == 1) { const int nmax_w = (a.wq0 + 31 - 31) >> 4; active = (a.wq0 + 31 >= 31) && key0 <= nmax_w; need_mask = true; }
    else if (MODE == 2) { active = (key0 <= a.wq0 + 31) && (key0 + 63 >= a.wq0 - 511); need_mask = (key0 + 63 > a.wq0) || (key0 < a.wq0 + 31 - 511); }
    else { active = (key0 <= a.whi) && (key0 + 63 >= a.wlo); need_mask = (key0 + 63 > a.mask_hi) || (key0 < a.mask_lo); }
    if (active) {
      int lim_hi, lim_lo;
      if (MODE == 0 || MODE == 3) { lim_hi = a.q; lim_lo = 0; }
      else if (MODE == 1) { lim_hi = (a.q >= 31) ? ((a.q - 31) >> 4) : -1; lim_lo = 0; }
      else if (MODE == 2) { lim_hi = a.q; lim_lo = a.q - 511; }
      else { lim_hi = a.lim_hi; lim_lo = a.lim_lo; }
      attn_tile<MODE, NKS>(tid, a, cur, key0, lim_hi, lim_lo, __builtin_amdgcn_readfirstlane((int)need_mask) != 0, qf, o, l);
    }
    if (t + 1 < a.t1) {
      tile_store(tid, rs, nxt, true);
      if (MODE == 0 && tid < 64) ((float*)(nxt + AT_COFF))[tid] = (a.base[t + 1] + cbs) * LOG2E;
    }
    __syncthreads();
  };
  if (!PF2) {
    for (int t = a.t0; t < a.t1; ++t) step(t, rA, cbA, rA, cbA, 1);
  } else {
    if (a.t0 + 1 < a.t1) { tile_load(tid, rA, a.K, a.Vt, a.ldv, (a.t0 + 1) * 64, true); if (MODE == 0 && tid < 64) cbA = a.cloc[(a.t0 + 1) * 64 + tid]; }
    for (int t = a.t0; t < a.t1; t += 2) {
      step(t, rA, cbA, rB, cbB, 2);
      if (t + 1 >= a.t1) break;
      step(t + 1, rB, cbB, rA, cbA, 2);
    }
  }
}

DI void zero_o(f32x16 (&o)[2]) {
#pragma unroll
  for (int d = 0; d < 2; ++d)
#pragma unroll
    for (int i = 0; i < 16; ++i) o[d][i] = 0.f;
}

DI void fox_chunk_bases(int tid, const Params& P, int hd, float* base, float* wtot) {
  const int lane = tid & 63, wave = tid >> 6;
  const float x = P.ctot[tid * 4 + hd];
  float inc = x;
#pragma unroll
  for (int o = 1; o < 64; o <<= 1) { float t = __shfl_up(inc, o); if (lane >= o) inc += t; }
  if (lane == 63) wtot[wave] = inc;
  __syncthreads();
  float off = 0.f;
  for (int w = 0; w < wave; ++w) off += wtot[w];
  base[tid] = inc - x + off;
  __syncthreads();
}

__device__ __forceinline__ void fox_item(const Params& P, int l, int hd, int qb, char* smem) {
  const int tid = opaque_tid(), lane = tid & 63, wave = tid >> 6, h = lane >> 5;
  float* base = (float*)(smem + AT_MISC);
  float* wtot = base + 256;
  fox_chunk_bases(tid, P, hd, base, wtot);
  const float M2 = 8.f * max_abs64(tid, P.fox_q_norm_w + l * 64) * max_abs64(tid, P.fox_k_norm_w + l * 64) * LOG2E * 1.01f + 0.1f;
  const int wq0 = qb * 128 + wave * 32, q = wq0 + (lane & 31);
  AttnArgs a;
  a.K = P.KF + (size_t)hd * S * 64; a.Vt = P.VFt + (size_t)hd * 64 * S; a.ldv = S;
  a.t1 = 2 * qb + 2; a.q = q; a.wq0 = wq0; a.M2 = M2;
  a.cloc = P.cloc + (size_t)hd * S; a.base = base;
  {
    const bool skip = (tid + 1 < 2 * qb) && ((base[2 * qb] - base[tid + 1]) * LOG2E < -160.f);
    a.t0 = __syncthreads_count(skip ? 1 : 0);
  }
  a.cq = (base[q >> 6] + a.cloc[q]) * LOG2E - M2;
  bf16x8 qf[4];
  load_q4(tid, qf, P.QF + (size_t)hd * S * 64, q);
  f32x16 o[2]; zero_o(o);
  float ls = 0.f;
  a.dofs = 0;
  attn_loop<0, 4, true>(tid, a, qf, o, ls, smem);
  ls += __shfl_xor(ls, 32);
  const float inv = (ABLATE & 1) ? 0.f : 1.f / ls;
  u16* dst = P.mix + (size_t)q * 1024 + hd * 64 + 4 * h;
#pragma unroll
  for (int dt = 0; dt < 2; ++dt)
#pragma unroll
    for (int rg = 0; rg < 4; ++rg)
      *(u32x2*)(dst + 32 * dt + 8 * rg) = mk2(pack2(o[dt][4 * rg] * inv, o[dt][4 * rg + 1] * inv), pack2(o[dt][4 * rg + 2] * inv, o[dt][4 * rg + 3] * inv));
}

__device__ __forceinline__ void diff_item(const Params& P, int l, int hd, int qb, char* smem) {
  const int tid = opaque_tid(), lane = tid & 63, wave = tid >> 6, h = lane >> 5;
  const float mq = wave_max(fabsf(P.diff_q_norm_w[l * 32 + (lane & 31)])), mk = wave_max(fabsf(P.diff_k_norm_w[l * 32 + (lane & 31)]));
  const float M2 = 5.656854249f * mq * mk * LOG2E * 1.01f + 0.1f;
  const float* lv = P.diff_lambda + l * 128;
  float d1 = (lane < 32) ? lv[lane] * lv[32 + lane] : 0.f, d2 = (lane < 32) ? lv[64 + lane] * lv[96 + lane] : 0.f;
  d1 = wave_sum(d1); d2 = wave_sum(d2);
  const float lam_init = 0.8f - 0.6f * expf(-0.3f * (float)l);
  const float lam = expf(d1) - expf(d2) + lam_init;
  const int wq0 = qb * 128 + wave * 32, q = wq0 + (lane & 31);
  AttnArgs a;
  a.K = P.KD + (size_t)hd * S * 64; a.Vt = P.VDt + (size_t)hd * 64 * S; a.ldv = S;
  a.t0 = 0; a.t1 = 2 * qb + 2; a.q = q; a.wq0 = wq0; a.M2 = M2; a.cq = 0.f; a.cloc = nullptr; a.base = nullptr;
  float* stash = P.dstash + (size_t)blockIdx.x * (128 * 64) + tid;
  f32x16 o[2];
#pragma unroll 1
  for (int c = 0; c < 2; ++c) {
    const int tid = opaque_tid(), lane = tid & 63, h = lane >> 5;
    bf16x8 qf[2];
    {
      const u16* b = P.QD + ((size_t)hd * S + q) * 64 + c * 32 + h * 8;
      qf[0] = *(const bf16x8*)b; qf[1] = *(const bf16x8*)(b + 16);
    }
    zero_o(o);
    float ls = 0.f;
    a.dofs = c * 64;
    attn_loop<3, 2>(tid, a, qf, o, ls, smem);
    ls += __shfl_xor(ls, 32);
    if (c == 0) {
      const float i0 = 1.f / ls;
#pragma unroll
      for (int dt = 0; dt < 2; ++dt)
#pragma unroll
        for (int i = 0; i < 16; ++i) stash[(dt * 16 + i) * 256] = o[dt][i] * i0;
    } else {
      const float i1 = lam / ls;
      float ss = 0.f;
#pragma unroll
      for (int dt = 0; dt < 2; ++dt)
#pragma unroll
        for (int i = 0; i < 16; ++i) { const float v = stash[(dt * 16 + i) * 256] - o[dt][i] * i1; o[dt][i] = v; ss += v * v; }
      ss += __shfl_xor(ss, 32);
      const float rn = rsqrtf(ss * (1.f / 64.f) + 1e-6f) * (1.f - lam_init);
      const float* sw = P.diff_subln_w + l * 64;
      u16* dst = P.mix + (size_t)q * 1024 + 768 + hd * 64 + 4 * h;
#pragma unroll
      for (int dt = 0; dt < 2; ++dt)
#pragma unroll
        for (int rg = 0; rg < 4; ++rg) {
          const int d0 = 32 * dt + 8 * rg + 4 * h;
          *(u32x2*)(dst + 32 * dt + 8 * rg) = mk2(pack2(o[dt][4 * rg] * rn * sw[d0], o[dt][4 * rg + 1] * rn * sw[d0 + 1]),
                                                 pack2(o[dt][4 * rg + 2] * rn * sw[d0 + 2], o[dt][4 * rg + 3] * rn * sw[d0 + 3]));
        }
    }
  }
}

struct SelFrags { u32x2 k[8]; u32x2 v[8]; };

DI void sel_load(int tid, SelFrags& f, const unsigned char* __restrict__ Kg, const unsigned char* __restrict__ Vtg, int b) {
  const int lane = tid & 63, i = lane & 15, h4 = lane >> 4;
  const int bu = __builtin_amdgcn_readfirstlane(b);
  const unsigned char* kb = Kg + (size_t)bu * 4096 + lane * 8;
  const unsigned char* vb = Vtg + (size_t)bu * 4096 + lane * 8;
  (void)i; (void)h4;
#pragma unroll
  for (int L = 0; L < 8; ++L) f.k[L] = *(const u32x2*)(kb + L * 512);
#pragma unroll
  for (int L = 0; L < 8; ++L) f.v[L] = *(const u32x2*)(vb + L * 512);
}
template <bool MASK>
DI void sel_compute_t(int tid, const SelFrags& f, const u32x2 (&qb)[2], int b, int qpos, float M2, f32x4 (&o)[4], f32x4& ol) {
  const int lane = tid & 63, h4 = lane >> 4;
  const float c0 = 8.f - M2;
  const u32x2 ones = mk2(0x38383838u, 0x38383838u);
#pragma unroll
  for (int G = 0; G < 2; ++G) {
    f32x4 s[2];
#pragma unroll
    for (int t = 0; t < 2; ++t) {
      s[t] = (f32x4){0.f, 0.f, 0.f, 0.f};
#pragma unroll
      for (int ks = 0; ks < 2; ++ks)
        s[t] = __builtin_amdgcn_mfma_f32_16x16x32_fp8_fp8(__builtin_bit_cast(long, f.k[G * 4 + t * 2 + ks]), __builtin_bit_cast(long, qb[ks]), s[t], 0, 0, 0);
    }
#pragma unroll
    for (int t = 0; t < 2; ++t)
#pragma unroll
      for (int r = 0; r < 4; ++r) {
        float p = __builtin_amdgcn_exp2f(s[t][r] * 0.0625f + c0);
        if (MASK) { const int key = b * 64 + 32 * G + 8 * h4 + 4 * t + r; if (key > qpos) p = 0.f; }
        s[t][r] = p;
      }
    int w0 = 0, w1 = 0;
    w0 = __builtin_amdgcn_cvt_pk_bf8_f32(s[0][0], s[0][1], w0, false);
    w0 = __builtin_amdgcn_cvt_pk_bf8_f32(s[0][2], s[0][3], w0, true);
    w1 = __builtin_amdgcn_cvt_pk_bf8_f32(s[1][0], s[1][1], w1, false);
    w1 = __builtin_amdgcn_cvt_pk_bf8_f32(s[1][2], s[1][3], w1, true);
    const u32x2 pb = mk2((u32)w0, (u32)w1);
#pragma unroll
    for (int dt = 0; dt < 4; ++dt)
      o[dt] = __builtin_amdgcn_mfma_f32_16x16x32_fp8_bf8(__builtin_bit_cast(long, f.v[G * 4 + dt]), __builtin_bit_cast(long, pb), o[dt], 0, 0, 0);
    ol = __builtin_amdgcn_mfma_f32_16x16x32_fp8_bf8(__builtin_bit_cast(long, ones), __builtin_bit_cast(long, pb), ol, 0, 0, 0);
  }
}
DI void sel_compute(int tid, const SelFrags& f, const u32x2 (&qb)[2], int b, int cur, int qpos, float M2, f32x4 (&o)[4], f32x4& ol) {
  if (__builtin_amdgcn_readfirstlane(b) == __builtin_amdgcn_readfirstlane(cur)) sel_compute_t<true>(tid, f, qb, b, qpos, M2, o, ol);
  else sel_compute_t<false>(tid, f, qb, b, qpos, M2, o, ol);
}

__device__ __forceinline__ void nsa_item(const Params& P, int l, int g, int qb, char* smem, int secmask = 7) {
  const int tid = opaque_tid(), lane = tid & 63, wave = tid >> 6, h = lane >> 5;
  const int q0 = qb * 128, wq0 = q0 + wave * 32, q = wq0 + (lane & 31), ql = wave * 32 + (lane & 31);
  const int item = g * 128 + qb;
  const float M2 = 8.f * max_abs64(tid, P.nsa_q_norm_w + l * 64) * max_abs64(tid, P.nsa_k_norm_w + l * 64) * LOG2E * 1.01f + 0.1f;
  unsigned char* sel = (unsigned char*)(smem + AT_MISC);
  unsigned char* nsel = sel + 2048;
  float* impA = P.impA + (size_t)item * 256 * 128;
  float* impB = P.impB + (size_t)item * 256 * 128;
  const u16* Kc = P.KCC + (size_t)g * 1024 * 64;
  const int ntc = ((q0 + 96) >> 10) + 1;
  const int nmaxq = (q >= 31) ? ((q - 31) >> 4) : -1;
  const int nmax_w = wq0 >> 4;

  {
    float lh[4] = {0.f, 0.f, 0.f, 0.f};
#pragma unroll 1
    for (int pass = 0; pass < 2; ++pass) {
      float inv[4];
      if (pass == 1) {
#pragma unroll
        for (int hh = 0; hh < 4; ++hh) { float t = lh[hh] + __shfl_xor(lh[hh], 32); inv[hh] = (t > 0.f) ? 1.f / t : 0.f; }
      }
      TileRegs r;
      tile_load(tid, r, Kc, nullptr, 0, 0, false);
      tile_store(tid, r, smem, false);
      __syncthreads();
      for (int t = 0; t < ntc; ++t) {
        char* cur = smem + (t & 1) * AT_STAGE;
        char* nxt = smem + ((t + 1) & 1) * AT_STAGE;
        const bool more = (t + 1 < ntc);
        if (more) tile_load(tid, r, Kc, nullptr, 0, (t + 1) * 64, false);
        const int key0 = t * 64;
        f32x16 ps[2];
#pragma unroll
        for (int kt = 0; kt < 2; ++kt)
#pragma unroll
          for (int i = 0; i < 16; ++i) ps[kt][i] = 0.f;
        if (key0 <= nmax_w) {
#pragma unroll
          for (int hh = 0; hh < 4; ++hh) {
            f32x16 s[2];
            bf16x8 qf[4];
            load_q4(tid, qf, P.QN + (size_t)(g * 4 + hh) * S * 64, q);
            qk_half<4, true>(tid, cur, 0, 0, qf, s[0]);
            qk_half<4, true>(tid, cur, 0, 1, qf, s[1]);
#pragma unroll
            for (int kt = 0; kt < 2; ++kt)
#pragma unroll
              for (int i = 0; i < 16; ++i) {
                float p = __builtin_amdgcn_exp2f(s[kt][i]);
                const int key = key0 + 32 * kt + crow(i, h);
                if (key > nmaxq) p = 0.f;
                if (pass == 0) lh[hh] += p; else ps[kt][i] += p * inv[hh];
              }
          }
        }
        if (pass == 1) {
#pragma unroll
          for (int kt = 0; kt < 2; ++kt)
#pragma unroll
            for (int rg = 0; rg < 4; ++rg) {
              const int j = 16 * t + 8 * kt + 2 * rg + h;
              impA[(size_t)j * 128 + ql] = ps[kt][4 * rg] + ps[kt][4 * rg + 1] + ps[kt][4 * rg + 2] + ps[kt][4 * rg + 3];
              impB[(size_t)j * 128 + ql] = ps[kt][4 * rg + 3];
            }
        }
        if (more) tile_store(tid, r, nxt, false);
        __syncthreads();
      }
    }
  }
  __threadfence_block();
  __syncthreads();
  {
    const int qt = tid >> 1, half = tid & 1;
    const int qp = q0 + qt, cur = qp >> 6;
    u32 lst[13];
#pragma unroll
    for (int i = 0; i < 13; ++i) lst[i] = 0u;
    for (int j0 = 1 + half; j0 <= cur - 2; j0 += 8) {
      float sc[4];
#pragma unroll
      for (int u = 0; u < 4; ++u) {
        const int j = j0 + 2 * u, jc = j <= cur - 2 ? j : 1;
        sc[u] = impA[(size_t)jc * 128 + qt] + impB[(size_t)(jc - 1) * 128 + qt];
      }
#pragma unroll
      for (int u = 0; u < 4; ++u) {
        const int j = j0 + 2 * u;
        u32 x = (j <= cur - 2) ? ((__float_as_uint(sc[u]) & 0xffffff00u) | (u32)j) : 0u;
#pragma unroll
        for (int i = 0; i < 13; ++i) { const u32 hi = max(lst[i], x); x = min(lst[i], x); lst[i] = hi; }
      }
    }
    u32 oth[13];
#pragma unroll
    for (int i = 0; i < 13; ++i) oth[i] = (u32)__shfl_xor((int)lst[i], 1);
#pragma unroll
    for (int k = 0; k < 13; ++k) {
      u32 x = oth[k];
#pragma unroll
      for (int i = 0; i < 13; ++i) { const u32 hi = max(lst[i], x); x = min(lst[i], x); lst[i] = hi; }
    }
    if (half == 0) {
      unsigned char* sp = sel + qt * 16;
      int n = 0;
      sp[n++] = 0;
      if (cur >= 1) sp[n++] = (unsigned char)cur;
      if (cur >= 2) sp[n++] = (unsigned char)(cur - 1);
      const int ncand = cur - 2 < 13 ? cur - 2 : 13;
#pragma unroll
      for (int i = 0; i < 13; ++i) if (i < ncand) sp[n++] = (unsigned char)(lst[i] & 0xffu);
      nsel[qt] = (unsigned char)n;
    }
  }
  __syncthreads();
  if (secmask & 2) {
    const unsigned char* Kg = P.KS8 + (size_t)g * S * 64; const unsigned char* Vtg = P.VS8t + (size_t)g * 64 * S;
    const int col = lane & 15, h4 = lane >> 4, hd = col & 3;
    const unsigned char* selw = sel + wave * 32 * 16;
    const unsigned char* nselw = nsel + wave * 32;
    u32x2* q8 = (u32x2*)(smem + wave * 8448);
    float* gl = (float*)(smem + 41472 + wave * 1600);
    u16* vis = (u16*)(smem + 41472 + wave * 1600 + 512);
    {
#pragma unroll 4
      for (int c = lane; c < 1024; c += 64) {
        const int qi = c >> 5, head = (c >> 3) & 3, ch = c & 7;
        const u32x4 qv = *(const u32x4*)(P.QR + ((size_t)(g * 4 + head) * S + wq0 + qi) * 64 + ch * 8);
        int w0 = 0, w1 = 0;
        w0 = __builtin_amdgcn_cvt_pk_fp8_f32(bflo(qv.x) * 16.f, bfhi(qv.x) * 16.f, w0, false);
        w0 = __builtin_amdgcn_cvt_pk_fp8_f32(bflo(qv.y) * 16.f, bfhi(qv.y) * 16.f, w0, true);
        w1 = __builtin_amdgcn_cvt_pk_fp8_f32(bflo(qv.z) * 16.f, bfhi(qv.z) * 16.f, w1, false);
        w1 = __builtin_amdgcn_cvt_pk_fp8_f32(bflo(qv.w) * 16.f, bfhi(qv.w) * 16.f, w1, true);
        q8[(qi * 8 + ch) * 4 + head] = mk2((u32)w0, (u32)w1);
      }
      if (lane < 32) q8[(32 * 8 + (lane >> 2)) * 4 + (lane & 3)] = mk2(0u, 0u);
      for (int c = lane; c < 128; c += 64) gl[c] = P.gates[(size_t)(wq0 + (c >> 2)) * 24 + (g * 4 + (c & 3)) * 3 + 1];
      int cnt = (lane < 32) ? (int)nselw[lane] : 0, pre = cnt;
#pragma unroll
      for (int o = 1; o < 32; o <<= 1) { const int t2 = __shfl_up(pre, o); if ((lane & 31) >= o) pre += t2; }
      const int V = __builtin_amdgcn_readlane(pre, 31);
      pre -= cnt;
      if (lane < 32) for (int i = 0; i < cnt; ++i) vis[pre + i] = (u16)(selw[lane * 16 + i] | (lane << 8) | (i + 1 == cnt ? 0x8000 : 0));
      if (lane < 5) vis[V + lane] = (u16)(32 << 8);
      __builtin_amdgcn_s_waitcnt(0xc07f);
      __builtin_amdgcn_wave_barrier();
      const int V3 = ((V + 2) / 3) * 3;
      SelFrags fr[3];
      sel_load(tid, fr[0], Kg, Vtg, vis[0] & 0xff);
      sel_load(tid, fr[1], Kg, Vtg, vis[1] & 0xff);
      f32x4 o[4];
#pragma unroll
      for (int dt = 0; dt < 4; ++dt) o[dt] = (f32x4){0.f, 0.f, 0.f, 0.f};
      f32x4 ol = (f32x4){0.f, 0.f, 0.f, 0.f};
#pragma unroll 1
      for (int v = 0; v < V3; v += 3) {
#pragma unroll
        for (int slot = 0; slot < 3; ++slot) {
          const int e = __builtin_amdgcn_readfirstlane((int)vis[v + slot]);
          const int e2 = __builtin_amdgcn_readfirstlane((int)vis[v + slot + 2]);
          sel_load(tid, fr[(slot + 2) % 3], Kg, Vtg, e2 & 0xff);
          const int qi = (e >> 8) & 63, bb = e & 0xff, qp = wq0 + qi;
          u32x2 qcur[2];
          qcur[0] = q8[(qi * 8 + h4) * 4 + hd]; qcur[1] = q8[(qi * 8 + 4 + h4) * 4 + hd];
          sel_compute(tid, fr[slot], qcur, bb, qp >> 6, qp, M2, o, ol);
          if (e & 0x8000) {
            const float lsum = ol[0];
            if (col < 4 && (!(secmask & 8) || lsum == 1.2345e33f)) {
              const float gs = (ABLATE & 4) ? 0.f : gl[qi * 4 + col] / lsum;
              u16* dst = P.mix + (size_t)qp * 1024 + 256 + (g * 4 + col) * 64 + 4 * h4;
#pragma unroll
              for (int dt = 0; dt < 4; ++dt)
                *(u32x2*)(dst + 16 * dt) = mk2(pack2(o[dt][0] * gs, o[dt][1] * gs), pack2(o[dt][2] * gs, o[dt][3] * gs));
            }
#pragma unroll
            for (int dt = 0; dt < 4; ++dt) o[dt] = (f32x4){0.f, 0.f, 0.f, 0.f};
            ol = (f32x4){0.f, 0.f, 0.f, 0.f};
          }
        }
      }
    }
  }
  __threadfence_block();
  __syncthreads();
#pragma unroll 1
  for (int hh = 0; hh < ((secmask & 4) ? 4 : 0); ++hh) {
    const int H = g * 4 + hh;
#pragma unroll 1
    for (int br = 0; br < 2; ++br) {
      AttnArgs a;
      a.q = q; a.wq0 = wq0; a.M2 = M2; a.cq = 0.f; a.cloc = nullptr; a.base = nullptr; a.dofs = 0;
      bf16x8 qf[4];
      f32x16 o[2]; zero_o(o);
      float ls = 0.f;
      if (br == 0) {
        load_q4(tid, qf, P.QN + (size_t)H * S * 64, q);
        a.K = Kc; a.Vt = P.VCCt + (size_t)g * 64 * 1024; a.ldv = 1024; a.t0 = 0; a.t1 = ntc;
        a.lim_hi = nmaxq; a.lim_lo = 0; a.whi = nmax_w; a.wlo = 0; a.mask_hi = (wq0 >= 31) ? ((wq0 - 31) >> 4) : -1; a.mask_lo = 0;
      } else {
        load_q4(tid, qf, P.QR + (size_t)H * S * 64, q);
        a.K = P.KW + (size_t)g * S * 64; a.Vt = P.VWt + (size_t)g * 64 * S; a.ldv = S;
        a.t0 = (q0 >> 6) - 8 < 0 ? 0 : (q0 >> 6) - 8; a.t1 = (q0 >> 6) + 2;
        a.lim_hi = q; a.lim_lo = q - 511; a.whi = wq0 + 31; a.wlo = wq0 - 511; a.mask_hi = wq0; a.mask_lo = wq0 + 31 - 511;
      }
      attn_loop<4, 4, true>(tid, a, qf, o, ls, smem);
      ls += __shfl_xor(ls, 32);
      float gt = (ls > 0.f) ? P.gates[(size_t)q * 24 + H * 3 + (br == 0 ? 0 : 2)] / ls : 0.f;
      if ((ABLATE & 2) && br == 0) gt = 0.f;
      if ((ABLATE & 8) && br == 1) gt = 0.f;
      u16* dst = P.mix + (size_t)q * 1024 + 256 + H * 64 + 4 * h;
      if (!(secmask & 8) || ls == 1.2345e33f)
#pragma unroll
      for (int dt = 0; dt < 2; ++dt)
#pragma unroll
        for (int rg = 0; rg < 4; ++rg) {
          u32x2* pp = (u32x2*)(dst + 32 * dt + 8 * rg);
          const u32x2 old = *pp;
          const float r0 = bflo(old.x) + gt * o[dt][4 * rg];
          const float r1 = bfhi(old.x) + gt * o[dt][4 * rg + 1];
          const float r2 = bflo(old.y) + gt * o[dt][4 * rg + 2];
          const float r3 = bfhi(old.y) + gt * o[dt][4 * rg + 3];
          *pp = mk2(pack2(r0, r1), pack2(r2, r3));
        }
    }
  }
}

DI unsigned xcc_id() { return (unsigned)__builtin_amdgcn_s_getreg((3 << 11) | 20) & 0xFu; }

__device__ __forceinline__ void phase_attention(const Params& P, int l, char* smem, unsigned* counter, int secmask = 7, int kmask = 0) {
  int* slot = (int*)(smem + AT_MISC + 4096);
  const int mygrp = (int)(xcc_id() & 1u);
#pragma unroll 1
  for (int pass = 0; pass < 2; ++pass) {
    const int g = pass == 0 ? mygrp : 1 - mygrp;
    for (;;) {
      __syncthreads();
      if (threadIdx.x == 0) *slot = (int)atomicAdd(counter + g, 1u);
      __syncthreads();
      const int it = *slot;
      if (it >= 128 || (kmask & 2)) break;
      nsa_item(P, l, g, 127 - it, smem, secmask);
    }
  }
  const int x = (int)(xcc_id() & 7u);
#pragma unroll 1
  for (int sidx = 0; sidx < 8; ++sidx) {
    const int k = ((x + (sidx >> 1)) & 7) ^ ((sidx & 1) << 2);
    for (;;) {
      __syncthreads();
      if (threadIdx.x == 0) *slot = (int)atomicAdd(counter + 2 + k, 1u);
      __syncthreads();
      const int it = *slot;
      if (it >= 128 || (kmask & 1)) break;
      const int qb = 127 - it;
      if (k < 4) { if (!(kmask & 4)) diff_item(P, l, k, qb, smem); } else { if (!(kmask & 8)) fox_item(P, l, k - 4, qb, smem); }
    }
  }
}

__device__ __forceinline__ void phase_outproj(const Params& P, int l, char* smem, bool dry = false) {
  const u16* Wt = P.WoutT + (size_t)l * D * D;
  float* tile = (float*)smem;
  const int tid = threadIdx.x;
  for (int it = blockIdx.x; it < 128 * 8; it += gridDim.x) {
    const int mt = it >> 3, nt = it & 7;
    f32x16 acc[2][2];
    zero_acc(acc);
    gemm_mainloop<false>(P.mix + (size_t)mt * 128 * D, D, Wt + (size_t)nt * 128 * D, D, D, smem, acc);
    acc_to_lds(acc, tile);
    __syncthreads();
    const int c4 = (tid & 31) * 4, r0 = tid >> 5;
#pragma unroll 4
    for (int i = 0; i < 16; ++i) {
      const int row = r0 + 8 * i;
      const size_t idx = (size_t)(mt * 128 + row) * D + nt * 128 + c4;
      const f32x4 a4 = *(const f32x4*)(tile + row * EPS_LD + c4);
      f32x4 h4 = *(const f32x4*)(P.out + idx);
      h4 += a4;
      if (!dry || h4[0] == 1.2345e33f) {
        *(f32x4*)(P.out + idx) = h4;
        *(u32x2*)(P.hb2 + idx) = mk2(pack2(h4[0], h4[1]), pack2(h4[2], h4[3]));
      }
    }
  }
}

constexpr int QT_ST = 272;
DI u32 ord_key(float x, u32 idx) {
  u32 u = __float_as_uint(x);
  u = (u & 0x80000000u) ? ~u : (u | 0x80000000u);
  return (u & 0xffffff80u) | idx;
}
DI float ord_val(u32 k) {
  return (k & 0x80000000u) ? __uint_as_float(k & 0x7fffff80u) : __uint_as_float((~k) & 0xffffff80u);
}
DI void merge16(u32 (&lst)[16], int xm) {
  u32 c[16];
#pragma unroll
  for (int i = 0; i < 16; ++i) { const u32 o = (u32)__shfl_xor((int)lst[15 - i], xm); c[i] = max(lst[i], o); }
#pragma unroll
  for (int st = 8; st > 0; st >>= 1)
#pragma unroll
    for (int i = 0; i < 16; ++i)
      if ((i & st) == 0) { const u32 a = max(c[i], c[i + st]), b = min(c[i], c[i + st]); c[i] = a; c[i + st] = b; }
#pragma unroll
  for (int i = 0; i < 16; ++i) lst[i] = c[i];
}

__device__ __forceinline__ void phase_peerq(const Params& P, int l, char* smem) {
  const u16* Wt = P.WqT + (size_t)l * 2048 * D;
  const int tid = threadIdx.x, lane = tid & 63, wave = tid >> 6, wr = wave >> 1, wc = wave & 1, h = lane >> 5;
  const float* rs = (const float*)(smem + G_RS_OFF);
  float* tile = (float*)smem;
  for (int it = blockIdx.x; it < 128 * 16; it += gridDim.x) {
    const int mt = it >> 4, nt = it & 15;
    f32x16 acc[2][2];
    zero_acc(acc);
    gemm_mainloop<true>(P.hb2 + (size_t)mt * 128 * D, D, Wt + (size_t)nt * 128 * D, D, D, smem, acc);
    __syncthreads();
#pragma unroll
    for (int i = 0; i < 2; ++i)
#pragma unroll
      for (int j = 0; j < 2; ++j)
#pragma unroll
        for (int r = 0; r < 16; ++r) {
          const int row = wr * 64 + i * 32 + crow(r, h);
          *(u16*)(smem + row * QT_ST + (wc * 64 + j * 32 + (lane & 31)) * 2) = f2bf(acc[i][j][r] * rs[row]);
        }
    __syncthreads();
    zero_acc(acc);
    {
      const u16* Bk = P.SubK + ((size_t)(l * 16 + nt) * 128 + wc * 64 + (lane & 31)) * 128 + h * 8;
      const char* Aq = smem + (wr * 64 + (lane & 31)) * QT_ST + h * 16;
#pragma unroll
      for (int ks = 0; ks < 8; ++ks) {
        bf16x8 af[2], bfr[2];
#pragma unroll
        for (int i = 0; i < 2; ++i) af[i] = *(const bf16x8*)(Aq + i * 32 * QT_ST + ks * 32);
#pragma unroll
        for (int j = 0; j < 2; ++j) bfr[j] = *(const bf16x8*)(Bk + (size_t)j * 32 * 128 + ks * 16);
#pragma unroll
        for (int i = 0; i < 2; ++i)
#pragma unroll
          for (int j = 0; j < 2; ++j) acc[i][j] = MFMA32(af[i], bfr[j], acc[i][j]);
      }
    }
    __syncthreads();
    acc_to_lds(acc, tile);
    __syncthreads();
#pragma unroll 1
    for (int half = 0; half < 2; ++half) {
      {
        const int row = half * 64 + (tid >> 2), part = tid & 3;
        u32 lst[16];
#pragma unroll
        for (int i = 0; i < 16; ++i) lst[i] = 0u;
        const f32x4* src = (const f32x4*)(tile + row * EPS_LD + part * 32);
#pragma unroll
        for (int c4 = 0; c4 < 8; ++c4) {
          const f32x4 v = src[c4];
#pragma unroll
          for (int e = 0; e < 4; ++e) {
            u32 x = ord_key(v[e], (u32)(part * 32 + c4 * 4 + e));
#pragma unroll
            for (int i = 0; i < 16; ++i) { const u32 hi = max(lst[i], x); x = min(lst[i], x); lst[i] = hi; }
          }
        }
        merge16(lst, 1);
        merge16(lst, 2);
        if (part == 0) {
          u32x4* dp = (u32x4*)(P.topk + ((size_t)(mt * 128 + row) * 16 + nt) * 16);
          dp[0] = mk4(lst[0], lst[1], lst[2], lst[3]); dp[1] = mk4(lst[4], lst[5], lst[6], lst[7]);
          dp[2] = mk4(lst[8], lst[9], lst[10], lst[11]); dp[3] = mk4(lst[12], lst[13], lst[14], lst[15]);
        }
      }
    }
  }
}

__device__ const unsigned char kCandIJ[50] = {
  0x00,0x01,0x02,0x03,0x04,0x05,0x06,0x07,0x08,0x09,0x0a,0x0b,0x0c,0x0d,0x0e,0x0f,
  0x10,0x11,0x12,0x13,0x14,0x15,0x16,0x17,
  0x20,0x21,0x22,0x23,0x24,
  0x30,0x31,0x32,0x33,
  0x40,0x41,0x42,
  0x50,0x51, 0x60,0x61, 0x70,0x71,
  0x80,0x90,0xa0,0xb0,0xc0,0xd0,0xe0,0xf0};
DI float gelu_exact(float x) { return 0.5f * x * (1.f + erff(x * 0.7071067811865476f)); }

__device__ __forceinline__ void phase_peer(const Params& P, int l, char* smem, bool dry = false) {
  const int tid = threadIdx.x, lane = tid & 63, wave = tid >> 6;
  char* wsm = smem + wave * 8192;
  u32* keys = (u32*)wsm;
  u32* cvk = (u32*)(wsm + 1024);
  int* exps = (int*)(wsm + 1024 + 1664);
  float* esc = (float*)(wsm + 3200);
  float* wts = (float*)(wsm + 3712);
  float* hraw = (float*)(wsm + 4224);
  unsigned char* xrow8 = (unsigned char*)(wsm + 5248);
  const unsigned char* U8 = P.U8 + (size_t)l * S * (D / 2);
  const unsigned char* V8 = P.V8 + (size_t)l * S * (D / 2);
  const float* Uinv = P.Uinv + l * S; const float* Vinv = P.Vinv + l * S;
  if (lane < 16) cvk[(lane >> 1) * 52 + 50 + (lane & 1)] = 0u;
  int it = blockIdx.x;
  u32x4 kq = mk4(0u, 0u, 0u, 0u), xa = kq, xb = kq;
  if (it < S / 4) {
    const int tok = it * 4 + wave;
    kq = *(const u32x4*)(P.topk + (size_t)tok * 256 + lane * 4);
    xa = *(const u32x4*)(P.hb2 + (size_t)tok * D + lane * 16); xb = *(const u32x4*)(P.hb2 + (size_t)tok * D + lane * 16 + 8);
  }
  for (; it < S / 4; it += gridDim.x) {
    const int tok = it * 4 + wave;
    *(u32x4*)(keys + lane * 4) = kq;
    float rstd = wave_sum(ssq8(xa) + ssq8(xb));
    rstd = rsqrtf(rstd * (1.f / 1024.f) + 1e-6f);
    float xinv;
    {
      float xv[16] = {bflo(xa.x), bfhi(xa.x), bflo(xa.y), bfhi(xa.y), bflo(xa.z), bfhi(xa.z), bflo(xa.w), bfhi(xa.w),
                      bflo(xb.x), bfhi(xb.x), bflo(xb.y), bfhi(xb.y), bflo(xb.z), bfhi(xb.z), bflo(xb.w), bfhi(xb.w)};
      float m = 0.f;
#pragma unroll
      for (int i = 0; i < 16; ++i) m = fmaxf(m, fabsf(xv[i]));
      m = wave_max(m);
      const float sx = (m > 0.f) ? 240.f / m : 0.f;
      xinv = m * (1.f / 240.f);
      u32 o4[4];
#pragma unroll
      for (int i = 0; i < 4; ++i) {
        int wd = 0;
        wd = __builtin_amdgcn_cvt_pk_fp8_f32(xv[4 * i] * sx, xv[4 * i + 1] * sx, wd, false);
        wd = __builtin_amdgcn_cvt_pk_fp8_f32(xv[4 * i + 2] * sx, xv[4 * i + 3] * sx, wd, true);
        o4[i] = (u32)wd;
      }
      *(u32x4*)(xrow8 + lane * 16) = mk4(o4[0], o4[1], o4[2], o4[3]);
    }
    {
      const int nit = it + gridDim.x;
      if (nit < S / 4) {
        const int ntok = nit * 4 + wave;
        kq = *(const u32x4*)(P.topk + (size_t)ntok * 256 + lane * 4);
        xa = *(const u32x4*)(P.hb2 + (size_t)ntok * D + lane * 16); xb = *(const u32x4*)(P.hb2 + (size_t)ntok * D + lane * 16 + 8);
      }
    }
    __builtin_amdgcn_s_waitcnt(0xc07f);
    const int hd = lane >> 3, sub = lane & 7;
    float myv[7]; int mye[7]; u32 mk[7];
#pragma unroll
    for (int m = 0; m < 7; ++m) {
      const int c = sub + 8 * m;
      myv[m] = -3.0e38f; mye[m] = 0; mk[m] = 0u;
      if (m < 6 || c < 50) {
        const int ij = kCandIJ[c], i = ij >> 4, j = ij & 15;
        const u32 k1 = keys[(hd * 2) * 16 + i], k2 = keys[(hd * 2 + 1) * 16 + j];
        myv[m] = ord_val(k1) + ord_val(k2);
        mye[m] = (int)((k1 & 127u) * 128u + (k2 & 127u));
        u32 sk = __float_as_uint(myv[m]);
        sk = (sk & 0x80000000u) ? ~sk : (sk | 0x80000000u);
        mk[m] = (sk & 0xffffffc0u) | (u32)(63 - c);
        cvk[hd * 52 + c] = mk[m];
      }
    }
    __builtin_amdgcn_s_waitcnt(0xc07f);
    {
      int rk[7];
#pragma unroll
      for (int m = 0; m < 7; ++m) rk[m] = 0;
#pragma unroll
      for (int j = 0; j < 13; ++j) {
        const u32x4 o = *(const u32x4*)(cvk + hd * 52 + 4 * j);
#pragma unroll
        for (int m = 0; m < 7; ++m) rk[m] += (int)(o.x > mk[m]) + (int)(o.y > mk[m]) + (int)(o.z > mk[m]) + (int)(o.w > mk[m]);
      }
#pragma unroll
      for (int m = 0; m < 7; ++m) {
        const int c = sub + 8 * m;
        if ((m < 6 || c < 50) && rk[m] < 16) { exps[hd * 16 + rk[m]] = mye[m]; esc[hd * 16 + rk[m]] = myv[m]; }
      }
    }
    __builtin_amdgcn_s_waitcnt(0xc07f);
    const int ex0 = exps[lane], ex1 = exps[lane + 64];
    const float ui0 = Uinv[ex0], ui1 = Uinv[ex1], vi0 = Vinv[ex0], vi1 = Vinv[ex1];
    float g0, g1;
    {
      const float mx = esc[hd * 16];
      const float e0 = expf(esc[hd * 16 + 2 * sub] - mx), e1 = expf(esc[hd * 16 + 2 * sub + 1] - mx);
      float sm = e0 + e1;
      sm += __shfl_xor(sm, 1); sm += __shfl_xor(sm, 2); sm += __shfl_xor(sm, 4);
      g0 = e0 / sm; g1 = e1 / sm;
    }
    wts[hd * 16 + 2 * sub] = g0; wts[hd * 16 + 2 * sub + 1] = g1;
    {
      const int i16 = lane & 15, h4 = lane >> 4;
      u32x4 a0[8], a1[8];
      auto uload = [&](u32x4 (&a)[8], int g) {
        const unsigned char* urow = U8 + (u32)(exps[g * 16 + i16] * (D / 2) + 16 * h4);
#pragma unroll
        for (int i = 0; i < 8; ++i) a[i] = *(const u32x4*)(urow + i * 64);
      };
      auto umma = [&](const u32x4 (&a)[8], int g) {
        f32x4 acc = (f32x4){0.f, 0.f, 0.f, 0.f};
#pragma unroll
        for (int i = 0; i < 8; ++i) {
          const u32x4 b0 = *(const u32x4*)(xrow8 + i * 128 + 16 * h4), b1 = *(const u32x4*)(xrow8 + i * 128 + 64 + 16 * h4);
          const i32x8 A = {(int)a[i].x, (int)a[i].y, (int)a[i].z, (int)a[i].w, 0, 0, 0, 0};
          const i32x8 B = {(int)b0.x, (int)b0.y, (int)b0.z, (int)b0.w, (int)b1.x, (int)b1.y, (int)b1.z, (int)b1.w};
          acc = __builtin_amdgcn_mfma_scale_f32_16x16x128_f8f6f4(A, B, acc, 4, 0, 0, 0x7f7f7f7f, 0, 0x7f7f7f7f);
        }
        if (i16 == 0) *(f32x4*)(hraw + g * 16 + 4 * h4) = acc;
      };
      uload(a0, 0);
#pragma unroll 1
      for (int g = 0; g < 8; g += 2) {
        uload(a1, g + 1);
        umma(a0, g);
        if (g + 2 < 8) uload(a0, g + 2);
        umma(a1, g + 1);
      }
    }
    __builtin_amdgcn_s_waitcnt(0xc07f);
    {
      const float h0 = hraw[lane], h1 = hraw[lane + 64];
      const float w0 = wts[lane], w1 = wts[lane + 64];
      wts[lane] = w0 * gelu_exact(rstd * h0 * ui0 * xinv) * vi0;
      wts[lane + 64] = w1 * gelu_exact(rstd * h1 * ui1 * xinv) * vi1;
    }
    __builtin_amdgcn_s_waitcnt(0xc07f);
    float o[16];
#pragma unroll
    for (int i = 0; i < 16; ++i) o[i] = 0.f;
    {
      u32x2 va[8], vb2[8];
      auto vload = [&](u32x2 (&x0)[8], int k) {
#pragma unroll
        for (int u = 0; u < 8; ++u) x0[u] = *(const u32x2*)(V8 + (u32)(exps[k + u] * (D / 2) + lane * 8));
      };
      auto vacc = [&](const u32x2 (&x0)[8], int k) {
#pragma unroll
        for (int u = 0; u < 8; ++u) {
          const float w = wts[k + u];
#pragma unroll
          for (int c = 0; c < 2; ++c) {
            const f32x2 d0 = __builtin_amdgcn_cvt_scalef32_pk_f32_fp4(x0[u][c], 1.0f, 0), d1 = __builtin_amdgcn_cvt_scalef32_pk_f32_fp4(x0[u][c], 1.0f, 1);
            const f32x2 d2 = __builtin_amdgcn_cvt_scalef32_pk_f32_fp4(x0[u][c], 1.0f, 2), d3 = __builtin_amdgcn_cvt_scalef32_pk_f32_fp4(x0[u][c], 1.0f, 3);
            o[8 * c] += w * d0[0]; o[8 * c + 1] += w * d0[1]; o[8 * c + 2] += w * d1[0]; o[8 * c + 3] += w * d1[1];
            o[8 * c + 4] += w * d2[0]; o[8 * c + 5] += w * d2[1]; o[8 * c + 6] += w * d3[0]; o[8 * c + 7] += w * d3[1];
          }
        }
      };
      vload(va, 0);
#pragma unroll 1
      for (int k = 0; k < 128; k += 16) {
        vload(vb2, k + 8);
        vacc(va, k);
        if (k + 16 < 128) vload(va, k + 16);
        vacc(vb2, k + 8);
      }
    }
    if (!dry || o[0] == 1.2345e33f) {
      f32x4* op = (f32x4*)(P.out + (size_t)tok * D + lane * 16);
      float r[16];
#pragma unroll
      for (int i = 0; i < 4; ++i) { f32x4 t = op[i]; t.x += o[4 * i]; t.y += o[4 * i + 1]; t.z += o[4 * i + 2]; t.w += o[4 * i + 3]; op[i] = t; r[4 * i] = t.x; r[4 * i + 1] = t.y; r[4 * i + 2] = t.z; r[4 * i + 3] = t.w; }
      u32x4* hp = (u32x4*)(P.hb2 + (size_t)tok * D + lane * 16);
      hp[0] = mk4(pack2(r[0], r[1]), pack2(r[2], r[3]), pack2(r[4], r[5]), pack2(r[6], r[7]));
      hp[1] = mk4(pack2(r[8], r[9]), pack2(r[10], r[11]), pack2(r[12], r[13]), pack2(r[14], r[15]));
    }
  }
}

__device__ __forceinline__ void phase_ple(const Params& P, int l, char* smem, bool dry = false) {
  const u16* Wg = P.WgT + (size_t)l * D * D;
  const u16* Wp = P.WpT + (size_t)l * D * 256;
  const u16* pb = P.pb + (size_t)l * S * 256;
  const int tid = threadIdx.x, lane = tid & 63, wave = tid >> 6, wr = wave >> 1, h = lane >> 5;
  const float* rs = (const float*)(smem + G_RS_OFF);
  float* tile = (float*)smem;
  for (int it = blockIdx.x; it < 128 * 8; it += gridDim.x) {
    const int mt = it >> 3, nt = it & 7;
    f32x16 acc[2][2];
    zero_acc(acc);
    gemm_mainloop<false>(pb + (size_t)mt * 128 * 256, 256, Wp + (size_t)nt * 128 * 256, 256, 256, smem, acc);
    u16* side = (u16*)(smem + 36864);
    const int wc = wave & 1;
#pragma unroll
    for (int i = 0; i < 2; ++i)
#pragma unroll
      for (int j = 0; j < 2; ++j)
#pragma unroll
        for (int r = 0; r < 16; ++r)
          side[(wr * 64 + i * 32 + crow(r, h)) * 136 + wc * 64 + j * 32 + (lane & 31)] = f2bf(acc[i][j][r]);
    zero_acc(acc);
    gemm_mainloop<true>(P.hb2 + (size_t)mt * 128 * D, D, Wg + (size_t)nt * 128 * D, D, D, smem, acc);
    __syncthreads();
#pragma unroll
    for (int i = 0; i < 2; ++i)
#pragma unroll
      for (int j = 0; j < 2; ++j)
#pragma unroll
        for (int r = 0; r < 16; ++r) {
          const int row = wr * 64 + i * 32 + crow(r, h);
          const float pv = bf2f(side[row * 136 + wc * 64 + j * 32 + (lane & 31)]);
          acc[i][j][r] = sigmoidf_(acc[i][j][r] * rs[row]) * pv;
        }
    __syncthreads();
    acc_to_lds(acc, tile);
    __syncthreads();
    const int c4 = (tid & 31) * 4, r0 = tid >> 5;
#pragma unroll 4
    for (int i = 0; i < 16; ++i) {
      const int row = r0 + 8 * i;
      const size_t idx = (size_t)(mt * 128 + row) * D + nt * 128 + c4;
      const f32x4 a4 = *(const f32x4*)(tile + row * EPS_LD + c4);
      f32x4 h4 = *(const f32x4*)(P.out + idx);
      h4 += a4;
      if (!dry || h4[0] == 1.2345e33f) {
        *(f32x4*)(P.out + idx) = h4;
        *(u32x2*)(P.hb + idx) = mk2(pack2(h4[0], h4[1]), pack2(h4[2], h4[3]));
      }
    }
  }
}

constexpr int N_PHASES = 15;
#define XB_TMO      128
#define XB_XCNT(j)  (256  + 64 * (j))
#define XB_XSUB(j)  (1280 + 64 * (j))
#define XB_XGEN(j)  (2304 + 64 * (j))
#define XB_TOP      3328
#define XB_TOPGEN   3392
#define XCD_BAR_WORDS 3456
#define XB_SPIN_CAP (1u << 24)
typedef __attribute__((address_space(3))) unsigned las_u32;
DI unsigned xb_ld(unsigned* p) { return __hip_atomic_load(p, __ATOMIC_RELAXED, __HIP_MEMORY_SCOPE_AGENT); }
DI unsigned xb_add(unsigned* p, unsigned v) { return __hip_atomic_fetch_add(p, v, __ATOMIC_RELAXED, __HIP_MEMORY_SCOPE_AGENT); }
#define XB_SPIN(cond, bar) do { unsigned _sp = 0; while (cond) { __builtin_amdgcn_s_sleep(1); \
    if ((++_sp & 255u) == 0u) { if (xb_ld(&(bar)[XB_TMO])) break; if (_sp > XB_SPIN_CAP) { (void)xb_add(&(bar)[XB_TMO], 1u); break; } } } } while (0)
struct XcdBarrier { unsigned* bar; unsigned x; volatile las_u32* st; };
DI XcdBarrier xcd_barrier_post(unsigned* bar, volatile las_u32* st) {
  XcdBarrier b; b.bar = bar; b.x = (unsigned)__builtin_amdgcn_s_getreg((3 << 11) | 20) & 0xFu; b.st = st;
  if (threadIdx.x == 0) (void)xb_add(&bar[XB_XCNT(b.x)], 1u);
  return b;
}
DI void xcd_barrier_complete(unsigned* bar, unsigned x, unsigned& nloc, unsigned& nx) {
  const unsigned G = gridDim.x * gridDim.y * gridDim.z;
  unsigned sum, cnt, mine, sp = 0u;
  for (;;) {
    sum = 0u; cnt = 0u; mine = 0u;
#pragma unroll
    for (unsigned j = 0; j < 16; ++j) { const unsigned c = xb_ld(&bar[XB_XCNT(j)]); sum += c; cnt += (c > 0u) ? 1u : 0u; mine = (j == x) ? c : mine; }
    if (sum == G) break;
    __builtin_amdgcn_s_sleep(1);
    if ((++sp & 255u) == 0u) { if (xb_ld(&bar[XB_TMO])) break; if (sp > XB_SPIN_CAP) { (void)xb_add(&bar[XB_TMO], 1u); break; } }
  }
  nloc = mine > 0u ? mine : 1u; nx = cnt > 0u ? cnt : 1u;
}
DI void xcd_barrier(unsigned* xbar, unsigned xx, volatile las_u32* xst_) {
  XcdBarrier b; b.bar = xbar; b.x = xx; b.st = xst_;
  asm volatile("s_waitcnt vmcnt(0)" ::: "memory");
  __syncthreads();
  if (threadIdx.x == 0) {
    unsigned* bar = b.bar;
    __builtin_amdgcn_s_waitcnt(0);
    unsigned nloc = b.st[0], nx = b.st[1];
    if (nloc == 0u) { xcd_barrier_complete(bar, b.x, nloc, nx); b.st[0] = nloc; b.st[1] = nx; }
    const unsigned old = xb_add(&bar[XB_XSUB(b.x)], 1u);
    const unsigned gen = old / nloc;
    if (old + 1u == (gen + 1u) * nloc) {
      __builtin_amdgcn_fence(__ATOMIC_RELEASE, "agent");
      asm volatile("s_waitcnt vmcnt(0)" ::: "memory");
      const unsigned og = xb_add(&bar[XB_TOP], 1u);
      const unsigned tg = og / nx;
      if (og + 1u == (tg + 1u) * nx) xb_add(&bar[XB_TOPGEN], 1u);
      else XB_SPIN(xb_ld(&bar[XB_TOPGEN]) == tg, bar);
      __builtin_amdgcn_fence(__ATOMIC_ACQUIRE, "agent");
      xb_add(&bar[XB_XGEN(b.x)], 1u);
      asm volatile("s_waitcnt vmcnt(0)" ::: "memory");
    } else {
      XB_SPIN(xb_ld(&bar[XB_XGEN(b.x)]) == gen, bar);
      __builtin_amdgcn_fence(__ATOMIC_ACQUIRE, "agent");
      asm volatile("s_waitcnt vmcnt(0)" ::: "memory");
    }
  }
  __syncthreads();
}
__global__ void __launch_bounds__(NT, 2) hymba_mega(Params P, unsigned* counters) {
  __shared__ __attribute__((aligned(16))) char smem[SMEM_BYTES];
  cg::grid_group grid = cg::this_grid();
  const int lo = P.phase_lo, hi = P.phase_hi;
#ifndef ONLY_PHASE
#define ONLY_PHASE -1
#endif
#define PH_ON(k) (ONLY_PHASE < 0 || ONLY_PHASE == (k))
  volatile las_u32* xst = (volatile las_u32*)(smem + SMEM_BYTES - 16);
  if (threadIdx.x < 4) xst[threadIdx.x] = 0u;
  __syncthreads();
  unsigned* const xbar = counters + 64;
  const unsigned xcc = xcd_barrier_post(xbar, xst).x;
#define RUN(ph, kind, call) if (lo <= (ph) && (ph) < hi) { const bool dry = false; const int rep = 0; (void)dry; (void)rep; if (PH_ON(kind)) { call; } if ((ph) + 1 < hi) { if ((ph) == 0) grid.sync(); else xcd_barrier(xbar, xcc, xst); } }
#define RUNREP(ph, kind, call) if (lo <= (ph) && (ph) < hi) { \
    const int nrep = ((ph) == P.rep_ph) ? P.rep_n : 1; \
    for (int rep = 0; rep < nrep; ++rep) { const bool dry = rep > 0; (void)dry; \
      if (PH_ON(kind)) { call; } \
      if ((ph) + 1 < hi || rep + 1 < nrep) { xcd_barrier(xbar, xcc, xst); } } }
#ifndef REPEAT
#define REPEAT -1
#define RSEC 7
#endif
  RUN(0, 7, phase_prep(P, smem))
  RUN(1, 0, phase_inproj(P, 0, smem))
  RUN(2, 1, phase_compress(P, 0, smem))
  RUNREP(3, 2, phase_attention(P, 0, smem, counters + 16 * rep, dry ? (P.rep_sec | 8) : 7, dry ? P.rep_nsa_only : 0))
  RUN(4, 3, phase_outproj(P, 0, smem, dry))
  RUN(5, 4, phase_peerq(P, 0, smem))
  RUN(6, 5, phase_peer(P, 0, smem, dry))
  RUN(7, 6, phase_ple(P, 0, smem, dry))
  RUN(8, 0, phase_inproj(P, 1, smem))
  RUN(9, 1, phase_compress(P, 1, smem))
  RUN(10, 2, phase_attention(P, 1, smem, counters + 32))
  RUN(11, 3, phase_outproj(P, 1, smem))
  RUN(12, 4, phase_peerq(P, 1, smem))
  RUN(13, 5, phase_peer(P, 1, smem))
  RUN(14, 6, phase_ple(P, 1, smem))
}

static size_t align_up(size_t x, size_t a) { return (x + a - 1) / a * a; }

extern "C" void kernel_launch(void* const* d_in, const int* in_sizes, int n_in, void* d_out, int out_size, void* d_ws, size_t ws_size, hipStream_t stream) {
  static int grid_blocks = 0;
  if (!grid_blocks) {
    int dev = 0, cus = 0, per_cu = 0;
    hipGetDevice(&dev);
    hipDeviceGetAttribute(&cus, hipDeviceAttributeMultiprocessorCount, dev);
    hipOccupancyMaxActiveBlocksPerMultiprocessor(&per_cu, hymba_mega, NT, 0);
    if (per_cu > 2) per_cu = 2;
    if (per_cu < 1) per_cu = 1;
    grid_blocks = cus * per_cu;
  }
  Params P;
  memset(&P, 0, sizeof(P));
  P.x = (const float*)d_in[0]; P.p = (const float*)d_in[1]; P.positions = (const int*)d_in[2];
  P.attn_norm_w = (const float*)d_in[3]; P.w_in = (const float*)d_in[4]; P.fox_f_bias = (const float*)d_in[5];
  P.fox_q_norm_w = (const float*)d_in[6]; P.fox_k_norm_w = (const float*)d_in[7];
  P.nsa_q_norm_w = (const float*)d_in[8]; P.nsa_k_norm_w = (const float*)d_in[9]; P.nsa_cmp_pos = (const float*)d_in[10]; P.nsa_cmp_w = (const float*)d_in[11];
  P.diff_q_norm_w = (const float*)d_in[12]; P.diff_k_norm_w = (const float*)d_in[13]; P.diff_lambda = (const float*)d_in[14]; P.diff_subln_w = (const float*)d_in[15];
  P.w_out = (const float*)d_in[16]; P.ffn_norm_w = (const float*)d_in[17]; P.peer_w_q = (const float*)d_in[18]; P.peer_sub_keys = (const float*)d_in[19];
  P.peer_u = (const float*)d_in[20]; P.peer_v = (const float*)d_in[21]; P.ple_norm_w = (const float*)d_in[22]; P.ple_w_gate = (const float*)d_in[23]; P.ple_w_proj = (const float*)d_in[24];
  P.out = (float*)d_out;
  char* w = (char*)d_ws; size_t off = 0;
  auto take = [&](size_t bytes) { char* p = w + off; off = align_up(off + bytes, 256); return p; };
  unsigned* counters = (unsigned*)take(256 + XCD_BAR_WORDS * 4);
  P.WinT = (u16*)take((size_t)2 * NINP * D * 2);
  P.WoutT = (u16*)take((size_t)2 * D * D * 2);
  P.WqT = (u16*)take((size_t)2 * 2048 * D * 2);
  P.WgT = (u16*)take((size_t)2 * D * D * 2);
  P.WpT = (u16*)take((size_t)2 * D * 256 * 2);
  P.SubK = (u16*)take((size_t)2 * 16 * 128 * 128 * 2);
  P.CmpWT = (u16*)take((size_t)2 * 2 * 128 * 2048 * 2);
  P.cmpbias = (float*)take(2 * 2 * 64 * 4);
  P.U8 = (unsigned char*)take((size_t)2 * S * D / 2);
  P.V8 = (unsigned char*)take((size_t)2 * S * D / 2);
  P.Uinv = (float*)take((size_t)2 * S * 4); P.Vinv = (float*)take((size_t)2 * S * 4);
  P.hb = (u16*)take((size_t)S * D * 2);
  P.hb2 = (u16*)take((size_t)S * D * 2);
  P.pb = (u16*)take((size_t)2 * S * 256 * 2);
  P.ropeN = (float*)take((size_t)S * 64 * 4);
  P.ropeD = (float*)take((size_t)S * 32 * 4);
  P.QF = (u16*)take((size_t)4 * S * 64 * 2); P.KF = (u16*)take((size_t)4 * S * 64 * 2); P.VFt = (u16*)take((size_t)4 * S * 64 * 2);
  P.cloc = (float*)take((size_t)4 * S * 4); P.ctot = (float*)take(256 * 4 * 4);
  P.QN = (u16*)take((size_t)8 * S * 64 * 2); P.QR = (u16*)take((size_t)8 * S * 64 * 2);
  P.KC = (u16*)take((size_t)2 * (S + 64) * 64 * 2); P.VC = (u16*)take((size_t)2 * (S + 64) * 64 * 2);
  P.KCC = (u16*)take((size_t)2 * 1024 * 64 * 2); P.VCCt = (u16*)take((size_t)2 * 64 * 1024 * 2);
  P.KS8 = (unsigned char*)take((size_t)2 * S * 64); P.VS8t = (unsigned char*)take((size_t)2 * S * 64);
  P.KW = (u16*)take((size_t)2 * S * 64 * 2); P.VWt = (u16*)take((size_t)2 * S * 64 * 2);
  P.gates = (float*)take((size_t)S * 24 * 4);
  P.QD = (u16*)take((size_t)4 * S * 64 * 2); P.KD = (u16*)take((size_t)4 * S * 64 * 2); P.VDt = (u16*)take((size_t)4 * S * 64 * 2);
  P.mix = (u16*)take((size_t)S * D * 2);
  P.dstash = (float*)take((size_t)grid_blocks * 128 * 64 * 4);
  P.impA = (float*)take((size_t)256 * 256 * 128 * 4); P.impB = (float*)take((size_t)256 * 256 * 128 * 4);
  P.topk = (u32*)take((size_t)S * 256 * 4);
  if (off > ws_size) { fprintf(stderr, "kernel_launch: workspace too small: need %zu, have %zu\n", off, ws_size); return; }
  hipMemsetAsync(counters, 0, 256 + XCD_BAR_WORDS * 4, stream);
#ifndef SINGLE_LAUNCH
#define SINGLE_LAUNCH 1
#endif
#ifndef REP_PH
#define REP_PH -1
#endif
#ifndef REP_N
#define REP_N 1
#endif
#ifndef REP_SEC
#define REP_SEC 7
#endif
#ifndef REP_NSA_ONLY
#define REP_NSA_ONLY 0
#endif
  P.rep_ph = REP_PH; P.rep_n = REP_N; P.rep_sec = REP_SEC; P.rep_nsa_only = REP_NSA_ONLY;
  if (SINGLE_LAUNCH) {
    P.phase_lo = 0; P.phase_hi = N_PHASES;
    void* args[] = {&P, &counters};
    hipError_t e = hipLaunchCooperativeKernel((void*)hymba_mega, dim3(grid_blocks), dim3(NT), args, 0, stream);
    if (e != hipSuccess) fprintf(stderr, "cooperative launch failed: %s (grid %d)\n", hipGetErrorString(e), grid_blocks);
  } else {
    for (int ph = 0; ph < N_PHASES; ++ph) {
      P.phase_lo = ph; P.phase_hi = ph + 1;
      void* args[] = {&P, &counters};
      hipError_t e = hipLaunchCooperativeKernel((void*)hymba_mega, dim3(grid_blocks), dim3(NT), args, 0, stream);
      if (e != hipSuccess) { fprintf(stderr, "cooperative launch failed: %s (grid %d, phase %d)\n", hipGetErrorString(e), grid_blocks, ph); break; }
    }
  }
}
```

```cpp
#include <hip/hip_runtime.h>
#include <hip/hip_cooperative_groups.h>
#include <cstdio>
#include <cstdint>
#include <cstring>
namespace cg = cooperative_groups;

typedef __attribute__((ext_vector_type(8))) short bf16x8;
typedef __attribute__((ext_vector_type(4))) short bf16x4;
typedef __attribute__((ext_vector_type(16))) float f32x16;
typedef __attribute__((ext_vector_type(4))) float f32x4;
typedef __attribute__((ext_vector_type(2))) float f32x2;
typedef __attribute__((ext_vector_type(2))) __bf16 bf2_t;
typedef unsigned short u16;
typedef unsigned int u32;
typedef __attribute__((ext_vector_type(4))) unsigned int u32x4;
typedef __attribute__((ext_vector_type(2))) unsigned int u32x2;

#define DI __device__ __forceinline__
#define MFMA32(a, b, c) __builtin_amdgcn_mfma_f32_32x32x16_bf16((a), (b), (c), 0, 0, 0)
#define MFMA16(a, b, c) __builtin_amdgcn_mfma_f32_16x16x32_bf16((a), (b), (c), 0, 0, 0)

constexpr int S = 16384;
constexpr int D = 1024;
constexpr int NT = 256;
constexpr int NIN = 2844;
constexpr int NINP = 2944;
constexpr int SMEM_BYTES = 72704;
constexpr float LOG2E = 1.4426950408889634f;
#ifndef ABLATE
#define ABLATE 0
#endif

typedef int i32x8 __attribute__((ext_vector_type(8)));
struct Params {
  const float* x; const float* p; const int* positions;
  const float* attn_norm_w; const float* w_in; const float* fox_f_bias; const float* fox_q_norm_w; const float* fox_k_norm_w;
  const float* nsa_q_norm_w; const float* nsa_k_norm_w; const float* nsa_cmp_pos; const float* nsa_cmp_w;
  const float* diff_q_norm_w; const float* diff_k_norm_w; const float* diff_lambda; const float* diff_subln_w;
  const float* w_out; const float* ffn_norm_w; const float* peer_w_q; const float* peer_sub_keys; const float* peer_u; const float* peer_v;
  const float* ple_norm_w; const float* ple_w_gate; const float* ple_w_proj;
  float* out;
  u16* WinT;
  u16* WoutT;
  u16* WqT;
  u16* WgT;
  u16* WpT;
  u16* SubK;
  u16* CmpWT;
  float* cmpbias;
  unsigned char* U8;
  unsigned char* V8;
  float* Uinv; float* Vinv;
  u16* hb;
  u16* hb2;
  u16* pb;
  float* ropeN;
  float* ropeD;
  u16* QF; u16* KF; u16* VFt;
  float* cloc; float* ctot;
  u16* QN; u16* QR;
  u16* KC; u16* VC;
  u16* KCC; u16* VCCt;
  unsigned char* KS8; unsigned char* VS8t;
  u16* KW; u16* VWt;
  float* gates;
  u16* QD; u16* KD; u16* VDt;
  u16* mix;
  float* dstash;
  float* impA; float* impB;
  u32* topk;
  int phase_lo, phase_hi;
  int rep_ph, rep_n, rep_sec, rep_nsa_only;
};

DI u32x4 mk4(u32 a, u32 b, u32 c, u32 d) { return (u32x4){a, b, c, d}; }
DI u32x2 mk2(u32 a, u32 b) { return (u32x2){a, b}; }
DI u32 pack2(float a, float b) { f32x2 v = {a, b}; bf2_t r = __builtin_convertvector(v, bf2_t); return __builtin_bit_cast(u32, r); }
DI u16 f2bf(float a) { return (u16)(pack2(a, 0.f) & 0xffffu); }
DI float bf2f(u16 x) { return __uint_as_float(((u32)x) << 16); }
DI float bflo(u32 x) { return __uint_as_float(x << 16); }
DI float bfhi(u32 x) { return __uint_as_float(x & 0xffff0000u); }
DI int opaque_tid() { int t = threadIdx.x; asm volatile("" : "+v"(t)); return t; }
DI int crow(int reg, int h) { return (reg & 3) + 8 * (reg >> 2) + 4 * h; }
DI float wave_sum(float v) {
#pragma unroll
  for (int o = 32; o > 0; o >>= 1) v += __shfl_xor(v, o);
  return v;
}
DI float wave_max(float v) {
#pragma unroll
  for (int o = 32; o > 0; o >>= 1) v = fmaxf(v, __shfl_xor(v, o));
  return v;
}

DI int inproj_old_col(int j) {
  if (j < 768) return j;
  if (j < 2048) return j + 4;
  if (j < 2816) return j + 28;
  if (j < 2820) return j - 2048;
  if (j < 2844) return j - 768;
  return -1;
}
DI void transpose_tile(const float* __restrict__ src, int ldsrc, u16* __restrict__ dst, int K, const float* __restrict__ scale,
                       int n0, int k0, int mode, int nvalid, float* tile) {
  const int t = threadIdx.x;
  const int nn = t & 63, kq = t >> 6;
  int col = n0 + nn;
  if (mode == 1) col = inproj_old_col(col); else if (col >= nvalid) col = -1;
  float v[16];
#pragma unroll
  for (int i = 0; i < 16; ++i) v[i] = (col >= 0) ? src[(size_t)(k0 + kq + 4 * i) * ldsrc + col] : 0.f;
  if (scale) {
#pragma unroll
    for (int i = 0; i < 16; ++i) v[i] *= scale[k0 + kq + 4 * i];
  }
#pragma unroll
  for (int i = 0; i < 16; ++i) tile[(kq + 4 * i) * 65 + nn] = v[i];
  __syncthreads();
  const int n2 = t >> 2, kc = (t & 3) * 16;
  u32 o[8];
#pragma unroll
  for (int i = 0; i < 8; ++i) o[i] = pack2(tile[(kc + 2 * i) * 65 + n2], tile[(kc + 2 * i + 1) * 65 + n2]);
  u32x4* dp = (u32x4*)(dst + (size_t)(n0 + n2) * K + k0 + kc);
  dp[0] = mk4(o[0], o[1], o[2], o[3]);
  dp[1] = mk4(o[4], o[5], o[6], o[7]);
  __syncthreads();
}

DI void convert_rows(const float* __restrict__ src, u16* __restrict__ dst, size_t n8, float* __restrict__ copy) {
  const size_t stride = (size_t)gridDim.x * NT;
  for (size_t i0 = (size_t)blockIdx.x * NT + threadIdx.x; i0 < n8; i0 += 4 * stride) {
    f32x4 a[4], b[4];
#pragma unroll
    for (int u = 0; u < 4; ++u) {
      const size_t i = i0 + u * stride;
      if (i < n8) { a[u] = ((const f32x4*)src)[2 * i]; b[u] = ((const f32x4*)src)[2 * i + 1]; }
    }
#pragma unroll
    for (int u = 0; u < 4; ++u) {
      const size_t i = i0 + u * stride;
      if (i < n8) {
        if (copy) { ((f32x4*)copy)[2 * i] = a[u]; ((f32x4*)copy)[2 * i + 1] = b[u]; }
        ((u32x4*)dst)[i] = mk4(pack2(a[u][0], a[u][1]), pack2(a[u][2], a[u][3]), pack2(b[u][0], b[u][1]), pack2(b[u][2], b[u][3]));
      }
    }
  }
}

__device__ __forceinline__ void phase_prep(const Params& P, char* smem) {
  float* tile = (float*)smem;
  const int bid = blockIdx.x, nb = gridDim.x, t = threadIdx.x;
  for (int it0 = bid; it0 < 2 * 1952; it0 += nb) {
    const int l = it0 / 1952;
    int it = it0 % 1952;
    if (it < 736) { transpose_tile(P.w_in + (size_t)l * D * NIN, NIN, P.WinT + (size_t)l * NINP * D, D, P.attn_norm_w + l * D, (it >> 4) * 64, (it & 15) * 64, 1, 0, tile); continue; }
    it -= 736;
    if (it < 256) { transpose_tile(P.w_out + (size_t)l * D * D, D, P.WoutT + (size_t)l * D * D, D, nullptr, (it >> 4) * 64, (it & 15) * 64, 0, D, tile); continue; }
    it -= 256;
    if (it < 512) { transpose_tile(P.peer_w_q + (size_t)l * D * 2048, 2048, P.WqT + (size_t)l * 2048 * D, D, P.ffn_norm_w + l * D, (it >> 4) * 64, (it & 15) * 64, 0, 2048, tile); continue; }
    it -= 512;
    if (it < 256) { transpose_tile(P.ple_w_gate + (size_t)l * D * D, D, P.WgT + (size_t)l * D * D, D, P.ple_norm_w + l * D, (it >> 4) * 64, (it & 15) * 64, 0, D, tile); continue; }
    it -= 256;
    if (it < 64) { transpose_tile(P.ple_w_proj + (size_t)l * 256 * D, D, P.WpT + (size_t)l * D * 256, 256, nullptr, (it >> 2) * 64, (it & 3) * 64, 0, D, tile); continue; }
    it -= 64;
    { const int kv = it >> 6, i2 = it & 63;
      transpose_tile(P.nsa_cmp_w + (size_t)(l * 2 + kv) * 2048 * 64, 64, P.CmpWT + (size_t)(l * 2 + kv) * 128 * 2048, 2048, nullptr, (i2 >> 5) * 64, (i2 & 31) * 64, 0, 64, tile); }
  }
  convert_rows(P.peer_sub_keys, P.SubK, (size_t)2 * 16 * 128 * 128 / 8, nullptr);
  {
    const int lane = t & 63, gw = bid * 4 + (t >> 6), ngw = nb * 4;
    for (int r = gw; r < 4 * S; r += ngw) {
      const int tbl = r / (2 * S), l = (r / S) & 1, e = r % S;
      const float* src = (tbl ? P.peer_v : P.peer_u) + ((size_t)l * S + e) * D + lane * 16;
      float v[16];
#pragma unroll
      for (int i = 0; i < 4; ++i) { const f32x4 q4 = ((const f32x4*)src)[i]; v[4 * i] = q4[0]; v[4 * i + 1] = q4[1]; v[4 * i + 2] = q4[2]; v[4 * i + 3] = q4[3]; }
      if (tbl == 0) {
        const float* w = P.ffn_norm_w + l * D + lane * 16;
#pragma unroll
        for (int i = 0; i < 16; ++i) v[i] *= w[i];
      }
      float m = 0.f;
#pragma unroll
      for (int i = 0; i < 16; ++i) m = fmaxf(m, fabsf(v[i]));
      m = wave_max(m);
      {
        const float sc = (m > 0.f) ? 6.f / m : 0.f;
        u32 o[2] = {0u, 0u};
#pragma unroll
        for (int i = 0; i < 8; ++i) {
          if ((i & 3) == 0) o[i >> 2] = __builtin_amdgcn_cvt_scalef32_pk_fp4_f32(o[i >> 2], v[2 * i] * sc, v[2 * i + 1] * sc, 1.0f, 0);
          else if ((i & 3) == 1) o[i >> 2] = __builtin_amdgcn_cvt_scalef32_pk_fp4_f32(o[i >> 2], v[2 * i] * sc, v[2 * i + 1] * sc, 1.0f, 1);
          else if ((i & 3) == 2) o[i >> 2] = __builtin_amdgcn_cvt_scalef32_pk_fp4_f32(o[i >> 2], v[2 * i] * sc, v[2 * i + 1] * sc, 1.0f, 2);
          else o[i >> 2] = __builtin_amdgcn_cvt_scalef32_pk_fp4_f32(o[i >> 2], v[2 * i] * sc, v[2 * i + 1] * sc, 1.0f, 3);
        }
        *(u32x2*)((tbl ? P.V8 : P.U8) + ((size_t)l * S + e) * (D / 2) + lane * 8) = mk2(o[0], o[1]);
        if (lane == 0) (tbl ? P.Vinv : P.Uinv)[l * S + e] = m * (1.f / 6.f);
      }
    }
  }
  convert_rows(P.p, P.pb, (size_t)2 * S * 256 / 8, nullptr);
  convert_rows(P.x, P.hb, (size_t)S * D / 8, nullptr);
  const size_t gtid = (size_t)bid * NT + t, gstride = (size_t)nb * NT;
  __syncthreads();
  if (t < 48) tile[t] = (t < 32) ? powf(10000.f, -(float)t / 32.f) : powf(10000.f, -(float)(t - 32) / 16.f);
  __syncthreads();
  for (size_t i = gtid; i < (size_t)S * 48; i += gstride) {
    const int tok = (int)(i / 48), r = (int)(i % 48);
    const float pos = (float)P.positions[tok];
    const float invf = tile[r];
    const float ang = pos * invf;
    const double rev = (double)ang * 0.15915494309189535;
    const float fr = (float)(rev - floor(rev));
    const float c = __builtin_amdgcn_cosf(fr), s = __builtin_amdgcn_sinf(fr);
    if (r < 32) { P.ropeN[(size_t)tok * 64 + r] = c; P.ropeN[(size_t)tok * 64 + 32 + r] = s; }
    else { P.ropeD[(size_t)tok * 32 + (r - 32)] = c; P.ropeD[(size_t)tok * 32 + 16 + (r - 32)] = s; }
  }
  {
    const int lane = t & 63, gw = bid * 4 + (t >> 6), ngw = nb * 4;
    for (int i = gw; i < 2 * 2 * 64; i += ngw) {
      const int lk = i >> 6, e = i & 63;
      const float* pos = P.nsa_cmp_pos + (size_t)lk * 2048;
      const float* w = P.nsa_cmp_w + (size_t)lk * 2048 * 64;
      float a = 0.f;
#pragma unroll 8
      for (int k = lane; k < 2048; k += 64) a += pos[k] * w[(size_t)k * 64 + e];
      a = wave_sum(a);
      if (lane == 0) P.cmpbias[i] = a;
    }
  }
  for (size_t i = gtid; i < 2 * 2 * 64 * 64; i += gstride) {
    const int which = (int)(i / (2 * 64 * 64)), r = (int)(i % (2 * 64 * 64));
    const int g = r / (64 * 64), o = r % (64 * 64);
    u16* base = which ? P.VC : P.KC;
    base[(size_t)g * (S + 64) * 64 + (size_t)S * 64 + o] = 0;
  }
}

constexpr int GST = 144;
constexpr int G_BOFF = 128 * GST;
constexpr int G_RS_OFF = 71680;

DI float ssq8(const u32x4& v) {
  float s = 0.f;
  float a;
  a = bflo(v.x); s += a * a; a = bfhi(v.x); s += a * a;
  a = bflo(v.y); s += a * a; a = bfhi(v.y); s += a * a;
  a = bflo(v.z); s += a * a; a = bfhi(v.z); s += a * a;
  a = bflo(v.w); s += a * a; a = bfhi(v.w); s += a * a;
  return s;
}

template <bool SSQ>
DI void gemm_mainloop(const u16* __restrict__ A, int lda, const u16* __restrict__ Bt, int ldb, int K, char* sm, f32x16 (&acc)[2][2]) {
  const int tid = threadIdx.x, lane = tid & 63, wave = tid >> 6;
  const int wr = wave >> 1, wc = wave & 1;
  const int lrow = tid >> 3, lcol = (tid & 7) * 8;
  char* As = sm; char* Bs = sm + G_BOFF;
  u32x4 ra[4], rb[4];
  float ssq[4] = {0.f, 0.f, 0.f, 0.f};
#pragma unroll
  for (int i = 0; i < 4; ++i) {
    ra[i] = *(const u32x4*)(A + (size_t)(lrow + 32 * i) * lda + lcol);
    rb[i] = *(const u32x4*)(Bt + (size_t)(lrow + 32 * i) * ldb + lcol);
  }
  const int aoff = (wr * 64 + (lane & 31)) * GST + (lane >> 5) * 16;
  const int boff = (wc * 64 + (lane & 31)) * GST + (lane >> 5) * 16;
  for (int k0 = 0; k0 < K; k0 += 64) {
    __syncthreads();
#pragma unroll
    for (int i = 0; i < 4; ++i) {
      *(u32x4*)(As + (lrow + 32 * i) * GST + lcol * 2) = ra[i];
      *(u32x4*)(Bs + (lrow + 32 * i) * GST + lcol * 2) = rb[i];
      if (SSQ) ssq[i] += ssq8(ra[i]);
    }
    __syncthreads();
    if (k0 + 64 < K) {
#pragma unroll
      for (int i = 0; i < 4; ++i) {
        ra[i] = *(const u32x4*)(A + (size_t)(lrow + 32 * i) * lda + k0 + 64 + lcol);
        rb[i] = *(const u32x4*)(Bt + (size_t)(lrow + 32 * i) * ldb + k0 + 64 + lcol);
      }
    }
#pragma unroll
    for (int ks = 0; ks < 4; ++ks) {
      bf16x8 af[2], bfr[2];
#pragma unroll
      for (int i = 0; i < 2; ++i) af[i] = *(const bf16x8*)(As + aoff + i * 32 * GST + ks * 32);
#pragma unroll
      for (int j = 0; j < 2; ++j) bfr[j] = *(const bf16x8*)(Bs + boff + j * 32 * GST + ks * 32);
#pragma unroll
      for (int i = 0; i < 2; ++i)
#pragma unroll
        for (int j = 0; j < 2; ++j) acc[i][j] = MFMA32(af[i], bfr[j], acc[i][j]);
    }
  }
  __syncthreads();
  if (SSQ) {
    float* rs = (float*)(sm + G_RS_OFF);
#pragma unroll
    for (int i = 0; i < 4; ++i) {
      float s = ssq[i];
      s += __shfl_xor(s, 1); s += __shfl_xor(s, 2); s += __shfl_xor(s, 4);
      if ((tid & 7) == 0) rs[lrow + 32 * i] = rsqrtf(s * (1.f / (float)K) + 1e-6f);
    }
  }
}

DI void zero_acc(f32x16 (&acc)[2][2]) {
#pragma unroll
  for (int i = 0; i < 2; ++i)
#pragma unroll
    for (int j = 0; j < 2; ++j)
#pragma unroll
      for (int r = 0; r < 16; ++r) acc[i][j][r] = 0.f;
}

constexpr int EPS_LD = 132;
DI void acc_to_lds(const f32x16 (&acc)[2][2], float* tile) {
  const int lane = threadIdx.x & 63, wave = threadIdx.x >> 6;
  const int wr = wave >> 1, wc = wave & 1;
#pragma unroll
  for (int i = 0; i < 2; ++i)
#pragma unroll
    for (int j = 0; j < 2; ++j)
#pragma unroll
      for (int r = 0; r < 16; ++r)
        tile[(wr * 64 + i * 32 + crow(r, lane >> 5)) * EPS_LD + wc * 64 + j * 32 + (lane & 31)] = acc[i][j][r];
}

DI float log_sigmoid(float x) { return fminf(x, 0.f) - log1pf(expf(-fabsf(x))); }
DI float sigmoidf_(float x) { return 1.f / (1.f + expf(-x)); }

DI void store32_bf16(u16* dst, const float* o) {
  u32x4* d4 = (u32x4*)dst;
#pragma unroll
  for (int i = 0; i < 4; ++i)
    d4[i] = mk4(pack2(o[8 * i], o[8 * i + 1]), pack2(o[8 * i + 2], o[8 * i + 3]), pack2(o[8 * i + 4], o[8 * i + 5]), pack2(o[8 * i + 6], o[8 * i + 7]));
}

__device__ __forceinline__ void inproj_epilogue_half(const Params& P, int l, int mt, int nt, int half, const float* tile, const float* rs) {
  const int tid = threadIdx.x, lane = tid & 63, wave = tid >> 6;
  const int hl = wave >> 1, h32 = wave & 1;
  const int sg = 2 * nt + hl;
  const int rloc = half * 64 + lane;
  const int tok = mt * 128 + rloc;
  const float rstd = rs[rloc];
  if (sg >= 45) return;
  float v[64];
  {
    const f32x4* src = (const f32x4*)(tile + rloc * EPS_LD + hl * 64);
#pragma unroll
    for (int i = 0; i < 16; ++i) { f32x4 t = src[i]; v[4 * i] = t[0] * rstd; v[4 * i + 1] = t[1] * rstd; v[4 * i + 2] = t[2] * rstd; v[4 * i + 3] = t[3] * rstd; }
  }
  const u32 hmask = (u32)(-(int)h32);
#define VO(i) __uint_as_float((__float_as_uint(v[32 + (i)]) & hmask) | (__float_as_uint(v[(i)]) & ~hmask))
  if (sg == 44) {
    if (h32 == 0) {
      const int chunk = tok >> 6;
#pragma unroll
      for (int hd = 0; hd < 4; ++hd) {
        float x = log_sigmoid(v[hd] + P.fox_f_bias[l * 4 + hd]);
#pragma unroll
        for (int o = 1; o < 64; o <<= 1) { float t = __shfl_up(x, o); if (lane >= o) x += t; }
        P.cloc[(size_t)hd * S + tok] = x;
        if (lane == 63) P.ctot[chunk * 4 + hd] = x;
      }
    } else {
      float* g = P.gates + (size_t)tok * 24;
#pragma unroll
      for (int i = 0; i < 24; ++i) g[i] = sigmoidf_(v[4 + i]);
    }
    return;
  }
  float o[32];
  const bool is_vt = (sg >= 8 && sg < 12) || (sg == 26 || sg == 27) || (sg == 30 || sg == 31) || (sg >= 40);
  const bool is_raw = (sg >= 20 && sg < 24);
  const bool is_diff = (sg >= 32 && sg < 40);
  if (is_vt) {
    if (sg == 26 || sg == 27) {
      const int key = tok & 63, G = key >> 5, h4 = (key & 31) >> 3, j = key & 7;
      unsigned char* b8 = P.VS8t + (size_t)(sg - 26) * 64 * S + (size_t)(tok >> 6) * 4096 + G * 2048 + h4 * 128 + j;
#pragma unroll
      for (int i = 0; i < 32; i += 2) {
        const int wd = __builtin_amdgcn_cvt_pk_fp8_f32(VO(i), VO(i + 1), 0, false);
        const int d0 = h32 * 32 + i, d1 = d0 + 1;
        b8[(d0 >> 4) * 512 + (d0 & 15) * 8] = (unsigned char)(wd & 0xff);
        b8[(d1 >> 4) * 512 + (d1 & 15) * 8] = (unsigned char)((wd >> 8) & 0xff);
      }
      return;
    }
    u16* base;
    if (sg < 12) base = P.VFt + (size_t)(sg - 8) * 64 * S;
    else if (sg < 32) base = P.VWt + (size_t)(sg - 30) * 64 * S;
    else base = P.VDt + (size_t)(sg - 40) * 64 * S;
#pragma unroll
    for (int i = 0; i < 32; ++i) base[(size_t)(h32 * 32 + i) * S + tok] = f2bf(VO(i));
    return;
  }
  if (is_raw) {
    u16* base = (sg < 22) ? P.KC + (size_t)(sg - 20) * (S + 64) * 64 : P.VC + (size_t)(sg - 22) * (S + 64) * 64;
#pragma unroll
    for (int i = 0; i < 32; ++i) o[i] = VO(i);
    store32_bf16(base + (size_t)tok * 64 + h32 * 32, o);
    return;
  }
  if (is_diff) {
    const float* w = (sg < 36 ? P.diff_q_norm_w : P.diff_k_norm_w) + l * 32;
    float ss = 0.f;
#pragma unroll
    for (int i = 0; i < 32; ++i) ss += VO(i) * VO(i);
    const float rn = rsqrtf(ss * (1.f / 32.f) + 1e-6f);
    const float sc = (sg < 36) ? 0.17677669529663687f * LOG2E : 1.f;
    const float* rp = P.ropeD + (size_t)tok * 32;
#pragma unroll
    for (int i = 0; i < 16; ++i) {
      const float y1 = VO(i) * rn * w[i], y2 = VO(16 + i) * rn * w[16 + i];
      const float c = rp[i], s = rp[16 + i];
      o[i] = (y1 * c - y2 * s) * sc;
      o[16 + i] = (y2 * c + y1 * s) * sc;
    }
    u16* base = (sg < 36) ? P.QD + (size_t)(sg - 32) * S * 64 : P.KD + (size_t)(sg - 36) * S * 64;
    store32_bf16(base + (size_t)tok * 64 + h32 * 32, o);
    return;
  }
  const float* w;
  if (sg < 4) w = P.fox_q_norm_w + l * 64; else if (sg < 8) w = P.fox_k_norm_w + l * 64; else if (sg < 20) w = P.nsa_q_norm_w + l * 64; else w = P.nsa_k_norm_w + l * 64;
  float ss = 0.f;
#pragma unroll
  for (int i = 0; i < 64; ++i) ss += v[i] * v[i];
  const float rn = rsqrtf(ss * (1.f / 64.f) + 1e-6f);
  const float qs = 0.125f * LOG2E;
  if (sg < 8) {
    const float sc = (sg < 4) ? qs : 1.f;
#pragma unroll
    for (int i = 0; i < 32; ++i) o[i] = VO(i) * rn * w[h32 * 32 + i] * sc;
    u16* base = (sg < 4) ? P.QF + (size_t)sg * S * 64 : P.KF + (size_t)(sg - 4) * S * 64;
    store32_bf16(base + (size_t)tok * 64 + h32 * 32, o);
    return;
  }
  const float* rp = P.ropeN + (size_t)tok * 64;
  const float sc = (sg < 20) ? qs : 1.f;
  if (sg < 20) {
#pragma unroll
    for (int i = 0; i < 32; ++i) o[i] = VO(i) * rn * w[h32 * 32 + i] * sc;
    store32_bf16(P.QN + ((size_t)(sg - 12) * S + tok) * 64 + h32 * 32, o);
  }
#pragma unroll
  for (int i = 0; i < 32; ++i) {
    const float y1 = v[i] * rn * w[i], y2 = v[32 + i] * rn * w[32 + i];
    const float c = rp[i], s = rp[32 + i];
    o[i] = (h32 == 0 ? (y1 * c - y2 * s) : (y2 * c + y1 * s)) * sc;
  }
  if (sg == 24 || sg == 25) {
    const int key = tok & 63, G = key >> 5, r32 = key & 31, t = (r32 >> 2) & 1, i = ((r32 >> 3) << 2) | (r32 & 3);
    unsigned char* d8 = P.KS8 + (size_t)(sg - 24) * S * 64 + (size_t)(tok >> 6) * 4096 + ((G * 2 + t) * 2 + h32) * 512 + i * 8;
#pragma unroll
    for (int h4 = 0; h4 < 4; ++h4) {
      int w0 = 0, w1 = 0;
      w0 = __builtin_amdgcn_cvt_pk_fp8_f32(o[8 * h4], o[8 * h4 + 1], w0, false);
      w0 = __builtin_amdgcn_cvt_pk_fp8_f32(o[8 * h4 + 2], o[8 * h4 + 3], w0, true);
      w1 = __builtin_amdgcn_cvt_pk_fp8_f32(o[8 * h4 + 4], o[8 * h4 + 5], w1, false);
      w1 = __builtin_amdgcn_cvt_pk_fp8_f32(o[8 * h4 + 6], o[8 * h4 + 7], w1, true);
      *(u32x2*)(d8 + h4 * 128) = mk2((u32)w0, (u32)w1);
    }
    return;
  }
  u16* base;
  if (sg < 20) base = P.QR + (size_t)(sg - 12) * S * 64;
  else base = P.KW + (size_t)(sg - 28) * S * 64;
  store32_bf16(base + (size_t)tok * 64 + h32 * 32, o);
}

#undef VO
__device__ __forceinline__ void phase_inproj(const Params& P, int l, char* smem) {
  const u16* Wt = P.WinT + (size_t)l * NINP * D;
  float* tile = (float*)smem;
  const float* rs = (const float*)(smem + G_RS_OFF);
  for (int it = blockIdx.x; it < 128 * 23; it += gridDim.x) {
    const int mt = it / 23, nt = it % 23;
    f32x16 acc[2][2];
    zero_acc(acc);
    gemm_mainloop<true>(P.hb + (size_t)mt * 128 * D, D, Wt + (size_t)nt * 128 * D, D, D, smem, acc);
    acc_to_lds(acc, tile);
    __syncthreads();
#pragma unroll 1
    for (int half = 0; half < 2; ++half) inproj_epilogue_half(P, l, mt, nt, half, tile, rs);
  }
}

__device__ __forceinline__ void phase_compress(const Params& P, int l, char* smem) {
  float* tile = (float*)smem;
  for (int it = blockIdx.x; it < 32; it += gridDim.x) {
    const int kv = it >> 4, g = (it >> 3) & 1, mt = it & 7;
    const u16* A = (kv ? P.VC : P.KC) + (size_t)g * (S + 64) * 64 + (size_t)mt * 128 * 1024;
    const u16* Bt = P.CmpWT + (size_t)(l * 2 + kv) * 128 * 2048;
    const float* bias = P.cmpbias + (l * 2 + kv) * 64;
    f32x16 acc[2][2];
    zero_acc(acc);
    gemm_mainloop<false>(A, 1024, Bt, 2048, 2048, smem, acc);
    acc_to_lds(acc, tile);
    __syncthreads();
#pragma unroll 1
    for (int half = 0; half < 2; ++half) {
      {
        const int lane = threadIdx.x & 63, wave = threadIdx.x >> 6;
        const int idx = mt * 128 + half * 64 + lane;
        float v[64];
        const f32x4* src = (const f32x4*)(tile + (half * 64 + lane) * EPS_LD);
#pragma unroll
        for (int i = 0; i < 16; ++i) { f32x4 t = src[i]; v[4 * i] = t[0] + bias[4 * i]; v[4 * i + 1] = t[1] + bias[4 * i + 1]; v[4 * i + 2] = t[2] + bias[4 * i + 2]; v[4 * i + 3] = t[3] + bias[4 * i + 3]; }
        float vo[16];
#pragma unroll
        for (int i = 0; i < 4; ++i) { f32x4 t = src[wave * 4 + i]; const float* bb = bias + wave * 16 + 4 * i; vo[4 * i] = t[0] + bb[0]; vo[4 * i + 1] = t[1] + bb[1]; vo[4 * i + 2] = t[2] + bb[2]; vo[4 * i + 3] = t[3] + bb[3]; }
        if (kv == 0) {
          const float* w = P.nsa_k_norm_w + l * 64;
          float ss = 0.f;
#pragma unroll
          for (int i = 0; i < 64; ++i) ss += v[i] * v[i];
          const float rn = rsqrtf(ss * (1.f / 64.f) + 1e-6f);
          u32 o[8];
#pragma unroll
          for (int i = 0; i < 8; ++i) o[i] = pack2(vo[2 * i] * rn * w[wave * 16 + 2 * i], vo[2 * i + 1] * rn * w[wave * 16 + 2 * i + 1]);
          u32x4* dp = (u32x4*)(P.KCC + ((size_t)g * 1024 + idx) * 64 + wave * 16);
          dp[0] = mk4(o[0], o[1], o[2], o[3]);
          dp[1] = mk4(o[4], o[5], o[6], o[7]);
        } else {
#pragma unroll
          for (int i = 0; i < 16; ++i) P.VCCt[((size_t)g * 64 + wave * 16 + i) * 1024 + idx] = f2bf(vo[i]);
        }
      }
    }
  }
}

constexpr int AK_ST = 144;
constexpr int AV_ST = 136;
constexpr int AT_VOFF = 64 * AK_ST;
constexpr int AT_COFF = AT_VOFF + 64 * AV_ST;
constexpr int AT_STAGE = AT_COFF + 256;
constexpr int AT_MISC = 2 * AT_STAGE;

struct TileRegs { u32x4 k[2]; u32x4 v[2]; };

DI void tile_load(int t, TileRegs& r, const u16* __restrict__ K, const u16* __restrict__ Vt, size_t ldv, int key0, bool with_v) {
#pragma unroll
  for (int i = 0; i < 2; ++i) {
    const int c = t + 256 * i, row = c >> 3, part = c & 7;
    r.k[i] = *(const u32x4*)(K + (size_t)(key0 + row) * 64 + part * 8);
    if (with_v) r.v[i] = *(const u32x4*)(Vt + (size_t)row * ldv + key0 + part * 8);
  }
}
DI void tile_store(int t, const TileRegs& r, char* st, bool with_v) {
#pragma unroll
  for (int i = 0; i < 2; ++i) {
    const int c = t + 256 * i, row = c >> 3, part = c & 7;
    *(u32x4*)(st + row * AK_ST + part * 16) = r.k[i];
    if (with_v) {
      u32x2* d = (u32x2*)(st + AT_VOFF + row * AV_ST + part * 16);
      d[0] = mk2(r.v[i].x, r.v[i].y);
      d[1] = mk2(r.v[i].z, r.v[i].w);
    }
  }
}
DI bf16x8 pack_p(const f32x16& p, int sp) {
  u32x4 u = mk4(pack2(p[8 * sp], p[8 * sp + 1]), pack2(p[8 * sp + 2], p[8 * sp + 3]), pack2(p[8 * sp + 4], p[8 * sp + 5]), pack2(p[8 * sp + 6], p[8 * sp + 7]));
  return __builtin_bit_cast(bf16x8, u);
}
template <int NKS, bool ZINIT>
DI void qk_half(int tid, const char* st, int dofs_bytes, int kt, const bf16x8 (&qf)[NKS], f32x16& s) {
  const int lane = tid & 63;
  const char* base = st + (kt * 32 + (lane & 31)) * AK_ST + (lane >> 5) * 16 + dofs_bytes;
#pragma unroll
  for (int ks = 0; ks < NKS; ++ks) {
    const bf16x8 a = *(const bf16x8*)(base + ks * 32);
    if (ZINIT && ks == 0) { const f32x16 z = {0.f, 0.f, 0.f, 0.f, 0.f, 0.f, 0.f, 0.f, 0.f, 0.f, 0.f, 0.f, 0.f, 0.f, 0.f, 0.f}; s = MFMA32(a, qf[ks], z); }
    else s = MFMA32(a, qf[ks], s);
  }
}
DI void pv_half(int tid, const char* st, int kt, const f32x16& p, f32x16 (&o)[2]) {
  const int lane = tid & 63;
  const char* vb = st + AT_VOFF + (lane & 31) * AV_ST + (lane >> 5) * 8 + kt * 64;
#pragma unroll
  for (int sp = 0; sp < 2; ++sp) {
    const bf16x8 pb = pack_p(p, sp);
#pragma unroll
    for (int dt = 0; dt < 2; ++dt) {
      const char* a = vb + dt * 32 * AV_ST + sp * 32;
      const u32x2 lo = *(const u32x2*)a, hi = *(const u32x2*)(a + 16);
      const u32x4 u = mk4(lo.x, lo.y, hi.x, hi.y);
      o[dt] = MFMA32(__builtin_bit_cast(bf16x8, u), pb, o[dt]);
    }
  }
}
DI void load_q4(int tid, bf16x8 (&qf)[4], const u16* __restrict__ Q, int tok) {
  const int lane = tid & 63;
  const u16* b = Q + (size_t)tok * 64 + (lane >> 5) * 8;
#pragma unroll
  for (int ks = 0; ks < 4; ++ks) qf[ks] = *(const bf16x8*)(b + ks * 16);
}
DI float max_abs64(int tid, const float* w) {
  return wave_max(fabsf(w[tid & 63]));
}

struct AttnArgs {
  const u16* K; const u16* Vt; size_t ldv;
  int t0, t1;
  int q;
  int wq0;
  float M2;
  int dofs;
  int lim_hi, lim_lo, whi, wlo;
  int mask_hi, mask_lo;
  float cq; const float* cloc; const float* base;
};

template <int MODE, int NKS>
DI void attn_tile(int tid, const AttnArgs& a, const char* cur, int key0, int lim_hi, int lim_lo, bool mask_u, const bf16x8 (&qf)[NKS], f32x16 (&o)[2], float& l) {
  const int h = (tid & 63) >> 5;
#pragma unroll
  for (int kt = 0; kt < 2; ++kt) {
    f32x16 s;
    if (MODE == 0) {
      const float* ckb = (const float*)(cur + AT_COFF);
#pragma unroll
      for (int rg = 0; rg < 4; ++rg) {
        const f32x4 c4 = *(const f32x4*)(ckb + 32 * kt + 8 * rg + 4 * h);
#pragma unroll
        for (int i = 0; i < 4; ++i) s[4 * rg + i] = a.cq - c4[i];
      }
      qk_half<NKS, false>(tid, cur, a.dofs, kt, qf, s);
    } else {
      qk_half<NKS, true>(tid, cur, a.dofs, kt, qf, s);
    }
#pragma unroll
    for (int i = 0; i < 16; ++i) s[i] = __builtin_amdgcn_exp2f(s[i]);
    if (mask_u) {
#pragma unroll
      for (int i = 0; i < 16; ++i) { const int key = key0 + 32 * kt + crow(i, h); if (key > lim_hi || key < lim_lo) s[i] = 0.f; }
    }
#pragma unroll
    for (int i = 0; i < 16; ++i) l += s[i];
    pv_half(tid, cur, kt, s, o);
  }
}
template <int MODE, int NKS, bool PF2 = false>
DI void attn_loop(int tid, const AttnArgs& a, const bf16x8 (&qf)[NKS], f32x16 (&o)[2], float& l, char* smem) {
  TileRegs rA, rB; float cbA = 0.f, cbB = 0.f;
  if (a.t0 >= a.t1) return;
  tile_load(tid, rA, a.K, a.Vt, a.ldv, a.t0 * 64, true);
  if (MODE == 0 && tid < 64) cbA = a.cloc[a.t0 * 64 + tid];
  tile_store(tid, rA, smem, true);
  if (MODE == 0 && tid < 64) ((float*)(smem + AT_COFF))[tid] = (a.base[a.t0] + cbA) * LOG2E;
  __syncthreads();
  auto step = [&](int t, TileRegs& rs, float& cbs, TileRegs& rl, float& cbl, int dist) {
    char* cur = smem + ((t - a.t0) & 1) * AT_STAGE;
    char* nxt = smem + ((t - a.t0 + 1) & 1) * AT_STAGE;
    if (t + dist < a.t1) {
      tile_load(tid, rl, a.K, a.Vt, a.ldv, (t + dist) * 64, true);
      if (MODE == 0 && tid < 64) cbl = a.cloc[(t + dist) * 64 + tid];
    }
    const int key0 = t * 64;
    bool active, need_mask;
    if (MODE == 0 || MODE == 3) { active = key0 <= a.wq0 + 31; need_mask = key0 + 63 > a.wq0; }
    else if (MODE == 1) { const int nmax_w = (a.wq0 + 31 - 31) >> 4; active = (a.wq0 + 31 >= 31) && key0 <= nmax_w; need_mask = true; }
    else if (MODE == 2) { active = (key0 <= a.wq0 + 31) && (key0 + 63 >= a.wq0 - 511); need_mask = (key0 + 63 > a.wq0) || (key0 < a.wq0 + 31 - 511); }
    else { active = (key0 <= a.whi) && (key0 + 63 >= a.wlo); need_mask = (key0 + 63 > a.mask_hi) || (key0 < a.mask_lo); }
    if (active) {
      int lim_hi, lim_lo;
      if (MODE == 0 || MODE == 3) { lim_hi = a.q; lim_lo = 0; }
      else if (MODE == 1) { lim_hi = (a.q >= 31) ? ((a.q - 31) >> 4) : -1; lim_lo = 0; }
      else if (MODE == 2) { lim_hi = a.q; lim_lo = a.q - 511; }
      else { lim_hi = a.lim_hi; lim_lo = a.lim_lo; }
      attn_tile<MODE, NKS>(tid, a, cur, key0, lim_hi, lim_lo, __builtin_amdgcn_readfirstlane((int)need_mask) != 0, qf, o, l);
    }
    if (t + 1 < a.t1) {
      tile_store(tid, rs, nxt, true);
      if (MODE == 0 && tid < 64) ((float*)(nxt + AT_COFF))[tid] = (a.base[t + 1] + cbs) * LOG2E;
    }
    __syncthreads();
  };
  if (!PF2) {
    for (int t = a.t0; t < a.t1; ++t) step(t, rA, cbA, rA, cbA, 1);
  } else {
    if (a.t0 + 1 < a.t1) { tile_load(tid, rA, a.K, a.Vt, a.ldv, (a.t0 + 1) * 64, true); if (MODE == 0 && tid < 64) cbA = a.cloc[(a.t0 + 1) * 64 + tid]; }
    for (int t = a.t0; t < a.t1; t += 2) {
      step(t, rA, cbA, rB, cbB, 2);
      if (t + 1 >= a.t1) break;
      step(t + 1, rB, cbB, rA, cbA, 2);
    }
  }
}

DI void zero_o(f32x16 (&o)[2]) {
#pragma unroll
  for (int d = 0; d < 2; ++d)
#pragma unroll
    for (int i = 0; i < 16; ++i) o[d][i] = 0.f;
}

DI void fox_chunk_bases(int tid, const Params& P, int hd, float* base, float* wtot) {
  const int lane = tid & 63, wave = tid >> 6;
  const float x = P.ctot[tid * 4 + hd];
  float inc = x;
#pragma unroll
  for (int o = 1; o < 64; o <<= 1) { float t = __shfl_up(inc, o); if (lane >= o) inc += t; }
  if (lane == 63) wtot[wave] = inc;
  __syncthreads();
  float off = 0.f;
  for (int w = 0; w < wave; ++w) off += wtot[w];
  base[tid] = inc - x + off;
  __syncthreads();
}

__device__ __forceinline__ void fox_item(const Params& P, int l, int hd, int qb, char* smem) {
  const int tid = opaque_tid(), lane = tid & 63, wave = tid >> 6, h = lane >> 5;
  float* base = (float*)(smem + AT_MISC);
  float* wtot = base + 256;
  fox_chunk_bases(tid, P, hd, base, wtot);
  const float M2 = 8.f * max_abs64(tid, P.fox_q_norm_w + l * 64) * max_abs64(tid, P.fox_k_norm_w + l * 64) * LOG2E * 1.01f + 0.1f;
  const int wq0 = qb * 128 + wave * 32, q = wq0 + (lane & 31);
  AttnArgs a;
  a.K = P.KF + (size_t)hd * S * 64; a.Vt = P.VFt + (size_t)hd * 64 * S; a.ldv = S;
  a.t1 = 2 * qb + 2; a.q = q; a.wq0 = wq0; a.M2 = M2;
  a.cloc = P.cloc + (size_t)hd * S; a.base = base;
  {
    const bool skip = (tid + 1 < 2 * qb) && ((base[2 * qb] - base[tid + 1]) * LOG2E < -160.f);
    a.t0 = __syncthreads_count(skip ? 1 : 0);
  }
  a.cq = (base[q >> 6] + a.cloc[q]) * LOG2E - M2;
  bf16x8 qf[4];
  load_q4(tid, qf, P.QF + (size_t)hd * S * 64, q);
  f32x16 o[2]; zero_o(o);
  float ls = 0.f;
  a.dofs = 0;
  attn_loop<0, 4, true>(tid, a, qf, o, ls, smem);
  ls += __shfl_xor(ls, 32);
  const float inv = (ABLATE & 1) ? 0.f : 1.f / ls;
  u16* dst = P.mix + (size_t)q * 1024 + hd * 64 + 4 * h;
#pragma unroll
  for (int dt = 0; dt < 2; ++dt)
#pragma unroll
    for (int rg = 0; rg < 4; ++rg)
      *(u32x2*)(dst + 32 * dt + 8 * rg) = mk2(pack2(o[dt][4 * rg] * inv, o[dt][4 * rg + 1] * inv), pack2(o[dt][4 * rg + 2] * inv, o[dt][4 * rg + 3] * inv));
}

__device__ __forceinline__ void diff_item(const Params& P, int l, int hd, int qb, char* smem) {
  const int tid = opaque_tid(), lane = tid & 63, wave = tid >> 6, h = lane >> 5;
  const float mq = wave_max(fabsf(P.diff_q_norm_w[l * 32 + (lane & 31)])), mk = wave_max(fabsf(P.diff_k_norm_w[l * 32 + (lane & 31)]));
  const float M2 = 5.656854249f * mq * mk * LOG2E * 1.01f + 0.1f;
  const float* lv = P.diff_lambda + l * 128;
  float d1 = (lane < 32) ? lv[lane] * lv[32 + lane] : 0.f, d2 = (lane < 32) ? lv[64 + lane] * lv[96 + lane] : 0.f;
  d1 = wave_sum(d1); d2 = wave_sum(d2);
  const float lam_init = 0.8f - 0.6f * expf(-0.3f * (float)l);
  const float lam = expf(d1) - expf(d2) + lam_init;
  const int wq0 = qb * 128 + wave * 32, q = wq0 + (lane & 31);
  AttnArgs a;
  a.K = P.KD + (size_t)hd * S * 64; a.Vt = P.VDt + (size_t)hd * 64 * S; a.ldv = S;
  a.t0 = 0; a.t1 = 2 * qb + 2; a.q = q; a.wq0 = wq0; a.M2 = M2; a.cq = 0.f; a.cloc = nullptr; a.base = nullptr;
  float* stash = P.dstash + (size_t)blockIdx.x * (128 * 64) + tid;
  f32x16 o[2];
#pragma unroll 1
  for (int c = 0; c < 2; ++c) {
    const int tid = opaque_tid(), lane = tid & 63, h = lane >> 5;
    bf16x8 qf[2];
    {
      const u16* b = P.QD + ((size_t)hd * S + q) * 64 + c * 32 + h * 8;
      qf[0] = *(const bf16x8*)b; qf[1] = *(const bf16x8*)(b + 16);
    }
    zero_o(o);
    float ls = 0.f;
    a.dofs = c * 64;
    attn_loop<3, 2>(tid, a, qf, o, ls, smem);
    ls += __shfl_xor(ls, 32);
    if (c == 0) {
      const float i0 = 1.f / ls;
#pragma unroll
      for (int dt = 0; dt < 2; ++dt)
#pragma unroll
        for (int i = 0; i < 16; ++i) stash[(dt * 16 + i) * 256] = o[dt][i] * i0;
    } else {
      const float i1 = lam / ls;
      float ss = 0.f;
#pragma unroll
      for (int dt = 0; dt < 2; ++dt)
#pragma unroll
        for (int i = 0; i < 16; ++i) { const float v = stash[(dt * 16 + i) * 256] - o[dt][i] * i1; o[dt][i] = v; ss += v * v; }
      ss += __shfl_xor(ss, 32);
      const float rn = rsqrtf(ss * (1.f / 64.f) + 1e-6f) * (1.f - lam_init);
      const float* sw = P.diff_subln_w + l * 64;
      u16* dst = P.mix + (size_t)q * 1024 + 768 + hd * 64 + 4 * h;
#pragma unroll
      for (int dt = 0; dt < 2; ++dt)
#pragma unroll
        for (int rg = 0; rg < 4; ++rg) {
          const int d0 = 32 * dt + 8 * rg + 4 * h;
          *(u32x2*)(dst + 32 * dt + 8 * rg) = mk2(pack2(o[dt][4 * rg] * rn * sw[d0], o[dt][4 * rg + 1] * rn * sw[d0 + 1]),
                                                 pack2(o[dt][4 * rg + 2] * rn * sw[d0 + 2], o[dt][4 * rg + 3] * rn * sw[d0 + 3]));
        }
    }
  }
}

struct SelFrags { u32x2 k[8]; u32x2 v[8]; };

DI void sel_load(int tid, SelFrags& f, const unsigned char* __restrict__ Kg, const unsigned char* __restrict__ Vtg, int b) {
  const int lane = tid & 63, i = lane & 15, h4 = lane >> 4;
  const int bu = __builtin_amdgcn_readfirstlane(b);
  const unsigned char* kb = Kg + (size_t)bu * 4096 + lane * 8;
  const unsigned char* vb = Vtg + (size_t)bu * 4096 + lane * 8;
  (void)i; (void)h4;
#pragma unroll
  for (int L = 0; L < 8; ++L) f.k[L] = *(const u32x2*)(kb + L * 512);
#pragma unroll
  for (int L = 0; L < 8; ++L) f.v[L] = *(const u32x2*)(vb + L * 512);
}
template <bool MASK>
DI void sel_compute_t(int tid, const SelFrags& f, const u32x2 (&qb)[2], int b, int qpos, float M2, f32x4 (&o)[4], f32x4& ol) {
  const int lane = tid & 63, h4 = lane >> 4;
  const float c0 = 8.f - M2;
  const u32x2 ones = mk2(0x38383838u, 0x38383838u);
#pragma unroll
  for (int G = 0; G < 2; ++G) {
    f32x4 s[2];
#pragma unroll
    for (int t = 0; t < 2; ++t) {
      s[t] = (f32x4){0.f, 0.f, 0.f, 0.f};
#pragma unroll
      for (int ks = 0; ks < 2; ++ks)
        s[t] = __builtin_amdgcn_mfma_f32_16x16x32_fp8_fp8(__builtin_bit_cast(long, f.k[G * 4 + t * 2 + ks]), __builtin_bit_cast(long, qb[ks]), s[t], 0, 0, 0);
    }
#pragma unroll
    for (int t = 0; t < 2; ++t)
#pragma unroll
      for (int r = 0; r < 4; ++r) {
        float p = __builtin_amdgcn_exp2f(s[t][r] * 0.0625f + c0);
        if (MASK) { const int key = b * 64 + 32 * G + 8 * h4 + 4 * t + r; if (key > qpos) p = 0.f; }
        s[t][r] = p;
      }
    int w0 = 0, w1 = 0;
    w0 = __builtin_amdgcn_cvt_pk_bf8_f32(s[0][0], s[0][1], w0, false);
    w0 = __builtin_amdgcn_cvt_pk_bf8_f32(s[0][2], s[0][3], w0, true);
    w1 = __builtin_amdgcn_cvt_pk_bf8_f32(s[1][0], s[1][1], w1, false);
    w1 = __builtin_amdgcn_cvt_pk_bf8_f32(s[1][2], s[1][3], w1, true);
    const u32x2 pb = mk2((u32)w0, (u32)w1);
#pragma unroll
    for (int dt = 0; dt < 4; ++dt)
      o[dt] = __builtin_amdgcn_mfma_f32_16x16x32_fp8_bf8(__builtin_bit_cast(long, f.v[G * 4 + dt]), __builtin_bit_cast(long, pb), o[dt], 0, 0, 0);
    ol = __builtin_amdgcn_mfma_f32_16x16x32_fp8_bf8(__builtin_bit_cast(long, ones), __builtin_bit_cast(long, pb), ol, 0, 0, 0);
  }
}
DI void sel_compute(int tid, const SelFrags& f, const u32x2 (&qb)[2], int b, int cur, int qpos, float M2, f32x4 (&o)[4], f32x4& ol) {
  if (__builtin_amdgcn_readfirstlane(b) == __builtin_amdgcn_readfirstlane(cur)) sel_compute_t<true>(tid, f, qb, b, qpos, M2, o, ol);
  else sel_compute_t<false>(tid, f, qb, b, qpos, M2, o, ol);
}

__device__ __forceinline__ void nsa_item(const Params& P, int l, int g, int qb, char* smem, int secmask = 7) {
  const int tid = opaque_tid(), lane = tid & 63, wave = tid >> 6, h = lane >> 5;
  const int q0 = qb * 128, wq0 = q0 + wave * 32, q = wq0 + (lane & 31), ql = wave * 32 + (lane & 31);
  const int item = g * 128 + qb;
  const float M2 = 8.f * max_abs64(tid, P.nsa_q_norm_w + l * 64) * max_abs64(tid, P.nsa_k_norm_w + l * 64) * LOG2E * 1.01f + 0.1f;
  unsigned char* sel = (unsigned char*)(smem + AT_MISC);
  unsigned char* nsel = sel + 2048;
  float* impA = P.impA + (size_t)item * 256 * 128;
  float* impB = P.impB + (size_t)item * 256 * 128;
  const u16* Kc = P.KCC + (size_t)g * 1024 * 64;
  const int ntc = ((q0 + 96) >> 10) + 1;
  const int nmaxq = (q >= 31) ? ((q - 31) >> 4) : -1;
  const int nmax_w = wq0 >> 4;

  {
    float lh[4] = {0.f, 0.f, 0.f, 0.f};
#pragma unroll 1
    for (int pass = 0; pass < 2; ++pass) {
      float inv[4];
      if (pass == 1) {
#pragma unroll
        for (int hh = 0; hh < 4; ++hh) { float t = lh[hh] + __shfl_xor(lh[hh], 32); inv[hh] = (t > 0.f) ? 1.f / t : 0.f; }
      }
      TileRegs r;
      tile_load(tid, r, Kc, nullptr, 0, 0, false);
      tile_store(tid, r, smem, false);
      __syncthreads();
      for (int t = 0; t < ntc; ++t) {
        char* cur = smem + (t & 1) * AT_STAGE;
        char* nxt = smem + ((t + 1) & 1) * AT_STAGE;
        const bool more = (t + 1 < ntc);
        if (more) tile_load(tid, r, Kc, nullptr, 0, (t + 1) * 64, false);
        const int key0 = t * 64;
        f32x16 ps[2];
#pragma unroll
        for (int kt = 0; kt < 2; ++kt)
#pragma unroll
          for (int i = 0; i < 16; ++i) ps[kt][i] = 0.f;
        if (key0 <= nmax_w) {
#pragma unroll
          for (int hh = 0; hh < 4; ++hh) {
            f32x16 s[2];
            bf16x8 qf[4];
            load_q4(tid, qf, P.QN + (size_t)(g * 4 + hh) * S * 64, q);
            qk_half<4, true>(tid, cur, 0, 0, qf, s[0]);
            qk_half<4, true>(tid, cur, 0, 1, qf, s[1]);
#pragma unroll
            for (int kt = 0; kt < 2; ++kt)
#pragma unroll
              for (int i = 0; i < 16; ++i) {
                float p = __builtin_amdgcn_exp2f(s[kt][i]);
                const int key = key0 + 32 * kt + crow(i, h);
                if (key > nmaxq) p = 0.f;
                if (pass == 0) lh[hh] += p; else ps[kt][i] += p * inv[hh];
              }
          }
        }
        if (pass == 1) {
#pragma unroll
          for (int kt = 0; kt < 2; ++kt)
#pragma unroll
            for (int rg = 0; rg < 4; ++rg) {
              const int j = 16 * t + 8 * kt + 2 * rg + h;
              impA[(size_t)j * 128 + ql] = ps[kt][4 * rg] + ps[kt][4 * rg + 1] + ps[kt][4 * rg + 2] + ps[kt][4 * rg + 3];
              impB[(size_t)j * 128 + ql] = ps[kt][4 * rg + 3];
            }
        }
        if (more) tile_store(tid, r, nxt, false);
        __syncthreads();
      }
    }
  }
  __threadfence_block();
  __syncthreads();
  {
    const int qt = tid >> 1, half = tid & 1;
    const int qp = q0 + qt, cur = qp >> 6;
    u32 lst[13];
#pragma unroll
    for (int i = 0; i < 13; ++i) lst[i] = 0u;
    for (int j0 = 1 + half; j0 <= cur - 2; j0 += 8) {
      float sc[4];
#pragma unroll
      for (int u = 0; u < 4; ++u) {
        const int j = j0 + 2 * u, jc = j <= cur - 2 ? j : 1;
        sc[u] = impA[(size_t)jc * 128 + qt] + impB[(size_t)(jc - 1) * 128 + qt];
      }
#pragma unroll
      for (int u = 0; u < 4; ++u) {
        const int j = j0 + 2 * u;
        u32 x = (j <= cur - 2) ? ((__float_as_uint(sc[u]) & 0xffffff00u) | (u32)j) : 0u;
#pragma unroll
        for (int i = 0; i < 13; ++i) { const u32 hi = max(lst[i], x); x = min(lst[i], x); lst[i] = hi; }
      }
    }
    u32 oth[13];
#pragma unroll
    for (int i = 0; i < 13; ++i) oth[i] = (u32)__shfl_xor((int)lst[i], 1);
#pragma unroll
    for (int k = 0; k < 13; ++k) {
      u32 x = oth[k];
#pragma unroll
      for (int i = 0; i < 13; ++i) { const u32 hi = max(lst[i], x); x = min(lst[i], x); lst[i] = hi; }
    }
    if (half == 0) {
      unsigned char* sp = sel + qt * 16;
      int n = 0;
      sp[n++] = 0;
      if (cur >= 1) sp[n++] = (unsigned char)cur;
      if (cur >= 2) sp[n++] = (unsigned char)(cur - 1);
      const int ncand = cur - 2 < 13 ? cur - 2 : 13;
#pragma unroll
      for (int i = 0; i < 13; ++i) if (i < ncand) sp[n++] = (unsigned char)(lst[i] & 0xffu);
      nsel[qt] = (unsigned char)n;
    }
  }
  __syncthreads();
  if (secmask & 2) {
    const unsigned char* Kg = P.KS8 + (size_t)g * S * 64; const unsigned char* Vtg = P.VS8t + (size_t)g * 64 * S;
    const int col = lane & 15, h4 = lane >> 4, hd = col & 3;
    const unsigned char* selw = sel + wave * 32 * 16;
    const unsigned char* nselw = nsel + wave * 32;
    u32x2* q8 = (u32x2*)(smem + wave * 8448);
    float* gl = (float*)(smem + 41472 + wave * 1600);
    u16* vis = (u16*)(smem + 41472 + wave * 1600 + 512);
    {
#pragma unroll 4
      for (int c = lane; c < 1024; c += 64) {
        const int qi = c >> 5, head = (c >> 3) & 3, ch = c & 7;
        const u32x4 qv = *(const u32x4*)(P.QR + ((size_t)(g * 4 + head) * S + wq0 + qi) * 64 + ch * 8);
        int w0 = 0, w1 = 0;
        w0 = __builtin_amdgcn_cvt_pk_fp8_f32(bflo(qv.x) * 16.f, bfhi(qv.x) * 16.f, w0, false);
        w0 = __builtin_amdgcn_cvt_pk_fp8_f32(bflo(qv.y) * 16.f, bfhi(qv.y) * 16.f, w0, true);
        w1 = __builtin_amdgcn_cvt_pk_fp8_f32(bflo(qv.z) * 16.f, bfhi(qv.z) * 16.f, w1, false);
        w1 = __builtin_amdgcn_cvt_pk_fp8_f32(bflo(qv.w) * 16.f, bfhi(qv.w) * 16.f, w1, true);
        q8[(qi * 8 + ch) * 4 + head] = mk2((u32)w0, (u32)w1);
      }
      if (lane < 32) q8[(32 * 8 + (lane >> 2)) * 4 + (lane & 3)] = mk2(0u, 0u);
      for (int c = lane; c < 128; c += 64) gl[c] = P.gates[(size_t)(wq0 + (c >> 2)) * 24 + (g * 4 + (c & 3)) * 3 + 1];
      int cnt = (lane < 32) ? (int)nselw[lane] : 0, pre = cnt;
#pragma unroll
      for (int o = 1; o < 32; o <<= 1) { const int t2 = __shfl_up(pre, o); if ((lane & 31) >= o) pre += t2; }
      const int V = __builtin_amdgcn_readlane(pre, 31);
      pre -= cnt;
      if (lane < 32) for (int i = 0; i < cnt; ++i) vis[pre + i] = (u16)(selw[lane * 16 + i] | (lane << 8) | (i + 1 == cnt ? 0x8000 : 0));
      if (lane < 5) vis[V + lane] = (u16)(32 << 8);
      __builtin_amdgcn_s_waitcnt(0xc07f);
      __builtin_amdgcn_wave_barrier();
      const int V3 = ((V + 2) / 3) * 3;
      SelFrags fr[3];
      sel_load(tid, fr[0], Kg, Vtg, vis[0] & 0xff);
      sel_load(tid, fr[1], Kg, Vtg, vis[1] & 0xff);
      f32x4 o[4];
#pragma unroll
      for (int dt = 0; dt < 4; ++dt) o[dt] = (f32x4){0.f, 0.f, 0.f, 0.f};
      f32x4 ol = (f32x4){0.f, 0.f, 0.f, 0.f};
#pragma unroll 1
      for (int v = 0; v < V3; v += 3) {
#pragma unroll
        for (int slot = 0; slot < 3; ++slot) {
          const int e = __builtin_amdgcn_readfirstlane((int)vis[v + slot]);
          const int e2 = __builtin_amdgcn_readfirstlane((int)vis[v + slot + 2]);
          sel_load(tid, fr[(slot + 2) % 3], Kg, Vtg, e2 & 0xff);
          const int qi = (e >> 8) & 63, bb = e & 0xff, qp = wq0 + qi;
          u32x2 qcur[2];
          qcur[0] = q8[(qi * 8 + h4) * 4 + hd]; qcur[1] = q8[(qi * 8 + 4 + h4) * 4 + hd];
          sel_compute(tid, fr[slot], qcur, bb, qp >> 6, qp, M2, o, ol);
          if (e & 0x8000) {
            const float lsum = ol[0];
            if (col < 4 && (!(secmask & 8) || lsum == 1.2345e33f)) {
              const float gs = (ABLATE & 4) ? 0.f : gl[qi * 4 + col] / lsum;
              u16* dst = P.mix + (size_t)qp * 1024 + 256 + (g * 4 + col) * 64 + 4 * h4;
#pragma unroll
              for (int dt = 0; dt < 4; ++dt)
                *(u32x2*)(dst + 16 * dt) = mk2(pack2(o[dt][0] * gs, o[dt][1] * gs), pack2(o[dt][2] * gs, o[dt][3] * gs));
            }
#pragma unroll
            for (int dt = 0; dt < 4; ++dt) o[dt] = (f32x4){0.f, 0.f, 0.f, 0.f};
            ol = (f32x4){0.f, 0.f, 0.f, 0.f};
          }
        }
      }
    }
  }
  __threadfence_block();
  __syncthreads();
#pragma unroll 1
  for (int hh = 0; hh < ((secmask & 4) ? 4 : 0); ++hh) {
    const int H = g * 4 + hh;
#pragma unroll 1
    for (int br = 0; br < 2; ++br) {
      AttnArgs a;
      a.q = q; a.wq0 = wq0; a.M2 = M2; a.cq = 0.f; a.cloc = nullptr; a.base = nullptr; a.dofs = 0;
      bf16x8 qf[4];
      f32x16 o[2]; zero_o(o);
      float ls = 0.f;
      if (br == 0) {
        load_q4(tid, qf, P.QN + (size_t)H * S * 64, q);
        a.K = Kc; a.Vt = P.VCCt + (size_t)g * 64 * 1024; a.ldv = 1024; a.t0 = 0; a.t1 = ntc;
        a.lim_hi = nmaxq; a.lim_lo = 0; a.whi = nmax_w; a.wlo = 0; a.mask_hi = (wq0 >= 31) ? ((wq0 - 31) >> 4) : -1; a.mask_lo = 0;
      } else {
        load_q4(tid, qf, P.QR + (size_t)H * S * 64, q);
        a.K = P.KW + (size_t)g * S * 64; a.Vt = P.VWt + (size_t)g * 64 * S; a.ldv = S;
        a.t0 = (q0 >> 6) - 8 < 0 ? 0 : (q0 >> 6) - 8; a.t1 = (q0 >> 6) + 2;
        a.lim_hi = q; a.lim_lo = q - 511; a.whi = wq0 + 31; a.wlo = wq0 - 511; a.mask_hi = wq0; a.mask_lo = wq0 + 31 - 511;
      }
      attn_loop<4, 4, true>(tid, a, qf, o, ls, smem);
      ls += __shfl_xor(ls, 32);
      float gt = (ls > 0.f) ? P.gates[(size_t)q * 24 + H * 3 + (br == 0 ? 0 : 2)] / ls : 0.f;
      if ((ABLATE & 2) && br == 0) gt = 0.f;
      if ((ABLATE & 8) && br == 1) gt = 0.f;
      u16* dst = P.mix + (size_t)q * 1024 + 256 + H * 64 + 4 * h;
      if (!(secmask & 8) || ls == 1.2345e33f)
#pragma unroll
      for (int dt = 0; dt < 2; ++dt)
#pragma unroll
        for (int rg = 0; rg < 4; ++rg) {
          u32x2* pp = (u32x2*)(dst + 32 * dt + 8 * rg);
          const u32x2 old = *pp;
          const float r0 = bflo(old.x) + gt * o[dt][4 * rg];
          const float r1 = bfhi(old.x) + gt * o[dt][4 * rg + 1];
          const float r2 = bflo(old.y) + gt * o[dt][4 * rg + 2];
          const float r3 = bfhi(old.y) + gt * o[dt][4 * rg + 3];
          *pp = mk2(pack2(r0, r1), pack2(r2, r3));
        }
    }
  }
}

DI unsigned xcc_id() { return (unsigned)__builtin_amdgcn_s_getreg((3 << 11) | 20) & 0xFu; }

__device__ __forceinline__ void phase_attention(const Params& P, int l, char* smem, unsigned* counter, int secmask = 7, int kmask = 0) {
  int* slot = (int*)(smem + AT_MISC + 4096);
  const int mygrp = (int)(xcc_id() & 1u);
#pragma unroll 1
  for (int pass = 0; pass < 2; ++pass) {
    const int g = pass == 0 ? mygrp : 1 - mygrp;
    for (;;) {
      __syncthreads();
      if (threadIdx.x == 0) *slot = (int)atomicAdd(counter + g, 1u);
      __syncthreads();
      const int it = *slot;
      if (it >= 128 || (kmask & 2)) break;
      nsa_item(P, l, g, 127 - it, smem, secmask);
    }
  }
  const int x = (int)(xcc_id() & 7u);
#pragma unroll 1
  for (int sidx = 0; sidx < 8; ++sidx) {
    const int k = ((x + (sidx >> 1)) & 7) ^ ((sidx & 1) << 2);
    for (;;) {
      __syncthreads();
      if (threadIdx.x == 0) *slot = (int)atomicAdd(counter + 2 + k, 1u);
      __syncthreads();
      const int it = *slot;
      if (it >= 128 || (kmask & 1)) break;
      const int qb = 127 - it;
      if (k < 4) { if (!(kmask & 4)) diff_item(P, l, k, qb, smem); } else { if (!(kmask & 8)) fox_item(P, l, k - 4, qb, smem); }
    }
  }
}

__device__ __forceinline__ void phase_outproj(const Params& P, int l, char* smem, bool dry = false) {
  const u16* Wt = P.WoutT + (size_t)l * D * D;
  float* tile = (float*)smem;
  const int tid = threadIdx.x;
  for (int it = blockIdx.x; it < 128 * 8; it += gridDim.x) {
    const int mt = it >> 3, nt = it & 7;
    f32x16 acc[2][2];
    zero_acc(acc);
    gemm_mainloop<false>(P.mix + (size_t)mt * 128 * D, D, Wt + (size_t)nt * 128 * D, D, D, smem, acc);
    acc_to_lds(acc, tile);
    __syncthreads();
    const int c4 = (tid & 31) * 4, r0 = tid >> 5;
#pragma unroll 4
    for (int i = 0; i < 16; ++i) {
      const int row = r0 + 8 * i;
      const size_t idx = (size_t)(mt * 128 + row) * D + nt * 128 + c4;
      const f32x4 a4 = *(const f32x4*)(tile + row * EPS_LD + c4);
      const u32x2 hv = *(const u32x2*)(P.hb + idx);
      f32x4 h4 = {bflo(hv.x), bfhi(hv.x), bflo(hv.y), bfhi(hv.y)};
      h4 += a4;
      if (!dry || h4[0] == 1.2345e33f) *(u32x2*)(P.hb2 + idx) = mk2(pack2(h4[0], h4[1]), pack2(h4[2], h4[3]));
    }
  }
}

constexpr int QT_ST = 272;
DI u32 ord_key(float x, u32 idx) {
  u32 u = __float_as_uint(x);
  u = (u & 0x80000000u) ? ~u : (u | 0x80000000u);
  return (u & 0xffffff80u) | idx;
}
DI float ord_val(u32 k) {
  return (k & 0x80000000u) ? __uint_as_float(k & 0x7fffff80u) : __uint_as_float((~k) & 0xffffff80u);
}
DI void merge16(u32 (&lst)[16], int xm) {
  u32 c[16];
#pragma unroll
  for (int i = 0; i < 16; ++i) { const u32 o = (u32)__shfl_xor((int)lst[15 - i], xm); c[i] = max(lst[i], o); }
#pragma unroll
  for (int st = 8; st > 0; st >>= 1)
#pragma unroll
    for (int i = 0; i < 16; ++i)
      if ((i & st) == 0) { const u32 a = max(c[i], c[i + st]), b = min(c[i], c[i + st]); c[i] = a; c[i + st] = b; }
#pragma unroll
  for (int i = 0; i < 16; ++i) lst[i] = c[i];
}

__device__ __forceinline__ void phase_peerq(const Params& P, int l, char* smem) {
  const u16* Wt = P.WqT + (size_t)l * 2048 * D;
  const int tid = threadIdx.x, lane = tid & 63, wave = tid >> 6, wr = wave >> 1, wc = wave & 1, h = lane >> 5;
  const float* rs = (const float*)(smem + G_RS_OFF);
  float* tile = (float*)smem;
  for (int it = blockIdx.x; it < 128 * 16; it += gridDim.x) {
    const int mt = it >> 4, nt = it & 15;
    f32x16 acc[2][2];
    zero_acc(acc);
    gemm_mainloop<true>(P.hb2 + (size_t)mt * 128 * D, D, Wt + (size_t)nt * 128 * D, D, D, smem, acc);
    __syncthreads();
#pragma unroll
    for (int i = 0; i < 2; ++i)
#pragma unroll
      for (int j = 0; j < 2; ++j)
#pragma unroll
        for (int r = 0; r < 16; ++r) {
          const int row = wr * 64 + i * 32 + crow(r, h);
          *(u16*)(smem + row * QT_ST + (wc * 64 + j * 32 + (lane & 31)) * 2) = f2bf(acc[i][j][r] * rs[row]);
        }
    __syncthreads();
    zero_acc(acc);
    {
      const u16* Bk = P.SubK + ((size_t)(l * 16 + nt) * 128 + wc * 64 + (lane & 31)) * 128 + h * 8;
      const char* Aq = smem + (wr * 64 + (lane & 31)) * QT_ST + h * 16;
#pragma unroll
      for (int ks = 0; ks < 8; ++ks) {
        bf16x8 af[2], bfr[2];
#pragma unroll
        for (int i = 0; i < 2; ++i) af[i] = *(const bf16x8*)(Aq + i * 32 * QT_ST + ks * 32);
#pragma unroll
        for (int j = 0; j < 2; ++j) bfr[j] = *(const bf16x8*)(Bk + (size_t)j * 32 * 128 + ks * 16);
#pragma unroll
        for (int i = 0; i < 2; ++i)
#pragma unroll
          for (int j = 0; j < 2; ++j) acc[i][j] = MFMA32(af[i], bfr[j], acc[i][j]);
      }
    }
    __syncthreads();
    acc_to_lds(acc, tile);
    __syncthreads();
#pragma unroll 1
    for (int half = 0; half < 2; ++half) {
      {
        const int row = half * 64 + (tid >> 2), part = tid & 3;
        u32 lst[16];
#pragma unroll
        for (int i = 0; i < 16; ++i) lst[i] = 0u;
        const f32x4* src = (const f32x4*)(tile + row * EPS_LD + part * 32);
#pragma unroll
        for (int c4 = 0; c4 < 8; ++c4) {
          const f32x4 v = src[c4];
#pragma unroll
          for (int e = 0; e < 4; ++e) {
            u32 x = ord_key(v[e], (u32)(part * 32 + c4 * 4 + e));
#pragma unroll
            for (int i = 0; i < 16; ++i) { const u32 hi = max(lst[i], x); x = min(lst[i], x); lst[i] = hi; }
          }
        }
        merge16(lst, 1);
        merge16(lst, 2);
        if (part == 0) {
          u32x4* dp = (u32x4*)(P.topk + ((size_t)(mt * 128 + row) * 16 + nt) * 16);
          dp[0] = mk4(lst[0], lst[1], lst[2], lst[3]); dp[1] = mk4(lst[4], lst[5], lst[6], lst[7]);
          dp[2] = mk4(lst[8], lst[9], lst[10], lst[11]); dp[3] = mk4(lst[12], lst[13], lst[14], lst[15]);
        }
      }
    }
  }
}

__device__ const unsigned char kCandIJ[50] = {
  0x00,0x01,0x02,0x03,0x04,0x05,0x06,0x07,0x08,0x09,0x0a,0x0b,0x0c,0x0d,0x0e,0x0f,
  0x10,0x11,0x12,0x13,0x14,0x15,0x16,0x17,
  0x20,0x21,0x22,0x23,0x24,
  0x30,0x31,0x32,0x33,
  0x40,0x41,0x42,
  0x50,0x51, 0x60,0x61, 0x70,0x71,
  0x80,0x90,0xa0,0xb0,0xc0,0xd0,0xe0,0xf0};
DI float gelu_exact(float x) { return 0.5f * x * (1.f + erff(x * 0.7071067811865476f)); }

__device__ __forceinline__ void phase_peer(const Params& P, int l, char* smem, bool dry = false) {
  const int tid = threadIdx.x, lane = tid & 63, wave = tid >> 6;
  char* wsm = smem + wave * 8192;
  u32* keys = (u32*)wsm;
  u32* cvk = (u32*)(wsm + 1024);
  int* exps = (int*)(wsm + 1024 + 1664);
  float* esc = (float*)(wsm + 3200);
  float* wts = (float*)(wsm + 3712);
  float* hraw = (float*)(wsm + 4224);
  unsigned char* xrow8 = (unsigned char*)(wsm + 5248);
  const unsigned char* U8 = P.U8 + (size_t)l * S * (D / 2);
  const unsigned char* V8 = P.V8 + (size_t)l * S * (D / 2);
  const float* Uinv = P.Uinv + l * S; const float* Vinv = P.Vinv + l * S;
  if (lane < 16) cvk[(lane >> 1) * 52 + 50 + (lane & 1)] = 0u;
  int it = blockIdx.x;
  u32x4 kq = mk4(0u, 0u, 0u, 0u), xa = kq, xb = kq;
  if (it < S / 4) {
    const int tok = it * 4 + wave;
    kq = *(const u32x4*)(P.topk + (size_t)tok * 256 + lane * 4);
    xa = *(const u32x4*)(P.hb2 + (size_t)tok * D + lane * 16); xb = *(const u32x4*)(P.hb2 + (size_t)tok * D + lane * 16 + 8);
  }
  for (; it < S / 4; it += gridDim.x) {
    const int tok = it * 4 + wave;
    *(u32x4*)(keys + lane * 4) = kq;
    float rstd = wave_sum(ssq8(xa) + ssq8(xb));
    rstd = rsqrtf(rstd * (1.f / 1024.f) + 1e-6f);
    float xinv;
    {
      float xv[16] = {bflo(xa.x), bfhi(xa.x), bflo(xa.y), bfhi(xa.y), bflo(xa.z), bfhi(xa.z), bflo(xa.w), bfhi(xa.w),
                      bflo(xb.x), bfhi(xb.x), bflo(xb.y), bfhi(xb.y), bflo(xb.z), bfhi(xb.z), bflo(xb.w), bfhi(xb.w)};
      float m = 0.f;
#pragma unroll
      for (int i = 0; i < 16; ++i) m = fmaxf(m, fabsf(xv[i]));
      m = wave_max(m);
      const float sx = (m > 0.f) ? 240.f / m : 0.f;
      xinv = m * (1.f / 240.f);
      u32 o4[4];
#pragma unroll
      for (int i = 0; i < 4; ++i) {
        int wd = 0;
        wd = __builtin_amdgcn_cvt_pk_fp8_f32(xv[4 * i] * sx, xv[4 * i + 1] * sx, wd, false);
        wd = __builtin_amdgcn_cvt_pk_fp8_f32(xv[4 * i + 2] * sx, xv[4 * i + 3] * sx, wd, true);
        o4[i] = (u32)wd;
      }
      *(u32x4*)(xrow8 + lane * 16) = mk4(o4[0], o4[1], o4[2], o4[3]);
    }
    {
      const int nit = it + gridDim.x;
      if (nit < S / 4) {
        const int ntok = nit * 4 + wave;
        kq = *(const u32x4*)(P.topk + (size_t)ntok * 256 + lane * 4);
        xa = *(const u32x4*)(P.hb2 + (size_t)ntok * D + lane * 16); xb = *(const u32x4*)(P.hb2 + (size_t)ntok * D + lane * 16 + 8);
      }
    }
    __builtin_amdgcn_s_waitcnt(0xc07f);
    const int hd = lane >> 3, sub = lane & 7;
    float myv[7]; int mye[7]; u32 mk[7];
#pragma unroll
    for (int m = 0; m < 7; ++m) {
      const int c = sub + 8 * m;
      myv[m] = -3.0e38f; mye[m] = 0; mk[m] = 0u;
      if (m < 6 || c < 50) {
        const int ij = kCandIJ[c], i = ij >> 4, j = ij & 15;
        const u32 k1 = keys[(hd * 2) * 16 + i], k2 = keys[(hd * 2 + 1) * 16 + j];
        myv[m] = ord_val(k1) + ord_val(k2);
        mye[m] = (int)((k1 & 127u) * 128u + (k2 & 127u));
        u32 sk = __float_as_uint(myv[m]);
        sk = (sk & 0x80000000u) ? ~sk : (sk | 0x80000000u);
        mk[m] = (sk & 0xffffffc0u) | (u32)(63 - c);
        cvk[hd * 52 + c] = mk[m];
      }
    }
    __builtin_amdgcn_s_waitcnt(0xc07f);
    {
      int rk[7];
#pragma unroll
      for (int m = 0; m < 7; ++m) rk[m] = 0;
#pragma unroll
      for (int j = 0; j < 13; ++j) {
        const u32x4 o = *(const u32x4*)(cvk + hd * 52 + 4 * j);
#pragma unroll
        for (int m = 0; m < 7; ++m) rk[m] += (int)(o.x > mk[m]) + (int)(o.y > mk[m]) + (int)(o.z > mk[m]) + (int)(o.w > mk[m]);
      }
#pragma unroll
      for (int m = 0; m < 7; ++m) {
        const int c = sub + 8 * m;
        if ((m < 6 || c < 50) && rk[m] < 16) { exps[hd * 16 + rk[m]] = mye[m]; esc[hd * 16 + rk[m]] = myv[m]; }
      }
    }
    __builtin_amdgcn_s_waitcnt(0xc07f);
    const int ex0 = exps[lane], ex1 = exps[lane + 64];
    const float ui0 = Uinv[ex0], ui1 = Uinv[ex1], vi0 = Vinv[ex0], vi1 = Vinv[ex1];
    float g0, g1;
    {
      const float mx = esc[hd * 16];
      const float e0 = expf(esc[hd * 16 + 2 * sub] - mx), e1 = expf(esc[hd * 16 + 2 * sub + 1] - mx);
      float sm = e0 + e1;
      sm += __shfl_xor(sm, 1); sm += __shfl_xor(sm, 2); sm += __shfl_xor(sm, 4);
      g0 = e0 / sm; g1 = e1 / sm;
    }
    wts[hd * 16 + 2 * sub] = g0; wts[hd * 16 + 2 * sub + 1] = g1;
    {
      const int i16 = lane & 15, h4 = lane >> 4;
      u32x4 a0[8], a1[8];
      auto uload = [&](u32x4 (&a)[8], int g) {
        const unsigned char* urow = U8 + (u32)(exps[g * 16 + i16] * (D / 2) + 16 * h4);
#pragma unroll
        for (int i = 0; i < 8; ++i) a[i] = *(const u32x4*)(urow + i * 64);
      };
      auto umma = [&](const u32x4 (&a)[8], int g) {
        f32x4 acc = (f32x4){0.f, 0.f, 0.f, 0.f};
#pragma unroll
        for (int i = 0; i < 8; ++i) {
          const u32x4 b0 = *(const u32x4*)(xrow8 + i * 128 + 16 * h4), b1 = *(const u32x4*)(xrow8 + i * 128 + 64 + 16 * h4);
          const i32x8 A = {(int)a[i].x, (int)a[i].y, (int)a[i].z, (int)a[i].w, 0, 0, 0, 0};
          const i32x8 B = {(int)b0.x, (int)b0.y, (int)b0.z, (int)b0.w, (int)b1.x, (int)b1.y, (int)b1.z, (int)b1.w};
          acc = __builtin_amdgcn_mfma_scale_f32_16x16x128_f8f6f4(A, B, acc, 4, 0, 0, 0x7f7f7f7f, 0, 0x7f7f7f7f);
        }
        if (i16 == 0) *(f32x4*)(hraw + g * 16 + 4 * h4) = acc;
      };
      uload(a0, 0);
#pragma unroll 1
      for (int g = 0; g < 8; g += 2) {
        uload(a1, g + 1);
        umma(a0, g);
        if (g + 2 < 8) uload(a0, g + 2);
        umma(a1, g + 1);
      }
    }
    __builtin_amdgcn_s_waitcnt(0xc07f);
    {
      const float h0 = hraw[lane], h1 = hraw[lane + 64];
      const float w0 = wts[lane], w1 = wts[lane + 64];
      wts[lane] = w0 * gelu_exact(rstd * h0 * ui0 * xinv) * vi0;
      wts[lane + 64] = w1 * gelu_exact(rstd * h1 * ui1 * xinv) * vi1;
    }
    __builtin_amdgcn_s_waitcnt(0xc07f);
    float o[16];
#pragma unroll
    for (int i = 0; i < 16; ++i) o[i] = 0.f;
    {
      u32x2 va[8], vb2[8];
      auto vload = [&](u32x2 (&x0)[8], int k) {
#pragma unroll
        for (int u = 0; u < 8; ++u) x0[u] = *(const u32x2*)(V8 + (u32)(exps[k + u] * (D / 2) + lane * 8));
      };
      auto vacc = [&](const u32x2 (&x0)[8], int k) {
#pragma unroll
        for (int u = 0; u < 8; ++u) {
          const float w = wts[k + u];
#pragma unroll
          for (int c = 0; c < 2; ++c) {
            const f32x2 d0 = __builtin_amdgcn_cvt_scalef32_pk_f32_fp4(x0[u][c], 1.0f, 0), d1 = __builtin_amdgcn_cvt_scalef32_pk_f32_fp4(x0[u][c], 1.0f, 1);
            const f32x2 d2 = __builtin_amdgcn_cvt_scalef32_pk_f32_fp4(x0[u][c], 1.0f, 2), d3 = __builtin_amdgcn_cvt_scalef32_pk_f32_fp4(x0[u][c], 1.0f, 3);
            o[8 * c] += w * d0[0]; o[8 * c + 1] += w * d0[1]; o[8 * c + 2] += w * d1[0]; o[8 * c + 3] += w * d1[1];
            o[8 * c + 4] += w * d2[0]; o[8 * c + 5] += w * d2[1]; o[8 * c + 6] += w * d3[0]; o[8 * c + 7] += w * d3[1];
          }
        }
      };
      vload(va, 0);
#pragma unroll 1
      for (int k = 0; k < 128; k += 16) {
        vload(vb2, k + 8);
        vacc(va, k);
        if (k + 16 < 128) vload(va, k + 16);
        vacc(vb2, k + 8);
      }
    }
    if (!dry || o[0] == 1.2345e33f) {
      u32x4* hp = (u32x4*)(P.hb2 + (size_t)tok * D + lane * 16);
      const u32x4 ca = hp[0], cb = hp[1];
      hp[0] = mk4(pack2(bflo(ca.x) + o[0], bfhi(ca.x) + o[1]), pack2(bflo(ca.y) + o[2], bfhi(ca.y) + o[3]), pack2(bflo(ca.z) + o[4], bfhi(ca.z) + o[5]), pack2(bflo(ca.w) + o[6], bfhi(ca.w) + o[7]));
      hp[1] = mk4(pack2(bflo(cb.x) + o[8], bfhi(cb.x) + o[9]), pack2(bflo(cb.y) + o[10], bfhi(cb.y) + o[11]), pack2(bflo(cb.z) + o[12], bfhi(cb.z) + o[13]), pack2(bflo(cb.w) + o[14], bfhi(cb.w) + o[15]));
    }
  }
}

__device__ __forceinline__ void phase_ple(const Params& P, int l, char* smem, bool dry = false) {
  const u16* Wg = P.WgT + (size_t)l * D * D;
  const u16* Wp = P.WpT + (size_t)l * D * 256;
  const u16* pb = P.pb + (size_t)l * S * 256;
  const int tid = threadIdx.x, lane = tid & 63, wave = tid >> 6, wr = wave >> 1, h = lane >> 5;
  const float* rs = (const float*)(smem + G_RS_OFF);
  float* tile = (float*)smem;
  for (int it = blockIdx.x; it < 128 * 8; it += gridDim.x) {
    const int mt = it >> 3, nt = it & 7;
    f32x16 acc[2][2];
    zero_acc(acc);
    gemm_mainloop<false>(pb + (size_t)mt * 128 * 256, 256, Wp + (size_t)nt * 128 * 256, 256, 256, smem, acc);
    u16* side = (u16*)(smem + 36864);
    const int wc = wave & 1;
#pragma unroll
    for (int i = 0; i < 2; ++i)
#pragma unroll
      for (int j = 0; j < 2; ++j)
#pragma unroll
        for (int r = 0; r < 16; ++r)
          side[(wr * 64 + i * 32 + crow(r, h)) * 136 + wc * 64 + j * 32 + (lane & 31)] = f2bf(acc[i][j][r]);
    zero_acc(acc);
    gemm_mainloop<true>(P.hb2 + (size_t)mt * 128 * D, D, Wg + (size_t)nt * 128 * D, D, D, smem, acc);
    __syncthreads();
#pragma unroll
    for (int i = 0; i < 2; ++i)
#pragma unroll
      for (int j = 0; j < 2; ++j)
#pragma unroll
        for (int r = 0; r < 16; ++r) {
          const int row = wr * 64 + i * 32 + crow(r, h);
          const float pv = bf2f(side[row * 136 + wc * 64 + j * 32 + (lane & 31)]);
          acc[i][j][r] = sigmoidf_(acc[i][j][r] * rs[row]) * pv;
        }
    __syncthreads();
    acc_to_lds(acc, tile);
    __syncthreads();
    const int c4 = (tid & 31) * 4, r0 = tid >> 5;
#pragma unroll 4
    for (int i = 0; i < 16; ++i) {
      const int row = r0 + 8 * i;
      const size_t idx = (size_t)(mt * 128 + row) * D + nt * 128 + c4;
      const f32x4 a4 = *(const f32x4*)(tile + row * EPS_LD + c4);
      const u32x2 hv = *(const u32x2*)(P.hb2 + idx);
      f32x4 h4 = {bflo(hv.x), bfhi(hv.x), bflo(hv.y), bfhi(hv.y)};
      h4 += a4;
      if (!dry || h4[0] == 1.2345e33f) {
        if (l == 1) *(f32x4*)(P.out + idx) = h4;
        else *(u32x2*)(P.hb + idx) = mk2(pack2(h4[0], h4[1]), pack2(h4[2], h4[3]));
      }
    }
  }
}

constexpr int N_PHASES = 15;
#define XB_TMO      128
#define XB_XCNT(j)  (256  + 64 * (j))
#define XB_XSUB(j)  (1280 + 64 * (j))
#define XB_XGEN(j)  (2304 + 64 * (j))
#define XB_TOP      3328
#define XB_TOPGEN   3392
#define XCD_BAR_WORDS 3456
#define XB_SPIN_CAP (1u << 24)
typedef __attribute__((address_space(3))) unsigned las_u32;
DI unsigned xb_ld(unsigned* p) { return __hip_atomic_load(p, __ATOMIC_RELAXED, __HIP_MEMORY_SCOPE_AGENT); }
DI unsigned xb_add(unsigned* p, unsigned v) { return __hip_atomic_fetch_add(p, v, __ATOMIC_RELAXED, __HIP_MEMORY_SCOPE_AGENT); }
#define XB_SPIN(cond, bar) do { unsigned _sp = 0; while (cond) { __builtin_amdgcn_s_sleep(1); \
    if ((++_sp & 255u) == 0u) { if (xb_ld(&(bar)[XB_TMO])) break; if (_sp > XB_SPIN_CAP) { (void)xb_add(&(bar)[XB_TMO], 1u); break; } } } } while (0)
struct XcdBarrier { unsigned* bar; unsigned x; volatile las_u32* st; };
DI XcdBarrier xcd_barrier_post(unsigned* bar, volatile las_u32* st) {
  XcdBarrier b; b.bar = bar; b.x = (unsigned)__builtin_amdgcn_s_getreg((3 << 11) | 20) & 0xFu; b.st = st;
  if (threadIdx.x == 0) (void)xb_add(&bar[XB_XCNT(b.x)], 1u);
  return b;
}
DI void xcd_barrier_complete(unsigned* bar, unsigned x, unsigned& nloc, unsigned& nx) {
  const unsigned G = gridDim.x * gridDim.y * gridDim.z;
  unsigned sum, cnt, mine, sp = 0u;
  for (;;) {
    sum = 0u; cnt = 0u; mine = 0u;
#pragma unroll
    for (unsigned j = 0; j < 16; ++j) { const unsigned c = xb_ld(&bar[XB_XCNT(j)]); sum += c; cnt += (c > 0u) ? 1u : 0u; mine = (j == x) ? c : mine; }
    if (sum == G) break;
    __builtin_amdgcn_s_sleep(1);
    if ((++sp & 255u) == 0u) { if (xb_ld(&bar[XB_TMO])) break; if (sp > XB_SPIN_CAP) { (void)xb_add(&bar[XB_TMO], 1u); break; } }
  }
  nloc = mine > 0u ? mine : 1u; nx = cnt > 0u ? cnt : 1u;
}
DI void xcd_barrier(unsigned* xbar, unsigned xx, volatile las_u32* xst_) {
  XcdBarrier b; b.bar = xbar; b.x = xx; b.st = xst_;
  asm volatile("s_waitcnt vmcnt(0)" ::: "memory");
  __syncthreads();
  if (threadIdx.x == 0) {
    unsigned* bar = b.bar;
    __builtin_amdgcn_s_waitcnt(0);
    unsigned nloc = b.st[0], nx = b.st[1];
    if (nloc == 0u) { xcd_barrier_complete(bar, b.x, nloc, nx); b.st[0] = nloc; b.st[1] = nx; }
    const unsigned old = xb_add(&bar[XB_XSUB(b.x)], 1u);
    const unsigned gen = old / nloc;
    if (old + 1u == (gen + 1u) * nloc) {
      __builtin_amdgcn_fence(__ATOMIC_RELEASE, "agent");
      asm volatile("s_waitcnt vmcnt(0)" ::: "memory");
      const unsigned og = xb_add(&bar[XB_TOP], 1u);
      const unsigned tg = og / nx;
      if (og + 1u == (tg + 1u) * nx) xb_add(&bar[XB_TOPGEN], 1u);
      else XB_SPIN(xb_ld(&bar[XB_TOPGEN]) == tg, bar);
      __builtin_amdgcn_fence(__ATOMIC_ACQUIRE, "agent");
      xb_add(&bar[XB_XGEN(b.x)], 1u);
      asm volatile("s_waitcnt vmcnt(0)" ::: "memory");
    } else {
      XB_SPIN(xb_ld(&bar[XB_XGEN(b.x)]) == gen, bar);
      __builtin_amdgcn_fence(__ATOMIC_ACQUIRE, "agent");
      asm volatile("s_waitcnt vmcnt(0)" ::: "memory");
    }
  }
  __syncthreads();
}
__global__ void __launch_bounds__(NT, 2) hymba_mega(Params P, unsigned* counters) {
  __shared__ __attribute__((aligned(16))) char smem[SMEM_BYTES];
  cg::grid_group grid = cg::this_grid();
  const int lo = P.phase_lo, hi = P.phase_hi;
#ifndef ONLY_PHASE
#define ONLY_PHASE -1
#endif
#define PH_ON(k) (ONLY_PHASE < 0 || ONLY_PHASE == (k))
  volatile las_u32* xst = (volatile las_u32*)(smem + SMEM_BYTES - 16);
  if (threadIdx.x < 4) xst[threadIdx.x] = 0u;
  __syncthreads();
  unsigned* const xbar = counters + 64;
  const unsigned xcc = xcd_barrier_post(xbar, xst).x;
#define RUN(ph, kind, call) if (lo <= (ph) && (ph) < hi) { const bool dry = false; const int rep = 0; (void)dry; (void)rep; if (PH_ON(kind)) { call; } if ((ph) + 1 < hi) { if ((ph) == 0) grid.sync(); else xcd_barrier(xbar, xcc, xst); } }
#define RUNREP(ph, kind, call) if (lo <= (ph) && (ph) < hi) { \
    const int nrep = ((ph) == P.rep_ph) ? P.rep_n : 1; \
    for (int rep = 0; rep < nrep; ++rep) { const bool dry = rep > 0; (void)dry; \
      if (PH_ON(kind)) { call; } \
      if ((ph) + 1 < hi || rep + 1 < nrep) { xcd_barrier(xbar, xcc, xst); } } }
#ifndef REPEAT
#define REPEAT -1
#define RSEC 7
#endif
  RUN(0, 7, phase_prep(P, smem))
  RUN(1, 0, phase_inproj(P, 0, smem))
  RUN(2, 1, phase_compress(P, 0, smem))
  RUNREP(3, 2, phase_attention(P, 0, smem, counters + 16 * rep, dry ? (P.rep_sec | 8) : 7, dry ? P.rep_nsa_only : 0))
  RUN(4, 3, phase_outproj(P, 0, smem, dry))
  RUN(5, 4, phase_peerq(P, 0, smem))
  RUN(6, 5, phase_peer(P, 0, smem, dry))
  RUN(7, 6, phase_ple(P, 0, smem, dry))
  RUN(8, 0, phase_inproj(P, 1, smem))
  RUN(9, 1, phase_compress(P, 1, smem))
  RUN(10, 2, phase_attention(P, 1, smem, counters + 32))
  RUN(11, 3, phase_outproj(P, 1, smem))
  RUN(12, 4, phase_peerq(P, 1, smem))
  RUN(13, 5, phase_peer(P, 1, smem))
  RUN(14, 6, phase_ple(P, 1, smem))
}

static size_t align_up(size_t x, size_t a) { return (x + a - 1) / a * a; }

extern "C" void kernel_launch(void* const* d_in, const int* in_sizes, int n_in, void* d_out, int out_size, void* d_ws, size_t ws_size, hipStream_t stream) {
  static int grid_blocks = 0;
  if (!grid_blocks) {
    int dev = 0, cus = 0, per_cu = 0;
    hipGetDevice(&dev);
    hipDeviceGetAttribute(&cus, hipDeviceAttributeMultiprocessorCount, dev);
    hipOccupancyMaxActiveBlocksPerMultiprocessor(&per_cu, hymba_mega, NT, 0);
    if (per_cu > 2) per_cu = 2;
    if (per_cu < 1) per_cu = 1;
    grid_blocks = cus * per_cu;
  }
  Params P;
  memset(&P, 0, sizeof(P));
  P.x = (const float*)d_in[0]; P.p = (const float*)d_in[1]; P.positions = (const int*)d_in[2];
  P.attn_norm_w = (const float*)d_in[3]; P.w_in = (const float*)d_in[4]; P.fox_f_bias = (const float*)d_in[5];
  P.fox_q_norm_w = (const float*)d_in[6]; P.fox_k_norm_w = (const float*)d_in[7];
  P.nsa_q_norm_w = (const float*)d_in[8]; P.nsa_k_norm_w = (const float*)d_in[9]; P.nsa_cmp_pos = (const float*)d_in[10]; P.nsa_cmp_w = (const float*)d_in[11];
  P.diff_q_norm_w = (const float*)d_in[12]; P.diff_k_norm_w = (const float*)d_in[13]; P.diff_lambda = (const float*)d_in[14]; P.diff_subln_w = (const float*)d_in[15];
  P.w_out = (const float*)d_in[16]; P.ffn_norm_w = (const float*)d_in[17]; P.peer_w_q = (const float*)d_in[18]; P.peer_sub_keys = (const float*)d_in[19];
  P.peer_u = (const float*)d_in[20]; P.peer_v = (const float*)d_in[21]; P.ple_norm_w = (const float*)d_in[22]; P.ple_w_gate = (const float*)d_in[23]; P.ple_w_proj = (const float*)d_in[24];
  P.out = (float*)d_out;
  char* w = (char*)d_ws; size_t off = 0;
  auto take = [&](size_t bytes) { char* p = w + off; off = align_up(off + bytes, 256); return p; };
  unsigned* counters = (unsigned*)take(256 + XCD_BAR_WORDS * 4);
  P.WinT = (u16*)take((size_t)2 * NINP * D * 2);
  P.WoutT = (u16*)take((size_t)2 * D * D * 2);
  P.WqT = (u16*)take((size_t)2 * 2048 * D * 2);
  P.WgT = (u16*)take((size_t)2 * D * D * 2);
  P.WpT = (u16*)take((size_t)2 * D * 256 * 2);
  P.SubK = (u16*)take((size_t)2 * 16 * 128 * 128 * 2);
  P.CmpWT = (u16*)take((size_t)2 * 2 * 128 * 2048 * 2);
  P.cmpbias = (float*)take(2 * 2 * 64 * 4);
  P.U8 = (unsigned char*)take((size_t)2 * S * D / 2);
  P.V8 = (unsigned char*)take((size_t)2 * S * D / 2);
  P.Uinv = (float*)take((size_t)2 * S * 4); P.Vinv = (float*)take((size_t)2 * S * 4);
  P.hb = (u16*)take((size_t)S * D * 2);
  P.hb2 = (u16*)take((size_t)S * D * 2);
  P.pb = (u16*)take((size_t)2 * S * 256 * 2);
  P.ropeN = (float*)take((size_t)S * 64 * 4);
  P.ropeD = (float*)take((size_t)S * 32 * 4);
  P.QF = (u16*)take((size_t)4 * S * 64 * 2); P.KF = (u16*)take((size_t)4 * S * 64 * 2); P.VFt = (u16*)take((size_t)4 * S * 64 * 2);
  P.cloc = (float*)take((size_t)4 * S * 4); P.ctot = (float*)take(256 * 4 * 4);
  P.QN = (u16*)take((size_t)8 * S * 64 * 2); P.QR = (u16*)take((size_t)8 * S * 64 * 2);
  P.KC = (u16*)take((size_t)2 * (S + 64) * 64 * 2); P.VC = (u16*)take((size_t)2 * (S + 64) * 64 * 2);
  P.KCC = (u16*)take((size_t)2 * 1024 * 64 * 2); P.VCCt = (u16*)take((size_t)2 * 64 * 1024 * 2);
  P.KS8 = (unsigned char*)take((size_t)2 * S * 64); P.VS8t = (unsigned char*)take((size_t)2 * S * 64);
  P.KW = (u16*)take((size_t)2 * S * 64 * 2); P.VWt = (u16*)take((size_t)2 * S * 64 * 2);
  P.gates = (float*)take((size_t)S * 24 * 4);
  P.QD = (u16*)take((size_t)4 * S * 64 * 2); P.KD = (u16*)take((size_t)4 * S * 64 * 2); P.VDt = (u16*)take((size_t)4 * S * 64 * 2);
  P.mix = (u16*)take((size_t)S * D * 2);
  P.dstash = (float*)take((size_t)grid_blocks * 128 * 64 * 4);
  P.impA = (float*)take((size_t)256 * 256 * 128 * 4); P.impB = (float*)take((size_t)256 * 256 * 128 * 4);
  P.topk = (u32*)take((size_t)S * 256 * 4);
  if (off > ws_size) { fprintf(stderr, "kernel_launch: workspace too small: need %zu, have %zu\n", off, ws_size); return; }
  hipMemsetAsync(counters, 0, 256 + XCD_BAR_WORDS * 4, stream);
#ifndef SINGLE_LAUNCH
#define SINGLE_LAUNCH 1
#endif
#ifndef REP_PH
#define REP_PH -1
#endif
#ifndef REP_N
#define REP_N 1
#endif
#ifndef REP_SEC
#define REP_SEC 7
#endif
#ifndef REP_NSA_ONLY
#define REP_NSA_ONLY 0
#endif
  P.rep_ph = REP_PH; P.rep_n = REP_N; P.rep_sec = REP_SEC; P.rep_nsa_only = REP_NSA_ONLY;
  if (SINGLE_LAUNCH) {
    P.phase_lo = 0; P.phase_hi = N_PHASES;
    void* args[] = {&P, &counters};
    hipError_t e = hipLaunchCooperativeKernel((void*)hymba_mega, dim3(grid_blocks), dim3(NT), args, 0, stream);
    if (e != hipSuccess) fprintf(stderr, "cooperative launch failed: %s (grid %d)\n", hipGetErrorString(e), grid_blocks);
  } else {
    for (int ph = 0; ph < N_PHASES; ++ph) {
      P.phase_lo = ph; P.phase_hi = ph + 1;
      void* args[] = {&P, &counters};
      hipError_t e = hipLaunchCooperativeKernel((void*)hymba_mega, dim3(grid_blocks), dim3(NT), args, 0, stream);
      if (e != hipSuccess) { fprintf(stderr, "cooperative launch failed: %s (grid %d, phase %d)\n", hipGetErrorString(e), grid_blocks, ph); break; }
    }
  }
}
```

```cpp
#include <hip/hip_runtime.h>
#include <hip/hip_cooperative_groups.h>
#include <cstdio>
#include <cstdint>
#include <cstring>
namespace cg = cooperative_groups;

typedef __attribute__((ext_vector_type(8))) short bf16x8;
typedef __attribute__((ext_vector_type(4))) short bf16x4;
typedef __attribute__((ext_vector_type(16))) float f32x16;
typedef __attribute__((ext_vector_type(4))) float f32x4;
typedef __attribute__((ext_vector_type(2))) float f32x2;
typedef __attribute__((ext_vector_type(2))) __bf16 bf2_t;
typedef unsigned short u16;
typedef unsigned int u32;
typedef __attribute__((ext_vector_type(4))) unsigned int u32x4;
typedef __attribute__((ext_vector_type(2))) unsigned int u32x2;

#define DI __device__ __forceinline__
#define MFMA32(a, b, c) __builtin_amdgcn_mfma_f32_32x32x16_bf16((a), (b), (c), 0, 0, 0)
#define MFMA16(a, b, c) __builtin_amdgcn_mfma_f32_16x16x32_bf16((a), (b), (c), 0, 0, 0)

constexpr int S = 16384;
constexpr int D = 1024;
constexpr int NT = 256;
constexpr int NIN = 2844;
constexpr int NINP = 2944;
constexpr int SMEM_BYTES = 72704;
constexpr float LOG2E = 1.4426950408889634f;
#ifndef ABLATE
#define ABLATE 0
#endif

typedef int i32x8 __attribute__((ext_vector_type(8)));
struct Params {
  const float* x; const float* p; const int* positions;
  const float* attn_norm_w; const float* w_in; const float* fox_f_bias; const float* fox_q_norm_w; const float* fox_k_norm_w;
  const float* nsa_q_norm_w; const float* nsa_k_norm_w; const float* nsa_cmp_pos; const float* nsa_cmp_w;
  const float* diff_q_norm_w; const float* diff_k_norm_w; const float* diff_lambda; const float* diff_subln_w;
  const float* w_out; const float* ffn_norm_w; const float* peer_w_q; const float* peer_sub_keys; const float* peer_u; const float* peer_v;
  const float* ple_norm_w; const float* ple_w_gate; const float* ple_w_proj;
  float* out;
  u16* WinT;
  u16* WoutT;
  u16* WqT;
  u16* WgT;
  u16* WpT;
  u16* SubK;
  u16* CmpWT;
  float* cmpbias;
  unsigned char* U8;
  unsigned char* V8;
  float* Uinv; float* Vinv;
  u16* hb;
  u16* hb2;
  u16* pb;
  float* ropeN;
  float* ropeD;
  u16* QF; u16* KF; u16* VFt;
  float* cloc; float* ctot;
  u16* QN; u16* QR;
  u16* KC; u16* VC;
  u16* KCC; u16* VCCt;
  unsigned char* KS8; unsigned char* VS8t;
  u16* KW; u16* VWt;
  float* gates;
  u16* QD; u16* KD; u16* VDt;
  u16* mix;
  float* dstash;
  float* impA; float* impB;
  u32* topk;
  int phase_lo, phase_hi;
  int rep_ph, rep_n, rep_sec, rep_nsa_only;
};

DI u32x4 mk4(u32 a, u32 b, u32 c, u32 d) { return (u32x4){a, b, c, d}; }
DI u32x2 mk2(u32 a, u32 b) { return (u32x2){a, b}; }
DI u32 pack2(float a, float b) { f32x2 v = {a, b}; bf2_t r = __builtin_convertvector(v, bf2_t); return __builtin_bit_cast(u32, r); }
DI u16 f2bf(float a) { return (u16)(pack2(a, 0.f) & 0xffffu); }
DI float bf2f(u16 x) { return __uint_as_float(((u32)x) << 16); }
DI float bflo(u32 x) { return __uint_as_float(x << 16); }
DI float bfhi(u32 x) { return __uint_as_float(x & 0xffff0000u); }
DI int opaque_tid() { int t = threadIdx.x; asm volatile("" : "+v"(t)); return t; }
DI int crow(int reg, int h) { return (reg & 3) + 8 * (reg >> 2) + 4 * h; }
DI float wave_sum(float v) {
#pragma unroll
  for (int o = 32; o > 0; o >>= 1) v += __shfl_xor(v, o);
  return v;
}
DI float wave_max(float v) {
#pragma unroll
  for (int o = 32; o > 0; o >>= 1) v = fmaxf(v, __shfl_xor(v, o));
  return v;
}

DI int inproj_old_col(int j) {
  if (j < 768) return j;
  if (j < 2048) return j + 4;
  if (j < 2816) return j + 28;
  if (j < 2820) return j - 2048;
  if (j < 2844) return j - 768;
  return -1;
}
DI void transpose_tile(const float* __restrict__ src, int ldsrc, u16* __restrict__ dst, int K, const float* __restrict__ scale,
                       int n0, int k0, int mode, int nvalid, float* tile) {
  const int t = threadIdx.x;
  const int nn = t & 63, kq = t >> 6;
  int col = n0 + nn;
  if (mode == 1) col = inproj_old_col(col); else if (col >= nvalid) col = -1;
  float v[16];
#pragma unroll
  for (int i = 0; i < 16; ++i) v[i] = (col >= 0) ? src[(size_t)(k0 + kq + 4 * i) * ldsrc + col] : 0.f;
  if (scale) {
#pragma unroll
    for (int i = 0; i < 16; ++i) v[i] *= scale[k0 + kq + 4 * i];
  }
#pragma unroll
  for (int i = 0; i < 16; ++i) tile[(kq + 4 * i) * 65 + nn] = v[i];
  __syncthreads();
  const int n2 = t >> 2, kc = (t & 3) * 16;
  u32 o[8];
#pragma unroll
  for (int i = 0; i < 8; ++i) o[i] = pack2(tile[(kc + 2 * i) * 65 + n2], tile[(kc + 2 * i + 1) * 65 + n2]);
  u32x4* dp = (u32x4*)(dst + (size_t)(n0 + n2) * K + k0 + kc);
  dp[0] = mk4(o[0], o[1], o[2], o[3]);
  dp[1] = mk4(o[4], o[5], o[6], o[7]);
  __syncthreads();
}

DI void convert_rows(const float* __restrict__ src, u16* __restrict__ dst, size_t n8, float* __restrict__ copy) {
  const size_t stride = (size_t)gridDim.x * NT;
  for (size_t i0 = (size_t)blockIdx.x * NT + threadIdx.x; i0 < n8; i0 += 4 * stride) {
    f32x4 a[4], b[4];
#pragma unroll
    for (int u = 0; u < 4; ++u) {
      const size_t i = i0 + u * stride;
      if (i < n8) { a[u] = ((const f32x4*)src)[2 * i]; b[u] = ((const f32x4*)src)[2 * i + 1]; }
    }
#pragma unroll
    for (int u = 0; u < 4; ++u) {
      const size_t i = i0 + u * stride;
      if (i < n8) {
        if (copy) { ((f32x4*)copy)[2 * i] = a[u]; ((f32x4*)copy)[2 * i + 1] = b[u]; }
        ((u32x4*)dst)[i] = mk4(pack2(a[u][0], a[u][1]), pack2(a[u][2], a[u][3]), pack2(b[u][0], b[u][1]), pack2(b[u][2], b[u][3]));
      }
    }
  }
}

__device__ __forceinline__ void phase_prep(const Params& P, char* smem) {
  float* tile = (float*)smem;
  const int bid = blockIdx.x, nb = gridDim.x, t = threadIdx.x;
  for (int it0 = bid; it0 < 2 * 1952; it0 += nb) {
    const int l = it0 / 1952;
    int it = it0 % 1952;
    if (it < 736) { transpose_tile(P.w_in + (size_t)l * D * NIN, NIN, P.WinT + (size_t)l * NINP * D, D, P.attn_norm_w + l * D, (it >> 4) * 64, (it & 15) * 64, 1, 0, tile); continue; }
    it -= 736;
    if (it < 256) { transpose_tile(P.w_out + (size_t)l * D * D, D, P.WoutT + (size_t)l * D * D, D, nullptr, (it >> 4) * 64, (it & 15) * 64, 0, D, tile); continue; }
    it -= 256;
    if (it < 512) { transpose_tile(P.peer_w_q + (size_t)l * D * 2048, 2048, P.WqT + (size_t)l * 2048 * D, D, P.ffn_norm_w + l * D, (it >> 4) * 64, (it & 15) * 64, 0, 2048, tile); continue; }
    it -= 512;
    if (it < 256) { transpose_tile(P.ple_w_gate + (size_t)l * D * D, D, P.WgT + (size_t)l * D * D, D, P.ple_norm_w + l * D, (it >> 4) * 64, (it & 15) * 64, 0, D, tile); continue; }
    it -= 256;
    if (it < 64) { transpose_tile(P.ple_w_proj + (size_t)l * 256 * D, D, P.WpT + (size_t)l * D * 256, 256, nullptr, (it >> 2) * 64, (it & 3) * 64, 0, D, tile); continue; }
    it -= 64;
    { const int kv = it >> 6, i2 = it & 63;
      transpose_tile(P.nsa_cmp_w + (size_t)(l * 2 + kv) * 2048 * 64, 64, P.CmpWT + (size_t)(l * 2 + kv) * 128 * 2048, 2048, nullptr, (i2 >> 5) * 64, (i2 & 31) * 64, 0, 64, tile); }
  }
  convert_rows(P.peer_sub_keys, P.SubK, (size_t)2 * 16 * 128 * 128 / 8, nullptr);
  {
    const int lane = t & 63, gw = bid * 4 + (t >> 6), ngw = nb * 4;
    for (int r = gw; r < 4 * S; r += ngw) {
      const int tbl = r / (2 * S), l = (r / S) & 1, e = r % S;
      const float* src = (tbl ? P.peer_v : P.peer_u) + ((size_t)l * S + e) * D + lane * 16;
      float v[16];
#pragma unroll
      for (int i = 0; i < 4; ++i) { const f32x4 q4 = ((const f32x4*)src)[i]; v[4 * i] = q4[0]; v[4 * i + 1] = q4[1]; v[4 * i + 2] = q4[2]; v[4 * i + 3] = q4[3]; }
      if (tbl == 0) {
        const float* w = P.ffn_norm_w + l * D + lane * 16;
#pragma unroll
        for (int i = 0; i < 16; ++i) v[i] *= w[i];
      }
      float m = 0.f;
#pragma unroll
      for (int i = 0; i < 16; ++i) m = fmaxf(m, fabsf(v[i]));
      m = wave_max(m);
      {
        const float sc = (m > 0.f) ? 6.f / m : 0.f;
        u32 o[2] = {0u, 0u};
#pragma unroll
        for (int i = 0; i < 8; ++i) {
          if ((i & 3) == 0) o[i >> 2] = __builtin_amdgcn_cvt_scalef32_pk_fp4_f32(o[i >> 2], v[2 * i] * sc, v[2 * i + 1] * sc, 1.0f, 0);
          else if ((i & 3) == 1) o[i >> 2] = __builtin_amdgcn_cvt_scalef32_pk_fp4_f32(o[i >> 2], v[2 * i] * sc, v[2 * i + 1] * sc, 1.0f, 1);
          else if ((i & 3) == 2) o[i >> 2] = __builtin_amdgcn_cvt_scalef32_pk_fp4_f32(o[i >> 2], v[2 * i] * sc, v[2 * i + 1] * sc, 1.0f, 2);
          else o[i >> 2] = __builtin_amdgcn_cvt_scalef32_pk_fp4_f32(o[i >> 2], v[2 * i] * sc, v[2 * i + 1] * sc, 1.0f, 3);
        }
        *(u32x2*)((tbl ? P.V8 : P.U8) + ((size_t)l * S + e) * (D / 2) + lane * 8) = mk2(o[0], o[1]);
        if (lane == 0) (tbl ? P.Vinv : P.Uinv)[l * S + e] = m * (1.f / 6.f);
      }
    }
  }
  convert_rows(P.p, P.pb, (size_t)2 * S * 256 / 8, nullptr);
  convert_rows(P.x, P.hb, (size_t)S * D / 8, nullptr);
  const size_t gtid = (size_t)bid * NT + t, gstride = (size_t)nb * NT;
  __syncthreads();
  if (t < 48) tile[t] = (t < 32) ? powf(10000.f, -(float)t / 32.f) : powf(10000.f, -(float)(t - 32) / 16.f);
  __syncthreads();
  for (size_t i = gtid; i < (size_t)S * 48; i += gstride) {
    const int tok = (int)(i / 48), r = (int)(i % 48);
    const float pos = (float)P.positions[tok];
    const float invf = tile[r];
    const float ang = pos * invf;
    const double rev = (double)ang * 0.15915494309189535;
    const float fr = (float)(rev - floor(rev));
    const float c = __builtin_amdgcn_cosf(fr), s = __builtin_amdgcn_sinf(fr);
    if (r < 32) { P.ropeN[(size_t)tok * 64 + r] = c; P.ropeN[(size_t)tok * 64 + 32 + r] = s; }
    else { P.ropeD[(size_t)tok * 32 + (r - 32)] = c; P.ropeD[(size_t)tok * 32 + 16 + (r - 32)] = s; }
  }
  {
    const int lane = t & 63, gw = bid * 4 + (t >> 6), ngw = nb * 4;
    for (int i = gw; i < 2 * 2 * 64; i += ngw) {
      const int lk = i >> 6, e = i & 63;
      const float* pos = P.nsa_cmp_pos + (size_t)lk * 2048;
      const float* w = P.nsa_cmp_w + (size_t)lk * 2048 * 64;
      float a = 0.f;
#pragma unroll 8
      for (int k = lane; k < 2048; k += 64) a += pos[k] * w[(size_t)k * 64 + e];
      a = wave_sum(a);
      if (lane == 0) P.cmpbias[i] = a;
    }
  }
  for (size_t i = gtid; i < 2 * 2 * 64 * 64; i += gstride) {
    const int which = (int)(i / (2 * 64 * 64)), r = (int)(i % (2 * 64 * 64));
    const int g = r / (64 * 64), o = r % (64 * 64);
    u16* base = which ? P.VC : P.KC;
    base[(size_t)g * (S + 64) * 64 + (size_t)S * 64 + o] = 0;
  }
}

constexpr int GST = 144;
constexpr int G_BOFF = 128 * GST;
constexpr int G_RS_OFF = 71680;

DI float ssq8(const u32x4& v) {
  float s = 0.f;
  float a;
  a = bflo(v.x); s += a * a; a = bfhi(v.x); s += a * a;
  a = bflo(v.y); s += a * a; a = bfhi(v.y); s += a * a;
  a = bflo(v.z); s += a * a; a = bfhi(v.z); s += a * a;
  a = bflo(v.w); s += a * a; a = bfhi(v.w); s += a * a;
  return s;
}

template <bool SSQ>
DI void gemm_mainloop(const u16* __restrict__ A, int lda, const u16* __restrict__ Bt, int ldb, int K, char* sm, f32x16 (&acc)[2][2]) {
  const int tid = threadIdx.x, lane = tid & 63, wave = tid >> 6;
  const int wr = wave >> 1, wc = wave & 1;
  const int lrow = tid >> 3, lcol = (tid & 7) * 8;
  char* As = sm; char* Bs = sm + G_BOFF;
  u32x4 ra[4], rb[4];
  float ssq[4] = {0.f, 0.f, 0.f, 0.f};
#pragma unroll
  for (int i = 0; i < 4; ++i) {
    ra[i] = *(const u32x4*)(A + (size_t)(lrow + 32 * i) * lda + lcol);
    rb[i] = *(const u32x4*)(Bt + (size_t)(lrow + 32 * i) * ldb + lcol);
  }
  const int aoff = (wr * 64 + (lane & 31)) * GST + (lane >> 5) * 16;
  const int boff = (wc * 64 + (lane & 31)) * GST + (lane >> 5) * 16;
  for (int k0 = 0; k0 < K; k0 += 64) {
    __syncthreads();
#pragma unroll
    for (int i = 0; i < 4; ++i) {
      *(u32x4*)(As + (lrow + 32 * i) * GST + lcol * 2) = ra[i];
      *(u32x4*)(Bs + (lrow + 32 * i) * GST + lcol * 2) = rb[i];
      if (SSQ) ssq[i] += ssq8(ra[i]);
    }
    __syncthreads();
    if (k0 + 64 < K) {
#pragma unroll
      for (int i = 0; i < 4; ++i) {
        ra[i] = *(const u32x4*)(A + (size_t)(lrow + 32 * i) * lda + k0 + 64 + lcol);
        rb[i] = *(const u32x4*)(Bt + (size_t)(lrow + 32 * i) * ldb + k0 + 64 + lcol);
      }
    }
#pragma unroll
    for (int ks = 0; ks < 4; ++ks) {
      bf16x8 af[2], bfr[2];
#pragma unroll
      for (int i = 0; i < 2; ++i) af[i] = *(const bf16x8*)(As + aoff + i * 32 * GST + ks * 32);
#pragma unroll
      for (int j = 0; j < 2; ++j) bfr[j] = *(const bf16x8*)(Bs + boff + j * 32 * GST + ks * 32);
#pragma unroll
      for (int i = 0; i < 2; ++i)
#pragma unroll
        for (int j = 0; j < 2; ++j) acc[i][j] = MFMA32(af[i], bfr[j], acc[i][j]);
    }
  }
  __syncthreads();
  if (SSQ) {
    float* rs = (float*)(sm + G_RS_OFF);
#pragma unroll
    for (int i = 0; i < 4; ++i) {
      float s = ssq[i];
      s += __shfl_xor(s, 1); s += __shfl_xor(s, 2); s += __shfl_xor(s, 4);
      if ((tid & 7) == 0) rs[lrow + 32 * i] = rsqrtf(s * (1.f / (float)K) + 1e-6f);
    }
  }
}

DI void zero_acc(f32x16 (&acc)[2][2]) {
#pragma unroll
  for (int i = 0; i < 2; ++i)
#pragma unroll
    for (int j = 0; j < 2; ++j)
#pragma unroll
      for (int r = 0; r < 16; ++r) acc[i][j][r] = 0.f;
}

constexpr int EPS_LD = 132;
DI void acc_to_lds(const f32x16 (&acc)[2][2], float* tile) {
  const int lane = threadIdx.x & 63, wave = threadIdx.x >> 6;
  const int wr = wave >> 1, wc = wave & 1;
#pragma unroll
  for (int i = 0; i < 2; ++i)
#pragma unroll
    for (int j = 0; j < 2; ++j)
#pragma unroll
      for (int r = 0; r < 16; ++r)
        tile[(wr * 64 + i * 32 + crow(r, lane >> 5)) * EPS_LD + wc * 64 + j * 32 + (lane & 31)] = acc[i][j][r];
}

DI float log_sigmoid(float x) { return fminf(x, 0.f) - log1pf(expf(-fabsf(x))); }
DI float sigmoidf_(float x) { return 1.f / (1.f + expf(-x)); }

DI void store32_bf16(u16* dst, const float* o) {
  u32x4* d4 = (u32x4*)dst;
#pragma unroll
  for (int i = 0; i < 4; ++i)
    d4[i] = mk4(pack2(o[8 * i], o[8 * i + 1]), pack2(o[8 * i + 2], o[8 * i + 3]), pack2(o[8 * i + 4], o[8 * i + 5]), pack2(o[8 * i + 6], o[8 * i + 7]));
}

__device__ __forceinline__ void inproj_epilogue_half(const Params& P, int l, int mt, int nt, int half, const float* tile, const float* rs) {
  const int tid = threadIdx.x, lane = tid & 63, wave = tid >> 6;
  const int hl = wave >> 1, h32 = wave & 1;
  const int sg = 2 * nt + hl;
  const int rloc = half * 64 + lane;
  const int tok = mt * 128 + rloc;
  const float rstd = rs[rloc];
  if (sg >= 45) return;
  float v[64];
  {
    const f32x4* src = (const f32x4*)(tile + rloc * EPS_LD + hl * 64);
#pragma unroll
    for (int i = 0; i < 16; ++i) { f32x4 t = src[i]; v[4 * i] = t[0] * rstd; v[4 * i + 1] = t[1] * rstd; v[4 * i + 2] = t[2] * rstd; v[4 * i + 3] = t[3] * rstd; }
  }
  const u32 hmask = (u32)(-(int)h32);
#define VO(i) __uint_as_float((__float_as_uint(v[32 + (i)]) & hmask) | (__float_as_uint(v[(i)]) & ~hmask))
  if (sg == 44) {
    if (h32 == 0) {
      const int chunk = tok >> 6;
#pragma unroll
      for (int hd = 0; hd < 4; ++hd) {
        float x = log_sigmoid(v[hd] + P.fox_f_bias[l * 4 + hd]);
#pragma unroll
        for (int o = 1; o < 64; o <<= 1) { float t = __shfl_up(x, o); if (lane >= o) x += t; }
        P.cloc[(size_t)hd * S + tok] = x;
        if (lane == 63) P.ctot[chunk * 4 + hd] = x;
      }
    } else {
      float* g = P.gates + (size_t)tok * 24;
#pragma unroll
      for (int i = 0; i < 24; ++i) g[i] = sigmoidf_(v[4 + i]);
    }
    return;
  }
  float o[32];
  const bool is_vt = (sg >= 8 && sg < 12) || (sg == 26 || sg == 27) || (sg == 30 || sg == 31) || (sg >= 40);
  const bool is_raw = (sg >= 20 && sg < 24);
  const bool is_diff = (sg >= 32 && sg < 40);
  if (is_vt) {
    if (sg == 26 || sg == 27) {
      const int key = tok & 63, G = key >> 5, h4 = (key & 31) >> 3, j = key & 7;
      unsigned char* b8 = P.VS8t + (size_t)(sg - 26) * 64 * S + (size_t)(tok >> 6) * 4096 + G * 2048 + h4 * 128 + j;
#pragma unroll
      for (int i = 0; i < 32; i += 2) {
        const int wd = __builtin_amdgcn_cvt_pk_fp8_f32(VO(i), VO(i + 1), 0, false);
        const int d0 = h32 * 32 + i, d1 = d0 + 1;
        b8[(d0 >> 4) * 512 + (d0 & 15) * 8] = (unsigned char)(wd & 0xff);
        b8[(d1 >> 4) * 512 + (d1 & 15) * 8] = (unsigned char)((wd >> 8) & 0xff);
      }
      return;
    }
    u16* base;
    if (sg < 12) base = P.VFt + (size_t)(sg - 8) * 64 * S;
    else if (sg < 32) base = P.VWt + (size_t)(sg - 30) * 64 * S;
    else base = P.VDt + (size_t)(sg - 40) * 64 * S;
#pragma unroll
    for (int i = 0; i < 32; ++i) base[(size_t)(h32 * 32 + i) * S + tok] = f2bf(VO(i));
    return;
  }
  if (is_raw) {
    u16* base = (sg < 22) ? P.KC + (size_t)(sg - 20) * (S + 64) * 64 : P.VC + (size_t)(sg - 22) * (S + 64) * 64;
#pragma unroll
    for (int i = 0; i < 32; ++i) o[i] = VO(i);
    store32_bf16(base + (size_t)tok * 64 + h32 * 32, o);
    return;
  }
  if (is_diff) {
    const float* w = (sg < 36 ? P.diff_q_norm_w : P.diff_k_norm_w) + l * 32;
    float ss = 0.f;
#pragma unroll
    for (int i = 0; i < 32; ++i) ss += VO(i) * VO(i);
    const float rn = rsqrtf(ss * (1.f / 32.f) + 1e-6f);
    const float sc = (sg < 36) ? 0.17677669529663687f * LOG2E : 1.f;
    const float* rp = P.ropeD + (size_t)tok * 32;
#pragma unroll
    for (int i = 0; i < 16; ++i) {
      const float y1 = VO(i) * rn * w[i], y2 = VO(16 + i) * rn * w[16 + i];
      const float c = rp[i], s = rp[16 + i];
      o[i] = (y1 * c - y2 * s) * sc;
      o[16 + i] = (y2 * c + y1 * s) * sc;
    }
    u16* base = (sg < 36) ? P.QD + (size_t)(sg - 32) * S * 64 : P.KD + (size_t)(sg - 36) * S * 64;
    store32_bf16(base + (size_t)tok * 64 + h32 * 32, o);
    return;
  }
  const float* w;
  if (sg < 4) w = P.fox_q_norm_w + l * 64; else if (sg < 8) w = P.fox_k_norm_w + l * 64; else if (sg < 20) w = P.nsa_q_norm_w + l * 64; else w = P.nsa_k_norm_w + l * 64;
  float ss = 0.f;
#pragma unroll
  for (int i = 0; i < 64; ++i) ss += v[i] * v[i];
  const float rn = rsqrtf(ss * (1.f / 64.f) + 1e-6f);
  const float qs = 0.125f * LOG2E;
  if (sg < 8) {
    const float sc = (sg < 4) ? qs : 1.f;
#pragma unroll
    for (int i = 0; i < 32; ++i) o[i] = VO(i) * rn * w[h32 * 32 + i] * sc;
    u16* base = (sg < 4) ? P.QF + (size_t)sg * S * 64 : P.KF + (size_t)(sg - 4) * S * 64;
    store32_bf16(base + (size_t)tok * 64 + h32 * 32, o);
    return;
  }
  const float* rp = P.ropeN + (size_t)tok * 64;
  const float sc = (sg < 20) ? qs : 1.f;
  if (sg < 20) {
#pragma unroll
    for (int i = 0; i < 32; ++i) o[i] = VO(i) * rn * w[h32 * 32 + i] * sc;
    store32_bf16(P.QN + ((size_t)(sg - 12) * S + tok) * 64 + h32 * 32, o);
  }
#pragma unroll
  for (int i = 0; i < 32; ++i) {
    const float y1 = v[i] * rn * w[i], y2 = v[32 + i] * rn * w[32 + i];
    const float c = rp[i], s = rp[32 + i];
    o[i] = (h32 == 0 ? (y1 * c - y2 * s) : (y2 * c + y1 * s)) * sc;
  }
  if (sg == 24 || sg == 25) {
    const int key = tok & 63, G = key >> 5, r32 = key & 31, t = (r32 >> 2) & 1, i = ((r32 >> 3) << 2) | (r32 & 3);
    unsigned char* d8 = P.KS8 + (size_t)(sg - 24) * S * 64 + (size_t)(tok >> 6) * 4096 + ((G * 2 + t) * 2 + h32) * 512 + i * 8;
#pragma unroll
    for (int h4 = 0; h4 < 4; ++h4) {
      int w0 = 0, w1 = 0;
      w0 = __builtin_amdgcn_cvt_pk_fp8_f32(o[8 * h4], o[8 * h4 + 1], w0, false);
      w0 = __builtin_amdgcn_cvt_pk_fp8_f32(o[8 * h4 + 2], o[8 * h4 + 3], w0, true);
      w1 = __builtin_amdgcn_cvt_pk_fp8_f32(o[8 * h4 + 4], o[8 * h4 + 5], w1, false);
      w1 = __builtin_amdgcn_cvt_pk_fp8_f32(o[8 * h4 + 6], o[8 * h4 + 7], w1, true);
      *(u32x2*)(d8 + h4 * 128) = mk2((u32)w0, (u32)w1);
    }
    return;
  }
  u16* base;
  if (sg < 20) base = P.QR + (size_t)(sg - 12) * S * 64;
  else base = P.KW + (size_t)(sg - 28) * S * 64;
  store32_bf16(base + (size_t)tok * 64 + h32 * 32, o);
}

#undef VO
__device__ __forceinline__ void phase_inproj(const Params& P, int l, char* smem) {
  const u16* Wt = P.WinT + (size_t)l * NINP * D;
  float* tile = (float*)smem;
  const float* rs = (const float*)(smem + G_RS_OFF);
  for (int it = blockIdx.x; it < 128 * 23; it += gridDim.x) {
    const int mt = it / 23, nt = it % 23;
    f32x16 acc[2][2];
    zero_acc(acc);
    gemm_mainloop<true>(P.hb + (size_t)mt * 128 * D, D, Wt + (size_t)nt * 128 * D, D, D, smem, acc);
    acc_to_lds(acc, tile);
    __syncthreads();
#pragma unroll 1
    for (int half = 0; half < 2; ++half) inproj_epilogue_half(P, l, mt, nt, half, tile, rs);
  }
}

__device__ __forceinline__ void phase_compress(const Params& P, int l, char* smem) {
  float* tile = (float*)smem;
  for (int it = blockIdx.x; it < 32; it += gridDim.x) {
    const int kv = it >> 4, g = (it >> 3) & 1, mt = it & 7;
    const u16* A = (kv ? P.VC : P.KC) + (size_t)g * (S + 64) * 64 + (size_t)mt * 128 * 1024;
    const u16* Bt = P.CmpWT + (size_t)(l * 2 + kv) * 128 * 2048;
    const float* bias = P.cmpbias + (l * 2 + kv) * 64;
    f32x16 acc[2][2];
    zero_acc(acc);
    gemm_mainloop<false>(A, 1024, Bt, 2048, 2048, smem, acc);
    acc_to_lds(acc, tile);
    __syncthreads();
#pragma unroll 1
    for (int half = 0; half < 2; ++half) {
      {
        const int lane = threadIdx.x & 63, wave = threadIdx.x >> 6;
        const int idx = mt * 128 + half * 64 + lane;
        float v[64];
        const f32x4* src = (const f32x4*)(tile + (half * 64 + lane) * EPS_LD);
#pragma unroll
        for (int i = 0; i < 16; ++i) { f32x4 t = src[i]; v[4 * i] = t[0] + bias[4 * i]; v[4 * i + 1] = t[1] + bias[4 * i + 1]; v[4 * i + 2] = t[2] + bias[4 * i + 2]; v[4 * i + 3] = t[3] + bias[4 * i + 3]; }
        float vo[16];
#pragma unroll
        for (int i = 0; i < 4; ++i) { f32x4 t = src[wave * 4 + i]; const float* bb = bias + wave * 16 + 4 * i; vo[4 * i] = t[0] + bb[0]; vo[4 * i + 1] = t[1] + bb[1]; vo[4 * i + 2] = t[2] + bb[2]; vo[4 * i + 3] = t[3] + bb[3]; }
        if (kv == 0) {
          const float* w = P.nsa_k_norm_w + l * 64;
          float ss = 0.f;
#pragma unroll
          for (int i = 0; i < 64; ++i) ss += v[i] * v[i];
          const float rn = rsqrtf(ss * (1.f / 64.f) + 1e-6f);
          u32 o[8];
#pragma unroll
          for (int i = 0; i < 8; ++i) o[i] = pack2(vo[2 * i] * rn * w[wave * 16 + 2 * i], vo[2 * i + 1] * rn * w[wave * 16 + 2 * i + 1]);
          u32x4* dp = (u32x4*)(P.KCC + ((size_t)g * 1024 + idx) * 64 + wave * 16);
          dp[0] = mk4(o[0], o[1], o[2], o[3]);
          dp[1] = mk4(o[4], o[5], o[6], o[7]);
        } else {
#pragma unroll
          for (int i = 0; i < 16; ++i) P.VCCt[((size_t)g * 64 + wave * 16 + i) * 1024 + idx] = f2bf(vo[i]);
        }
      }
    }
  }
}

constexpr int AK_ST = 144;
constexpr int AV_ST = 136;
constexpr int AT_VOFF = 64 * AK_ST;
constexpr int AT_COFF = AT_VOFF + 64 * AV_ST;
constexpr int AT_STAGE = AT_COFF + 256;
constexpr int AT_MISC = 2 * AT_STAGE;

struct TileRegs { u32x4 k[2]; u32x4 v[2]; };

DI void tile_load(int t, TileRegs& r, const u16* __restrict__ K, const u16* __restrict__ Vt, size_t ldv, int key0, bool with_v) {
#pragma unroll
  for (int i = 0; i < 2; ++i) {
    const int c = t + 256 * i, row = c >> 3, part = c & 7;
    r.k[i] = *(const u32x4*)(K + (size_t)(key0 + row) * 64 + part * 8);
    if (with_v) r.v[i] = *(const u32x4*)(Vt + (size_t)row * ldv + key0 + part * 8);
  }
}
DI void tile_store(int t, const TileRegs& r, char* st, bool with_v) {
#pragma unroll
  for (int i = 0; i < 2; ++i) {
    const int c = t + 256 * i, row = c >> 3, part = c & 7;
    *(u32x4*)(st + row * AK_ST + part * 16) = r.k[i];
    if (with_v) {
      u32x2* d = (u32x2*)(st + AT_VOFF + row * AV_ST + part * 16);
      d[0] = mk2(r.v[i].x, r.v[i].y);
      d[1] = mk2(r.v[i].z, r.v[i].w);
    }
  }
}
DI bf16x8 pack_p(const f32x16& p, int sp) {
  u32x4 u = mk4(pack2(p[8 * sp], p[8 * sp + 1]), pack2(p[8 * sp + 2], p[8 * sp + 3]), pack2(p[8 * sp + 4], p[8 * sp + 5]), pack2(p[8 * sp + 6], p[8 * sp + 7]));
  return __builtin_bit_cast(bf16x8, u);
}
template <int NKS, bool ZINIT>
DI void qk_half(int tid, const char* st, int dofs_bytes, int kt, const bf16x8 (&qf)[NKS], f32x16& s) {
  const int lane = tid & 63;
  const char* base = st + (kt * 32 + (lane & 31)) * AK_ST + (lane >> 5) * 16 + dofs_bytes;
#pragma unroll
  for (int ks = 0; ks < NKS; ++ks) {
    const bf16x8 a = *(const bf16x8*)(base + ks * 32);
    if (ZINIT && ks == 0) { const f32x16 z = {0.f, 0.f, 0.f, 0.f, 0.f, 0.f, 0.f, 0.f, 0.f, 0.f, 0.f, 0.f, 0.f, 0.f, 0.f, 0.f}; s = MFMA32(a, qf[ks], z); }
    else s = MFMA32(a, qf[ks], s);
  }
}
DI void pv_half(int tid, const char* st, int kt, const f32x16& p, f32x16 (&o)[2]) {
  const int lane = tid & 63;
  const char* vb = st + AT_VOFF + (lane & 31) * AV_ST + (lane >> 5) * 8 + kt * 64;
#pragma unroll
  for (int sp = 0; sp < 2; ++sp) {
    const bf16x8 pb = pack_p(p, sp);
#pragma unroll
    for (int dt = 0; dt < 2; ++dt) {
      const char* a = vb + dt * 32 * AV_ST + sp * 32;
      const u32x2 lo = *(const u32x2*)a, hi = *(const u32x2*)(a + 16);
      const u32x4 u = mk4(lo.x, lo.y, hi.x, hi.y);
      o[dt] = MFMA32(__builtin_bit_cast(bf16x8, u), pb, o[dt]);
    }
  }
}
DI void load_q4(int tid, bf16x8 (&qf)[4], const u16* __restrict__ Q, int tok) {
  const int lane = tid & 63;
  const u16* b = Q + (size_t)tok * 64 + (lane >> 5) * 8;
#pragma unroll
  for (int ks = 0; ks < 4; ++ks) qf[ks] = *(const bf16x8*)(b + ks * 16);
}
DI float max_abs64(int tid, const float* w) {
  return wave_max(fabsf(w[tid & 63]));
}

struct AttnArgs {
  const u16* K; const u16* Vt; size_t ldv;
  int t0, t1;
  int q;
  int wq0;
  float M2;
  int dofs;
  int lim_hi, lim_lo, whi, wlo;
  int mask_hi, mask_lo;
  float cq; const float* cloc; const float* base;
};

template <int MODE, int NKS>
DI void attn_tile(int tid, const AttnArgs& a, const char* cur, int key0, int lim_hi, int lim_lo, bool mask_u, const bf16x8 (&qf)[NKS], f32x16 (&o)[2], float& l) {
  const int h = (tid & 63) >> 5;
#pragma unroll
  for (int kt = 0; kt < 2; ++kt) {
    f32x16 s;
    if (MODE == 0) {
      const float* ckb = (const float*)(cur + AT_COFF);
#pragma unroll
      for (int rg = 0; rg < 4; ++rg) {
        const f32x4 c4 = *(const f32x4*)(ckb + 32 * kt + 8 * rg + 4 * h);
#pragma unroll
        for (int i = 0; i < 4; ++i) s[4 * rg + i] = a.cq - c4[i];
      }
      qk_half<NKS, false>(tid, cur, a.dofs, kt, qf, s);
    } else {
      qk_half<NKS, true>(tid, cur, a.dofs, kt, qf, s);
    }
#pragma unroll
    for (int i = 0; i < 16; ++i) s[i] = __builtin_amdgcn_exp2f(s[i]);
    if (mask_u) {
#pragma unroll
      for (int i = 0; i < 16; ++i) { const int key = key0 + 32 * kt + crow(i, h); if (key > lim_hi || key < lim_lo) s[i] = 0.f; }
    }
#pragma unroll
    for (int i = 0; i < 16; ++i) l += s[i];
    pv_half(tid, cur, kt, s, o);
  }
}
template <int MODE, int NKS, bool PF2 = false>
DI void attn_loop(int tid, const AttnArgs& a, const bf16x8 (&qf)[NKS], f32x16 (&o)[2], float& l, char* smem) {
  TileRegs rA, rB; float cbA = 0.f, cbB = 0.f;
  if (a.t0 >= a.t1) return;
  tile_load(tid, rA, a.K, a.Vt, a.ldv, a.t0 * 64, true);
  if (MODE == 0 && tid < 64) cbA = a.cloc[a.t0 * 64 + tid];
  tile_store(tid, rA, smem, true);
  if (MODE == 0 && tid < 64) ((float*)(smem + AT_COFF))[tid] = (a.base[a.t0] + cbA) * LOG2E;
  __syncthreads();
  auto step = [&](int t, TileRegs& rs, float& cbs, TileRegs& rl, float& cbl, int dist) {
    char* cur = smem + ((t - a.t0) & 1) * AT_STAGE;
    char* nxt = smem + ((t - a.t0 + 1) & 1) * AT_STAGE;
    if (t + dist < a.t1) {
      tile_load(tid, rl, a.K, a.Vt, a.ldv, (t + dist) * 64, true);
      if (MODE == 0 && tid < 64) cbl = a.cloc[(t + dist) * 64 + tid];
    }
    const int key0 = t * 64;
    bool active, need_mask;
    if (MODE == 0 || MODE == 3) { active = key0 <= a.wq0 + 31; need_mask = key0 + 63 > a.wq0; }
    else if (MODE == 1) { const int nmax_w = (a.wq0 + 31 - 31) >> 4; active = (a.wq0 + 31 >= 31) && key0 <= nmax_w; need_mask = true; }
    else if (MODE == 2) { active = (key0 <= a.wq0 + 31) && (key0 + 63 >= a.wq0 - 511); need_mask = (key0 + 63 > a.wq0) || (key0 < a.wq0 + 31 - 511); }
    else { active = (key0 <= a.whi) && (key0 + 63 >= a.wlo); need_mask = (key0 + 63 > a.mask_hi) || (key0 < a.mask_lo); }
    if (active) {
      int lim_hi, lim_lo;
      if (MODE == 0 || MODE == 3) { lim_hi = a.q; lim_lo = 0; }
      else if (MODE == 1) { lim_hi = (a.q >= 31) ? ((a.q - 31) >> 4) : -1; lim_lo = 0; }
      else if (MODE == 2) { lim_hi = a.q; lim_lo = a.q - 511; }
      else { lim_hi = a.lim_hi; lim_lo = a.lim_lo; }
      attn_tile<MODE, NKS>(tid, a, cur, key0, lim_hi, lim_lo, __builtin_amdgcn_readfirstlane((int)need_mask) != 0, qf, o, l);
    }
    if (t + 1 < a.t1) {
      tile_store(tid, rs, nxt, true);
      if (MODE == 0 && tid < 64) ((float*)(nxt + AT_COFF))[tid] = (a.base[t + 1] + cbs) * LOG2E;
    }
    __syncthreads();
  };
  if (!PF2) {
    for (int t = a.t0; t < a.t1; ++t) step(t, rA, cbA, rA, cbA, 1);
  } else {
    if (a.t0 + 1 < a.t1) { tile_load(tid, rA, a.K, a.Vt, a.ldv, (a.t0 + 1) * 64, true); if (MODE == 0 && tid < 64) cbA = a.cloc[(a.t0 + 1) * 64 + tid]; }
    for (int t = a.t0; t < a.t1; t += 2) {
      step(t, rA, cbA, rB, cbB, 2);
      if (t + 1 >= a.t1) break;
      step(t + 1, rB, cbB, rA, cbA, 2);
    }
  }
}

DI void zero_o(f32x16 (&o)[2]) {
#pragma unroll
  for (int d = 0; d < 2; ++d)
#pragma unroll
    for (int i = 0; i < 16; ++i) o[d][i] = 0.f;
}

DI void fox_chunk_bases(int tid, const Params& P, int hd, float* base, float* wtot) {
  const int lane = tid & 63, wave = tid >> 6;
  const float x = P.ctot[tid * 4 + hd];
  float inc = x;
#pragma unroll
  for (int o = 1; o < 64; o <<= 1) { float t = __shfl_up(inc, o); if (lane >= o) inc += t; }
  if (lane == 63) wtot[wave] = inc;
  __syncthreads();
  float off = 0.f;
  for (int w = 0; w < wave; ++w) off += wtot[w];
  base[tid] = inc - x + off;
  __syncthreads();
}

__device__ __forceinline__ void fox_item(const Params& P, int l, int hd, int qb, char* smem) {
  const int tid = opaque_tid(), lane = tid & 63, wave = tid >> 6, h = lane >> 5;
  float* base = (float*)(smem + AT_MISC);
  float* wtot = base + 256;
  fox_chunk_bases(tid, P, hd, base, wtot);
  const float M2 = 8.f * max_abs64(tid, P.fox_q_norm_w + l * 64) * max_abs64(tid, P.fox_k_norm_w + l * 64) * LOG2E * 1.01f + 0.1f;
  const int wq0 = qb * 128 + wave * 32, q = wq0 + (lane & 31);
  AttnArgs a;
  a.K = P.KF + (size_t)hd * S * 64; a.Vt = P.VFt + (size_t)hd * 64 * S; a.ldv = S;
  a.t1 = 2 * qb + 2; a.q = q; a.wq0 = wq0; a.M2 = M2;
  a.cloc = P.cloc + (size_t)hd * S; a.base = base;
  {
    const bool skip = (tid + 1 < 2 * qb) && ((base[2 * qb] - base[tid + 1]) * LOG2E < -160.f);
    a.t0 = __syncthreads_count(skip ? 1 : 0);
  }
  a.cq = (base[q >> 6] + a.cloc[q]) * LOG2E - M2;
  bf16x8 qf[4];
  load_q4(tid, qf, P.QF + (size_t)hd * S * 64, q);
  f32x16 o[2]; zero_o(o);
  float ls = 0.f;
  a.dofs = 0;
  attn_loop<0, 4, true>(tid, a, qf, o, ls, smem);
  ls += __shfl_xor(ls, 32);
  const float inv = (ABLATE & 1) ? 0.f : 1.f / ls;
  u16* dst = P.mix + (size_t)q * 1024 + hd * 64 + 4 * h;
#pragma unroll
  for (int dt = 0; dt < 2; ++dt)
#pragma unroll
    for (int rg = 0; rg < 4; ++rg)
      *(u32x2*)(dst + 32 * dt + 8 * rg) = mk2(pack2(o[dt][4 * rg] * inv, o[dt][4 * rg + 1] * inv), pack2(o[dt][4 * rg + 2] * inv, o[dt][4 * rg + 3] * inv));
}

__device__ __forceinline__ void diff_item(const Params& P, int l, int hd, int qb, char* smem) {
  const int tid = opaque_tid(), lane = tid & 63, wave = tid >> 6, h = lane >> 5;
  const float mq = wave_max(fabsf(P.diff_q_norm_w[l * 32 + (lane & 31)])), mk = wave_max(fabsf(P.diff_k_norm_w[l * 32 + (lane & 31)]));
  const float M2 = 5.656854249f * mq * mk * LOG2E * 1.01f + 0.1f;
  const float* lv = P.diff_lambda + l * 128;
  float d1 = (lane < 32) ? lv[lane] * lv[32 + lane] : 0.f, d2 = (lane < 32) ? lv[64 + lane] * lv[96 + lane] : 0.f;
  d1 = wave_sum(d1); d2 = wave_sum(d2);
  const float lam_init = 0.8f - 0.6f * expf(-0.3f * (float)l);
  const float lam = expf(d1) - expf(d2) + lam_init;
  const int wq0 = qb * 128 + wave * 32, q = wq0 + (lane & 31);
  AttnArgs a;
  a.K = P.KD + (size_t)hd * S * 64; a.Vt = P.VDt + (size_t)hd * 64 * S; a.ldv = S;
  a.t0 = 0; a.t1 = 2 * qb + 2; a.q = q; a.wq0 = wq0; a.M2 = M2; a.cq = 0.f; a.cloc = nullptr; a.base = nullptr;
  float* stash = P.dstash + (size_t)blockIdx.x * (128 * 64) + tid;
  f32x16 o[2];
#pragma unroll 1
  for (int c = 0; c < 2; ++c) {
    const int tid = opaque_tid(), lane = tid & 63, h = lane >> 5;
    bf16x8 qf[2];
    {
      const u16* b = P.QD + ((size_t)hd * S + q) * 64 + c * 32 + h * 8;
      qf[0] = *(const bf16x8*)b; qf[1] = *(const bf16x8*)(b + 16);
    }
    zero_o(o);
    float ls = 0.f;
    a.dofs = c * 64;
    attn_loop<3, 2>(tid, a, qf, o, ls, smem);
    ls += __shfl_xor(ls, 32);
    if (c == 0) {
      const float i0 = 1.f / ls;
#pragma unroll
      for (int dt = 0; dt < 2; ++dt)
#pragma unroll
        for (int i = 0; i < 16; ++i) stash[(dt * 16 + i) * 256] = o[dt][i] * i0;
    } else {
      const float i1 = lam / ls;
      float ss = 0.f;
#pragma unroll
      for (int dt = 0; dt < 2; ++dt)
#pragma unroll
        for (int i = 0; i < 16; ++i) { const float v = stash[(dt * 16 + i) * 256] - o[dt][i] * i1; o[dt][i] = v; ss += v * v; }
      ss += __shfl_xor(ss, 32);
      const float rn = rsqrtf(ss * (1.f / 64.f) + 1e-6f) * (1.f - lam_init);
      const float* sw = P.diff_subln_w + l * 64;
      u16* dst = P.mix + (size_t)q * 1024 + 768 + hd * 64 + 4 * h;
#pragma unroll
      for (int dt = 0; dt < 2; ++dt)
#pragma unroll
        for (int rg = 0; rg < 4; ++rg) {
          const int d0 = 32 * dt + 8 * rg + 4 * h;
          *(u32x2*)(dst + 32 * dt + 8 * rg) = mk2(pack2(o[dt][4 * rg] * rn * sw[d0], o[dt][4 * rg + 1] * rn * sw[d0 + 1]),
                                                 pack2(o[dt][4 * rg + 2] * rn * sw[d0 + 2], o[dt][4 * rg + 3] * rn * sw[d0 + 3]));
        }
    }
  }
}

struct SelFrags { u32x2 k[8]; u32x2 v[8]; };

DI void sel_load(int tid, SelFrags& f, const unsigned char* __restrict__ Kg, const unsigned char* __restrict__ Vtg, int b) {
  const int lane = tid & 63, i = lane & 15, h4 = lane >> 4;
  const int bu = __builtin_amdgcn_readfirstlane(b);
  const unsigned char* kb = Kg + (size_t)bu * 4096 + lane * 8;
  const unsigned char* vb = Vtg + (size_t)bu * 4096 + lane * 8;
  (void)i; (void)h4;
#pragma unroll
  for (int L = 0; L < 8; ++L) f.k[L] = *(const u32x2*)(kb + L * 512);
#pragma unroll
  for (int L = 0; L < 8; ++L) f.v[L] = *(const u32x2*)(vb + L * 512);
}
template <bool MASK>
DI void sel_compute_t(int tid, const SelFrags& f, const u32x2 (&qb)[2], int b, int qpos, float M2, f32x4 (&o)[4], f32x4& ol) {
  const int lane = tid & 63, h4 = lane >> 4;
  const float c0 = 8.f - M2;
  const u32x2 ones = mk2(0x38383838u, 0x38383838u);
#pragma unroll
  for (int G = 0; G < 2; ++G) {
    f32x4 s[2];
#pragma unroll
    for (int t = 0; t < 2; ++t) {
      s[t] = (f32x4){0.f, 0.f, 0.f, 0.f};
#pragma unroll
      for (int ks = 0; ks < 2; ++ks)
        s[t] = __builtin_amdgcn_mfma_f32_16x16x32_fp8_fp8(__builtin_bit_cast(long, f.k[G * 4 + t * 2 + ks]), __builtin_bit_cast(long, qb[ks]), s[t], 0, 0, 0);
    }
#pragma unroll
    for (int t = 0; t < 2; ++t)
#pragma unroll
      for (int r = 0; r < 4; ++r) {
        float p = __builtin_amdgcn_exp2f(s[t][r] * 0.0625f + c0);
        if (MASK) { const int key = b * 64 + 32 * G + 8 * h4 + 4 * t + r; if (key > qpos) p = 0.f; }
        s[t][r] = p;
      }
    int w0 = 0, w1 = 0;
    w0 = __builtin_amdgcn_cvt_pk_bf8_f32(s[0][0], s[0][1], w0, false);
    w0 = __builtin_amdgcn_cvt_pk_bf8_f32(s[0][2], s[0][3], w0, true);
    w1 = __builtin_amdgcn_cvt_pk_bf8_f32(s[1][0], s[1][1], w1, false);
    w1 = __builtin_amdgcn_cvt_pk_bf8_f32(s[1][2], s[1][3], w1, true);
    const u32x2 pb = mk2((u32)w0, (u32)w1);
#pragma unroll
    for (int dt = 0; dt < 4; ++dt)
      o[dt] = __builtin_amdgcn_mfma_f32_16x16x32_fp8_bf8(__builtin_bit_cast(long, f.v[G * 4 + dt]), __builtin_bit_cast(long, pb), o[dt], 0, 0, 0);
    ol = __builtin_amdgcn_mfma_f32_16x16x32_fp8_bf8(__builtin_bit_cast(long, ones), __builtin_bit_cast(long, pb), ol, 0, 0, 0);
  }
}
DI void sel_compute(int tid, const SelFrags& f, const u32x2 (&qb)[2], int b, int cur, int qpos, float M2, f32x4 (&o)[4], f32x4& ol) {
  if (__builtin_amdgcn_readfirstlane(b) == __builtin_amdgcn_readfirstlane(cur)) sel_compute_t<true>(tid, f, qb, b, qpos, M2, o, ol);
  else sel_compute_t<false>(tid, f, qb, b, qpos, M2, o, ol);
}

__device__ __forceinline__ void nsa_item(const Params& P, int l, int g, int qb, char* smem, int secmask = 7) {
  const int tid = opaque_tid(), lane = tid & 63, wave = tid >> 6, h = lane >> 5;
  const int q0 = qb * 128, wq0 = q0 + wave * 32, q = wq0 + (lane & 31), ql = wave * 32 + (lane & 31);
  const int item = g * 128 + qb;
  const float M2 = 8.f * max_abs64(tid, P.nsa_q_norm_w + l * 64) * max_abs64(tid, P.nsa_k_norm_w + l * 64) * LOG2E * 1.01f + 0.1f;
  unsigned char* sel = (unsigned char*)(smem + AT_MISC);
  unsigned char* nsel = sel + 2048;
  float* impA = P.impA + (size_t)item * 256 * 128;
  float* impB = P.impB + (size_t)item * 256 * 128;
  const u16* Kc = P.KCC + (size_t)g * 1024 * 64;
  const int ntc = ((q0 + 96) >> 10) + 1;
  const int nmaxq = (q >= 31) ? ((q - 31) >> 4) : -1;
  const int nmax_w = wq0 >> 4;

  {
    float lh[4] = {0.f, 0.f, 0.f, 0.f};
#pragma unroll 1
    for (int pass = 0; pass < 2; ++pass) {
      float inv[4];
      if (pass == 1) {
#pragma unroll
        for (int hh = 0; hh < 4; ++hh) { float t = lh[hh] + __shfl_xor(lh[hh], 32); inv[hh] = (t > 0.f) ? 1.f / t : 0.f; }
      }
      TileRegs r;
      tile_load(tid, r, Kc, nullptr, 0, 0, false);
      tile_store(tid, r, smem, false);
      __syncthreads();
      for (int t = 0; t < ntc; ++t) {
        char* cur = smem + (t & 1) * AT_STAGE;
        char* nxt = smem + ((t + 1) & 1) * AT_STAGE;
        const bool more = (t + 1 < ntc);
        if (more) tile_load(tid, r, Kc, nullptr, 0, (t + 1) * 64, false);
        const int key0 = t * 64;
        f32x16 ps[2];
#pragma unroll
        for (int kt = 0; kt < 2; ++kt)
#pragma unroll
          for (int i = 0; i < 16; ++i) ps[kt][i] = 0.f;
        if (key0 <= nmax_w) {
#pragma unroll
          for (int hh = 0; hh < 4; ++hh) {
            f32x16 s[2];
            bf16x8 qf[4];
            load_q4(tid, qf, P.QN + (size_t)(g * 4 + hh) * S * 64, q);
            qk_half<4, true>(tid, cur, 0, 0, qf, s[0]);
            qk_half<4, true>(tid, cur, 0, 1, qf, s[1]);
#pragma unroll
            for (int kt = 0; kt < 2; ++kt)
#pragma unroll
              for (int i = 0; i < 16; ++i) {
                float p = __builtin_amdgcn_exp2f(s[kt][i]);
                const int key = key0 + 32 * kt + crow(i, h);
                if (key > nmaxq) p = 0.f;
                if (pass == 0) lh[hh] += p; else ps[kt][i] += p * inv[hh];
              }
          }
        }
        if (pass == 1) {
#pragma unroll
          for (int kt = 0; kt < 2; ++kt)
#pragma unroll
            for (int rg = 0; rg < 4; ++rg) {
              const int j = 16 * t + 8 * kt + 2 * rg + h;
              impA[(size_t)j * 128 + ql] = ps[kt][4 * rg] + ps[kt][4 * rg + 1] + ps[kt][4 * rg + 2] + ps[kt][4 * rg + 3];
              impB[(size_t)j * 128 + ql] = ps[kt][4 * rg + 3];
            }
        }
        if (more) tile_store(tid, r, nxt, false);
        __syncthreads();
      }
    }
  }
  __threadfence_block();
  __syncthreads();
  {
    const int qt = tid >> 1, half = tid & 1;
    const int qp = q0 + qt, cur = qp >> 6;
    u32 lst[13];
#pragma unroll
    for (int i = 0; i < 13; ++i) lst[i] = 0u;
    for (int j0 = 1 + half; j0 <= cur - 2; j0 += 8) {
      float sc[4];
#pragma unroll
      for (int u = 0; u < 4; ++u) {
        const int j = j0 + 2 * u, jc = j <= cur - 2 ? j : 1;
        sc[u] = impA[(size_t)jc * 128 + qt] + impB[(size_t)(jc - 1) * 128 + qt];
      }
#pragma unroll
      for (int u = 0; u < 4; ++u) {
        const int j = j0 + 2 * u;
        u32 x = (j <= cur - 2) ? ((__float_as_uint(sc[u]) & 0xffffff00u) | (u32)j) : 0u;
#pragma unroll
        for (int i = 0; i < 13; ++i) { const u32 hi = max(lst[i], x); x = min(lst[i], x); lst[i] = hi; }
      }
    }
    u32 oth[13];
#pragma unroll
    for (int i = 0; i < 13; ++i) oth[i] = (u32)__shfl_xor((int)lst[i], 1);
#pragma unroll
    for (int k = 0; k < 13; ++k) {
      u32 x = oth[k];
#pragma unroll
      for (int i = 0; i < 13; ++i) { const u32 hi = max(lst[i], x); x = min(lst[i], x); lst[i] = hi; }
    }
    if (half == 0) {
      unsigned char* sp = sel + qt * 16;
      int n = 0;
      sp[n++] = 0;
      if (cur >= 1) sp[n++] = (unsigned char)cur;
      if (cur >= 2) sp[n++] = (unsigned char)(cur - 1);
      const int ncand = cur - 2 < 13 ? cur - 2 : 13;
#pragma unroll
      for (int i = 0; i < 13; ++i) if (i < ncand) sp[n++] = (unsigned char)(lst[i] & 0xffu);
      nsel[qt] = (unsigned char)n;
    }
  }
  __syncthreads();
  if (secmask & 2) {
    const unsigned char* Kg = P.KS8 + (size_t)g * S * 64; const unsigned char* Vtg = P.VS8t + (size_t)g * 64 * S;
    const int col = lane & 15, h4 = lane >> 4, hd = col & 3;
    const unsigned char* selw = sel + wave * 32 * 16;
    const unsigned char* nselw = nsel + wave * 32;
    u32x2* q8 = (u32x2*)(smem + wave * 8448);
    float* gl = (float*)(smem + 41472 + wave * 1600);
    u16* vis = (u16*)(smem + 41472 + wave * 1600 + 512);
    {
#pragma unroll 4
      for (int c = lane; c < 1024; c += 64) {
        const int qi = c >> 5, head = (c >> 3) & 3, ch = c & 7;
        const u32x4 qv = *(const u32x4*)(P.QR + ((size_t)(g * 4 + head) * S + wq0 + qi) * 64 + ch * 8);
        int w0 = 0, w1 = 0;
        w0 = __builtin_amdgcn_cvt_pk_fp8_f32(bflo(qv.x) * 16.f, bfhi(qv.x) * 16.f, w0, false);
        w0 = __builtin_amdgcn_cvt_pk_fp8_f32(bflo(qv.y) * 16.f, bfhi(qv.y) * 16.f, w0, true);
        w1 = __builtin_amdgcn_cvt_pk_fp8_f32(bflo(qv.z) * 16.f, bfhi(qv.z) * 16.f, w1, false);
        w1 = __builtin_amdgcn_cvt_pk_fp8_f32(bflo(qv.w) * 16.f, bfhi(qv.w) * 16.f, w1, true);
        q8[(qi * 8 + ch) * 4 + head] = mk2((u32)w0, (u32)w1);
      }
      if (lane < 32) q8[(32 * 8 + (lane >> 2)) * 4 + (lane & 3)] = mk2(0u, 0u);
      for (int c = lane; c < 128; c += 64) gl[c] = P.gates[(size_t)(wq0 + (c >> 2)) * 24 + (g * 4 + (c & 3)) * 3 + 1];
      int cnt = (lane < 32) ? (int)nselw[lane] : 0, pre = cnt;
#pragma unroll
      for (int o = 1; o < 32; o <<= 1) { const int t2 = __shfl_up(pre, o); if ((lane & 31) >= o) pre += t2; }
      const int V = __builtin_amdgcn_readlane(pre, 31);
      pre -= cnt;
      if (lane < 32) for (int i = 0; i < cnt; ++i) vis[pre + i] = (u16)(selw[lane * 16 + i] | (lane << 8) | (i + 1 == cnt ? 0x8000 : 0));
      if (lane < 5) vis[V + lane] = (u16)(32 << 8);
      __builtin_amdgcn_s_waitcnt(0xc07f);
      __builtin_amdgcn_wave_barrier();
      const int V3 = ((V + 2) / 3) * 3;
      SelFrags fr[3];
      sel_load(tid, fr[0], Kg, Vtg, vis[0] & 0xff);
      sel_load(tid, fr[1], Kg, Vtg, vis[1] & 0xff);
      f32x4 o[4];
#pragma unroll
      for (int dt = 0; dt < 4; ++dt) o[dt] = (f32x4){0.f, 0.f, 0.f, 0.f};
      f32x4 ol = (f32x4){0.f, 0.f, 0.f, 0.f};
#pragma unroll 1
      for (int v = 0; v < V3; v += 3) {
#pragma unroll
        for (int slot = 0; slot < 3; ++slot) {
          const int e = __builtin_amdgcn_readfirstlane((int)vis[v + slot]);
          const int e2 = __builtin_amdgcn_readfirstlane((int)vis[v + slot + 2]);
          sel_load(tid, fr[(slot + 2) % 3], Kg, Vtg, e2 & 0xff);
          const int qi = (e >> 8) & 63, bb = e & 0xff, qp = wq0 + qi;
          u32x2 qcur[2];
          qcur[0] = q8[(qi * 8 + h4) * 4 + hd]; qcur[1] = q8[(qi * 8 + 4 + h4) * 4 + hd];
          sel_compute(tid, fr[slot], qcur, bb, qp >> 6, qp, M2, o, ol);
          if (e & 0x8000) {
            const float lsum = ol[0];
            if (col < 4 && (!(secmask & 8) || lsum == 1.2345e33f)) {
              const float gs = (ABLATE & 4) ? 0.f : gl[qi * 4 + col] / lsum;
              u16* dst = P.mix + (size_t)qp * 1024 + 256 + (g * 4 + col) * 64 + 4 * h4;
#pragma unroll
              for (int dt = 0; dt < 4; ++dt)
                *(u32x2*)(dst + 16 * dt) = mk2(pack2(o[dt][0] * gs, o[dt][1] * gs), pack2(o[dt][2] * gs, o[dt][3] * gs));
            }
#pragma unroll
            for (int dt = 0; dt < 4; ++dt) o[dt] = (f32x4){0.f, 0.f, 0.f, 0.f};
            ol = (f32x4){0.f, 0.f, 0.f, 0.f};
          }
        }
      }
    }
  }
  __threadfence_block();
  __syncthreads();
#pragma unroll 1
  for (int hh = 0; hh < ((secmask & 4) ? 4 : 0); ++hh) {
    const int H = g * 4 + hh;
#pragma unroll 1
    for (int br = 0; br < 2; ++br) {
      AttnArgs a;
      a.q = q; a.wq0 = wq0; a.M2 = M2; a.cq = 0.f; a.cloc = nullptr; a.base = nullptr; a.dofs = 0;
      bf16x8 qf[4];
      f32x16 o[2]; zero_o(o);
      float ls = 0.f;
      if (br == 0) {
        load_q4(tid, qf, P.QN + (size_t)H * S * 64, q);
        a.K = Kc; a.Vt = P.VCCt + (size_t)g * 64 * 1024; a.ldv = 1024; a.t0 = 0; a.t1 = ntc;
        a.lim_hi = nmaxq; a.lim_lo = 0; a.whi = nmax_w; a.wlo = 0; a.mask_hi = (wq0 >= 31) ? ((wq0 - 31) >> 4) : -1; a.mask_lo = 0;
      } else {
        load_q4(tid, qf, P.QR + (size_t)H * S * 64, q);
        a.K = P.KW + (size_t)g * S * 64; a.Vt = P.VWt + (size_t)g * 64 * S; a.ldv = S;
        a.t0 = (q0 >> 6) - 8 < 0 ? 0 : (q0 >> 6) - 8; a.t1 = (q0 >> 6) + 2;
        a.lim_hi = q; a.lim_lo = q - 511; a.whi = wq0 + 31; a.wlo = wq0 - 511; a.mask_hi = wq0; a.mask_lo = wq0 + 31 - 511;
      }
      attn_loop<4, 4, true>(tid, a, qf, o, ls, smem);
      ls += __shfl_xor(ls, 32);
      float gt = (ls > 0.f) ? P.gates[(size_t)q * 24 + H * 3 + (br == 0 ? 0 : 2)] / ls : 0.f;
      if ((ABLATE & 2) && br == 0) gt = 0.f;
      if ((ABLATE & 8) && br == 1) gt = 0.f;
      u16* dst = P.mix + (size_t)q * 1024 + 256 + H * 64 + 4 * h;
      if (!(secmask & 8) || ls == 1.2345e33f)
#pragma unroll
      for (int dt = 0; dt < 2; ++dt)
#pragma unroll
        for (int rg = 0; rg < 4; ++rg) {
          u32x2* pp = (u32x2*)(dst + 32 * dt + 8 * rg);
          const u32x2 old = *pp;
          const float r0 = bflo(old.x) + gt * o[dt][4 * rg];
          const float r1 = bfhi(old.x) + gt * o[dt][4 * rg + 1];
          const float r2 = bflo(old.y) + gt * o[dt][4 * rg + 2];
          const float r3 = bfhi(old.y) + gt * o[dt][4 * rg + 3];
          *pp = mk2(pack2(r0, r1), pack2(r2, r3));
        }
    }
  }
}

DI unsigned xcc_id() { return (unsigned)__builtin_amdgcn_s_getreg((3 << 11) | 20) & 0xFu; }

__device__ __forceinline__ void phase_attention(const Params& P, int l, char* smem, unsigned* counter, int secmask = 7, int kmask = 0) {
  int* slot = (int*)(smem + AT_MISC + 4096);
  const int mygrp = (int)(xcc_id() & 1u);
#pragma unroll 1
  for (int pass = 0; pass < 2; ++pass) {
    const int g = pass == 0 ? mygrp : 1 - mygrp;
    for (;;) {
      __syncthreads();
      if (threadIdx.x == 0) *slot = (int)atomicAdd(counter + g, 1u);
      __syncthreads();
      const int it = *slot;
      if (it >= 128 || (kmask & 2)) break;
      nsa_item(P, l, g, 127 - it, smem, secmask);
    }
  }
  const int x = (int)(xcc_id() & 7u);
#pragma unroll 1
  for (int sidx = 0; sidx < 8; ++sidx) {
    const int k = ((x + (sidx >> 1)) & 7) ^ ((sidx & 1) << 2);
    for (;;) {
      __syncthreads();
      if (threadIdx.x == 0) *slot = (int)atomicAdd(counter + 2 + k, 1u);
      __syncthreads();
      const int it = *slot;
      if (it >= 128 || (kmask & 1)) break;
      const int qb = 127 - it;
      if (k < 4) { if (!(kmask & 4)) diff_item(P, l, k, qb, smem); } else { if (!(kmask & 8)) fox_item(P, l, k - 4, qb, smem); }
    }
  }
}

__device__ __forceinline__ void phase_outproj(const Params& P, int l, char* smem, bool dry = false) {
  const u16* Wt = P.WoutT + (size_t)l * D * D;
  float* tile = (float*)smem;
  const int tid = threadIdx.x;
  for (int it = blockIdx.x; it < 128 * 8; it += gridDim.x) {
    const int mt = it >> 3, nt = it & 7;
    f32x16 acc[2][2];
    zero_acc(acc);
    gemm_mainloop<false>(P.mix + (size_t)mt * 128 * D, D, Wt + (size_t)nt * 128 * D, D, D, smem, acc);
    acc_to_lds(acc, tile);
    __syncthreads();
    const int c4 = (tid & 31) * 4, r0 = tid >> 5;
#pragma unroll 4
    for (int i = 0; i < 16; ++i) {
      const int row = r0 + 8 * i;
      const size_t idx = (size_t)(mt * 128 + row) * D + nt * 128 + c4;
      const f32x4 a4 = *(const f32x4*)(tile + row * EPS_LD + c4);
      const u32x2 hv = *(const u32x2*)(P.hb + idx);
      f32x4 h4 = {bflo(hv.x), bfhi(hv.x), bflo(hv.y), bfhi(hv.y)};
      h4 += a4;
      if (!dry || h4[0] == 1.2345e33f) *(u32x2*)(P.hb2 + idx) = mk2(pack2(h4[0], h4[1]), pack2(h4[2], h4[3]));
    }
  }
}

constexpr int QT_ST = 272;
DI u32 ord_key(float x, u32 idx) {
  u32 u = __float_as_uint(x);
  u = (u & 0x80000000u) ? ~u : (u | 0x80000000u);
  return (u & 0xffffff80u) | idx;
}
DI float ord_val(u32 k) {
  return (k & 0x80000000u) ? __uint_as_float(k & 0x7fffff80u) : __uint_as_float((~k) & 0xffffff80u);
}
DI void sort16_desc(u32 (&v)[16]) {
#pragma unroll
  for (int k = 2; k <= 16; k <<= 1)
#pragma unroll
    for (int j = k >> 1; j > 0; j >>= 1)
#pragma unroll
      for (int i = 0; i < 16; ++i) {
        const int m = i ^ j;
        if (m > i) {
          const u32 a = v[i], b = v[m];
          if ((i & k) == 0) { v[i] = max(a, b); v[m] = min(a, b); } else { v[i] = min(a, b); v[m] = max(a, b); }
        }
      }
}
DI void top16_merge(u32 (&a)[16], const u32 (&b)[16]) {
  u32 c[16];
#pragma unroll
  for (int i = 0; i < 16; ++i) c[i] = max(a[i], b[15 - i]);
#pragma unroll
  for (int st = 8; st > 0; st >>= 1)
#pragma unroll
    for (int i = 0; i < 16; ++i)
      if ((i & st) == 0) { const u32 x = max(c[i], c[i + st]), y = min(c[i], c[i + st]); c[i] = x; c[i + st] = y; }
#pragma unroll
  for (int i = 0; i < 16; ++i) a[i] = c[i];
}
DI void merge16(u32 (&lst)[16], int xm) {
  u32 c[16];
#pragma unroll
  for (int i = 0; i < 16; ++i) { const u32 o = (u32)__shfl_xor((int)lst[15 - i], xm); c[i] = max(lst[i], o); }
#pragma unroll
  for (int st = 8; st > 0; st >>= 1)
#pragma unroll
    for (int i = 0; i < 16; ++i)
      if ((i & st) == 0) { const u32 a = max(c[i], c[i + st]), b = min(c[i], c[i + st]); c[i] = a; c[i + st] = b; }
#pragma unroll
  for (int i = 0; i < 16; ++i) lst[i] = c[i];
}

__device__ __forceinline__ void phase_peerq(const Params& P, int l, char* smem) {
  const u16* Wt = P.WqT + (size_t)l * 2048 * D;
  const int tid = threadIdx.x, lane = tid & 63, wave = tid >> 6, wr = wave >> 1, wc = wave & 1, h = lane >> 5;
  const float* rs = (const float*)(smem + G_RS_OFF);
  float* tile = (float*)smem;
  for (int it = blockIdx.x; it < 128 * 16; it += gridDim.x) {
    const int mt = it >> 4, nt = it & 15;
    f32x16 acc[2][2];
    zero_acc(acc);
    gemm_mainloop<true>(P.hb2 + (size_t)mt * 128 * D, D, Wt + (size_t)nt * 128 * D, D, D, smem, acc);
    __syncthreads();
#pragma unroll
    for (int i = 0; i < 2; ++i)
#pragma unroll
      for (int j = 0; j < 2; ++j)
#pragma unroll
        for (int r = 0; r < 16; ++r) {
          const int row = wr * 64 + i * 32 + crow(r, h);
          *(u16*)(smem + row * QT_ST + (wc * 64 + j * 32 + (lane & 31)) * 2) = f2bf(acc[i][j][r] * rs[row]);
        }
    __syncthreads();
    zero_acc(acc);
    {
      const u16* Bk = P.SubK + ((size_t)(l * 16 + nt) * 128 + wc * 64 + (lane & 31)) * 128 + h * 8;
      const char* Aq = smem + (wr * 64 + (lane & 31)) * QT_ST + h * 16;
#pragma unroll
      for (int ks = 0; ks < 8; ++ks) {
        bf16x8 af[2], bfr[2];
#pragma unroll
        for (int i = 0; i < 2; ++i) af[i] = *(const bf16x8*)(Aq + i * 32 * QT_ST + ks * 32);
#pragma unroll
        for (int j = 0; j < 2; ++j) bfr[j] = *(const bf16x8*)(Bk + (size_t)j * 32 * 128 + ks * 16);
#pragma unroll
        for (int i = 0; i < 2; ++i)
#pragma unroll
          for (int j = 0; j < 2; ++j) acc[i][j] = MFMA32(af[i], bfr[j], acc[i][j]);
      }
    }
    __syncthreads();
    acc_to_lds(acc, tile);
    __syncthreads();
#pragma unroll 1
    for (int half = 0; half < 2; ++half) {
      {
        const int row = half * 64 + (tid >> 2), part = tid & 3;
        u32 lst[16], l2[16];
        const f32x4* src = (const f32x4*)(tile + row * EPS_LD + part * 32);
#pragma unroll
        for (int c4 = 0; c4 < 4; ++c4) {
          const f32x4 v = src[c4], w = src[c4 + 4];
#pragma unroll
          for (int e = 0; e < 4; ++e) {
            lst[c4 * 4 + e] = ord_key(v[e], (u32)(part * 32 + c4 * 4 + e));
            l2[c4 * 4 + e] = ord_key(w[e], (u32)(part * 32 + 16 + c4 * 4 + e));
          }
        }
        sort16_desc(lst); sort16_desc(l2);
        top16_merge(lst, l2);
        merge16(lst, 1);
        merge16(lst, 2);
        if (part == 0) {
          u32x4* dp = (u32x4*)(P.topk + ((size_t)(mt * 128 + row) * 16 + nt) * 16);
          dp[0] = mk4(lst[0], lst[1], lst[2], lst[3]); dp[1] = mk4(lst[4], lst[5], lst[6], lst[7]);
          dp[2] = mk4(lst[8], lst[9], lst[10], lst[11]); dp[3] = mk4(lst[12], lst[13], lst[14], lst[15]);
        }
      }
    }
  }
}

__device__ const unsigned char kCandIJ[50] = {
  0x00,0x01,0x02,0x03,0x04,0x05,0x06,0x07,0x08,0x09,0x0a,0x0b,0x0c,0x0d,0x0e,0x0f,
  0x10,0x11,0x12,0x13,0x14,0x15,0x16,0x17,
  0x20,0x21,0x22,0x23,0x24,
  0x30,0x31,0x32,0x33,
  0x40,0x41,0x42,
  0x50,0x51, 0x60,0x61, 0x70,0x71,
  0x80,0x90,0xa0,0xb0,0xc0,0xd0,0xe0,0xf0};
DI float gelu_exact(float x) { return 0.5f * x * (1.f + erff(x * 0.7071067811865476f)); }

__device__ __forceinline__ void phase_peer(const Params& P, int l, char* smem, bool dry = false) {
  const int tid = threadIdx.x, lane = tid & 63, wave = tid >> 6;
  char* wsm = smem + wave * 8192;
  u32* keys = (u32*)wsm;
  u32* cvk = (u32*)(wsm + 1024);
  int* exps = (int*)(wsm + 1024 + 1664);
  float* esc = (float*)(wsm + 3200);
  float* wts = (float*)(wsm + 3712);
  float* hraw = (float*)(wsm + 4224);
  unsigned char* xrow8 = (unsigned char*)(wsm + 5248);
  const unsigned char* U8 = P.U8 + (size_t)l * S * (D / 2);
  const unsigned char* V8 = P.V8 + (size_t)l * S * (D / 2);
  const float* Uinv = P.Uinv + l * S; const float* Vinv = P.Vinv + l * S;
  if (lane < 16) cvk[(lane >> 1) * 52 + 50 + (lane & 1)] = 0u;
  int it = blockIdx.x;
  u32x4 kq = mk4(0u, 0u, 0u, 0u), xa = kq, xb = kq;
  if (it < S / 4) {
    const int tok = it * 4 + wave;
    kq = *(const u32x4*)(P.topk + (size_t)tok * 256 + lane * 4);
    xa = *(const u32x4*)(P.hb2 + (size_t)tok * D + lane * 16); xb = *(const u32x4*)(P.hb2 + (size_t)tok * D + lane * 16 + 8);
  }
  for (; it < S / 4; it += gridDim.x) {
    const int tok = it * 4 + wave;
    *(u32x4*)(keys + lane * 4) = kq;
    float rstd = wave_sum(ssq8(xa) + ssq8(xb));
    rstd = rsqrtf(rstd * (1.f / 1024.f) + 1e-6f);
    float xinv;
    {
      float xv[16] = {bflo(xa.x), bfhi(xa.x), bflo(xa.y), bfhi(xa.y), bflo(xa.z), bfhi(xa.z), bflo(xa.w), bfhi(xa.w),
                      bflo(xb.x), bfhi(xb.x), bflo(xb.y), bfhi(xb.y), bflo(xb.z), bfhi(xb.z), bflo(xb.w), bfhi(xb.w)};
      float m = 0.f;
#pragma unroll
      for (int i = 0; i < 16; ++i) m = fmaxf(m, fabsf(xv[i]));
      m = wave_max(m);
      const float sx = (m > 0.f) ? 240.f / m : 0.f;
      xinv = m * (1.f / 240.f);
      u32 o4[4];
#pragma unroll
      for (int i = 0; i < 4; ++i) {
        int wd = 0;
        wd = __builtin_amdgcn_cvt_pk_fp8_f32(xv[4 * i] * sx, xv[4 * i + 1] * sx, wd, false);
        wd = __builtin_amdgcn_cvt_pk_fp8_f32(xv[4 * i + 2] * sx, xv[4 * i + 3] * sx, wd, true);
        o4[i] = (u32)wd;
      }
      *(u32x4*)(xrow8 + lane * 16) = mk4(o4[0], o4[1], o4[2], o4[3]);
    }
    {
      const int nit = it + gridDim.x;
      if (nit < S / 4) {
        const int ntok = nit * 4 + wave;
        kq = *(const u32x4*)(P.topk + (size_t)ntok * 256 + lane * 4);
        xa = *(const u32x4*)(P.hb2 + (size_t)ntok * D + lane * 16); xb = *(const u32x4*)(P.hb2 + (size_t)ntok * D + lane * 16 + 8);
      }
    }
    __builtin_amdgcn_s_waitcnt(0xc07f);
    const int hd = lane >> 3, sub = lane & 7;
    float myv[7]; int mye[7]; u32 mk[7];
#pragma unroll
    for (int m = 0; m < 7; ++m) {
      const int c = sub + 8 * m;
      myv[m] = -3.0e38f; mye[m] = 0; mk[m] = 0u;
      if (m < 6 || c < 50) {
        const int ij = kCandIJ[c], i = ij >> 4, j = ij & 15;
        const u32 k1 = keys[(hd * 2) * 16 + i], k2 = keys[(hd * 2 + 1) * 16 + j];
        myv[m] = ord_val(k1) + ord_val(k2);
        mye[m] = (int)((k1 & 127u) * 128u + (k2 & 127u));
        u32 sk = __float_as_uint(myv[m]);
        sk = (sk & 0x80000000u) ? ~sk : (sk | 0x80000000u);
        mk[m] = (sk & 0xffffffc0u) | (u32)(63 - c);
        cvk[hd * 52 + c] = mk[m];
      }
    }
    __builtin_amdgcn_s_waitcnt(0xc07f);
    {
      int rk[7];
#pragma unroll
      for (int m = 0; m < 7; ++m) rk[m] = 0;
#pragma unroll
      for (int j = 0; j < 13; ++j) {
        const u32x4 o = *(const u32x4*)(cvk + hd * 52 + 4 * j);
#pragma unroll
        for (int m = 0; m < 7; ++m) rk[m] += (int)(o.x > mk[m]) + (int)(o.y > mk[m]) + (int)(o.z > mk[m]) + (int)(o.w > mk[m]);
      }
#pragma unroll
      for (int m = 0; m < 7; ++m) {
        const int c = sub + 8 * m;
        if ((m < 6 || c < 50) && rk[m] < 16) { exps[hd * 16 + rk[m]] = mye[m]; esc[hd * 16 + rk[m]] = myv[m]; }
      }
    }
    __builtin_amdgcn_s_waitcnt(0xc07f);
    const int ex0 = exps[lane], ex1 = exps[lane + 64];
    const float ui0 = Uinv[ex0], ui1 = Uinv[ex1], vi0 = Vinv[ex0], vi1 = Vinv[ex1];
    float g0, g1;
    {
      const float mx = esc[hd * 16];
      const float e0 = expf(esc[hd * 16 + 2 * sub] - mx), e1 = expf(esc[hd * 16 + 2 * sub + 1] - mx);
      float sm = e0 + e1;
      sm += __shfl_xor(sm, 1); sm += __shfl_xor(sm, 2); sm += __shfl_xor(sm, 4);
      g0 = e0 / sm; g1 = e1 / sm;
    }
    wts[hd * 16 + 2 * sub] = g0; wts[hd * 16 + 2 * sub + 1] = g1;
    {
      const int i16 = lane & 15, h4 = lane >> 4;
      u32x4 a0[8], a1[8];
      auto uload = [&](u32x4 (&a)[8], int g) {
        const unsigned char* urow = U8 + (u32)(exps[g * 16 + i16] * (D / 2) + 16 * h4);
#pragma unroll
        for (int i = 0; i < 8; ++i) a[i] = *(const u32x4*)(urow + i * 64);
      };
      auto umma = [&](const u32x4 (&a)[8], int g) {
        f32x4 acc = (f32x4){0.f, 0.f, 0.f, 0.f};
#pragma unroll
        for (int i = 0; i < 8; ++i) {
          const u32x4 b0 = *(const u32x4*)(xrow8 + i * 128 + 16 * h4), b1 = *(const u32x4*)(xrow8 + i * 128 + 64 + 16 * h4);
          const i32x8 A = {(int)a[i].x, (int)a[i].y, (int)a[i].z, (int)a[i].w, 0, 0, 0, 0};
          const i32x8 B = {(int)b0.x, (int)b0.y, (int)b0.z, (int)b0.w, (int)b1.x, (int)b1.y, (int)b1.z, (int)b1.w};
          acc = __builtin_amdgcn_mfma_scale_f32_16x16x128_f8f6f4(A, B, acc, 4, 0, 0, 0x7f7f7f7f, 0, 0x7f7f7f7f);
        }
        if (i16 == 0) *(f32x4*)(hraw + g * 16 + 4 * h4) = acc;
      };
      uload(a0, 0);
#pragma unroll 1
      for (int g = 0; g < 8; g += 2) {
        uload(a1, g + 1);
        umma(a0, g);
        if (g + 2 < 8) uload(a0, g + 2);
        umma(a1, g + 1);
      }
    }
    __builtin_amdgcn_s_waitcnt(0xc07f);
    {
      const float h0 = hraw[lane], h1 = hraw[lane + 64];
      const float w0 = wts[lane], w1 = wts[lane + 64];
      wts[lane] = w0 * gelu_exact(rstd * h0 * ui0 * xinv) * vi0;
      wts[lane + 64] = w1 * gelu_exact(rstd * h1 * ui1 * xinv) * vi1;
    }
    __builtin_amdgcn_s_waitcnt(0xc07f);
    float o[16];
#pragma unroll
    for (int i = 0; i < 16; ++i) o[i] = 0.f;
    {
      u32x2 va[8], vb2[8];
      auto vload = [&](u32x2 (&x0)[8], int k) {
#pragma unroll
        for (int u = 0; u < 8; ++u) x0[u] = *(const u32x2*)(V8 + (u32)(exps[k + u] * (D / 2) + lane * 8));
      };
      auto vacc = [&](const u32x2 (&x0)[8], int k) {
#pragma unroll
        for (int u = 0; u < 8; ++u) {
          const float w = wts[k + u];
#pragma unroll
          for (int c = 0; c < 2; ++c) {
            const f32x2 d0 = __builtin_amdgcn_cvt_scalef32_pk_f32_fp4(x0[u][c], 1.0f, 0), d1 = __builtin_amdgcn_cvt_scalef32_pk_f32_fp4(x0[u][c], 1.0f, 1);
            const f32x2 d2 = __builtin_amdgcn_cvt_scalef32_pk_f32_fp4(x0[u][c], 1.0f, 2), d3 = __builtin_amdgcn_cvt_scalef32_pk_f32_fp4(x0[u][c], 1.0f, 3);
            o[8 * c] += w * d0[0]; o[8 * c + 1] += w * d0[1]; o[8 * c + 2] += w * d1[0]; o[8 * c + 3] += w * d1[1];
            o[8 * c + 4] += w * d2[0]; o[8 * c + 5] += w * d2[1]; o[8 * c + 6] += w * d3[0]; o[8 * c + 7] += w * d3[1];
          }
        }
      };
      vload(va, 0);
#pragma unroll 1
      for (int k = 0; k < 128; k += 16) {
        vload(vb2, k + 8);
        vacc(va, k);
        if (k + 16 < 128) vload(va, k + 16);
        vacc(vb2, k + 8);
      }
    }
    if (!dry || o[0] == 1.2345e33f) {
      u32x4* hp = (u32x4*)(P.hb2 + (size_t)tok * D + lane * 16);
      const u32x4 ca = hp[0], cb = hp[1];
      hp[0] = mk4(pack2(bflo(ca.x) + o[0], bfhi(ca.x) + o[1]), pack2(bflo(ca.y) + o[2], bfhi(ca.y) + o[3]), pack2(bflo(ca.z) + o[4], bfhi(ca.z) + o[5]), pack2(bflo(ca.w) + o[6], bfhi(ca.w) + o[7]));
      hp[1] = mk4(pack2(bflo(cb.x) + o[8], bfhi(cb.x) + o[9]), pack2(bflo(cb.y) + o[10], bfhi(cb.y) + o[11]), pack2(bflo(cb.z) + o[12], bfhi(cb.z) + o[13]), pack2(bflo(cb.w) + o[14], bfhi(cb.w) + o[15]));
    }
  }
}

__device__ __forceinline__ void phase_ple(const Params& P, int l, char* smem, bool dry = false) {
  const u16* Wg = P.WgT + (size_t)l * D * D;
  const u16* Wp = P.WpT + (size_t)l * D * 256;
  const u16* pb = P.pb + (size_t)l * S * 256;
  const int tid = threadIdx.x, lane = tid & 63, wave = tid >> 6, wr = wave >> 1, h = lane >> 5;
  const float* rs = (const float*)(smem + G_RS_OFF);
  float* tile = (float*)smem;
  for (int it = blockIdx.x; it < 128 * 8; it += gridDim.x) {
    const int mt = it >> 3, nt = it & 7;
    f32x16 acc[2][2];
    zero_acc(acc);
    gemm_mainloop<false>(pb + (size_t)mt * 128 * 256, 256, Wp + (size_t)nt * 128 * 256, 256, 256, smem, acc);
    u16* side = (u16*)(smem + 36864);
    const int wc = wave & 1;
#pragma unroll
    for (int i = 0; i < 2; ++i)
#pragma unroll
      for (int j = 0; j < 2; ++j)
#pragma unroll
        for (int r = 0; r < 16; ++r)
          side[(wr * 64 + i * 32 + crow(r, h)) * 136 + wc * 64 + j * 32 + (lane & 31)] = f2bf(acc[i][j][r]);
    zero_acc(acc);
    gemm_mainloop<true>(P.hb2 + (size_t)mt * 128 * D, D, Wg + (size_t)nt * 128 * D, D, D, smem, acc);
    __syncthreads();
#pragma unroll
    for (int i = 0; i < 2; ++i)
#pragma unroll
      for (int j = 0; j < 2; ++j)
#pragma unroll
        for (int r = 0; r < 16; ++r) {
          const int row = wr * 64 + i * 32 + crow(r, h);
          const float pv = bf2f(side[row * 136 + wc * 64 + j * 32 + (lane & 31)]);
          acc[i][j][r] = sigmoidf_(acc[i][j][r] * rs[row]) * pv;
        }
    __syncthreads();
    acc_to_lds(acc, tile);
    __syncthreads();
    const int c4 = (tid & 31) * 4, r0 = tid >> 5;
#pragma unroll 4
    for (int i = 0; i < 16; ++i) {
      const int row = r0 + 8 * i;
      const size_t idx = (size_t)(mt * 128 + row) * D + nt * 128 + c4;
      const f32x4 a4 = *(const f32x4*)(tile + row * EPS_LD + c4);
      const u32x2 hv = *(const u32x2*)(P.hb2 + idx);
      f32x4 h4 = {bflo(hv.x), bfhi(hv.x), bflo(hv.y), bfhi(hv.y)};
      h4 += a4;
      if (!dry || h4[0] == 1.2345e33f) {
        if (l == 1) *(f32x4*)(P.out + idx) = h4;
        else *(u32x2*)(P.hb + idx) = mk2(pack2(h4[0], h4[1]), pack2(h4[2], h4[3]));
      }
    }
  }
}

constexpr int N_PHASES = 15;
#define XB_TMO      128
#define XB_XCNT(j)  (256  + 64 * (j))
#define XB_XSUB(j)  (1280 + 64 * (j))
#define XB_XGEN(j)  (2304 + 64 * (j))
#define XB_TOP      3328
#define XB_TOPGEN   3392
#define XCD_BAR_WORDS 3456
#define XB_SPIN_CAP (1u << 24)
typedef __attribute__((address_space(3))) unsigned las_u32;
DI unsigned xb_ld(unsigned* p) { return __hip_atomic_load(p, __ATOMIC_RELAXED, __HIP_MEMORY_SCOPE_AGENT); }
DI unsigned xb_add(unsigned* p, unsigned v) { return __hip_atomic_fetch_add(p, v, __ATOMIC_RELAXED, __HIP_MEMORY_SCOPE_AGENT); }
#define XB_SPIN(cond, bar) do { unsigned _sp = 0; while (cond) { __builtin_amdgcn_s_sleep(1); \
    if ((++_sp & 255u) == 0u) { if (xb_ld(&(bar)[XB_TMO])) break; if (_sp > XB_SPIN_CAP) { (void)xb_add(&(bar)[XB_TMO], 1u); break; } } } } while (0)
struct XcdBarrier { unsigned* bar; unsigned x; volatile las_u32* st; };
DI XcdBarrier xcd_barrier_post(unsigned* bar, volatile las_u32* st) {
  XcdBarrier b; b.bar = bar; b.x = (unsigned)__builtin_amdgcn_s_getreg((3 << 11) | 20) & 0xFu; b.st = st;
  if (threadIdx.x == 0) (void)xb_add(&bar[XB_XCNT(b.x)], 1u);
  return b;
}
DI void xcd_barrier_complete(unsigned* bar, unsigned x, unsigned& nloc, unsigned& nx) {
  const unsigned G = gridDim.x * gridDim.y * gridDim.z;
  unsigned sum, cnt, mine, sp = 0u;
  for (;;) {
    sum = 0u; cnt = 0u; mine = 0u;
#pragma unroll
    for (unsigned j = 0; j < 16; ++j) { const unsigned c = xb_ld(&bar[XB_XCNT(j)]); sum += c; cnt += (c > 0u) ? 1u : 0u; mine = (j == x) ? c : mine; }
    if (sum == G) break;
    __builtin_amdgcn_s_sleep(1);
    if ((++sp & 255u) == 0u) { if (xb_ld(&bar[XB_TMO])) break; if (sp > XB_SPIN_CAP) { (void)xb_add(&bar[XB_TMO], 1u); break; } }
  }
  nloc = mine > 0u ? mine : 1u; nx = cnt > 0u ? cnt : 1u;
}
DI void xcd_barrier(unsigned* xbar, unsigned xx, volatile las_u32* xst_) {
  XcdBarrier b; b.bar = xbar; b.x = xx; b.st = xst_;
  asm volatile("s_waitcnt vmcnt(0)" ::: "memory");
  __syncthreads();
  if (threadIdx.x == 0) {
    unsigned* bar = b.bar;
    __builtin_amdgcn_s_waitcnt(0);
    unsigned nloc = b.st[0], nx = b.st[1];
    if (nloc == 0u) { xcd_barrier_complete(bar, b.x, nloc, nx); b.st[0] = nloc; b.st[1] = nx; }
    const unsigned old = xb_add(&bar[XB_XSUB(b.x)], 1u);
    const unsigned gen = old / nloc;
    if (old + 1u == (gen + 1u) * nloc) {
      __builtin_amdgcn_fence(__ATOMIC_RELEASE, "agent");
      asm volatile("s_waitcnt vmcnt(0)" ::: "memory");
      const unsigned og = xb_add(&bar[XB_TOP], 1u);
      const unsigned tg = og / nx;
      if (og + 1u == (tg + 1u) * nx) xb_add(&bar[XB_TOPGEN], 1u);
      else XB_SPIN(xb_ld(&bar[XB_TOPGEN]) == tg, bar);
      __builtin_amdgcn_fence(__ATOMIC_ACQUIRE, "agent");
      xb_add(&bar[XB_XGEN(b.x)], 1u);
      asm volatile("s_waitcnt vmcnt(0)" ::: "memory");
    } else {
      XB_SPIN(xb_ld(&bar[XB_XGEN(b.x)]) == gen, bar);
      __builtin_amdgcn_fence(__ATOMIC_ACQUIRE, "agent");
      asm volatile("s_waitcnt vmcnt(0)" ::: "memory");
    }
  }
  __syncthreads();
}
__global__ void __launch_bounds__(NT, 2) hymba_mega(Params P, unsigned* counters) {
  __shared__ __attribute__((aligned(16))) char smem[SMEM_BYTES];
  cg::grid_group grid = cg::this_grid();
  const int lo = P.phase_lo, hi = P.phase_hi;
#ifndef ONLY_PHASE
#define ONLY_PHASE -1
#endif
#define PH_ON(k) (ONLY_PHASE < 0 || ONLY_PHASE == (k))
  volatile las_u32* xst = (volatile las_u32*)(smem + SMEM_BYTES - 16);
  if (threadIdx.x < 4) xst[threadIdx.x] = 0u;
  __syncthreads();
  unsigned* const xbar = counters + 64;
  const unsigned xcc = xcd_barrier_post(xbar, xst).x;
#define RUN(ph, kind, call) if (lo <= (ph) && (ph) < hi) { const bool dry = false; const int rep = 0; (void)dry; (void)rep; if (PH_ON(kind)) { call; } if ((ph) + 1 < hi) { if ((ph) == 0) grid.sync(); else xcd_barrier(xbar, xcc, xst); } }
#define RUNREP(ph, kind, call) if (lo <= (ph) && (ph) < hi) { \
    const int nrep = ((ph) == P.rep_ph) ? P.rep_n : 1; \
    for (int rep = 0; rep < nrep; ++rep) { const bool dry = rep > 0; (void)dry; \
      if (PH_ON(kind)) { call; } \
      if ((ph) + 1 < hi || rep + 1 < nrep) { xcd_barrier(xbar, xcc, xst); } } }
#ifndef REPEAT
#define REPEAT -1
#define RSEC 7
#endif
  RUN(0, 7, phase_prep(P, smem))
  RUN(1, 0, phase_inproj(P, 0, smem))
  RUN(2, 1, phase_compress(P, 0, smem))
  RUNREP(3, 2, phase_attention(P, 0, smem, counters + 16 * rep, dry ? (P.rep_sec | 8) : 7, dry ? P.rep_nsa_only : 0))
  RUN(4, 3, phase_outproj(P, 0, smem, dry))
  RUN(5, 4, phase_peerq(P, 0, smem))
  RUN(6, 5, phase_peer(P, 0, smem, dry))
  RUN(7, 6, phase_ple(P, 0, smem, dry))
  RUN(8, 0, phase_inproj(P, 1, smem))
  RUN(9, 1, phase_compress(P, 1, smem))
  RUN(10, 2, phase_attention(P, 1, smem, counters + 32))
  RUN(11, 3, phase_outproj(P, 1, smem))
  RUN(12, 4, phase_peerq(P, 1, smem))
  RUN(13, 5, phase_peer(P, 1, smem))
  RUN(14, 6, phase_ple(P, 1, smem))
}

static size_t align_up(size_t x, size_t a) { return (x + a - 1) / a * a; }

extern "C" void kernel_launch(void* const* d_in, const int* in_sizes, int n_in, void* d_out, int out_size, void* d_ws, size_t ws_size, hipStream_t stream) {
  static int grid_blocks = 0;
  if (!grid_blocks) {
    int dev = 0, cus = 0, per_cu = 0;
    hipGetDevice(&dev);
    hipDeviceGetAttribute(&cus, hipDeviceAttributeMultiprocessorCount, dev);
    hipOccupancyMaxActiveBlocksPerMultiprocessor(&per_cu, hymba_mega, NT, 0);
    if (per_cu > 2) per_cu = 2;
    if (per_cu < 1) per_cu = 1;
    grid_blocks = cus * per_cu;
  }
  Params P;
  memset(&P, 0, sizeof(P));
  P.x = (const float*)d_in[0]; P.p = (const float*)d_in[1]; P.positions = (const int*)d_in[2];
  P.attn_norm_w = (const float*)d_in[3]; P.w_in = (const float*)d_in[4]; P.fox_f_bias = (const float*)d_in[5];
  P.fox_q_norm_w = (const float*)d_in[6]; P.fox_k_norm_w = (const float*)d_in[7];
  P.nsa_q_norm_w = (const float*)d_in[8]; P.nsa_k_norm_w = (const float*)d_in[9]; P.nsa_cmp_pos = (const float*)d_in[10]; P.nsa_cmp_w = (const float*)d_in[11];
  P.diff_q_norm_w = (const float*)d_in[12]; P.diff_k_norm_w = (const float*)d_in[13]; P.diff_lambda = (const float*)d_in[14]; P.diff_subln_w = (const float*)d_in[15];
  P.w_out = (const float*)d_in[16]; P.ffn_norm_w = (const float*)d_in[17]; P.peer_w_q = (const float*)d_in[18]; P.peer_sub_keys = (const float*)d_in[19];
  P.peer_u = (const float*)d_in[20]; P.peer_v = (const float*)d_in[21]; P.ple_norm_w = (const float*)d_in[22]; P.ple_w_gate = (const float*)d_in[23]; P.ple_w_proj = (const float*)d_in[24];
  P.out = (float*)d_out;
  char* w = (char*)d_ws; size_t off = 0;
  auto take = [&](size_t bytes) { char* p = w + off; off = align_up(off + bytes, 256); return p; };
  unsigned* counters = (unsigned*)take(256 + XCD_BAR_WORDS * 4);
  P.WinT = (u16*)take((size_t)2 * NINP * D * 2);
  P.WoutT = (u16*)take((size_t)2 * D * D * 2);
  P.WqT = (u16*)take((size_t)2 * 2048 * D * 2);
  P.WgT = (u16*)take((size_t)2 * D * D * 2);
  P.WpT = (u16*)take((size_t)2 * D * 256 * 2);
  P.SubK = (u16*)take((size_t)2 * 16 * 128 * 128 * 2);
  P.CmpWT = (u16*)take((size_t)2 * 2 * 128 * 2048 * 2);
  P.cmpbias = (float*)take(2 * 2 * 64 * 4);
  P.U8 = (unsigned char*)take((size_t)2 * S * D / 2);
  P.V8 = (unsigned char*)take((size_t)2 * S * D / 2);
  P.Uinv = (float*)take((size_t)2 * S * 4); P.Vinv = (float*)take((size_t)2 * S * 4);
  P.hb = (u16*)take((size_t)S * D * 2);
  P.hb2 = (u16*)take((size_t)S * D * 2);
  P.pb = (u16*)take((size_t)2 * S * 256 * 2);
  P.ropeN = (float*)take((size_t)S * 64 * 4);
  P.ropeD = (float*)take((size_t)S * 32 * 4);
  P.QF = (u16*)take((size_t)4 * S * 64 * 2); P.KF = (u16*)take((size_t)4 * S * 64 * 2); P.VFt = (u16*)take((size_t)4 * S * 64 * 2);
  P.cloc = (float*)take((size_t)4 * S * 4); P.ctot = (float*)take(256 * 4 * 4);
  P.QN = (u16*)take((size_t)8 * S * 64 * 2); P.QR = (u16*)take((size_t)8 * S * 64 * 2);
  P.KC = (u16*)take((size_t)2 * (S + 64) * 64 * 2); P.VC = (u16*)take((size_t)2 * (S + 64) * 64 * 2);
  P.KCC = (u16*)take((size_t)2 * 1024 * 64 * 2); P.VCCt = (u16*)take((size_t)2 * 64 * 1024 * 2);
  P.KS8 = (unsigned char*)take((size_t)2 * S * 64); P.VS8t = (unsigned char*)take((size_t)2 * S * 64);
  P.KW = (u16*)take((size_t)2 * S * 64 * 2); P.VWt = (u16*)take((size_t)2 * S * 64 * 2);
  P.gates = (float*)take((size_t)S * 24 * 4);
  P.QD = (u16*)take((size_t)4 * S * 64 * 2); P.KD = (u16*)take((size_t)4 * S * 64 * 2); P.VDt = (u16*)take((size_t)4 * S * 64 * 2);
  P.mix = (u16*)take((size_t)S * D * 2);
  P.dstash = (float*)take((size_t)grid_blocks * 128 * 64 * 4);
  P.impA = (float*)take((size_t)256 * 256 * 128 * 4); P.impB = (float*)take((size_t)256 * 256 * 128 * 4);
  P.topk = (u32*)take((size_t)S * 256 * 4);
  if (off > ws_size) { fprintf(stderr, "kernel_launch: workspace too small: need %zu, have %zu\n", off, ws_size); return; }
  hipMemsetAsync(counters, 0, 256 + XCD_BAR_WORDS * 4, stream);
#ifndef SINGLE_LAUNCH
#define SINGLE_LAUNCH 1
#endif
#ifndef REP_PH
#define REP_PH -1
#endif
#ifndef REP_N
#define REP_N 1
#endif
#ifndef REP_SEC
#define REP_SEC 7
#endif
#ifndef REP_NSA_ONLY
#define REP_NSA_ONLY 0
#endif
  P.rep_ph = REP_PH; P.rep_n = REP_N; P.rep_sec = REP_SEC; P.rep_nsa_only = REP_NSA_ONLY;
  if (SINGLE_LAUNCH) {
    P.phase_lo = 0; P.phase_hi = N_PHASES;
    void* args[] = {&P, &counters};
    hipError_t e = hipLaunchCooperativeKernel((void*)hymba_mega, dim3(grid_blocks), dim3(NT), args, 0, stream);
    if (e != hipSuccess) fprintf(stderr, "cooperative launch failed: %s (grid %d)\n", hipGetErrorString(e), grid_blocks);
  } else {
    for (int ph = 0; ph < N_PHASES; ++ph) {
      P.phase_lo = ph; P.phase_hi = ph + 1;
      void* args[] = {&P, &counters};
      hipError_t e = hipLaunchCooperativeKernel((void*)hymba_mega, dim3(grid_blocks), dim3(NT), args, 0, stream);
      if (e != hipSuccess) { fprintf(stderr, "cooperative launch failed: %s (grid %d, phase %d)\n", hipGetErrorString(e), grid_blocks, ph); break; }
    }
  }
}
```
